# Optimizing an MI355X kernel written in HIP

```python
import math
import jax, jax.numpy as jnp
from jax import lax
import numpy as np

D_MODEL = 1024
BATCH = 2
SEQ = 8192
DEPTH = 1

HEAD_DIM = 64
Q_BLOCK = 128
NSA_Q_HEADS = 8
NSA_KV_GROUPS = 2
NSA_HPG = NSA_Q_HEADS // NSA_KV_GROUPS
CMP_BLOCK = 32
CMP_STRIDE = 16
CMP_HIDDEN = 4 * HEAD_DIM
SLC_BLOCK = 64
N_SELECT = 16
N_LOCAL_FORCED = 2
WIN = 512
DIL_PATTERNS = ((128, 1), (512, 4), (2048, 16))
DIL_HPG = 4
DIL_HEADS = DIL_HPG * len(DIL_PATTERNS)
REL_BUCKETS = 32
REL_MAX_DIST = 2048
N_HEADS_TOTAL = NSA_Q_HEADS + DIL_HEADS
D_FF = 2816
EPS = 1e-6
NEG = -1e30
BIG = 1e30
NSA_Q_W = NSA_Q_HEADS * HEAD_DIM
NSA_KV_W = NSA_KV_GROUPS * HEAD_DIM
DIL_W = DIL_HEADS * HEAD_DIM
PROJ_WIDTHS = (NSA_Q_W, NSA_KV_W, NSA_KV_W, NSA_KV_W, NSA_KV_W, NSA_KV_W, NSA_KV_W,
               3 * NSA_Q_HEADS, DIL_W, DIL_W, DIL_W, D_MODEL, D_MODEL)
PROJ_WIDTH = sum(PROJ_WIDTHS)
BRANCH_A_W = NSA_Q_W
BRANCH_B_W = DIL_HPG * HEAD_DIM

kernel_name = "hybrid_nsa_dilated_macaron_block"


def rms_norm(x, g):
    xf = x.astype(jnp.float32)
    y = xf * lax.rsqrt(jnp.mean(xf * xf, axis=-1, keepdims=True) + EPS)
    return (y * g.astype(jnp.float32)).astype(x.dtype)


def swiglu(x, w_gu, w_down):
    g, u = jnp.split(x @ w_gu, 2, axis=-1)
    return (jax.nn.silu(g) * u) @ w_down


def t5_bucket(dist):
    max_exact = REL_BUCKETS // 2
    d = jnp.maximum(dist, 0)
    df = jnp.maximum(d, max_exact).astype(jnp.float32)
    large = max_exact + (jnp.log(df / max_exact) / math.log(REL_MAX_DIST / max_exact)
                         * (REL_BUCKETS - max_exact)).astype(jnp.int32)
    large = jnp.minimum(large, REL_BUCKETS - 1)
    return jnp.where(d < max_exact, d, large)


def masked_softmax(s, mask):
    s = jnp.where(mask, s, NEG)
    m = jnp.max(s, axis=-1, keepdims=True)
    p = jnp.where(mask, jnp.exp(s - m), 0.0)
    den = jnp.sum(p, axis=-1, keepdims=True)
    probs = p / jnp.maximum(den, 1e-30)
    lse = m[..., 0] + jnp.log(jnp.maximum(den[..., 0], 1e-30))
    return probs, lse


def nsa_attention(q, k_cmp, v_cmp, k_slc, v_slc, k_win, v_win, gates,
                  pos_k, w1_k, w2_k, pos_v, w1_v, w2_v, rel_tab):
    B_, S_, H, dh = q.shape
    G, hpg = NSA_KV_GROUPS, NSA_HPG
    scale = dh ** -0.5
    dtype = q.dtype
    n_cmp = (S_ - CMP_BLOCK) // CMP_STRIDE + 1
    blk_idx = np.arange(n_cmp)[:, None] * CMP_STRIDE + np.arange(CMP_BLOCK)[None, :]
    cmp_end = jnp.asarray(blk_idx[:, -1], jnp.int32)

    def compress(a, pos, w1, w2):
        blocks = a[:, blk_idx] + pos[None, None, :, None, :]
        blocks = blocks.transpose(0, 1, 3, 2, 4).reshape(B_, n_cmp, G, CMP_BLOCK * dh)
        return (jax.nn.silu(blocks @ w1) @ w2).transpose(0, 2, 1, 3)

    kc = compress(k_cmp, pos_k, w1_k, w2_k)
    vc = compress(v_cmp, pos_v, w1_v, w2_v)
    n_slc = S_ // SLC_BLOCK
    n_sel = min(N_SELECT, n_slc)
    slc_start = np.arange(n_slc) * SLC_BLOCK
    overlap = (blk_idx[:, :1] < slc_start[None] + SLC_BLOCK) & (blk_idx[:, -1:] >= slc_start[None])
    cmp_to_slc = jnp.asarray(overlap, jnp.float32)
    slc_ids = jnp.arange(n_slc, dtype=jnp.int32)
    qg = q.reshape(B_, S_, G, hpg, dh).transpose(0, 2, 3, 1, 4)
    gg = gates.reshape(B_, S_, G, hpg, 3).transpose(0, 2, 3, 1, 4)
    ks = k_slc.transpose(0, 2, 1, 3)
    vs = v_slc.transpose(0, 2, 1, 3)
    kw = jnp.pad(k_win.transpose(0, 2, 1, 3), ((0, 0), (0, 0), (WIN, 0), (0, 0)))
    vw = jnp.pad(v_win.transpose(0, 2, 1, 3), ((0, 0), (0, 0), (WIN, 0), (0, 0)))
    tab = rel_tab.reshape(REL_BUCKETS, G, hpg)
    tab_g = tab.transpose(1, 0, 2)
    g_ids = jnp.arange(G)[None, :, None, None]
    gather_rows = jax.vmap(jax.vmap(lambda a, i: a[i]))
    n_wk = WIN + Q_BLOCK
    dist_w = np.arange(Q_BLOCK)[:, None] + WIN - np.arange(n_wk)[None, :]
    band_w = jnp.asarray((dist_w >= 0) & (dist_w < WIN))
    bias_w = tab[t5_bucket(jnp.asarray(dist_w, jnp.int32))].transpose(2, 3, 0, 1)

    def chunk(c):
        t0 = c * Q_BLOCK
        t = t0 + jnp.arange(Q_BLOCK, dtype=jnp.int32)
        qc = lax.dynamic_slice_in_dim(qg, t0, Q_BLOCK, axis=3)
        gc = lax.dynamic_slice_in_dim(gg, t0, Q_BLOCK, axis=3)
        dist_c = t[:, None] - cmp_end[None, :]
        s_c = jnp.einsum('bghqd,bgkd->bghqk', qc, kc, preferred_element_type=jnp.float32) * scale
        s_c = s_c + tab[t5_bucket(dist_c)].transpose(2, 3, 0, 1)
        p_c, _ = masked_softmax(s_c, dist_c >= 0)
        o_c = jnp.einsum('bghqk,bgkd->bghqd', p_c.astype(dtype), vc)
        imp = jnp.einsum('bghqk,ks->bgqs', p_c, cmp_to_slc)
        rel = (t // SLC_BLOCK)[:, None] - slc_ids[None, :]
        forced = (slc_ids[None, :] == 0) | ((rel >= 0) & (rel < N_LOCAL_FORCED))
        score = jnp.where(forced, BIG, jnp.where(rel < 0, NEG, imp))
        _, sel = lax.top_k(score, n_sel)
        pos = (sel[..., None] * SLC_BLOCK + jnp.arange(SLC_BLOCK, dtype=jnp.int32))
        pos = pos.reshape(B_, G, Q_BLOCK, n_sel * SLC_BLOCK)
        pos_flat = pos.reshape(B_, G, Q_BLOCK * n_sel * SLC_BLOCK)
        k_sel = gather_rows(ks, pos_flat).reshape(B_, G, Q_BLOCK, n_sel * SLC_BLOCK, dh)
        v_sel = gather_rows(vs, pos_flat).reshape(B_, G, Q_BLOCK, n_sel * SLC_BLOCK, dh)
        dist_s = t[:, None] - pos
        bias_s = jnp.moveaxis(tab_g[g_ids, t5_bucket(dist_s)], -1, 2)
        s_s = jnp.einsum('bghqd,bgqkd->bghqk', qc, k_sel, preferred_element_type=jnp.float32) * scale + bias_s
        p_s, _ = masked_softmax(s_s, (dist_s >= 0)[:, :, None])
        o_s = jnp.einsum('bghqk,bgqkd->bghqd', p_s.astype(dtype), v_sel)
        kwc = lax.dynamic_slice_in_dim(kw, t0, n_wk, axis=2)
        vwc = lax.dynamic_slice_in_dim(vw, t0, n_wk, axis=2)
        kpos = t0 - WIN + jnp.arange(n_wk, dtype=jnp.int32)
        s_w = jnp.einsum('bghqd,bgkd->bghqk', qc, kwc, preferred_element_type=jnp.float32) * scale + bias_w
        p_w, _ = masked_softmax(s_w, band_w & (kpos >= 0)[None, :])
        o_w = jnp.einsum('bghqk,bgkd->bghqd', p_w.astype(dtype), vwc)
        return gc[..., 0:1] * o_c + gc[..., 1:2] * o_s + gc[..., 2:3] * o_w

    out = lax.map(chunk, jnp.arange(S_ // Q_BLOCK, dtype=jnp.int32))
    return out.transpose(1, 0, 4, 2, 3, 5).reshape(B_, S_, H * dh)


def strided_band_attention(q, k, v, rel_tab, steps, dilation):
    B_, S_, h, dh = q.shape
    L = S_ // dilation
    n_blk = -(-L // Q_BLOCK)
    Lp = n_blk * Q_BLOCK
    N = B_ * dilation

    def blocks(a):
        a = a.reshape(B_, L, dilation, h, dh).transpose(0, 2, 1, 3, 4).reshape(N, L, h, dh)
        a = jnp.pad(a, ((0, 0), (0, Lp - L), (0, 0), (0, 0)))
        return a.reshape(N, n_blk, Q_BLOCK, h, dh)

    def with_prev(a):
        prev = jnp.pad(a[:, :-1], ((0, 0), (1, 0), (0, 0), (0, 0), (0, 0)))
        return jnp.concatenate([prev, a], axis=2)

    qb = blocks(q)
    kk = with_prev(blocks(k))
    vv = with_prev(blocks(v))
    qi = np.arange(Q_BLOCK)[:, None]
    kj = np.arange(2 * Q_BLOCK)[None, :]
    dist = qi + Q_BLOCK - kj
    mask = ((dist >= 0) & (dist <= steps))[None] & \
        ((np.arange(n_blk)[:, None, None] > 0) | (kj[None] >= Q_BLOCK))
    bias = rel_tab[t5_bucket(jnp.asarray(dist * dilation, jnp.int32))].transpose(2, 0, 1)
    s = jnp.einsum('nbqhd,nbkhd->nbhqk', qb, kk, preferred_element_type=jnp.float32) * dh ** -0.5 + bias
    p, lse = masked_softmax(s, jnp.asarray(mask)[None, :, None])
    o = jnp.einsum('nbhqk,nbkhd->nbqhd', p.astype(v.dtype), vv).reshape(N, Lp, h, dh)[:, :L]
    lse = lse.transpose(0, 1, 3, 2).reshape(N, Lp, h)[:, :L]

    def unstride(a):
        return a.reshape((B_, dilation, L) + a.shape[2:]).swapaxes(1, 2).reshape((B_, S_) + a.shape[2:])

    return unstride(o), unstride(lse)


def dilated_attention(q, k, v, rel_tab):
    B_, S_, _, dh = q.shape
    outs, lses = [], []
    for g, (window, dilation) in enumerate(DIL_PATTERNS):
        hs = slice(g * DIL_HPG, (g + 1) * DIL_HPG)
        o, lse = strided_band_attention(q[:, :, hs], k[:, :, hs], v[:, :, hs], rel_tab[:, hs],
                                        window // dilation, dilation)
        outs.append(o)
        lses.append(lse)
    w = jax.nn.softmax(jnp.stack(lses), axis=0)
    o = jnp.sum(w[..., None] * jnp.stack(outs).astype(jnp.float32), axis=0).astype(q.dtype)
    return o.reshape(B_, S_, DIL_HPG * dh)


def setup_inputs(seed: int = 0) -> dict:
    key = jax.random.key(seed)
    ks = jax.random.split(key, 24)

    def w(k, shape, fan_in):
        return jax.random.normal(k, shape, jnp.float32) * fan_in ** -0.5

    def gain(k):
        return 1.0 + 0.05 * jax.random.normal(k, (DEPTH, D_MODEL), jnp.float32)

    L = DEPTH
    return {
        "x": jax.random.normal(ks[0], (BATCH, SEQ, D_MODEL), jnp.float32),
        "ffn1_norm_pre": gain(ks[1]),
        "ffn1_w_gu": w(ks[2], (L, D_MODEL, 2 * D_FF), D_MODEL),
        "ffn1_w_down": w(ks[3], (L, D_FF, D_MODEL), D_FF),
        "ffn1_norm_post": gain(ks[4]),
        "mix_norm_pre": gain(ks[5]),
        "w_in": w(ks[6], (L, D_MODEL, PROJ_WIDTH), D_MODEL),
        "cmp_pos_k": 0.1 * jax.random.normal(ks[7], (L, CMP_BLOCK, HEAD_DIM), jnp.float32),
        "cmp_w1_k": w(ks[8], (L, CMP_BLOCK * HEAD_DIM, CMP_HIDDEN), CMP_BLOCK * HEAD_DIM),
        "cmp_w2_k": w(ks[9], (L, CMP_HIDDEN, HEAD_DIM), CMP_HIDDEN),
        "cmp_pos_v": 0.1 * jax.random.normal(ks[10], (L, CMP_BLOCK, HEAD_DIM), jnp.float32),
        "cmp_w1_v": w(ks[11], (L, CMP_BLOCK * HEAD_DIM, CMP_HIDDEN), CMP_BLOCK * HEAD_DIM),
        "cmp_w2_v": w(ks[12], (L, CMP_HIDDEN, HEAD_DIM), CMP_HIDDEN),
        "w_branch_nsa": w(ks[13], (L, BRANCH_A_W, D_MODEL), BRANCH_A_W),
        "w_branch_dil": w(ks[14], (L, BRANCH_B_W, D_MODEL), BRANCH_B_W),
        "w_out": w(ks[15], (L, D_MODEL, D_MODEL), D_MODEL),
        "mix_norm_post": gain(ks[16]),
        "ffn2_norm_pre": gain(ks[17]),
        "ffn2_w_gu": w(ks[18], (L, D_MODEL, 2 * D_FF), D_MODEL),
        "ffn2_w_down": w(ks[19], (L, D_FF, D_MODEL), D_FF),
        "ffn2_norm_post": gain(ks[20]),
        "rel_bias": 0.1 * jax.random.normal(ks[21], (REL_BUCKETS, N_HEADS_TOTAL), jnp.float32),
    }


def reference(x, ffn1_norm_pre, ffn1_w_gu, ffn1_w_down, ffn1_norm_post, mix_norm_pre, w_in,
              cmp_pos_k, cmp_w1_k, cmp_w2_k, cmp_pos_v, cmp_w1_v, cmp_w2_v,
              w_branch_nsa, w_branch_dil, w_out, mix_norm_post,
              ffn2_norm_pre, ffn2_w_gu, ffn2_w_down, ffn2_norm_post, rel_bias):
    B_, S_, _ = x.shape
    split_idx = [int(i) for i in np.cumsum(PROJ_WIDTHS)[:-1]]

    def heads(a, n):
        return a.reshape(B_, S_, n, HEAD_DIM)

    for l in range(DEPTH):
        x = x + 0.5 * rms_norm(swiglu(rms_norm(x, ffn1_norm_pre[l]), ffn1_w_gu[l], ffn1_w_down[l]),
                               ffn1_norm_post[l])
        h = rms_norm(x, mix_norm_pre[l])
        (q_n, kc, vc, ksl, vsl, kwn, vwn, g_n, q_d, k_d, v_d, g_a, g_b) = jnp.split(h @ w_in[l], split_idx, axis=-1)
        y_nsa = nsa_attention(heads(q_n, NSA_Q_HEADS), heads(kc, NSA_KV_GROUPS), heads(vc, NSA_KV_GROUPS),
                              heads(ksl, NSA_KV_GROUPS), heads(vsl, NSA_KV_GROUPS),
                              heads(kwn, NSA_KV_GROUPS), heads(vwn, NSA_KV_GROUPS),
                              jax.nn.sigmoid(g_n).reshape(B_, S_, NSA_Q_HEADS, 3),
                              cmp_pos_k[l], cmp_w1_k[l], cmp_w2_k[l], cmp_pos_v[l], cmp_w1_v[l], cmp_w2_v[l],
                              rel_bias[:, :NSA_Q_HEADS])
        y_dil = dilated_attention(heads(q_d, DIL_HEADS), heads(k_d, DIL_HEADS), heads(v_d, DIL_HEADS),
                                  rel_bias[:, NSA_Q_HEADS:])
        merged = jax.nn.sigmoid(g_a) * (y_nsa @ w_branch_nsa[l]) + jax.nn.sigmoid(g_b) * (y_dil @ w_branch_dil[l])
        x = x + rms_norm(merged @ w_out[l], mix_norm_post[l])
        x = x + 0.5 * rms_norm(swiglu(rms_norm(x, ffn2_norm_pre[l]), ffn2_w_gu[l], ffn2_w_down[l]),
                               ffn2_norm_post[l])
    return x
```

```cpp
#include <hip/hip_runtime.h>
#include <cstdio>
#include <cstdint>
namespace pg8 {
#define PG8_LAS __attribute__((address_space(3)))
typedef unsigned short bf16_t;
typedef short bf16x8 __attribute__((ext_vector_type(8)));
typedef float f32x4 __attribute__((ext_vector_type(4)));
typedef unsigned u32x4 __attribute__((ext_vector_type(4)));
constexpr int BM = 256, BK = 64, HALF = 128, HTB = HALF * BK * 2  , STAGE_BYTES = 8 * HTB, NXCD = 8, WGM = 8;

__host__ __device__ __forceinline__ int lds_byte(int r, int c) { const int st = (r >> 4) * 2 + (c >> 5), rr = r & 15, cc = c & 31, ob = rr * 64 + cc * 2; return st * 1024 + (ob ^ (((ob >> 9) & 1) << 5)); }
__host__ __device__ __forceinline__ void stage_rc(int b, int& R, int& C) { const int st = b / 1024, sb = b % 1024, swz = sb ^ (((sb >> 9) & 1) << 5); R = (st >> 1) * 16 + swz / 64; C = (st & 1) * 32 + (swz % 64) / 2; }
__host__ __device__ __forceinline__ int perm32(int rho) { const int n = rho >> 4, i = rho & 15; return 8 * (i >> 2) + 4 * n + (i & 3); }

struct Unit { int pm, pn; };
struct Gemm { const bf16_t* A; const bf16_t* Bt; int M, N, K; };

struct StaticOrder {
    int nM, nN, nwg, G, c;
    __host__ __device__ void init(int M, int N, int G_, int c_) { nM = M / BM; nN = N / BM; nwg = nM * nN; G = G_; c = c_; }
    __host__ __device__ bool next(int i, Unit& u) const {
        const long L = (long)i * G + c; if (L >= nwg) return false;
        int wgid = (int)L; { const int q = nwg / NXCD, r = nwg % NXCD, xcd = wgid % NXCD, off = wgid / NXCD; wgid = (xcd < r ? xcd * (q + 1) : r * (q + 1) + (xcd - r) * q) + off; }
        const int nig = WGM * nN, gid = wgid / nig, fm = gid * WGM, gsz = (nM - fm) < WGM ? (nM - fm) : WGM;
        u.pm = fm + ((wgid % nig) % gsz); u.pn = (wgid % nig) / gsz; return true;
    }
    __device__ __forceinline__ void a_ready(const Unit&) const {}
    __device__ __forceinline__ void done(const Unit&) const {}
};

__device__ __forceinline__ unsigned cvt_pk_bf16(float lo, float hi) { unsigned r; asm volatile("v_cvt_pk_bf16_f32 %0, %1, %2" : "=v"(r) : "v"(lo), "v"(hi)); return r; }
typedef float f32x2 __attribute__((ext_vector_type(2)));
__device__ __forceinline__ float sigmoid_f(float v) { return __builtin_amdgcn_rcpf(1.0f + __builtin_amdgcn_exp2f(-1.4426950408889634f * v)); }
__device__ __forceinline__ float bf_lo(unsigned w) { return __uint_as_float(w << 16); }
__device__ __forceinline__ float bf_hi(unsigned w) { return __uint_as_float(w & 0xffff0000u); }

struct EpiSwiGLU {
    static constexpr bool PERM = true, AFTER_DRAIN = false;
    bf16_t* H; int ldh;
    __device__ __forceinline__ void operator()(const f32x4 (&acc)[2][2][4][2], const Unit& u, int wr, int wc, int fr, int fq) const {
        const int row0 = u.pm * BM + wr * 64 + fr, col0 = u.pn * HALF + wc * 32 + 8 * fq;
#pragma unroll
        for (int ai = 0; ai < 2; ++ai)
#pragma unroll
            for (int m = 0; m < 4; ++m) { bf16_t* rowp = H + (size_t)(row0 + ai * HALF + m * 16) * ldh + col0;
                const f32x4 g0 = acc[ai][0][m][0], g1 = acc[ai][0][m][1], u0 = acc[ai][1][m][0], u1 = acc[ai][1][m][1];
                float h[8];
#pragma unroll
                for (int i = 0; i < 4; ++i) { h[i] = g0[i] * sigmoid_f(g0[i]) * u0[i]; h[4 + i] = g1[i] * sigmoid_f(g1[i]) * u1[i]; }
                u32x4 w; w.x = cvt_pk_bf16(h[0], h[1]); w.y = cvt_pk_bf16(h[2], h[3]); w.z = cvt_pk_bf16(h[4], h[5]); w.w = cvt_pk_bf16(h[6], h[7]);
                *(u32x4*)rowp = w; }
    }
};
struct EpiF32 {
    static constexpr bool PERM = true, AFTER_DRAIN = false;
    float* Y; int ldc;
    __device__ __forceinline__ void operator()(const f32x4 (&acc)[2][2][4][2], const Unit& u, int wr, int wc, int fr, int fq) const {
        const int row0 = u.pm * BM + wr * 64 + fr, col0 = u.pn * BM + wc * 32 + 8 * fq;
#pragma unroll
        for (int ai = 0; ai < 2; ++ai)
#pragma unroll
            for (int m = 0; m < 4; ++m) { float* rowp = Y + (size_t)(row0 + ai * HALF + m * 16) * ldc + col0;
#pragma unroll
                for (int bj = 0; bj < 2; ++bj) { *(f32x4*)(rowp + bj * HALF) = acc[ai][bj][m][0]; *(f32x4*)(rowp + bj * HALF + 4) = acc[ai][bj][m][1]; } }
    }
};
struct EpiBranchA {
    static constexpr bool PERM = true, AFTER_DRAIN = false;
    const bf16_t* G; float* Y;
    __device__ __forceinline__ void operator()(const f32x4 (&acc)[2][2][4][2], const Unit& u, int wr, int wc, int fr, int fq) const {
        const int row0 = u.pm * BM + wr * 64 + fr, col0 = u.pn * BM + wc * 32 + 8 * fq;
#pragma unroll
        for (int ai = 0; ai < 2; ++ai)
#pragma unroll
            for (int m = 0; m < 4; ++m) { const size_t off = (size_t)(row0 + ai * HALF + m * 16) * 1024 + col0;
#pragma unroll
                for (int bj = 0; bj < 2; ++bj) { const u32x4 g = *(const u32x4*)(G + off + bj * HALF); const f32x4 a0 = acc[ai][bj][m][0], a1 = acc[ai][bj][m][1];
                    f32x4 o0, o1; o0[0] = a0[0] * bf_lo(g.x); o0[1] = a0[1] * bf_hi(g.x); o0[2] = a0[2] * bf_lo(g.y); o0[3] = a0[3] * bf_hi(g.y);
                    o1[0] = a1[0] * bf_lo(g.z); o1[1] = a1[1] * bf_hi(g.z); o1[2] = a1[2] * bf_lo(g.w); o1[3] = a1[3] * bf_hi(g.w);
                    *(f32x4*)(Y + off + bj * HALF) = o0; *(f32x4*)(Y + off + bj * HALF + 4) = o1; } }
    }
};
struct EpiBranchB {
    static constexpr bool PERM = true, AFTER_DRAIN = false;
    const bf16_t* G; const float* Y; bf16_t* O;
    __device__ __forceinline__ void operator()(const f32x4 (&acc)[2][2][4][2], const Unit& u, int wr, int wc, int fr, int fq) const {
        const int row0 = u.pm * BM + wr * 64 + fr, col0 = u.pn * BM + wc * 32 + 8 * fq;
#pragma unroll
        for (int ai = 0; ai < 2; ++ai)
#pragma unroll
            for (int m = 0; m < 4; ++m) { const size_t off = (size_t)(row0 + ai * HALF + m * 16) * 1024 + col0;
#pragma unroll
                for (int bj = 0; bj < 2; ++bj) { const u32x4 g = *(const u32x4*)(G + off + bj * HALF); const f32x4 a0 = acc[ai][bj][m][0], a1 = acc[ai][bj][m][1];
                    const f32x4 y0 = *(const f32x4*)(Y + off + bj * HALF), y1 = *(const f32x4*)(Y + off + bj * HALF + 4);
                    u32x4 w; w.x = cvt_pk_bf16(y0[0] + a0[0] * bf_lo(g.x), y0[1] + a0[1] * bf_hi(g.x)); w.y = cvt_pk_bf16(y0[2] + a0[2] * bf_lo(g.y), y0[3] + a0[3] * bf_hi(g.y));
                    w.z = cvt_pk_bf16(y1[0] + a1[0] * bf_lo(g.z), y1[1] + a1[1] * bf_hi(g.z)); w.w = cvt_pk_bf16(y1[2] + a1[2] * bf_lo(g.w), y1[3] + a1[3] * bf_hi(g.w));
                    *(u32x4*)(O + off + bj * HALF) = w; } }
    }
};
struct EpiProj {
    static constexpr bool PERM = true, AFTER_DRAIN = false;
    bf16_t *QN, *PL, *QD, *KD, *VD, *GA, *GB; float* GN; float qscale;
    __device__ __forceinline__ void operator()(const f32x4 (&acc)[2][2][4][2], const Unit& u, int wr, int wc, int fr, int fq) const {
        const int sub = (wc & 1) * 32 + 8 * fq;
#pragma unroll
        for (int bj = 0; bj < 2; ++bj) {
            const int hidx = __builtin_amdgcn_readfirstlane(u.pn * 4 + bj * 2 + (wc >> 1));
            bf16_t* base = nullptr; long pitch = 0, bstride = 0; int mode = 0;
            if (hidx < 8) { base = QN + hidx * 64; pitch = 512; bstride = 8192L * 512; mode = 1; }
            else if (hidx < 20) { const int ti = (hidx - 8) >> 1, g = (hidx - 8) & 1; base = PL + (size_t)ti * (4u * 8192u * 64u) + (size_t)g * (8192u * 64u); pitch = 64; bstride = 2L * 8192 * 64; mode = 0; }
            else if (hidx < 32) { base = QD + (hidx - 20) * 64; pitch = 768; bstride = 8192L * 768; mode = 1; }
            else if (hidx < 44) { base = KD + (size_t)(hidx - 32) * (8192u * 64u); pitch = 64; bstride = 12L * 8192 * 64; mode = 0; }
            else if (hidx < 56) { base = VD + (size_t)(hidx - 44) * (8192u * 64u); pitch = 64; bstride = 12L * 8192 * 64; mode = 0; }
            else if (hidx < 72) { base = GA + (hidx - 56) * 64; pitch = 1024; bstride = 8192L * 1024; mode = 2; }
            else if (hidx < 88) { base = GB + (hidx - 72) * 64; pitch = 1024; bstride = 8192L * 1024; mode = 2; }
            else if (hidx == 88) mode = 3; else mode = 4;
            if (mode == 4) continue;
#pragma unroll
            for (int ai = 0; ai < 2; ++ai)
#pragma unroll
                for (int m = 0; m < 4; ++m) { const int R = u.pm * BM + ai * HALF + wr * 64 + m * 16 + fr, b = R >> 13, t = R & 8191;
                    f32x4 v0 = acc[ai][bj][m][0], v1 = acc[ai][bj][m][1];
                    if (mode == 3) { if (sub < 24) { float* p = GN + (size_t)R * 32 + sub;
#pragma unroll
                            for (int i = 0; i < 4; ++i) { v0[i] = sigmoid_f(v0[i]); v1[i] = sigmoid_f(v1[i]); }
                            *(f32x4*)p = v0; *(f32x4*)(p + 4) = v1; } }
                    else { if (mode == 1) { v0 = v0 * qscale; v1 = v1 * qscale; }
                        if (mode == 2) {
#pragma unroll
                            for (int i = 0; i < 4; ++i) { v0[i] = sigmoid_f(v0[i]); v1[i] = sigmoid_f(v1[i]); } }
                        u32x4 w; w.x = cvt_pk_bf16(v0[0], v0[1]); w.y = cvt_pk_bf16(v0[2], v0[3]); w.z = cvt_pk_bf16(v1[0], v1[1]); w.w = cvt_pk_bf16(v1[2], v1[3]);
                        *(u32x4*)(base + (size_t)b * bstride + (size_t)t * pitch + sub) = w; } }
        }
    }
};
template <class Epi, class Sched, bool ALIGN_EPI = false, bool SP2 = false>
__device__ __forceinline__ void gemm_phase(PG8_LAS unsigned char* lds, const Gemm g, const Sched& S, const Epi& E) {
    const int tid = threadIdx.x, wid = __builtin_amdgcn_readfirstlane(tid >> 6), lane = tid & 63, wr = wid >> 2, wc = wid & 3, fr = lane & 15, fq = lane >> 4;
    const int K = g.K, nt = K / BK;
    unsigned voffA[2], voffB[2];
#pragma unroll
    for (int i = 0; i < 2; ++i) { int R, C; stage_rc(tid * 16 + i * 8192, R, C); const int Rb = Epi::PERM ? ((R & ~31) + perm32(R & 31)) : R;
        voffA[i] = (unsigned)(R * K + C) * 2u; voffB[i] = (unsigned)(Rb * K + C) * 2u; }
    const size_t kstep = (size_t)(BK * 2);
    const size_t hstep = (size_t)HALF * K * 2;
    const size_t tstep = 2 * hstep;
    const unsigned ldsw = (unsigned)wid * 1024u;
    const int aoff = lds_byte(wr * 64 + fr, fq * 8), boff = lds_byte(wc * 32 + fr, fq * 8);
#define PG8_SA(b, h) (((b) * 2 + (h)) * HTB)
#define PG8_SB(b, h) ((4 + (b) * 2 + (h)) * HTB)
#define PG8_STAGE(bufoff, gbase, voff) do { _Pragma("unroll") for (int _i = 0; _i < 2; ++_i) \
        __builtin_amdgcn_global_load_lds((const unsigned*)((const char*)(gbase) + (voff)[_i]), (PG8_LAS unsigned*)(lds + (bufoff) + ldsw + _i * 8192), 16, 0, 0); } while (0)
#define PG8_LDA(dst, b, h) do { _Pragma("unroll") for (int m = 0; m < 4; ++m) _Pragma("unroll") for (int k = 0; k < 2; ++k) dst[m][k] = *(const PG8_LAS bf16x8*)(lds + PG8_SA(b, h) + aoff + m * 2048 + k * 1024); } while (0)
#define PG8_LDB(dst, b, h) do { _Pragma("unroll") for (int n = 0; n < 2; ++n) _Pragma("unroll") for (int k = 0; k < 2; ++k) dst[n][k] = *(const PG8_LAS bf16x8*)(lds + PG8_SB(b, h) + boff + n * 2048 + k * 1024); } while (0)
#define PG8_MMA(ai, bj, At, Bt) do { __builtin_amdgcn_s_setprio(1); _Pragma("unroll") for (int m = 0; m < 4; ++m) _Pragma("unroll") for (int n = 0; n < 2; ++n) _Pragma("unroll") for (int k = 0; k < 2; ++k) \
        acc[ai][bj][m][n] = __builtin_amdgcn_mfma_f32_16x16x32_bf16(Bt[n][k], At[m][k], acc[ai][bj][m][n], 0, 0, 0); __builtin_amdgcn_s_setprio(0); } while (0)
#define PG8_WAIT_V(n) asm volatile("s_waitcnt vmcnt(" #n ")" ::: "memory")
#define PG8_WAIT_L(n) asm volatile("s_waitcnt lgkmcnt(" #n ")" ::: "memory")
#define PG8_BAR __builtin_amdgcn_s_barrier()
#define PG8_SCHED __builtin_amdgcn_sched_barrier(0)
    Unit cur, nxt; int ui = 0;
    if (!S.next(0, cur)) return;
    f32x4 acc[2][2][4][2];
#pragma unroll
    for (int a = 0; a < 2; ++a)
#pragma unroll
        for (int b = 0; b < 2; ++b)
#pragma unroll
            for (int m = 0; m < 4; ++m)
#pragma unroll
                for (int n = 0; n < 2; ++n) acc[a][b][m][n] = (f32x4){0.f, 0.f, 0.f, 0.f};
    bf16x8 At[4][2], B0[2][2], B1[2][2];
    const char* cA = (const char*)g.A + (size_t)cur.pm * tstep; const char* cB = (const char*)g.Bt + (size_t)cur.pn * tstep;
    S.a_ready(cur);
    if constexpr (SP2) {
        PG8_STAGE(PG8_SB(0, 0), cB, voffB); PG8_STAGE(PG8_SB(0, 1), cB + hstep, voffB); PG8_STAGE(PG8_SA(0, 0), cA, voffA); PG8_STAGE(PG8_SA(0, 1), cA + hstep, voffA);
        if (wr == 1) PG8_BAR;
        PG8_WAIT_V(2); PG8_BAR;
        PG8_STAGE(PG8_SB(1, 0), cB + kstep, voffB); PG8_STAGE(PG8_SA(1, 0), cA + kstep, voffA); PG8_STAGE(PG8_SB(1, 1), cB + hstep + kstep, voffB);
        PG8_WAIT_V(6); PG8_BAR;
    } else {
        PG8_STAGE(PG8_SB(0, 0), cB, voffB); PG8_STAGE(PG8_SA(0, 0), cA, voffA); PG8_STAGE(PG8_SB(0, 1), cB + hstep, voffB); PG8_STAGE(PG8_SA(0, 1), cA + hstep, voffA);
        if (wr == 1) PG8_BAR;
        PG8_WAIT_V(4); PG8_BAR;
        PG8_STAGE(PG8_SB(1, 0), cB + kstep, voffB); PG8_STAGE(PG8_SA(1, 0), cA + kstep, voffA); PG8_STAGE(PG8_SB(1, 1), cB + hstep + kstep, voffB);
        PG8_WAIT_V(6); PG8_BAR;
    }
    for (;;) {
        const bool has_next = S.next(ui + 1, nxt);
        const char* nA = has_next ? (const char*)g.A + (size_t)nxt.pm * tstep : cA; const char* nB = has_next ? (const char*)g.Bt + (size_t)nxt.pn * tstep : cB;
        for (int t = 0; t < nt; t += 2) {
            const bool last = (t == nt - 2);
            const char* a1 = cA + (size_t)(t + 1) * kstep;
            const char* a2 = last ? nA : cA + (size_t)(t + 2) * kstep; const char* b2 = last ? nB : cB + (size_t)(t + 2) * kstep;
            const char* a3 = a2 + kstep; const char* b3 = b2 + kstep;
            if (last && has_next) S.a_ready(nxt);
            if constexpr (SP2) {
            PG8_LDB(B0, 0, 0); PG8_LDB(B1, 0, 1); PG8_SCHED; PG8_LDA(At, 0, 0); PG8_STAGE(PG8_SA(1, 1), a1 + hstep, voffA);
            PG8_WAIT_V(8); PG8_WAIT_L(0); PG8_BAR; PG8_MMA(0, 0, At, B0); PG8_MMA(0, 1, At, B1); PG8_BAR; PG8_SCHED;
            PG8_LDA(At, 0, 1); PG8_STAGE(PG8_SB(0, 0), b2, voffB); PG8_STAGE(PG8_SB(0, 1), b2 + hstep, voffB); PG8_STAGE(PG8_SA(0, 0), a2, voffA);
            PG8_WAIT_V(8); PG8_WAIT_L(0); PG8_BAR; PG8_MMA(1, 0, At, B0); PG8_MMA(1, 1, At, B1); PG8_BAR; PG8_SCHED;
            PG8_LDB(B0, 1, 0); PG8_LDB(B1, 1, 1); PG8_SCHED; PG8_LDA(At, 1, 0); PG8_STAGE(PG8_SA(0, 1), a2 + hstep, voffA);
            PG8_WAIT_V(8); PG8_WAIT_L(0); PG8_BAR; PG8_MMA(0, 0, At, B0); PG8_MMA(0, 1, At, B1); PG8_BAR; PG8_SCHED;
            PG8_LDA(At, 1, 1); PG8_STAGE(PG8_SB(1, 0), b3, voffB); PG8_STAGE(PG8_SB(1, 1), b3 + hstep, voffB); PG8_STAGE(PG8_SA(1, 0), a3, voffA);
            PG8_WAIT_V(8); PG8_WAIT_L(0); PG8_BAR; PG8_MMA(1, 0, At, B0); PG8_MMA(1, 1, At, B1); PG8_BAR; PG8_SCHED;
            } else {
            PG8_LDB(B0, 0, 0); PG8_SCHED; PG8_LDA(At, 0, 0); PG8_STAGE(PG8_SA(1, 1), a1 + hstep, voffA);
            PG8_WAIT_L(8); PG8_BAR; PG8_WAIT_L(0); PG8_MMA(0, 0, At, B0); PG8_BAR; PG8_SCHED;
            PG8_LDB(B1, 0, 1); PG8_STAGE(PG8_SB(0, 0), b2, voffB);
            PG8_BAR; PG8_WAIT_L(0); PG8_MMA(0, 1, At, B1); PG8_BAR;
            PG8_LDA(At, 0, 1); PG8_STAGE(PG8_SA(0, 0), a2, voffA);
            PG8_BAR; PG8_WAIT_L(0); PG8_MMA(1, 0, At, B0); PG8_BAR; PG8_SCHED;
            PG8_STAGE(PG8_SB(0, 1), b2 + hstep, voffB);
            PG8_WAIT_V(6); PG8_BAR; PG8_MMA(1, 1, At, B1); PG8_BAR;
            PG8_LDB(B0, 1, 0); PG8_SCHED; PG8_LDA(At, 1, 0); PG8_STAGE(PG8_SA(0, 1), a2 + hstep, voffA);
            PG8_WAIT_L(8); PG8_BAR; PG8_WAIT_L(0); PG8_MMA(0, 0, At, B0); PG8_BAR; PG8_SCHED;
            PG8_LDB(B1, 1, 1); PG8_STAGE(PG8_SB(1, 0), b3, voffB);
            PG8_BAR; PG8_WAIT_L(0); PG8_MMA(0, 1, At, B1); PG8_BAR;
            PG8_LDA(At, 1, 1); PG8_STAGE(PG8_SA(1, 0), a3, voffA);
            PG8_BAR; PG8_WAIT_L(0); PG8_MMA(1, 0, At, B0); PG8_BAR; PG8_SCHED;
            PG8_STAGE(PG8_SB(1, 1), b3 + hstep, voffB);
            PG8_WAIT_V(6); PG8_BAR; PG8_MMA(1, 1, At, B1); PG8_BAR;
            }
        }
        if constexpr (ALIGN_EPI) { if (wr == 0) PG8_BAR; }
        if constexpr (!Epi::AFTER_DRAIN) { E(acc, cur, wr, wc, fr, fq); S.done(cur); }
        if (!has_next) break;
#pragma unroll
        for (int a = 0; a < 2; ++a)
#pragma unroll
            for (int b = 0; b < 2; ++b)
#pragma unroll
                for (int m = 0; m < 4; ++m)
#pragma unroll
                    for (int n = 0; n < 2; ++n) acc[a][b][m][n] = (f32x4){0.f, 0.f, 0.f, 0.f};
        cur = nxt; cA = nA; cB = nB; ++ui;
        if constexpr (ALIGN_EPI) { if (wr == 1) PG8_BAR; }
    }
    PG8_WAIT_V(0);
    if constexpr (!ALIGN_EPI) { if (wr == 0) PG8_BAR; }
    PG8_BAR;
    if constexpr (Epi::AFTER_DRAIN) { E.fused(acc, cur, wr, wc, fr, fq, lds, wid, lane); S.done(cur); }
#undef PG8_SA
#undef PG8_SB
#undef PG8_STAGE
#undef PG8_LDA
#undef PG8_LDB
#undef PG8_MMA
#undef PG8_WAIT_V
#undef PG8_WAIT_L
#undef PG8_BAR
#undef PG8_SCHED
}
}
#define GAS __attribute__((address_space(1)))
#define LAS __attribute__((address_space(3)))
typedef unsigned short bf16;
typedef unsigned v4u __attribute__((ext_vector_type(4)));
typedef float f32x4 __attribute__((ext_vector_type(4)));
typedef short bf16x8 __attribute__((ext_vector_type(8)));
typedef GAS unsigned gu32;
typedef GAS unsigned long long gu64;
#define RLX_AGENT __ATOMIC_RELAXED, __HIP_MEMORY_SCOPE_AGENT
#define LDS_WAIT() asm volatile("s_waitcnt lgkmcnt(0)" ::: "memory")
#define VM_WAIT() asm volatile("s_waitcnt vmcnt(0)" ::: "memory")
__device__ __forceinline__ unsigned long long rt() { return __builtin_amdgcn_s_memrealtime(); }
__device__ __forceinline__ unsigned f2bf(float f) { unsigned u = __builtin_bit_cast(unsigned, f); return (u + 0x7fffu + ((u >> 16) & 1u)) >> 16; }
__device__ __forceinline__ unsigned pk2(float lo, float hi) { return f2bf(lo) | (f2bf(hi) << 16); }

#define XB_TMO      128
#define XB_XCNT(j)  (256  + 64 * (j))
#define XB_XSUB(j)  (1280 + 64 * (j))
#define XB_XGEN(j)  (2304 + 64 * (j))
#define XB_TOP      3328
#define XB_TOPGEN   3392
#define XCD_BAR_WORDS 3456
#define XB_SPIN_CAP (1u << 18)

__device__ __forceinline__ unsigned xb_ld(unsigned* p)              { return __hip_atomic_load(p, __ATOMIC_RELAXED, __HIP_MEMORY_SCOPE_AGENT); }
__device__ __forceinline__ unsigned xb_add(unsigned* p, unsigned v) { return __hip_atomic_fetch_add(p, v, __ATOMIC_RELAXED, __HIP_MEMORY_SCOPE_AGENT); }
__device__ __forceinline__ unsigned xb_xcc_id() { return (unsigned)__builtin_amdgcn_s_getreg((3 << 11) | 20) & 0xFu; }
#define XB_SPIN(cond, bar) do { unsigned _sp = 0; while (cond) { __builtin_amdgcn_s_sleep(1); \
    if ((++_sp & 255u) == 0u) { if (xb_ld(&(bar)[XB_TMO])) break; if (_sp > XB_SPIN_CAP) { atomicAdd(&(bar)[XB_TMO], 1u); break; } } } } while (0)

struct XcdBarrier {
    unsigned* bar; unsigned x;
    volatile LAS unsigned* st;
};

__device__ __forceinline__ XcdBarrier xcd_barrier_post(unsigned* bar, volatile LAS unsigned* st) {
    XcdBarrier b; b.bar = bar; b.x = xb_xcc_id(); b.st = st;
    if (threadIdx.x == 0) (void)xb_add(&bar[XB_XCNT(b.x)], 1u);
    return b;
}
__device__ __forceinline__ void xcd_barrier_complete(unsigned* bar, unsigned x, unsigned& nloc, unsigned& nx) {
    const unsigned G = gridDim.x * gridDim.y * gridDim.z;
    unsigned sum, cnt, mine, sp = 0u;
    for (;;) {
        sum = 0u; cnt = 0u; mine = 0u;
#pragma unroll
        for (unsigned j = 0; j < 16; ++j) { const unsigned c = xb_ld(&bar[XB_XCNT(j)]); sum += c; cnt += (c > 0u) ? 1u : 0u; mine = (j == x) ? c : mine; }
        if (sum == G) break;
        __builtin_amdgcn_s_sleep(1);
        if ((++sp & 255u) == 0u) { if (xb_ld(&bar[XB_TMO])) break; if (sp > XB_SPIN_CAP) { atomicAdd(&bar[XB_TMO], 1u); break; } }
    }
    nloc = mine > 0u ? mine : 1u; nx = cnt > 0u ? cnt : 1u;
}

__device__ __forceinline__ void xcd_barrier(const XcdBarrier& b) {
    asm volatile("s_waitcnt vmcnt(0)" ::: "memory");
    __syncthreads();
    if (threadIdx.x == 0) {
        unsigned* bar = b.bar;
        __builtin_amdgcn_s_waitcnt(0);
        unsigned nloc = b.st[0], nx = b.st[1];
        if (nloc == 0u) { xcd_barrier_complete(bar, b.x, nloc, nx); b.st[0] = nloc; b.st[1] = nx; }
        const unsigned old = xb_add(&bar[XB_XSUB(b.x)], 1u);
        const unsigned gen = old / nloc;
        if (old + 1u == (gen + 1u) * nloc) {
            __builtin_amdgcn_fence(__ATOMIC_RELEASE, "agent");
            asm volatile("s_waitcnt vmcnt(0)" ::: "memory");
            const unsigned og = xb_add(&bar[XB_TOP], 1u);
            const unsigned tg = og / nx;
            if (og + 1u == (tg + 1u) * nx) xb_add(&bar[XB_TOPGEN], 1u);
            else XB_SPIN(xb_ld(&bar[XB_TOPGEN]) == tg, bar);
            __builtin_amdgcn_fence(__ATOMIC_ACQUIRE, "agent");
            xb_add(&bar[XB_XGEN(b.x)], 1u);
            asm volatile("s_waitcnt vmcnt(0)" ::: "memory");
        } else {
            XB_SPIN(xb_ld(&bar[XB_XGEN(b.x)]) == gen, bar);
            __builtin_amdgcn_fence(__ATOMIC_ACQUIRE, "agent");
            asm volatile("s_waitcnt vmcnt(0)" ::: "memory");
        }
    }
    __syncthreads();
}

constexpr int NWAVES = 8;
constexpr int BATCH = 2, SEQ = 8192, D = 1024, FF = 2816, M = BATCH * SEQ;
constexpr int NPROJ_SRC = 5656, NPROJ = 5888;
constexpr float RMS_EPS = 1e-6f;
constexpr float LOG2E = 1.4426950408889634f;
constexpr float QSCALE = 0.125f * LOG2E;
constexpr int LUT_N = 2049, LUT_S = 2052;

constexpr size_t MiB = 1u << 20;
constexpr size_t WS_CTL = 0, CTL_ZERO_BYTES = 64 * 1024;
constexpr size_t WS_LUT = 1 * MiB;
constexpr size_t WS_CB = WS_LUT + 20 * LUT_S * 4;
constexpr size_t WS_KCMP = 1 * MiB + 256 * 1024, WS_VCMP = WS_KCMP + 256 * 1024;
constexpr size_t WS_WIN = 2 * MiB;
constexpr size_t WS_WC1K = WS_WIN + (size_t)NPROJ * D * 2;
constexpr size_t WS_WC1V = WS_WC1K + 1 * MiB;
constexpr size_t WS_WC2K = WS_WC1V + 1 * MiB;
constexpr size_t WS_WC2V = WS_WC2K + 32 * 1024;
constexpr size_t WS_WBN = WS_WC2V + 32 * 1024;
constexpr size_t WS_WBD = WS_WBN + 1 * MiB;
constexpr size_t WS_WOUT = WS_WBD + MiB / 2;
constexpr size_t WS_WGU2 = WS_WOUT + 2 * MiB;
constexpr size_t WS_WD2 = WS_WGU2 + (size_t)2 * FF * D * 2;
constexpr size_t WS_WGU1 = 36 * MiB;
constexpr size_t WS_WD1 = WS_WGU1 + (size_t)2 * FF * D * 2;
static_assert(WS_WD2 + (size_t)D * FF * 2 <= WS_WGU1, "weights A");
static_assert(WS_WD1 + (size_t)D * FF * 2 <= 53 * MiB, "weights B");
constexpr size_t WS_QN = 36 * MiB;
constexpr size_t WS_XN = 53 * MiB;
constexpr size_t WS_MG = WS_XN;
constexpr size_t WS_H = 85 * MiB;
constexpr size_t WS_Y = 173 * MiB;
constexpr size_t WS_PL = 85 * MiB;
constexpr size_t WS_QD = 109 * MiB;
constexpr size_t WS_KD = 133 * MiB, WS_VD = 157 * MiB;
constexpr size_t WS_GA = 181 * MiB, WS_GB = 213 * MiB;
constexpr size_t WS_GN = 245 * MiB;
constexpr size_t WS_YD = 247 * MiB;
constexpr size_t WS_Y2 = 109 * MiB;
constexpr size_t WS_END = 256 * MiB;
static_assert(WS_H + (size_t)M * FF * 2 <= WS_Y && WS_Y + (size_t)M * D * 4 <= WS_END, "ffn map");
static_assert(WS_YD + (size_t)M * 256 * 2 <= WS_END && WS_GN + (size_t)M * 32 * 4 <= WS_YD && WS_Y2 + (size_t)M * D * 4 <= WS_GA, "mixer map");
constexpr size_t PLSZ = (size_t)4 * 8192 * 64;
constexpr int CW_TMO = 0, CW_BAR = 1024;

constexpr int RING_OFF = 0, RING_BYTES = 131072;
constexpr int LDSCTL_OFF = RING_BYTES, MISC_OFF = LDSCTL_OFF + 320;
constexpr int LDS_BYTES = 147456;
constexpr int A_KV = 0;
constexpr int A_LUT = 32768;
constexpr int A_IMP = A_LUT + 4 * LUT_S * 4;
constexpr int IMP_S = 132;
constexpr int A_SEL = A_IMP + 64 * IMP_S * 4;
constexpr int A_UM = A_SEL + 64 * 16;
constexpr int A_WSF = A_UM + 64;
constexpr int A_END = A_WSF + 8 * 256;
static_assert(A_END <= RING_BYTES, "attention LDS");

__device__ __forceinline__ int fresh_tid() { int t = threadIdx.x; asm volatile("" : "+v"(t)); return t; }
struct Frame {
    LAS unsigned char* lds;
    volatile LAS unsigned* MISC;
    gu32* ctl;
    int vcu, G;
};

__device__ __forceinline__ float wave_sum(float v) {
#pragma unroll
    for (int o = 1; o < 64; o <<= 1) v += __shfl_xor(v, o);
    return v;
}
__device__ __forceinline__ void tr_item(const float* W, int K, int Nsrc, int sc0, int nvalid, bf16* WT, int dr0, int kb, LAS float* scr, int lane) {
    const int k0 = 64 * kb;
#pragma unroll 8
    for (int i = 0; i < 32; ++i) { const int kk = 2 * i + (lane >> 5), n = lane & 31; scr[kk * 33 + n] = (n < nvalid) ? W[(size_t)(k0 + kk) * Nsrc + sc0 + n] : 0.f; }
    LDS_WAIT(); asm volatile("" ::: "memory");
    const int c = lane & 7;
#pragma unroll
    for (int j = 0; j < 4; ++j) { const int n = (lane >> 3) + 8 * j; const LAS float* s = scr + (8 * c) * 33 + n;
        v4u o; o.x = pk2(s[0 * 33], s[1 * 33]); o.y = pk2(s[2 * 33], s[3 * 33]); o.z = pk2(s[4 * 33], s[5 * 33]); o.w = pk2(s[6 * 33], s[7 * 33]);
        *(GAS v4u*)(WT + (size_t)(dr0 + n) * K + k0 + 8 * c) = o; }
    LDS_WAIT(); asm volatile("" ::: "memory");
}
__device__ __forceinline__ void win_map(int dblk, int& sc0, int& nvalid) {
    const int hidx = dblk >> 1, half = dblk & 1; nvalid = 32;
    if (hidx < 8) sc0 = hidx * 64 + half * 32;
    else if (hidx < 20) sc0 = 512 + (hidx - 8) * 64 + half * 32;
    else if (hidx < 32) sc0 = 1304 + (hidx - 20) * 64 + half * 32;
    else if (hidx < 44) sc0 = 2072 + (hidx - 32) * 64 + half * 32;
    else if (hidx < 56) sc0 = 2840 + (hidx - 44) * 64 + half * 32;
    else if (hidx < 72) sc0 = 3608 + (hidx - 56) * 64 + half * 32;
    else if (hidx < 88) sc0 = 4632 + (hidx - 72) * 64 + half * 32;
    else if (hidx == 88 && half == 0) { sc0 = 1280; nvalid = 24; }
    else { sc0 = 0; nvalid = 0; }
}
__device__ __forceinline__ void gu_map(int dblk, int& sc0) { const int pn = dblk >> 3, q = dblk & 7; sc0 = (q < 4) ? (128 * pn + 32 * q) : (FF + 128 * pn + 32 * (q - 4)); }
__device__ __forceinline__ int t5_bucket(int d) {
    if (d < 16) return d;
    int b = 16;
    b += (d >= 22); b += (d >= 30); b += (d >= 40); b += (d >= 54); b += (d >= 73); b += (d >= 99); b += (d >= 134); b += (d >= 182);
    b += (d >= 246); b += (d >= 332); b += (d >= 450); b += (d >= 609); b += (d >= 825); b += (d >= 1117); b += (d >= 1513);
    return b;
}
struct In {
    const float *x, *f1_pre, *f1_wgu, *f1_wd, *f1_post, *mix_pre, *w_in, *cpos_k, *cw1_k, *cw2_k, *cpos_v, *cw1_v, *cw2_v, *w_bn, *w_bd, *w_out, *mix_post, *f2_pre, *f2_wgu, *f2_wd, *f2_post, *rel_bias;
};
__device__ __forceinline__ void rms_row_to_bf16(const float* xrow, const float* gain, bf16* orow, int lane) {
    const GAS f32x4* xr = (const GAS f32x4*)xrow + lane; const GAS f32x4* gr = (const GAS f32x4*)gain + lane;
    f32x4 v[4]; float s = 0.f;
#pragma unroll
    for (int j = 0; j < 4; ++j) { v[j] = xr[64 * j]; s += (v[j].x * v[j].x + v[j].y * v[j].y) + (v[j].z * v[j].z + v[j].w * v[j].w); }
    const float r = 1.f / sqrtf(wave_sum(s) * (1.f / D) + RMS_EPS);
    GAS unsigned long long* o8 = (GAS unsigned long long*)orow + lane;
#pragma unroll
    for (int j = 0; j < 4; ++j) { const f32x4 g = gr[64 * j]; o8[64 * j] = (unsigned long long)pk2(v[j].x * r * g.x, v[j].y * r * g.y) | ((unsigned long long)pk2(v[j].z * r * g.z, v[j].w * r * g.w) << 32); }
}
__device__ __forceinline__ void p0_prologue(Frame& F, const In& in, unsigned char* ws) {
    const int tid = fresh_tid(), lane = tid & 63, wave = __builtin_amdgcn_readfirstlane(tid >> 6);
    LAS float* scr = (LAS float*)(F.lds + RING_OFF + wave * 16384);
    const int gw = F.vcu * NWAVES + wave, NGW = F.G * NWAVES;
    constexpr int I_GU = 176 * 16, I_D = 32 * 44, I_IN = 184 * 16, I_C1 = 8 * 32, I_C2 = 2 * 4, I_BN = 32 * 8, I_BD = 32 * 4, I_O = 32 * 16;
    constexpr int NITEMS = 2 * I_GU + 2 * I_D + I_IN + 2 * I_C1 + 2 * I_C2 + I_BN + I_BD + I_O;
    for (int it = gw; it < NITEMS; it += NGW) {
        int r = it, sc0, nv = 32;
        if (r < I_GU) { const int dblk = r / 16, kb = r % 16; gu_map(dblk, sc0); tr_item(in.f1_wgu, D, 2 * FF, sc0, 32, (bf16*)(ws + WS_WGU1), dblk * 32, kb, scr, lane); continue; } r -= I_GU;
        if (r < I_GU) { const int dblk = r / 16, kb = r % 16; gu_map(dblk, sc0); tr_item(in.f2_wgu, D, 2 * FF, sc0, 32, (bf16*)(ws + WS_WGU2), dblk * 32, kb, scr, lane); continue; } r -= I_GU;
        if (r < I_D) { const int dblk = r / 44, kb = r % 44; tr_item(in.f1_wd, FF, D, dblk * 32, 32, (bf16*)(ws + WS_WD1), dblk * 32, kb, scr, lane); continue; } r -= I_D;
        if (r < I_D) { const int dblk = r / 44, kb = r % 44; tr_item(in.f2_wd, FF, D, dblk * 32, 32, (bf16*)(ws + WS_WD2), dblk * 32, kb, scr, lane); continue; } r -= I_D;
        if (r < I_IN) { const int dblk = r / 16, kb = r % 16; win_map(dblk, sc0, nv); tr_item(in.w_in, D, NPROJ_SRC, sc0, nv, (bf16*)(ws + WS_WIN), dblk * 32, kb, scr, lane); continue; } r -= I_IN;
        if (r < I_C1) { const int dblk = r / 32, kb = r % 32; tr_item(in.cw1_k, 2048, 256, dblk * 32, 32, (bf16*)(ws + WS_WC1K), dblk * 32, kb, scr, lane); continue; } r -= I_C1;
        if (r < I_C1) { const int dblk = r / 32, kb = r % 32; tr_item(in.cw1_v, 2048, 256, dblk * 32, 32, (bf16*)(ws + WS_WC1V), dblk * 32, kb, scr, lane); continue; } r -= I_C1;
        if (r < I_C2) { const int dblk = r / 4, kb = r % 4; tr_item(in.cw2_k, 256, 64, dblk * 32, 32, (bf16*)(ws + WS_WC2K), dblk * 32, kb, scr, lane); continue; } r -= I_C2;
        if (r < I_C2) { const int dblk = r / 4, kb = r % 4; tr_item(in.cw2_v, 256, 64, dblk * 32, 32, (bf16*)(ws + WS_WC2V), dblk * 32, kb, scr, lane); continue; } r -= I_C2;
        if (r < I_BN) { const int dblk = r / 8, kb = r % 8; tr_item(in.w_bn, 512, D, dblk * 32, 32, (bf16*)(ws + WS_WBN), dblk * 32, kb, scr, lane); continue; } r -= I_BN;
        if (r < I_BD) { const int dblk = r / 4, kb = r % 4; tr_item(in.w_bd, 256, D, dblk * 32, 32, (bf16*)(ws + WS_WBD), dblk * 32, kb, scr, lane); continue; } r -= I_BD;
        { const int dblk = r / 16, kb = r % 16; tr_item(in.w_out, D, D, dblk * 32, 32, (bf16*)(ws + WS_WOUT), dblk * 32, kb, scr, lane); }
    }
    { float* lut = (float*)(ws + WS_LUT); const int gt = F.vcu * (NWAVES * 64) + tid, NGT = F.G * NWAVES * 64;
      for (int e = gt; e < 20 * LUT_S; e += NGT) { const int hd = e / LUT_S, d = e % LUT_S; lut[e] = (d < LUT_N) ? in.rel_bias[t5_bucket(d) * 20 + hd] * LOG2E : 0.f; } }
    { float* cb = (float*)(ws + WS_CB);
      for (int o = gw; o < 512; o += NGW) { const int ts = o >> 8, n = o & 255; const float* pos = ts ? in.cpos_v : in.cpos_k; const float* w1 = ts ? in.cw1_v : in.cw1_k;
          float s = 0.f; for (int k = lane; k < 2048; k += 64) s += pos[k] * w1[(size_t)k * 256 + n];
          s = wave_sum(s); if (lane == 0) cb[o] = s; } }
    for (int m = gw; m < M; m += NGW) rms_row_to_bf16(in.x + (size_t)m * D, in.f1_pre, (bf16*)(ws + WS_XN) + (size_t)m * D, lane);
}
__device__ __forceinline__ void row_pass(Frame& F, const float* Y, const float* base, float* out, float alpha, const float* gpost, const float* gnext, bf16* XN) {
    const int tid = fresh_tid(), lane = tid & 63, wave = __builtin_amdgcn_readfirstlane(tid >> 6);
    const int gw = F.vcu * NWAVES + wave, NGW = F.G * NWAVES;
    for (int m = gw; m < M; m += NGW) {
        const GAS f32x4* yr = (const GAS f32x4*)(Y + (size_t)m * D) + lane; const GAS f32x4* br = (const GAS f32x4*)(base + (size_t)m * D) + lane;
        const GAS f32x4* gp = (const GAS f32x4*)gpost + lane;
        f32x4 v[4], bv[4]; float s = 0.f;
#pragma unroll
        for (int j = 0; j < 4; ++j) { v[j] = yr[64 * j]; bv[j] = br[64 * j]; s += (v[j].x * v[j].x + v[j].y * v[j].y) + (v[j].z * v[j].z + v[j].w * v[j].w); }
        const float r = alpha / sqrtf(wave_sum(s) * (1.f / D) + RMS_EPS);
        float s2 = 0.f;
        GAS f32x4* orow = (GAS f32x4*)(out + (size_t)m * D) + lane;
#pragma unroll
        for (int j = 0; j < 4; ++j) { const f32x4 g = gp[64 * j]; v[j] = bv[j] + v[j] * r * g; orow[64 * j] = v[j]; s2 += (v[j].x * v[j].x + v[j].y * v[j].y) + (v[j].z * v[j].z + v[j].w * v[j].w); }
        if (gnext) {
            const float r2 = 1.f / sqrtf(wave_sum(s2) * (1.f / D) + RMS_EPS);
            const GAS f32x4* gn = (const GAS f32x4*)gnext + lane;
            GAS unsigned long long* o8 = (GAS unsigned long long*)(XN + (size_t)m * D) + lane;
#pragma unroll
            for (int j = 0; j < 4; ++j) { const f32x4 g = gn[64 * j]; o8[64 * j] = (unsigned long long)pk2(v[j].x * r2 * g.x, v[j].y * r2 * g.y) | ((unsigned long long)pk2(v[j].z * r2 * g.z, v[j].w * r2 * g.w) << 32); }
        }
    }
}

namespace att {
typedef float f32x16 __attribute__((ext_vector_type(16)));
typedef short s16x4 __attribute__((ext_vector_type(4)));
typedef short v4i16_t __attribute__((ext_vector_type(4)));
constexpr float NEGV = -1.0e30f;
constexpr int KVB = 16384;
__device__ __forceinline__ int crow(int r, int hi) { return (r & 3) + 8 * (r >> 2) + 4 * hi; }
__device__ __forceinline__ unsigned cvtpk(float lo, float hi) { unsigned r; asm volatile("v_cvt_pk_bf16_f32 %0, %1, %2" : "=v"(r) : "v"(lo), "v"(hi)); return r; }
__device__ __forceinline__ float swapmax(float v) { auto rr = __builtin_amdgcn_permlane32_swap(__float_as_uint(v), __float_as_uint(v), false, false); return fmaxf(__uint_as_float(rr[0]), __uint_as_float(rr[1])); }
__device__ __forceinline__ float swapsum(float v) { auto rr = __builtin_amdgcn_permlane32_swap(__float_as_uint(v), __float_as_uint(v), false, false); return __uint_as_float(rr[0]) + __uint_as_float(rr[1]); }
__device__ __forceinline__ float quadsum(float v) {
    v += __int_as_float(__builtin_amdgcn_mov_dpp(__float_as_int(v), 0xB1, 0xF, 0xF, true));
    v += __int_as_float(__builtin_amdgcn_mov_dpp(__float_as_int(v), 0x4E, 0xF, 0xF, true));
    return v;
}
struct Stage { v4u k, v; };
__device__ __forceinline__ void tile_load(Stage& s, const bf16* Kp, const bf16* Vp, long row, int tid) {
    const int ch = tid & 7; s.k = *(const GAS v4u*)(Kp + row * 64 + ch * 8); s.v = *(const GAS v4u*)(Vp + row * 64 + ch * 8);
}
__device__ __forceinline__ void tile_store(LAS unsigned char* buf, const Stage& s, int tid) {
    const int key = tid >> 3, ch = tid & 7;
    *(LAS v4u*)(buf + ch * 1024 + key * 16) = s.k;
    *(LAS v4u*)(buf + 8192 + (ch >> 2) * 4096 + key * 64 + (ch & 3) * 16) = s.v;
}
#define ATT_BAR() asm volatile("s_waitcnt lgkmcnt(0)\n\ts_barrier" ::: "memory")
__device__ __forceinline__ void qk(f32x16& p0, f32x16& p1, const LAS unsigned char* kb, const bf16x8 (&qr)[4]) {
    p0 = f32x16{}; p1 = f32x16{};
#pragma unroll
    for (int d0 = 0; d0 < 4; ++d0) {
        const bf16x8 b0 = *(const LAS bf16x8*)(kb + d0 * 2048), b1 = *(const LAS bf16x8*)(kb + d0 * 2048 + 512);
        p0 = __builtin_amdgcn_mfma_f32_32x32x16_bf16(b0, qr[d0], p0, 0, 0, 0);
        p1 = __builtin_amdgcn_mfma_f32_32x32x16_bf16(b1, qr[d0], p1, 0, 0, 0);
    }
}
__device__ __forceinline__ s16x4 vtr(const LAS unsigned char* p) { return __builtin_bit_cast(s16x4, __builtin_amdgcn_ds_read_tr16_b64_v4i16((LAS v4i16_t*)p)); }
__device__ __forceinline__ void pv(f32x16 (&o)[2], const LAS unsigned char* vb, const f32x16& p0, const f32x16& p1) {
    v4u pw[4];
#pragma unroll
    for (int s = 0; s < 2; ++s) {
        pw[s]     = (v4u){cvtpk(p0[8 * s], p0[8 * s + 1]), cvtpk(p0[8 * s + 2], p0[8 * s + 3]), cvtpk(p0[8 * s + 4], p0[8 * s + 5]), cvtpk(p0[8 * s + 6], p0[8 * s + 7])};
        pw[2 + s] = (v4u){cvtpk(p1[8 * s], p1[8 * s + 1]), cvtpk(p1[8 * s + 2], p1[8 * s + 3]), cvtpk(p1[8 * s + 4], p1[8 * s + 5]), cvtpk(p1[8 * s + 6], p1[8 * s + 7])};
    }
#pragma unroll
    for (int dh = 0; dh < 2; ++dh)
#pragma unroll
        for (int kg = 0; kg < 4; ++kg) {
            const s16x4 lo = vtr(vb + dh * 4096 + kg * 1024), hi = vtr(vb + dh * 4096 + kg * 1024 + 512);
            const bf16x8 vf = (bf16x8){lo[0], lo[1], lo[2], lo[3], hi[0], hi[1], hi[2], hi[3]};
            o[dh] = __builtin_amdgcn_mfma_f32_32x32x16_bf16(__builtin_bit_cast(bf16x8, pw[kg]), vf, o[dh], 0, 0, 0);
        }
}
struct Soft { float mref, lsum; };
__device__ __forceinline__ void soft_update(f32x16& p0, f32x16& p1, Soft& st, f32x16 (&o)[2], LAS float* wsf, int r32, int hi) {
    float rm = fmaxf(p0[0], p1[0]);
#pragma unroll
    for (int r = 1; r < 16; ++r) rm = fmaxf(rm, fmaxf(p0[r], p1[r]));
    rm = swapmax(rm);
    if (__any(rm > st.mref + 8.0f)) {
        float f = 1.0f;
        if (rm > st.mref) { f = __builtin_amdgcn_exp2f(st.mref - rm); st.mref = rm; }
        st.lsum *= f;
        if (hi == 0) wsf[r32] = f;
        asm volatile("s_waitcnt lgkmcnt(0)" ::: "memory");
#pragma unroll
        for (int r = 0; r < 16; ++r) { const float fr = wsf[crow(r, hi)]; o[0][r] *= fr; o[1][r] *= fr; }
        asm volatile("s_waitcnt lgkmcnt(0)" ::: "memory");
    }
    float s = 0.f;
#pragma unroll
    for (int r = 0; r < 16; ++r) { p0[r] = __builtin_amdgcn_exp2f(p0[r] - st.mref); p1[r] = __builtin_amdgcn_exp2f(p1[r] - st.mref); s += p0[r] + p1[r]; }
    st.lsum += s;
}
__device__ __forceinline__ void acc_rows(f32x16 (&y)[2], const f32x16 (&o)[2], float fac, LAS float* wsf, int r32, int hi) {
    if (hi == 0) wsf[r32] = fac;
    asm volatile("s_waitcnt lgkmcnt(0)" ::: "memory");
#pragma unroll
    for (int r = 0; r < 16; ++r) { const float fr = wsf[crow(r, hi)]; y[0][r] += o[0][r] * fr; y[1][r] += o[1][r] * fr; }
    asm volatile("s_waitcnt lgkmcnt(0)" ::: "memory");
}
__device__ __forceinline__ float soft_final_inv(const Soft& st) { const float l = swapsum(st.lsum); return (st.mref > -1.0e29f) ? 1.0f / l : 0.f; }

struct MaskWin { int t; const LAS float* lut;
    __device__ __forceinline__ float operator()(float s, int k) const { const int d = t - k; const bool ok = ((unsigned)d < 512u) && (k >= 0); const float b = lut[ok ? d : 0]; return ok ? s + b : NEGV; } };
struct MaskCmp { int t; const LAS float* lut;
    __device__ __forceinline__ float operator()(float s, int i) const { const int d = t - 16 * i - 31; const bool ok = d >= 0; const int di = d < 0 ? 0 : (d > 2048 ? 2048 : d); const float b = lut[di]; return ok ? s + b : NEGV; } };
struct MaskSel { int t; const LAS float* lut; bool sel;
    __device__ __forceinline__ float operator()(float s, int k) const { const int d = t - k; const bool ok = sel && (d >= 0); const int di = d < 0 ? 0 : (d > 2048 ? 2048 : d); const float b = lut[di]; return ok ? s + b : NEGV; } };
struct MaskDil { int t; const LAS float* lut; int maxd, dm;
    __device__ __forceinline__ float operator()(float s, int k) const { const int d = t - k; const bool ok = ((unsigned)d <= (unsigned)maxd) && ((d & dm) == 0) && (k >= 0); const float b = lut[ok ? d : 0]; return ok ? s + b : NEGV; } };

template <class MF> __device__ __forceinline__ void apply_mask(f32x16& p0, f32x16& p1, const MF& mf, int kbase, int hi) {
#pragma unroll
    for (int r = 0; r < 16; ++r) { const int kk = kbase + crow(r, hi); p0[r] = mf(p0[r], kk); p1[r] = mf(p1[r], kk + 32); }
}
template <class MF> __device__ __forceinline__ void tile_full(const LAS unsigned char* buf, const bf16x8 (&qr)[4], const MF& mf, int kbase, Soft& st, f32x16 (&o)[2], LAS float* wsf, int r32, int hi, int trb) {
    f32x16 p0, p1; qk(p0, p1, buf + hi * 1024 + r32 * 16, qr);
    apply_mask(p0, p1, mf, kbase, hi);
    soft_update(p0, p1, st, o, wsf, r32, hi);
    pv(o, buf + 8192 + trb, p0, p1);
}
}

struct Mix {
    bf16 *QN, *PL, *QD, *KD, *VD, *YD, *KCMP, *VCMP; const float* GN; const float* LUT; const float* CB;
    const bf16 *WC1K, *WC1V, *WC2K, *WC2V;
};
__device__ __forceinline__ void lut_to_lds(Frame& F, int tid, const float* lutg, int nheads, int head0, int hstride) {
    LAS float* L = (LAS float*)(F.lds + A_LUT);
    for (int e = tid; e < nheads * LUT_S; e += NWAVES * 64) { const int i = e / LUT_S, d = e % LUT_S; L[e] = lutg[(size_t)(head0 + i * hstride) * LUT_S + d]; }
}
__device__ __forceinline__ bf16x8 ldq(const bf16* p) { return *(const GAS bf16x8*)p; }

__device__ __forceinline__ int next_sel(int j, int c, unsigned u0, unsigned u1, unsigned u2, unsigned u3) {
    while (j <= c) { const unsigned w = (j < 32) ? u0 : (j < 64) ? u1 : (j < 96) ? u2 : u3; if ((w >> (j & 31)) & 1u) break; ++j; }
    return j;
}
template <bool ADD> __device__ __forceinline__ void yn_rows(bf16* YN, const att::f32x16 (&o)[2], float fac, LAS float* wsf, int r32, int hi, size_t R0, int g, int lane) {
    if (hi == 0) wsf[r32] = fac;
    asm volatile("s_waitcnt lgkmcnt(0)" ::: "memory");
#pragma unroll
    for (int r = 0; r < 16; ++r) { const int q = att::crow(r, hi); const float fr = wsf[q];
        bf16* op = YN + (R0 + (q >> 2)) * 512 + (4 * g + (q & 3)) * 64 + (lane & 31);
        float a0 = o[0][r] * fr, a1 = o[1][r] * fr;
        if (ADD) { a0 += __uint_as_float((unsigned)op[0] << 16); a1 += __uint_as_float((unsigned)op[32] << 16); }
        op[0] = (bf16)f2bf(a0); op[32] = (bf16)f2bf(a1); }
    asm volatile("s_waitcnt lgkmcnt(0)" ::: "memory");
}
__device__ __forceinline__ void nsa_unit(Frame& F, const Mix& X, int b, int g, int c, int& buf) {
    using namespace att;
    const int tid = fresh_tid(), lane = tid & 63, wave = __builtin_amdgcn_readfirstlane(tid >> 6), r32 = lane & 31, hi = lane >> 5;
    LAS unsigned char* kv = F.lds + A_KV; LAS float* lutl = (LAS float*)(F.lds + A_LUT); LAS float* imp = (LAS float*)(F.lds + A_IMP);
    LAS unsigned* selm = (LAS unsigned*)(F.lds + A_SEL); LAS unsigned* um = (LAS unsigned*)(F.lds + A_UM); LAS float* wsf = (LAS float*)(F.lds + A_WSF) + wave * 64;
    const int trb = ((lane >> 4) & 1) * 32 + (lane & 3) * 8 + (4 * hi + ((lane & 15) >> 2)) * 64;
    const int t0 = 64 * c, tok = 8 * wave + (r32 >> 2), h = r32 & 3, t = t0 + tok;
    const size_t R = (size_t)b * SEQ + t;
    const int plane = b * 2 + g;
    const bf16* KS = X.PL + 2 * PLSZ + (size_t)plane * SEQ * 64; const bf16* VS = X.PL + 3 * PLSZ + (size_t)plane * SEQ * 64;
    const bf16* KW = X.PL + 4 * PLSZ + (size_t)plane * SEQ * 64; const bf16* VW = X.PL + 5 * PLSZ + (size_t)plane * SEQ * 64;
    const bf16* KC = X.KCMP + (size_t)plane * 512 * 64; const bf16* VC = X.VCMP + (size_t)plane * 512 * 64;
    __syncthreads();
    lut_to_lds(F, tid, X.LUT, 4, 4 * g, 1);
    for (int e = tid; e < 64 * IMP_S; e += NWAVES * 64) imp[e] = 0.f;
    if (tid < 4) um[tid] = 0u;
    bf16x8 qr[4];
#pragma unroll
    for (int d0 = 0; d0 < 4; ++d0) qr[d0] = ldq(X.QN + R * 512 + (4 * g + h) * 64 + 16 * d0 + 8 * hi);
    const float g0 = X.GN[R * 32 + (4 * g + h) * 3 + 0], g1 = X.GN[R * 32 + (4 * g + h) * 3 + 1], g2 = X.GN[R * 32 + (4 * g + h) * 3 + 2];
    const LAS float* lrow = lutl + h * LUT_S;
    __syncthreads();
    const int key = tid >> 3;
    Stage sg;
    {
        Soft st{NEGV, 0.f}; f32x16 o[2]; o[0] = f32x16{}; o[1] = f32x16{};
        const MaskWin mf{t, lrow};
        int it = (c >= 8) ? 0 : (8 - c);
        { const int kb = t0 - 512 + 64 * it; int row = kb + key; row = row < 0 ? 0 : row; tile_load(sg, KW, VW, row, tid); }
        for (; it < 9; ++it) {
            const int kb = t0 - 512 + 64 * it;
            LAS unsigned char* bp = kv + buf * KVB;
            tile_store(bp, sg, tid); ATT_BAR();
            if (it + 1 < 9) { int row = kb + 64 + key; row = row < 0 ? 0 : row; tile_load(sg, KW, VW, row, tid); }
            tile_full(bp, qr, mf, kb, st, o, wsf, r32, hi, trb);
            buf ^= 1;
        }
        yn_rows<false>(X.QN, o, g2 * soft_final_inv(st), wsf, r32, hi, (size_t)b * SEQ + t0 + 8 * wave, g, lane);
    }
    {
        const int imax = (4 * c + 2 > 510) ? 510 : (4 * c + 2), ntc = imax / 64 + 1;
        const MaskCmp mf{t, lrow};
        float m = NEGV, l = 0.f;
        { tile_load(sg, KC, VC, key, tid); }
        for (int it = 0; it < ntc; ++it) {
            LAS unsigned char* bp = kv + buf * KVB;
            tile_store(bp, sg, tid); ATT_BAR();
            if (it + 1 < ntc) tile_load(sg, KC, VC, 64 * (it + 1) + key, tid);
            f32x16 p0, p1; qk(p0, p1, bp + hi * 1024 + r32 * 16, qr);
            apply_mask(p0, p1, mf, 64 * it, hi);
            float rm = fmaxf(p0[0], p1[0]);
#pragma unroll
            for (int r = 1; r < 16; ++r) rm = fmaxf(rm, fmaxf(p0[r], p1[r]));
            rm = swapmax(rm);
            const float mn = fmaxf(m, rm); float s = 0.f;
#pragma unroll
            for (int r = 0; r < 16; ++r) s += __builtin_amdgcn_exp2f(p0[r] - mn) + __builtin_amdgcn_exp2f(p1[r] - mn);
            l = l * __builtin_amdgcn_exp2f(m - mn) + s; m = mn;
            buf ^= 1;
        }
        const float ltot = swapsum(l);
        const float invl = (m > -1.0e29f) ? 1.0f / ltot : 0.f;
        f32x16 o[2]; o[0] = f32x16{}; o[1] = f32x16{};
        LAS float* improw = imp + tok * IMP_S;
        { tile_load(sg, KC, VC, key, tid); }
        for (int it = 0; it < ntc; ++it) {
            LAS unsigned char* bp = kv + buf * KVB;
            tile_store(bp, sg, tid); ATT_BAR();
            if (it + 1 < ntc) tile_load(sg, KC, VC, 64 * (it + 1) + key, tid);
            f32x16 p0, p1; qk(p0, p1, bp + hi * 1024 + r32 * 16, qr);
            apply_mask(p0, p1, mf, 64 * it, hi);
#pragma unroll
            for (int r = 0; r < 16; ++r) { p0[r] = __builtin_amdgcn_exp2f(p0[r] - m) * invl; p1[r] = __builtin_amdgcn_exp2f(p1[r] - m) * invl; }
#pragma unroll
            for (int q = 0; q < 4; ++q) {
                float a = (p0[4 * q] + p0[4 * q + 1]) + (p0[4 * q + 2] + p0[4 * q + 3]), al = p0[4 * q + 3];
                float e = (p1[4 * q] + p1[4 * q + 1]) + (p1[4 * q + 2] + p1[4 * q + 3]), el = p1[4 * q + 3];
                a = quadsum(a); al = quadsum(al); e = quadsum(e); el = quadsum(el);
                if (h == 0) { const int G = 16 * it + 2 * q + hi;
                    __hip_atomic_fetch_add(improw + G, a, __ATOMIC_RELAXED, __HIP_MEMORY_SCOPE_WORKGROUP); __hip_atomic_fetch_add(improw + G + 1, al, __ATOMIC_RELAXED, __HIP_MEMORY_SCOPE_WORKGROUP);
                    __hip_atomic_fetch_add(improw + G + 8, e, __ATOMIC_RELAXED, __HIP_MEMORY_SCOPE_WORKGROUP); __hip_atomic_fetch_add(improw + G + 9, el, __ATOMIC_RELAXED, __HIP_MEMORY_SCOPE_WORKGROUP); }
            }
            pv(o, bp + 8192 + trb, p0, p1);
            buf ^= 1;
        }
        yn_rows<true>(X.QN, o, g0, wsf, r32, hi, (size_t)b * SEQ + t0 + 8 * wave, g, lane);
    }
    asm volatile("s_waitcnt lgkmcnt(0)" ::: "memory");
    unsigned msk[4] = {0u, 0u, 0u, 0u};
    if (c >= 16) {
        const int tl = lane >> 3, part = lane & 7;
        const LAS float* ir = imp + (8 * wave + tl) * IMP_S + part * 16;
        unsigned v[16];
#pragma unroll
        for (int r = 0; r < 16; ++r) { const int j = part * 16 + r; const unsigned bits = __float_as_uint(ir[r]); v[r] = (j >= 1 && j <= c - 2) ? ((bits & ~127u) | (unsigned)(127 - j)) : 0u; }
        unsigned sm[4] = {0u, 0u, 0u, 0u};
        for (int itn = 0; itn < 13; ++itn) {
            unsigned mx = v[0];
#pragma unroll
            for (int r = 1; r < 16; ++r) mx = mx > v[r] ? mx : v[r];
            { unsigned o1 = (unsigned)__shfl_xor((int)mx, 1); mx = mx > o1 ? mx : o1; o1 = (unsigned)__shfl_xor((int)mx, 2); mx = mx > o1 ? mx : o1; o1 = (unsigned)__shfl_xor((int)mx, 4); mx = mx > o1 ? mx : o1; }
            const int j = 127 - (int)(mx & 127u); const unsigned bit = 1u << (j & 31); const int w = j >> 5;
            if (mx != 0u) { sm[0] |= (w == 0) ? bit : 0u; sm[1] |= (w == 1) ? bit : 0u; sm[2] |= (w == 2) ? bit : 0u; sm[3] |= (w == 3) ? bit : 0u; }
#pragma unroll
            for (int r = 0; r < 16; ++r) v[r] = (v[r] == mx) ? 0u : v[r];
        }
        sm[0] |= 1u;
        { const int j = c - 1; const unsigned bit = 1u << (j & 31); const int w = j >> 5; sm[0] |= (w == 0) ? bit : 0u; sm[1] |= (w == 1) ? bit : 0u; sm[2] |= (w == 2) ? bit : 0u; sm[3] |= (w == 3) ? bit : 0u; }
        { const int j = c; const unsigned bit = 1u << (j & 31); const int w = j >> 5; sm[0] |= (w == 0) ? bit : 0u; sm[1] |= (w == 1) ? bit : 0u; sm[2] |= (w == 2) ? bit : 0u; sm[3] |= (w == 3) ? bit : 0u; }
        if (part == 0) {
#pragma unroll
            for (int w = 0; w < 4; ++w) { selm[(8 * wave + tl) * 4 + w] = sm[w]; __hip_atomic_fetch_or(um + w, sm[w], __ATOMIC_RELAXED, __HIP_MEMORY_SCOPE_WORKGROUP); }
        }
        __syncthreads();
#pragma unroll
        for (int w = 0; w < 4; ++w) msk[w] = selm[tok * 4 + w];
    } else {
        msk[0] = (c >= 31) ? 0xffffffffu : ((2u << c) - 1u);
        __syncthreads();
    }
    unsigned umr[4];
#pragma unroll
    for (int w = 0; w < 4; ++w) umr[w] = (c >= 16) ? (unsigned)__builtin_amdgcn_readfirstlane((int)um[w]) : ((w == 0) ? ((2u << c) - 1u) : 0u);
    {
        Soft st{NEGV, 0.f}; f32x16 o[2]; o[0] = f32x16{}; o[1] = f32x16{};
        int j = next_sel(0, c, umr[0], umr[1], umr[2], umr[3]);
        if (j <= c) tile_load(sg, KS, VS, 64 * j + key, tid);
        while (j <= c) {
            LAS unsigned char* bp = kv + buf * KVB;
            tile_store(bp, sg, tid); ATT_BAR();
            const int jn = next_sel(j + 1, c, umr[0], umr[1], umr[2], umr[3]);
            if (jn <= c) tile_load(sg, KS, VS, 64 * jn + key, tid);
            const unsigned mw = (j < 32) ? msk[0] : (j < 64) ? msk[1] : (j < 96) ? msk[2] : msk[3];
            const bool sel = (mw >> (j & 31)) & 1u;
            if (__any(sel)) { const MaskSel mf{t, lrow, sel}; tile_full(bp, qr, mf, 64 * j, st, o, wsf, r32, hi, trb); }
            buf ^= 1; j = jn;
        }
        yn_rows<true>(X.QN, o, g1 * soft_final_inv(st), wsf, r32, hi, (size_t)b * SEQ + t0 + 8 * wave, g, lane);
    }
}

__device__ __forceinline__ void dil_unit(Frame& F, const Mix& X, int b, int s, int u, int& buf) {
    using namespace att;
    const int tid = fresh_tid(), lane = tid & 63, wave = __builtin_amdgcn_readfirstlane(tid >> 6), r32 = lane & 31, hi = lane >> 5;
    LAS unsigned char* kv = F.lds + A_KV; LAS float* lutl = (LAS float*)(F.lds + A_LUT); LAS float* wsf = (LAS float*)(F.lds + A_WSF) + wave * 64;
    const int trb = ((lane >> 4) & 1) * 32 + (lane & 3) * 8 + (4 * hi + ((lane & 15) >> 2)) * 64;
    const int T0 = 256 * u, Tw = T0 + 32 * wave, t = Tw + r32, key = tid >> 3;
    const size_t R = (size_t)b * SEQ + t;
    __syncthreads();
    lut_to_lds(F, tid, X.LUT, 3, 8 + s, 4);
    __syncthreads();
    Soft st{NEGV, 0.f}; f32x16 o[2]; o[0] = f32x16{}; o[1] = f32x16{};
    Stage sg;
#pragma unroll 1
    for (int gi = 0; gi < 3; ++gi) {
        const int dil = 1 << (2 * gi), hd = 4 * gi + s, span = 128 * dil, nt = 2 * dil + 4;
        bf16x8 qr[4];
#pragma unroll
        for (int d0 = 0; d0 < 4; ++d0) qr[d0] = ldq(X.QD + R * 768 + hd * 64 + 16 * d0 + 8 * hi);
        const bf16* Kp = X.KD + (size_t)(b * 12 + hd) * SEQ * 64; const bf16* Vp = X.VD + (size_t)(b * 12 + hd) * SEQ * 64;
        const MaskDil mf{t, lutl + gi * LUT_S, span, dil - 1};
        int it = 0; while (T0 - span + 64 * it + 63 < 0) ++it;
        { int row = T0 - span + 64 * it + key; row = row < 0 ? 0 : row; tile_load(sg, Kp, Vp, row, tid); }
        for (; it < nt; ++it) {
            const int kb = T0 - span + 64 * it;
            LAS unsigned char* bp = kv + buf * KVB;
            tile_store(bp, sg, tid); ATT_BAR();
            if (it + 1 < nt) { int row = kb + 64 + key; row = row < 0 ? 0 : row; tile_load(sg, Kp, Vp, row, tid); }
            if (!(kb + 63 < Tw - span || kb > Tw + 31)) tile_full(bp, qr, mf, kb, st, o, wsf, r32, hi, trb);
            buf ^= 1;
        }
    }
    const float inv = soft_final_inv(st);
    if (hi == 0) wsf[r32] = inv;
    asm volatile("s_waitcnt lgkmcnt(0)" ::: "memory");
#pragma unroll
    for (int r = 0; r < 16; ++r) { const int q = crow(r, hi); const float fr = wsf[q]; const size_t Rq = (size_t)b * SEQ + Tw + q;
        bf16* op = X.YD + Rq * 256 + s * 64 + (lane & 31);
        op[0] = (bf16)f2bf(o[0][r] * fr); op[32] = (bf16)f2bf(o[1][r] * fr); }
    asm volatile("s_waitcnt lgkmcnt(0)" ::: "memory");
}

__device__ __forceinline__ void cmp_unit(Frame& F, const Mix& X, int cu) {
    using namespace att;
    const int tid = fresh_tid(), lane = tid & 63, wave = __builtin_amdgcn_readfirstlane(tid >> 6), r32 = lane & 31, hi = lane >> 5;
    const int ts = cu >> 5, rb = cu & 31, plane = rb >> 3, i0 = (rb & 7) * 64;
    const bf16* src = X.PL + (size_t)ts * PLSZ + (size_t)plane * SEQ * 64;
    const bf16* W1 = ts ? X.WC1V : X.WC1K; const bf16* W2 = ts ? X.WC2V : X.WC2K; const float* cb = X.CB + ts * 256;
    bf16* dst = (ts ? X.VCMP : X.KCMP) + (size_t)plane * 512 * 64;
    LAS unsigned char* hid = F.lds + A_KV;
    __syncthreads();
    f32x16 acc[2]; acc[0] = f32x16{}; acc[1] = f32x16{};
    int ia = i0 + r32, ib = i0 + 32 + r32; ia = ia > 510 ? 510 : ia; ib = ib > 510 ? 510 : ib;
    const bf16* a0p = src + (size_t)ia * 1024 + 8 * hi; const bf16* a1p = src + (size_t)ib * 1024 + 8 * hi;
    const bf16* bp = W1 + (size_t)(32 * wave + r32) * 2048 + 8 * hi;
#pragma unroll 8
    for (int k0 = 0; k0 < 2048; k0 += 16) {
        const bf16x8 a0 = ldq(a0p + k0), a1 = ldq(a1p + k0), bb = ldq(bp + k0);
        acc[0] = __builtin_amdgcn_mfma_f32_32x32x16_bf16(a0, bb, acc[0], 0, 0, 0);
        acc[1] = __builtin_amdgcn_mfma_f32_32x32x16_bf16(a1, bb, acc[1], 0, 0, 0);
    }
    { const int col = 32 * wave + r32; const float bias = cb[col];
#pragma unroll
      for (int mt = 0; mt < 2; ++mt)
#pragma unroll
        for (int r = 0; r < 16; ++r) { const float v = acc[mt][r] + bias; const float hv = v * __builtin_amdgcn_rcpf(1.0f + __builtin_amdgcn_exp2f(-LOG2E * v));
            *(LAS unsigned short*)(hid + (32 * mt + crow(r, hi)) * 528 + col * 2) = (unsigned short)f2bf(hv); } }
    __syncthreads();
    if (wave < 4) {
        const int mt = wave & 1, nt = wave >> 1;
        f32x16 o2 = f32x16{};
        const LAS unsigned char* ap = hid + (32 * mt + r32) * 528 + 16 * hi; const bf16* b2 = W2 + (size_t)(32 * nt + r32) * 256 + 8 * hi;
#pragma unroll
        for (int k0 = 0; k0 < 256; k0 += 16) { const bf16x8 a = *(const LAS bf16x8*)(ap + k0 * 2); const bf16x8 bb = ldq(b2 + k0); o2 = __builtin_amdgcn_mfma_f32_32x32x16_bf16(a, bb, o2, 0, 0, 0); }
#pragma unroll
        for (int r = 0; r < 16; ++r) { const int i = i0 + 32 * mt + crow(r, hi); dst[(size_t)i * 64 + 32 * nt + r32] = (bf16)f2bf(o2[r]); }
    }
}

#ifndef MK_N_LAUNCHES
#define MK_N_LAUNCHES 1
#endif
constexpr int N_PHASES = 13;
constexpr int N_LAUNCHES = MK_N_LAUNCHES;
struct Args { const float* in[22]; float* out; unsigned char* ws; int ph_lo, ph_hi, li, pad; };
__global__ void __launch_bounds__(NWAVES * 64, 2) mk_fwd(Args args) {
    extern __shared__ __attribute__((aligned(16))) unsigned char lds[];
    Frame F;
    F.lds = (LAS unsigned char*)lds;
    F.MISC = (volatile LAS unsigned*)(F.lds + MISC_OFF);
    F.G = gridDim.x; { const int bx = blockIdx.x; F.vcu = (F.G % 8 == 0) ? (bx % 8) * (F.G / 8) + bx / 8 : bx; }
    unsigned char* ws = args.ws;
    F.ctl = (gu32*)(ws + WS_CTL);
    In in;
    in.x = args.in[0]; in.f1_pre = args.in[1]; in.f1_wgu = args.in[2]; in.f1_wd = args.in[3]; in.f1_post = args.in[4]; in.mix_pre = args.in[5]; in.w_in = args.in[6];
    in.cpos_k = args.in[7]; in.cw1_k = args.in[8]; in.cw2_k = args.in[9]; in.cpos_v = args.in[10]; in.cw1_v = args.in[11]; in.cw2_v = args.in[12];
    in.w_bn = args.in[13]; in.w_bd = args.in[14]; in.w_out = args.in[15]; in.mix_post = args.in[16]; in.f2_pre = args.in[17]; in.f2_wgu = args.in[18]; in.f2_wd = args.in[19]; in.f2_post = args.in[20]; in.rel_bias = args.in[21];
    float* out = args.out;
    for (int u = threadIdx.x; u < (LDS_BYTES - LDSCTL_OFF) / 4; u += NWAVES * 64) ((LAS unsigned*)(F.lds + LDSCTL_OFF))[u] = 0u;
    __syncthreads();
    const bool use_bar = (args.ph_hi - args.ph_lo) > 1;
    XcdBarrier bar; bar.bar = (unsigned*)(F.ctl + CW_BAR) + args.li * XCD_BAR_WORDS; bar.x = 0; bar.st = nullptr;
    if (use_bar) bar = xcd_barrier_post((unsigned*)(F.ctl + CW_BAR) + args.li * XCD_BAR_WORDS, F.MISC + 8);
    const int lo = args.ph_lo, hi = args.ph_hi;
#define IN(k) (lo <= (k) && (k) < hi)
#define SEAM(k) do { if (IN(k) && IN((k) + 1)) xcd_barrier(bar); } while (0)
    bf16* XN = (bf16*)(ws + WS_XN); bf16* H = (bf16*)(ws + WS_H); float* Y = (float*)(ws + WS_Y); float* Y2 = (float*)(ws + WS_Y2); bf16* MG = (bf16*)(ws + WS_MG);
    Mix X; X.QN = (bf16*)(ws + WS_QN); X.PL = (bf16*)(ws + WS_PL); X.QD = (bf16*)(ws + WS_QD); X.KD = (bf16*)(ws + WS_KD); X.VD = (bf16*)(ws + WS_VD); X.YD = (bf16*)(ws + WS_YD);
    X.KCMP = (bf16*)(ws + WS_KCMP); X.VCMP = (bf16*)(ws + WS_VCMP); X.GN = (const float*)(ws + WS_GN); X.LUT = (const float*)(ws + WS_LUT); X.CB = (const float*)(ws + WS_CB);
    X.WC1K = (const bf16*)(ws + WS_WC1K); X.WC1V = (const bf16*)(ws + WS_WC1V); X.WC2K = (const bf16*)(ws + WS_WC2K); X.WC2V = (const bf16*)(ws + WS_WC2V);
    bf16* GA = (bf16*)(ws + WS_GA); bf16* GB = (bf16*)(ws + WS_GB);

    if (IN(0)) { p0_prologue(F, in, ws); }
    SEAM(0);
    if (IN(1)) { pg8::Gemm g{XN, (const bf16*)(ws + WS_WGU1), M, 2 * FF, D}; pg8::StaticOrder S; S.init(M, 2 * FF, F.G, (int)blockIdx.x);
        pg8::EpiSwiGLU E{H, FF}; pg8::gemm_phase<pg8::EpiSwiGLU, pg8::StaticOrder, true, true>(F.lds + RING_OFF, g, S, E); }
    SEAM(1);
    if (IN(2)) { pg8::Gemm g{H, (const bf16*)(ws + WS_WD1), M, D, FF}; pg8::StaticOrder S; S.init(M, D, F.G, (int)blockIdx.x);
        pg8::EpiF32 E{Y, D}; pg8::gemm_phase<pg8::EpiF32, pg8::StaticOrder, true, true>(F.lds + RING_OFF, g, S, E); }
    SEAM(2);
    if (IN(3)) { row_pass(F, Y, in.x, out, 0.5f, in.f1_post, in.mix_pre, XN); }
    SEAM(3);
    if (IN(4)) { pg8::Gemm g{XN, (const bf16*)(ws + WS_WIN), M, NPROJ, D}; pg8::StaticOrder S; S.init(M, NPROJ, F.G, (int)blockIdx.x);
        pg8::EpiProj E{X.QN, X.PL, X.QD, X.KD, X.VD, GA, GB, (float*)(ws + WS_GN), QSCALE};
        pg8::gemm_phase<pg8::EpiProj, pg8::StaticOrder, true, true>(F.lds + RING_OFF, g, S, E); }
    SEAM(4);
    if (IN(5)) { int buf = 0;
        for (int cu = F.vcu; cu < 64; cu += F.G) cmp_unit(F, X, cu);
        for (int du = F.vcu; du < 256; du += F.G) dil_unit(F, X, du >> 7, (du >> 5) & 3, du & 31, buf);
        __syncthreads(); }
    SEAM(5);
    if (IN(6)) { int buf = 0;
        for (int p = F.vcu; p < 256; p += F.G) { const int b = p >> 7, g = (p >> 6) & 1, cc = p & 63;
#pragma unroll 1
            for (int k = 0; k < 2; ++k) nsa_unit(F, X, b, g, k ? cc : 127 - cc, buf); }
        __syncthreads(); }
    SEAM(6);
    if (IN(7)) {
        { pg8::Gemm g{X.QN, (const bf16*)(ws + WS_WBN), M, D, 512}; pg8::StaticOrder S; S.init(M, D, F.G, (int)blockIdx.x);
          pg8::EpiBranchA E{GA, Y2}; pg8::gemm_phase<pg8::EpiBranchA, pg8::StaticOrder, true, true>(F.lds + RING_OFF, g, S, E); }
        { pg8::Gemm g{X.YD, (const bf16*)(ws + WS_WBD), M, D, 256}; pg8::StaticOrder S; S.init(M, D, F.G, (int)blockIdx.x);
          pg8::EpiBranchB E{GB, Y2, MG}; pg8::gemm_phase<pg8::EpiBranchB, pg8::StaticOrder, true, true>(F.lds + RING_OFF, g, S, E); }
    }
    SEAM(7);
    if (IN(8)) { pg8::Gemm g{MG, (const bf16*)(ws + WS_WOUT), M, D, D}; pg8::StaticOrder S; S.init(M, D, F.G, (int)blockIdx.x);
        pg8::EpiF32 E{Y2, D}; pg8::gemm_phase<pg8::EpiF32, pg8::StaticOrder, true, true>(F.lds + RING_OFF, g, S, E); }
    SEAM(8);
    if (IN(9)) { row_pass(F, Y2, out, out, 1.0f, in.mix_post, in.f2_pre, XN); }
    SEAM(9);
    if (IN(10)) { pg8::Gemm g{XN, (const bf16*)(ws + WS_WGU2), M, 2 * FF, D}; pg8::StaticOrder S; S.init(M, 2 * FF, F.G, (int)blockIdx.x);
        pg8::EpiSwiGLU E{H, FF}; pg8::gemm_phase<pg8::EpiSwiGLU, pg8::StaticOrder, true, true>(F.lds + RING_OFF, g, S, E); }
    SEAM(10);
    if (IN(11)) { pg8::Gemm g{H, (const bf16*)(ws + WS_WD2), M, D, FF}; pg8::StaticOrder S; S.init(M, D, F.G, (int)blockIdx.x);
        pg8::EpiF32 E{Y, D}; pg8::gemm_phase<pg8::EpiF32, pg8::StaticOrder, true, true>(F.lds + RING_OFF, g, S, E); }
    SEAM(11);
    if (IN(12)) { row_pass(F, Y, out, out, 0.5f, in.f2_post, nullptr, nullptr); }
#undef IN
#undef SEAM
}

extern "C" void kernel_launch(void* const* d_in, const int* in_sizes, int n_in, void* d_out, int out_size, void* d_ws, size_t ws_size, hipStream_t stream) {
    static int grid = 0;
    if (grid == 0) {
        if (n_in != 22 || in_sizes[0] != M * D || out_size != M * D || ws_size < WS_END) { fprintf(stderr, "kernel_launch: unexpected shapes (n_in %d, in0 %d, out %d, ws %zu); nothing launched\n", n_in, n_in > 0 ? in_sizes[0] : -1, out_size, ws_size); grid = -1; return; }
        int dev = 0, cus = 0, per_cu = 0;
        if (hipGetDevice(&dev) != hipSuccess || hipDeviceGetAttribute(&cus, hipDeviceAttributeMultiprocessorCount, dev) != hipSuccess) { grid = -1; return; }
        if (hipFuncSetAttribute((const void*)mk_fwd, hipFuncAttributeMaxDynamicSharedMemorySize, LDS_BYTES) != hipSuccess) { fprintf(stderr, "kernel_launch: hipFuncSetAttribute failed\n"); grid = -1; return; }
        if (hipOccupancyMaxActiveBlocksPerMultiprocessor(&per_cu, (const void*)mk_fwd, NWAVES * 64, LDS_BYTES) != hipSuccess || per_cu < 1)
            fprintf(stderr, "kernel_launch: note: occupancy query reports %d workgroups per CU\n", per_cu);
        (void)hipGetLastError();
        grid = cus;
    }
    if (grid < 0) return;
    if (hipMemsetAsync((char*)d_ws + WS_CTL, 0, CTL_ZERO_BYTES, stream) != hipSuccess) return;
    Args a{};
    for (int i = 0; i < 22; ++i) a.in[i] = (const float*)d_in[i];
    a.out = (float*)d_out; a.ws = (unsigned char*)d_ws;
    if (N_LAUNCHES == 1) { a.ph_lo = 0; a.ph_hi = N_PHASES; a.li = 0; hipLaunchKernelGGL(mk_fwd, dim3(grid), dim3(NWAVES * 64), LDS_BYTES, stream, a); }
    else { for (int li = 0; li < N_PHASES; ++li) { a.ph_lo = li; a.ph_hi = li + 1; a.li = 0; hipLaunchKernelGGL(mk_fwd, dim3(grid), dim3(NWAVES * 64), LDS_BYTES, stream, a); } }
}
```

```cpp
#include <hip/hip_runtime.h>
#include <cstdio>
#include <cstdint>
namespace pg8 {
#define PG8_LAS __attribute__((address_space(3)))
typedef unsigned short bf16_t;
typedef short bf16x8 __attribute__((ext_vector_type(8)));
typedef float f32x4 __attribute__((ext_vector_type(4)));
typedef unsigned u32x4 __attribute__((ext_vector_type(4)));
constexpr int BM = 256, BK = 64, HALF = 128, HTB = HALF * BK * 2  , STAGE_BYTES = 8 * HTB, NXCD = 8, WGM = 8;

__host__ __device__ __forceinline__ int lds_byte(int r, int c) { const int st = (r >> 4) * 2 + (c >> 5), rr = r & 15, cc = c & 31, ob = rr * 64 + cc * 2; return st * 1024 + (ob ^ (((ob >> 9) & 1) << 5)); }
__host__ __device__ __forceinline__ void stage_rc(int b, int& R, int& C) { const int st = b / 1024, sb = b % 1024, swz = sb ^ (((sb >> 9) & 1) << 5); R = (st >> 1) * 16 + swz / 64; C = (st & 1) * 32 + (swz % 64) / 2; }
__host__ __device__ __forceinline__ int perm32(int rho) { const int n = rho >> 4, i = rho & 15; return 8 * (i >> 2) + 4 * n + (i & 3); }

struct Unit { int pm, pn; };
struct Gemm { const bf16_t* A; const bf16_t* Bt; int M, N, K; };

struct StaticOrder {
    int nM, nN, nwg, G, c;
    __host__ __device__ void init(int M, int N, int G_, int c_) { nM = M / BM; nN = N / BM; nwg = nM * nN; G = G_; c = c_; }
    __host__ __device__ bool next(int i, Unit& u) const {
        const long L = (long)i * G + c; if (L >= nwg) return false;
        int wgid = (int)L; { const int q = nwg / NXCD, r = nwg % NXCD, xcd = wgid % NXCD, off = wgid / NXCD; wgid = (xcd < r ? xcd * (q + 1) : r * (q + 1) + (xcd - r) * q) + off; }
        const int nig = WGM * nN, gid = wgid / nig, fm = gid * WGM, gsz = (nM - fm) < WGM ? (nM - fm) : WGM;
        u.pm = fm + ((wgid % nig) % gsz); u.pn = (wgid % nig) / gsz; return true;
    }
    __device__ __forceinline__ void a_ready(const Unit&) const {}
    __device__ __forceinline__ void done(const Unit&) const {}
};

__device__ __forceinline__ unsigned cvt_pk_bf16(float lo, float hi) { unsigned r; asm volatile("v_cvt_pk_bf16_f32 %0, %1, %2" : "=v"(r) : "v"(lo), "v"(hi)); return r; }
typedef float f32x2 __attribute__((ext_vector_type(2)));
__device__ __forceinline__ float sigmoid_f(float v) { return __builtin_amdgcn_rcpf(1.0f + __builtin_amdgcn_exp2f(-1.4426950408889634f * v)); }
__device__ __forceinline__ float bf_lo(unsigned w) { return __uint_as_float(w << 16); }
__device__ __forceinline__ float bf_hi(unsigned w) { return __uint_as_float(w & 0xffff0000u); }

struct EpiSwiGLU {
    static constexpr bool PERM = true, AFTER_DRAIN = false;
    bf16_t* H; int ldh;
    __device__ __forceinline__ void operator()(const f32x4 (&acc)[2][2][4][2], const Unit& u, int wr, int wc, int fr, int fq) const {
        const int row0 = u.pm * BM + wr * 64 + fr, col0 = u.pn * HALF + wc * 32 + 8 * fq;
#pragma unroll
        for (int ai = 0; ai < 2; ++ai)
#pragma unroll
            for (int m = 0; m < 4; ++m) { bf16_t* rowp = H + (size_t)(row0 + ai * HALF + m * 16) * ldh + col0;
                const f32x4 g0 = acc[ai][0][m][0], g1 = acc[ai][0][m][1], u0 = acc[ai][1][m][0], u1 = acc[ai][1][m][1];
                float h[8];
#pragma unroll
                for (int i = 0; i < 4; ++i) { h[i] = g0[i] * sigmoid_f(g0[i]) * u0[i]; h[4 + i] = g1[i] * sigmoid_f(g1[i]) * u1[i]; }
                u32x4 w; w.x = cvt_pk_bf16(h[0], h[1]); w.y = cvt_pk_bf16(h[2], h[3]); w.z = cvt_pk_bf16(h[4], h[5]); w.w = cvt_pk_bf16(h[6], h[7]);
                *(u32x4*)rowp = w; }
    }
};
struct EpiF32 {
    static constexpr bool PERM = true, AFTER_DRAIN = false;
    float* Y; int ldc;
    __device__ __forceinline__ void operator()(const f32x4 (&acc)[2][2][4][2], const Unit& u, int wr, int wc, int fr, int fq) const {
        const int row0 = u.pm * BM + wr * 64 + fr, col0 = u.pn * BM + wc * 32 + 8 * fq;
#pragma unroll
        for (int ai = 0; ai < 2; ++ai)
#pragma unroll
            for (int m = 0; m < 4; ++m) { float* rowp = Y + (size_t)(row0 + ai * HALF + m * 16) * ldc + col0;
#pragma unroll
                for (int bj = 0; bj < 2; ++bj) { *(f32x4*)(rowp + bj * HALF) = acc[ai][bj][m][0]; *(f32x4*)(rowp + bj * HALF + 4) = acc[ai][bj][m][1]; } }
    }
};
struct EpiBranchA {
    static constexpr bool PERM = true, AFTER_DRAIN = false;
    const bf16_t* G; float* Y;
    __device__ __forceinline__ void operator()(const f32x4 (&acc)[2][2][4][2], const Unit& u, int wr, int wc, int fr, int fq) const {
        const int row0 = u.pm * BM + wr * 64 + fr, col0 = u.pn * BM + wc * 32 + 8 * fq;
#pragma unroll
        for (int ai = 0; ai < 2; ++ai)
#pragma unroll
            for (int m = 0; m < 4; ++m) { const size_t off = (size_t)(row0 + ai * HALF + m * 16) * 1024 + col0;
#pragma unroll
                for (int bj = 0; bj < 2; ++bj) { const u32x4 g = *(const u32x4*)(G + off + bj * HALF); const f32x4 a0 = acc[ai][bj][m][0], a1 = acc[ai][bj][m][1];
                    f32x4 o0, o1; o0[0] = a0[0] * bf_lo(g.x); o0[1] = a0[1] * bf_hi(g.x); o0[2] = a0[2] * bf_lo(g.y); o0[3] = a0[3] * bf_hi(g.y);
                    o1[0] = a1[0] * bf_lo(g.z); o1[1] = a1[1] * bf_hi(g.z); o1[2] = a1[2] * bf_lo(g.w); o1[3] = a1[3] * bf_hi(g.w);
                    *(f32x4*)(Y + off + bj * HALF) = o0; *(f32x4*)(Y + off + bj * HALF + 4) = o1; } }
    }
};
struct EpiBranchB {
    static constexpr bool PERM = true, AFTER_DRAIN = false;
    const bf16_t* G; const float* Y; bf16_t* O;
    __device__ __forceinline__ void operator()(const f32x4 (&acc)[2][2][4][2], const Unit& u, int wr, int wc, int fr, int fq) const {
        const int row0 = u.pm * BM + wr * 64 + fr, col0 = u.pn * BM + wc * 32 + 8 * fq;
#pragma unroll
        for (int ai = 0; ai < 2; ++ai)
#pragma unroll
            for (int m = 0; m < 4; ++m) { const size_t off = (size_t)(row0 + ai * HALF + m * 16) * 1024 + col0;
#pragma unroll
                for (int bj = 0; bj < 2; ++bj) { const u32x4 g = *(const u32x4*)(G + off + bj * HALF); const f32x4 a0 = acc[ai][bj][m][0], a1 = acc[ai][bj][m][1];
                    const f32x4 y0 = *(const f32x4*)(Y + off + bj * HALF), y1 = *(const f32x4*)(Y + off + bj * HALF + 4);
                    u32x4 w; w.x = cvt_pk_bf16(y0[0] + a0[0] * bf_lo(g.x), y0[1] + a0[1] * bf_hi(g.x)); w.y = cvt_pk_bf16(y0[2] + a0[2] * bf_lo(g.y), y0[3] + a0[3] * bf_hi(g.y));
                    w.z = cvt_pk_bf16(y1[0] + a1[0] * bf_lo(g.z), y1[1] + a1[1] * bf_hi(g.z)); w.w = cvt_pk_bf16(y1[2] + a1[2] * bf_lo(g.w), y1[3] + a1[3] * bf_hi(g.w));
                    *(u32x4*)(O + off + bj * HALF) = w; } }
    }
};
struct EpiProj {
    static constexpr bool PERM = true, AFTER_DRAIN = false;
    bf16_t *QN, *PL, *QD, *KD, *VD, *GA, *GB; float* GN; float qscale;
    __device__ __forceinline__ void operator()(const f32x4 (&acc)[2][2][4][2], const Unit& u, int wr, int wc, int fr, int fq) const {
        const int sub = (wc & 1) * 32 + 8 * fq;
#pragma unroll
        for (int bj = 0; bj < 2; ++bj) {
            const int hidx = __builtin_amdgcn_readfirstlane(u.pn * 4 + bj * 2 + (wc >> 1));
            bf16_t* base = nullptr; long pitch = 0, bstride = 0; int mode = 0;
            if (hidx < 8) { base = QN + hidx * 64; pitch = 512; bstride = 8192L * 512; mode = 1; }
            else if (hidx < 20) { const int ti = (hidx - 8) >> 1, g = (hidx - 8) & 1; base = PL + (size_t)ti * (4u * 8192u * 64u) + (size_t)g * (8192u * 64u); pitch = 64; bstride = 2L * 8192 * 64; mode = 0; }
            else if (hidx < 32) { base = QD + (hidx - 20) * 64; pitch = 768; bstride = 8192L * 768; mode = 1; }
            else if (hidx < 44) { base = KD + (size_t)(hidx - 32) * (8192u * 64u); pitch = 64; bstride = 12L * 8192 * 64; mode = 0; }
            else if (hidx < 56) { base = VD + (size_t)(hidx - 44) * (8192u * 64u); pitch = 64; bstride = 12L * 8192 * 64; mode = 0; }
            else if (hidx < 72) { base = GA + (hidx - 56) * 64; pitch = 1024; bstride = 8192L * 1024; mode = 2; }
            else if (hidx < 88) { base = GB + (hidx - 72) * 64; pitch = 1024; bstride = 8192L * 1024; mode = 2; }
            else if (hidx == 88) mode = 3; else mode = 4;
            if (mode == 4) continue;
#pragma unroll
            for (int ai = 0; ai < 2; ++ai)
#pragma unroll
                for (int m = 0; m < 4; ++m) { const int R = u.pm * BM + ai * HALF + wr * 64 + m * 16 + fr, b = R >> 13, t = R & 8191;
                    f32x4 v0 = acc[ai][bj][m][0], v1 = acc[ai][bj][m][1];
                    if (mode == 3) { if (sub < 24) { float* p = GN + (size_t)R * 32 + sub;
#pragma unroll
                            for (int i = 0; i < 4; ++i) { v0[i] = sigmoid_f(v0[i]); v1[i] = sigmoid_f(v1[i]); }
                            *(f32x4*)p = v0; *(f32x4*)(p + 4) = v1; } }
                    else { if (mode == 1) { v0 = v0 * qscale; v1 = v1 * qscale; }
                        if (mode == 2) {
#pragma unroll
                            for (int i = 0; i < 4; ++i) { v0[i] = sigmoid_f(v0[i]); v1[i] = sigmoid_f(v1[i]); } }
                        u32x4 w; w.x = cvt_pk_bf16(v0[0], v0[1]); w.y = cvt_pk_bf16(v0[2], v0[3]); w.z = cvt_pk_bf16(v1[0], v1[1]); w.w = cvt_pk_bf16(v1[2], v1[3]);
                        *(u32x4*)(base + (size_t)b * bstride + (size_t)t * pitch + sub) = w; } }
        }
    }
};
template <class Epi, class Sched, bool ALIGN_EPI = false, bool SP2 = false>
__device__ __forceinline__ void gemm_phase(PG8_LAS unsigned char* lds, const Gemm g, const Sched& S, const Epi& E) {
    const int tid = threadIdx.x, wid = __builtin_amdgcn_readfirstlane(tid >> 6), lane = tid & 63, wr = wid >> 2, wc = wid & 3, fr = lane & 15, fq = lane >> 4;
    const int K = g.K, nt = K / BK;
    unsigned voffA[2], voffB[2];
#pragma unroll
    for (int i = 0; i < 2; ++i) { int R, C; stage_rc(tid * 16 + i * 8192, R, C); const int Rb = Epi::PERM ? ((R & ~31) + perm32(R & 31)) : R;
        voffA[i] = (unsigned)(R * K + C) * 2u; voffB[i] = (unsigned)(Rb * K + C) * 2u; }
    const size_t kstep = (size_t)(BK * 2);
    const size_t hstep = (size_t)HALF * K * 2;
    const size_t tstep = 2 * hstep;
    const unsigned ldsw = (unsigned)wid * 1024u;
    const int aoff = lds_byte(wr * 64 + fr, fq * 8), boff = lds_byte(wc * 32 + fr, fq * 8);
#define PG8_SA(b, h) (((b) * 2 + (h)) * HTB)
#define PG8_SB(b, h) ((4 + (b) * 2 + (h)) * HTB)
#define PG8_STAGE(bufoff, gbase, voff) do { _Pragma("unroll") for (int _i = 0; _i < 2; ++_i) \
        __builtin_amdgcn_global_load_lds((const unsigned*)((const char*)(gbase) + (voff)[_i]), (PG8_LAS unsigned*)(lds + (bufoff) + ldsw + _i * 8192), 16, 0, 0); } while (0)
#define PG8_LDA(dst, b, h) do { _Pragma("unroll") for (int m = 0; m < 4; ++m) _Pragma("unroll") for (int k = 0; k < 2; ++k) dst[m][k] = *(const PG8_LAS bf16x8*)(lds + PG8_SA(b, h) + aoff + m * 2048 + k * 1024); } while (0)
#define PG8_LDB(dst, b, h) do { _Pragma("unroll") for (int n = 0; n < 2; ++n) _Pragma("unroll") for (int k = 0; k < 2; ++k) dst[n][k] = *(const PG8_LAS bf16x8*)(lds + PG8_SB(b, h) + boff + n * 2048 + k * 1024); } while (0)
#define PG8_MMA(ai, bj, At, Bt) do { __builtin_amdgcn_s_setprio(1); _Pragma("unroll") for (int m = 0; m < 4; ++m) _Pragma("unroll") for (int n = 0; n < 2; ++n) _Pragma("unroll") for (int k = 0; k < 2; ++k) \
        acc[ai][bj][m][n] = __builtin_amdgcn_mfma_f32_16x16x32_bf16(Bt[n][k], At[m][k], acc[ai][bj][m][n], 0, 0, 0); __builtin_amdgcn_s_setprio(0); } while (0)
#define PG8_WAIT_V(n) asm volatile("s_waitcnt vmcnt(" #n ")" ::: "memory")
#define PG8_WAIT_L(n) asm volatile("s_waitcnt lgkmcnt(" #n ")" ::: "memory")
#define PG8_BAR __builtin_amdgcn_s_barrier()
#define PG8_SCHED __builtin_amdgcn_sched_barrier(0)
    Unit cur, nxt; int ui = 0;
    if (!S.next(0, cur)) return;
    f32x4 acc[2][2][4][2];
#pragma unroll
    for (int a = 0; a < 2; ++a)
#pragma unroll
        for (int b = 0; b < 2; ++b)
#pragma unroll
            for (int m = 0; m < 4; ++m)
#pragma unroll
                for (int n = 0; n < 2; ++n) acc[a][b][m][n] = (f32x4){0.f, 0.f, 0.f, 0.f};
    bf16x8 At[4][2], B0[2][2], B1[2][2];
    const char* cA = (const char*)g.A + (size_t)cur.pm * tstep; const char* cB = (const char*)g.Bt + (size_t)cur.pn * tstep;
    S.a_ready(cur);
    if constexpr (SP2) {
        PG8_STAGE(PG8_SB(0, 0), cB, voffB); PG8_STAGE(PG8_SB(0, 1), cB + hstep, voffB); PG8_STAGE(PG8_SA(0, 0), cA, voffA); PG8_STAGE(PG8_SA(0, 1), cA + hstep, voffA);
        if (wr == 1) PG8_BAR;
        PG8_WAIT_V(2); PG8_BAR;
        PG8_STAGE(PG8_SB(1, 0), cB + kstep, voffB); PG8_STAGE(PG8_SA(1, 0), cA + kstep, voffA); PG8_STAGE(PG8_SB(1, 1), cB + hstep + kstep, voffB);
        PG8_WAIT_V(6); PG8_BAR;
    } else {
        PG8_STAGE(PG8_SB(0, 0), cB, voffB); PG8_STAGE(PG8_SA(0, 0), cA, voffA); PG8_STAGE(PG8_SB(0, 1), cB + hstep, voffB); PG8_STAGE(PG8_SA(0, 1), cA + hstep, voffA);
        if (wr == 1) PG8_BAR;
        PG8_WAIT_V(4); PG8_BAR;
        PG8_STAGE(PG8_SB(1, 0), cB + kstep, voffB); PG8_STAGE(PG8_SA(1, 0), cA + kstep, voffA); PG8_STAGE(PG8_SB(1, 1), cB + hstep + kstep, voffB);
        PG8_WAIT_V(6); PG8_BAR;
    }
    for (;;) {
        const bool has_next = S.next(ui + 1, nxt);
        const char* nA = has_next ? (const char*)g.A + (size_t)nxt.pm * tstep : cA; const char* nB = has_next ? (const char*)g.Bt + (size_t)nxt.pn * tstep : cB;
        for (int t = 0; t < nt; t += 2) {
            const bool last = (t == nt - 2);
            const char* a1 = cA + (size_t)(t + 1) * kstep;
            const char* a2 = last ? nA : cA + (size_t)(t + 2) * kstep; const char* b2 = last ? nB : cB + (size_t)(t + 2) * kstep;
            const char* a3 = a2 + kstep; const char* b3 = b2 + kstep;
            if (last && has_next) S.a_ready(nxt);
            if constexpr (SP2) {
            PG8_LDB(B0, 0, 0); PG8_LDB(B1, 0, 1); PG8_SCHED; PG8_LDA(At, 0, 0); PG8_STAGE(PG8_SA(1, 1), a1 + hstep, voffA);
            PG8_WAIT_V(8); PG8_WAIT_L(0); PG8_BAR; PG8_MMA(0, 0, At, B0); PG8_MMA(0, 1, At, B1); PG8_BAR; PG8_SCHED;
            PG8_LDA(At, 0, 1); PG8_STAGE(PG8_SB(0, 0), b2, voffB); PG8_STAGE(PG8_SB(0, 1), b2 + hstep, voffB); PG8_STAGE(PG8_SA(0, 0), a2, voffA);
            PG8_WAIT_V(8); PG8_WAIT_L(0); PG8_BAR; PG8_MMA(1, 0, At, B0); PG8_MMA(1, 1, At, B1); PG8_BAR; PG8_SCHED;
            PG8_LDB(B0, 1, 0); PG8_LDB(B1, 1, 1); PG8_SCHED; PG8_LDA(At, 1, 0); PG8_STAGE(PG8_SA(0, 1), a2 + hstep, voffA);
            PG8_WAIT_V(8); PG8_WAIT_L(0); PG8_BAR; PG8_MMA(0, 0, At, B0); PG8_MMA(0, 1, At, B1); PG8_BAR; PG8_SCHED;
            PG8_LDA(At, 1, 1); PG8_STAGE(PG8_SB(1, 0), b3, voffB); PG8_STAGE(PG8_SB(1, 1), b3 + hstep, voffB); PG8_STAGE(PG8_SA(1, 0), a3, voffA);
            PG8_WAIT_V(8); PG8_WAIT_L(0); PG8_BAR; PG8_MMA(1, 0, At, B0); PG8_MMA(1, 1, At, B1); PG8_BAR; PG8_SCHED;
            } else {
            PG8_LDB(B0, 0, 0); PG8_SCHED; PG8_LDA(At, 0, 0); PG8_STAGE(PG8_SA(1, 1), a1 + hstep, voffA);
            PG8_WAIT_L(8); PG8_BAR; PG8_WAIT_L(0); PG8_MMA(0, 0, At, B0); PG8_BAR; PG8_SCHED;
            PG8_LDB(B1, 0, 1); PG8_STAGE(PG8_SB(0, 0), b2, voffB);
            PG8_BAR; PG8_WAIT_L(0); PG8_MMA(0, 1, At, B1); PG8_BAR;
            PG8_LDA(At, 0, 1); PG8_STAGE(PG8_SA(0, 0), a2, voffA);
            PG8_BAR; PG8_WAIT_L(0); PG8_MMA(1, 0, At, B0); PG8_BAR; PG8_SCHED;
            PG8_STAGE(PG8_SB(0, 1), b2 + hstep, voffB);
            PG8_WAIT_V(6); PG8_BAR; PG8_MMA(1, 1, At, B1); PG8_BAR;
            PG8_LDB(B0, 1, 0); PG8_SCHED; PG8_LDA(At, 1, 0); PG8_STAGE(PG8_SA(0, 1), a2 + hstep, voffA);
            PG8_WAIT_L(8); PG8_BAR; PG8_WAIT_L(0); PG8_MMA(0, 0, At, B0); PG8_BAR; PG8_SCHED;
            PG8_LDB(B1, 1, 1); PG8_STAGE(PG8_SB(1, 0), b3, voffB);
            PG8_BAR; PG8_WAIT_L(0); PG8_MMA(0, 1, At, B1); PG8_BAR;
            PG8_LDA(At, 1, 1); PG8_STAGE(PG8_SA(1, 0), a3, voffA);
            PG8_BAR; PG8_WAIT_L(0); PG8_MMA(1, 0, At, B0); PG8_BAR; PG8_SCHED;
            PG8_STAGE(PG8_SB(1, 1), b3 + hstep, voffB);
            PG8_WAIT_V(6); PG8_BAR; PG8_MMA(1, 1, At, B1); PG8_BAR;
            }
        }
        if constexpr (ALIGN_EPI) { if (wr == 0) PG8_BAR; }
        if constexpr (!Epi::AFTER_DRAIN) { E(acc, cur, wr, wc, fr, fq); S.done(cur); }
        if (!has_next) break;
#pragma unroll
        for (int a = 0; a < 2; ++a)
#pragma unroll
            for (int b = 0; b < 2; ++b)
#pragma unroll
                for (int m = 0; m < 4; ++m)
#pragma unroll
                    for (int n = 0; n < 2; ++n) acc[a][b][m][n] = (f32x4){0.f, 0.f, 0.f, 0.f};
        cur = nxt; cA = nA; cB = nB; ++ui;
        if constexpr (ALIGN_EPI) { if (wr == 1) PG8_BAR; }
    }
    PG8_WAIT_V(0);
    if constexpr (!ALIGN_EPI) { if (wr == 0) PG8_BAR; }
    PG8_BAR;
    if constexpr (Epi::AFTER_DRAIN) { E.fused(acc, cur, wr, wc, fr, fq, lds, wid, lane); S.done(cur); }
#undef PG8_SA
#undef PG8_SB
#undef PG8_STAGE
#undef PG8_LDA
#undef PG8_LDB
#undef PG8_MMA
#undef PG8_WAIT_V
#undef PG8_WAIT_L
#undef PG8_BAR
#undef PG8_SCHED
}
}
#define GAS __attribute__((address_space(1)))
#define LAS __attribute__((address_space(3)))
typedef unsigned short bf16;
typedef unsigned v4u __attribute__((ext_vector_type(4)));
typedef float f32x4 __attribute__((ext_vector_type(4)));
typedef short bf16x8 __attribute__((ext_vector_type(8)));
typedef GAS unsigned gu32;
typedef GAS unsigned long long gu64;
#define RLX_AGENT __ATOMIC_RELAXED, __HIP_MEMORY_SCOPE_AGENT
#define LDS_WAIT() asm volatile("s_waitcnt lgkmcnt(0)" ::: "memory")
#define VM_WAIT() asm volatile("s_waitcnt vmcnt(0)" ::: "memory")
__device__ __forceinline__ unsigned long long rt() { return __builtin_amdgcn_s_memrealtime(); }
__device__ __forceinline__ unsigned f2bf(float f) { unsigned u = __builtin_bit_cast(unsigned, f); return (u + 0x7fffu + ((u >> 16) & 1u)) >> 16; }
__device__ __forceinline__ unsigned pk2(float lo, float hi) { return f2bf(lo) | (f2bf(hi) << 16); }

#define XB_TMO      128
#define XB_XCNT(j)  (256  + 64 * (j))
#define XB_XSUB(j)  (1280 + 64 * (j))
#define XB_XGEN(j)  (2304 + 64 * (j))
#define XB_TOP      3328
#define XB_TOPGEN   3392
#define XCD_BAR_WORDS 3456
#define XB_SPIN_CAP (1u << 18)

__device__ __forceinline__ unsigned xb_ld(unsigned* p)              { return __hip_atomic_load(p, __ATOMIC_RELAXED, __HIP_MEMORY_SCOPE_AGENT); }
__device__ __forceinline__ unsigned xb_add(unsigned* p, unsigned v) { return __hip_atomic_fetch_add(p, v, __ATOMIC_RELAXED, __HIP_MEMORY_SCOPE_AGENT); }
__device__ __forceinline__ unsigned xb_xcc_id() { return (unsigned)__builtin_amdgcn_s_getreg((3 << 11) | 20) & 0xFu; }
#define XB_SPIN(cond, bar) do { unsigned _sp = 0; while (cond) { __builtin_amdgcn_s_sleep(1); \
    if ((++_sp & 255u) == 0u) { if (xb_ld(&(bar)[XB_TMO])) break; if (_sp > XB_SPIN_CAP) { atomicAdd(&(bar)[XB_TMO], 1u); break; } } } } while (0)

struct XcdBarrier {
    unsigned* bar; unsigned x;
    volatile LAS unsigned* st;
};

__device__ __forceinline__ XcdBarrier xcd_barrier_post(unsigned* bar, volatile LAS unsigned* st) {
    XcdBarrier b; b.bar = bar; b.x = xb_xcc_id(); b.st = st;
    if (threadIdx.x == 0) (void)xb_add(&bar[XB_XCNT(b.x)], 1u);
    return b;
}
__device__ __forceinline__ void xcd_barrier_complete(unsigned* bar, unsigned x, unsigned& nloc, unsigned& nx) {
    const unsigned G = gridDim.x * gridDim.y * gridDim.z;
    unsigned sum, cnt, mine, sp = 0u;
    for (;;) {
        sum = 0u; cnt = 0u; mine = 0u;
#pragma unroll
        for (unsigned j = 0; j < 16; ++j) { const unsigned c = xb_ld(&bar[XB_XCNT(j)]); sum += c; cnt += (c > 0u) ? 1u : 0u; mine = (j == x) ? c : mine; }
        if (sum == G) break;
        __builtin_amdgcn_s_sleep(1);
        if ((++sp & 255u) == 0u) { if (xb_ld(&bar[XB_TMO])) break; if (sp > XB_SPIN_CAP) { atomicAdd(&bar[XB_TMO], 1u); break; } }
    }
    nloc = mine > 0u ? mine : 1u; nx = cnt > 0u ? cnt : 1u;
}

__device__ __forceinline__ void xcd_barrier(const XcdBarrier& b) {
    asm volatile("s_waitcnt vmcnt(0)" ::: "memory");
    __syncthreads();
    if (threadIdx.x == 0) {
        unsigned* bar = b.bar;
        __builtin_amdgcn_s_waitcnt(0);
        unsigned nloc = b.st[0], nx = b.st[1];
        if (nloc == 0u) { xcd_barrier_complete(bar, b.x, nloc, nx); b.st[0] = nloc; b.st[1] = nx; }
        const unsigned old = xb_add(&bar[XB_XSUB(b.x)], 1u);
        const unsigned gen = old / nloc;
        if (old + 1u == (gen + 1u) * nloc) {
            __builtin_amdgcn_fence(__ATOMIC_RELEASE, "agent");
            asm volatile("s_waitcnt vmcnt(0)" ::: "memory");
            const unsigned og = xb_add(&bar[XB_TOP], 1u);
            const unsigned tg = og / nx;
            if (og + 1u == (tg + 1u) * nx) xb_add(&bar[XB_TOPGEN], 1u);
            else XB_SPIN(xb_ld(&bar[XB_TOPGEN]) == tg, bar);
            __builtin_amdgcn_fence(__ATOMIC_ACQUIRE, "agent");
            xb_add(&bar[XB_XGEN(b.x)], 1u);
            asm volatile("s_waitcnt vmcnt(0)" ::: "memory");
        } else {
            XB_SPIN(xb_ld(&bar[XB_XGEN(b.x)]) == gen, bar);
            __builtin_amdgcn_fence(__ATOMIC_ACQUIRE, "agent");
            asm volatile("s_waitcnt vmcnt(0)" ::: "memory");
        }
    }
    __syncthreads();
}

constexpr int NWAVES = 8;
constexpr int BATCH = 2, SEQ = 8192, D = 1024, FF = 2816, M = BATCH * SEQ;
constexpr int NPROJ_SRC = 5656, NPROJ = 5888;
constexpr float RMS_EPS = 1e-6f;
constexpr float LOG2E = 1.4426950408889634f;
constexpr float QSCALE = 0.125f * LOG2E;
constexpr int LUT_N = 2049, LUT_S = 2052;

constexpr size_t MiB = 1u << 20;
constexpr size_t WS_CTL = 0, CTL_ZERO_BYTES = 64 * 1024;
constexpr size_t WS_LUT = 1 * MiB;
constexpr size_t WS_CB = WS_LUT + 20 * LUT_S * 4;
constexpr size_t WS_KCMP = 1 * MiB + 256 * 1024, WS_VCMP = WS_KCMP + 256 * 1024;
constexpr size_t WS_WIN = 2 * MiB;
constexpr size_t WS_WC1K = WS_WIN + (size_t)NPROJ * D * 2;
constexpr size_t WS_WC1V = WS_WC1K + 1 * MiB;
constexpr size_t WS_WC2K = WS_WC1V + 1 * MiB;
constexpr size_t WS_WC2V = WS_WC2K + 32 * 1024;
constexpr size_t WS_WBN = WS_WC2V + 32 * 1024;
constexpr size_t WS_WBD = WS_WBN + 1 * MiB;
constexpr size_t WS_WOUT = WS_WBD + MiB / 2;
constexpr size_t WS_WGU2 = WS_WOUT + 2 * MiB;
constexpr size_t WS_WD2 = WS_WGU2 + (size_t)2 * FF * D * 2;
constexpr size_t WS_WGU1 = 36 * MiB;
constexpr size_t WS_WD1 = WS_WGU1 + (size_t)2 * FF * D * 2;
static_assert(WS_WD2 + (size_t)D * FF * 2 <= WS_WGU1, "weights A");
static_assert(WS_WD1 + (size_t)D * FF * 2 <= 53 * MiB, "weights B");
constexpr size_t WS_QN = 36 * MiB;
constexpr size_t WS_XN = 53 * MiB;
constexpr size_t WS_MG = WS_XN;
constexpr size_t WS_H = 85 * MiB;
constexpr size_t WS_Y = 173 * MiB;
constexpr size_t WS_PL = 85 * MiB;
constexpr size_t WS_QD = 109 * MiB;
constexpr size_t WS_KD = 133 * MiB, WS_VD = 157 * MiB;
constexpr size_t WS_GA = 181 * MiB, WS_GB = 213 * MiB;
constexpr size_t WS_GN = 245 * MiB;
constexpr size_t WS_YD = 247 * MiB;
constexpr size_t WS_Y2 = 109 * MiB;
constexpr size_t WS_END = 256 * MiB;
static_assert(WS_H + (size_t)M * FF * 2 <= WS_Y && WS_Y + (size_t)M * D * 4 <= WS_END, "ffn map");
static_assert(WS_YD + (size_t)M * 256 * 2 <= WS_END && WS_GN + (size_t)M * 32 * 4 <= WS_YD && WS_Y2 + (size_t)M * D * 4 <= WS_GA, "mixer map");
constexpr size_t PLSZ = (size_t)4 * 8192 * 64;
constexpr int CW_TMO = 0, CW_BAR = 1024;

constexpr int RING_OFF = 0, RING_BYTES = 131072;
constexpr int LDSCTL_OFF = 143360, MISC_OFF = LDSCTL_OFF + 320;
constexpr int LDS_BYTES = 147456;
constexpr int LUT_PAD = 64, LUTW = 1664;
constexpr int A_KV = 0;
constexpr int A_LUT = 65536;
constexpr int A_IMP = A_LUT + 4 * LUTW * 4;
constexpr int IMP_S = 132;
constexpr int A_SEL = A_IMP + 64 * IMP_S * 4;
constexpr int A_UM = A_SEL + 64 * 16;
constexpr int A_WSF = A_UM + 64;
constexpr int A_END = A_WSF + 8 * 512;
static_assert(A_END <= LDSCTL_OFF, "attention LDS");
constexpr size_t WS_OD = 53 * MiB;
constexpr size_t WS_LSE = 69 * MiB;

__device__ __forceinline__ int fresh_tid() { int t = threadIdx.x; asm volatile("" : "+v"(t)); return t; }
struct Frame {
    LAS unsigned char* lds;
    volatile LAS unsigned* MISC;
    gu32* ctl;
    int vcu, G;
};

__device__ __forceinline__ float wave_sum(float v) {
#pragma unroll
    for (int o = 1; o < 64; o <<= 1) v += __shfl_xor(v, o);
    return v;
}
__device__ __forceinline__ void tr_item(const float* W, int K, int Nsrc, int sc0, int nvalid, bf16* WT, int dr0, int kb, LAS float* scr, int lane) {
    const int k0 = 64 * kb;
#pragma unroll 8
    for (int i = 0; i < 32; ++i) { const int kk = 2 * i + (lane >> 5), n = lane & 31; scr[kk * 33 + n] = (n < nvalid) ? W[(size_t)(k0 + kk) * Nsrc + sc0 + n] : 0.f; }
    LDS_WAIT(); asm volatile("" ::: "memory");
    const int c = lane & 7;
#pragma unroll
    for (int j = 0; j < 4; ++j) { const int n = (lane >> 3) + 8 * j; const LAS float* s = scr + (8 * c) * 33 + n;
        v4u o; o.x = pk2(s[0 * 33], s[1 * 33]); o.y = pk2(s[2 * 33], s[3 * 33]); o.z = pk2(s[4 * 33], s[5 * 33]); o.w = pk2(s[6 * 33], s[7 * 33]);
        *(GAS v4u*)(WT + (size_t)(dr0 + n) * K + k0 + 8 * c) = o; }
    LDS_WAIT(); asm volatile("" ::: "memory");
}
__device__ __forceinline__ void win_map(int dblk, int& sc0, int& nvalid) {
    const int hidx = dblk >> 1, half = dblk & 1; nvalid = 32;
    if (hidx < 8) sc0 = hidx * 64 + half * 32;
    else if (hidx < 20) sc0 = 512 + (hidx - 8) * 64 + half * 32;
    else if (hidx < 32) sc0 = 1304 + (hidx - 20) * 64 + half * 32;
    else if (hidx < 44) sc0 = 2072 + (hidx - 32) * 64 + half * 32;
    else if (hidx < 56) sc0 = 2840 + (hidx - 44) * 64 + half * 32;
    else if (hidx < 72) sc0 = 3608 + (hidx - 56) * 64 + half * 32;
    else if (hidx < 88) sc0 = 4632 + (hidx - 72) * 64 + half * 32;
    else if (hidx == 88 && half == 0) { sc0 = 1280; nvalid = 24; }
    else { sc0 = 0; nvalid = 0; }
}
__device__ __forceinline__ void gu_map(int dblk, int& sc0) { const int pn = dblk >> 3, q = dblk & 7; sc0 = (q < 4) ? (128 * pn + 32 * q) : (FF + 128 * pn + 32 * (q - 4)); }
__device__ __forceinline__ int t5_bucket(int d) {
    if (d < 16) return d;
    int b = 16;
    b += (d >= 22); b += (d >= 30); b += (d >= 40); b += (d >= 54); b += (d >= 73); b += (d >= 99); b += (d >= 134); b += (d >= 182);
    b += (d >= 246); b += (d >= 332); b += (d >= 450); b += (d >= 609); b += (d >= 825); b += (d >= 1117); b += (d >= 1513);
    return b;
}
struct In {
    const float *x, *f1_pre, *f1_wgu, *f1_wd, *f1_post, *mix_pre, *w_in, *cpos_k, *cw1_k, *cw2_k, *cpos_v, *cw1_v, *cw2_v, *w_bn, *w_bd, *w_out, *mix_post, *f2_pre, *f2_wgu, *f2_wd, *f2_post, *rel_bias;
};
__device__ __forceinline__ void rms_row_to_bf16(const float* xrow, const float* gain, bf16* orow, int lane) {
    const GAS f32x4* xr = (const GAS f32x4*)xrow + lane; const GAS f32x4* gr = (const GAS f32x4*)gain + lane;
    f32x4 v[4]; float s = 0.f;
#pragma unroll
    for (int j = 0; j < 4; ++j) { v[j] = xr[64 * j]; s += (v[j].x * v[j].x + v[j].y * v[j].y) + (v[j].z * v[j].z + v[j].w * v[j].w); }
    const float r = 1.f / sqrtf(wave_sum(s) * (1.f / D) + RMS_EPS);
    GAS unsigned long long* o8 = (GAS unsigned long long*)orow + lane;
#pragma unroll
    for (int j = 0; j < 4; ++j) { const f32x4 g = gr[64 * j]; o8[64 * j] = (unsigned long long)pk2(v[j].x * r * g.x, v[j].y * r * g.y) | ((unsigned long long)pk2(v[j].z * r * g.z, v[j].w * r * g.w) << 32); }
}
__device__ __forceinline__ void p0_prologue(Frame& F, const In& in, unsigned char* ws) {
    const int tid = fresh_tid(), lane = tid & 63, wave = __builtin_amdgcn_readfirstlane(tid >> 6);
    LAS float* scr = (LAS float*)(F.lds + RING_OFF + wave * 16384);
    const int gw = F.vcu * NWAVES + wave, NGW = F.G * NWAVES;
    constexpr int I_GU = 176 * 16, I_D = 32 * 44, I_IN = 184 * 16, I_C1 = 8 * 32, I_C2 = 2 * 4, I_BN = 32 * 8, I_BD = 32 * 4, I_O = 32 * 16;
    constexpr int NITEMS = 2 * I_GU + 2 * I_D + I_IN + 2 * I_C1 + 2 * I_C2 + I_BN + I_BD + I_O;
    for (int it = gw; it < NITEMS; it += NGW) {
        int r = it, sc0, nv = 32;
        if (r < I_GU) { const int dblk = r / 16, kb = r % 16; gu_map(dblk, sc0); tr_item(in.f1_wgu, D, 2 * FF, sc0, 32, (bf16*)(ws + WS_WGU1), dblk * 32, kb, scr, lane); continue; } r -= I_GU;
        if (r < I_GU) { const int dblk = r / 16, kb = r % 16; gu_map(dblk, sc0); tr_item(in.f2_wgu, D, 2 * FF, sc0, 32, (bf16*)(ws + WS_WGU2), dblk * 32, kb, scr, lane); continue; } r -= I_GU;
        if (r < I_D) { const int dblk = r / 44, kb = r % 44; tr_item(in.f1_wd, FF, D, dblk * 32, 32, (bf16*)(ws + WS_WD1), dblk * 32, kb, scr, lane); continue; } r -= I_D;
        if (r < I_D) { const int dblk = r / 44, kb = r % 44; tr_item(in.f2_wd, FF, D, dblk * 32, 32, (bf16*)(ws + WS_WD2), dblk * 32, kb, scr, lane); continue; } r -= I_D;
        if (r < I_IN) { const int dblk = r / 16, kb = r % 16; win_map(dblk, sc0, nv); tr_item(in.w_in, D, NPROJ_SRC, sc0, nv, (bf16*)(ws + WS_WIN), dblk * 32, kb, scr, lane); continue; } r -= I_IN;
        if (r < I_C1) { const int dblk = r / 32, kb = r % 32; tr_item(in.cw1_k, 2048, 256, dblk * 32, 32, (bf16*)(ws + WS_WC1K), dblk * 32, kb, scr, lane); continue; } r -= I_C1;
        if (r < I_C1) { const int dblk = r / 32, kb = r % 32; tr_item(in.cw1_v, 2048, 256, dblk * 32, 32, (bf16*)(ws + WS_WC1V), dblk * 32, kb, scr, lane); continue; } r -= I_C1;
        if (r < I_C2) { const int dblk = r / 4, kb = r % 4; tr_item(in.cw2_k, 256, 64, dblk * 32, 32, (bf16*)(ws + WS_WC2K), dblk * 32, kb, scr, lane); continue; } r -= I_C2;
        if (r < I_C2) { const int dblk = r / 4, kb = r % 4; tr_item(in.cw2_v, 256, 64, dblk * 32, 32, (bf16*)(ws + WS_WC2V), dblk * 32, kb, scr, lane); continue; } r -= I_C2;
        if (r < I_BN) { const int dblk = r / 8, kb = r % 8; tr_item(in.w_bn, 512, D, dblk * 32, 32, (bf16*)(ws + WS_WBN), dblk * 32, kb, scr, lane); continue; } r -= I_BN;
        if (r < I_BD) { const int dblk = r / 4, kb = r % 4; tr_item(in.w_bd, 256, D, dblk * 32, 32, (bf16*)(ws + WS_WBD), dblk * 32, kb, scr, lane); continue; } r -= I_BD;
        { const int dblk = r / 16, kb = r % 16; tr_item(in.w_out, D, D, dblk * 32, 32, (bf16*)(ws + WS_WOUT), dblk * 32, kb, scr, lane); }
    }
    { float* lut = (float*)(ws + WS_LUT); const int gt = F.vcu * (NWAVES * 64) + tid, NGT = F.G * NWAVES * 64;
      for (int e = gt; e < 20 * LUT_S; e += NGT) { const int hd = e / LUT_S, d = e % LUT_S; lut[e] = (d < LUT_N) ? in.rel_bias[t5_bucket(d) * 20 + hd] * LOG2E : 0.f; } }
    { float* cb = (float*)(ws + WS_CB);
      for (int o = gw; o < 512; o += NGW) { const int ts = o >> 8, n = o & 255; const float* pos = ts ? in.cpos_v : in.cpos_k; const float* w1 = ts ? in.cw1_v : in.cw1_k;
          float s = 0.f; for (int k = lane; k < 2048; k += 64) s += pos[k] * w1[(size_t)k * 256 + n];
          s = wave_sum(s); if (lane == 0) cb[o] = s; } }
    for (int m = gw; m < M; m += NGW) rms_row_to_bf16(in.x + (size_t)m * D, in.f1_pre, (bf16*)(ws + WS_XN) + (size_t)m * D, lane);
}
__device__ __forceinline__ void row_pass(Frame& F, const float* Y, const float* base, float* out, float alpha, const float* gpost, const float* gnext, bf16* XN) {
    const int tid = fresh_tid(), lane = tid & 63, wave = __builtin_amdgcn_readfirstlane(tid >> 6);
    const int gw = F.vcu * NWAVES + wave, NGW = F.G * NWAVES;
    for (int m = gw; m < M; m += NGW) {
        const GAS f32x4* yr = (const GAS f32x4*)(Y + (size_t)m * D) + lane; const GAS f32x4* br = (const GAS f32x4*)(base + (size_t)m * D) + lane;
        const GAS f32x4* gp = (const GAS f32x4*)gpost + lane;
        f32x4 v[4], bv[4]; float s = 0.f;
#pragma unroll
        for (int j = 0; j < 4; ++j) { v[j] = yr[64 * j]; bv[j] = br[64 * j]; s += (v[j].x * v[j].x + v[j].y * v[j].y) + (v[j].z * v[j].z + v[j].w * v[j].w); }
        const float r = alpha / sqrtf(wave_sum(s) * (1.f / D) + RMS_EPS);
        float s2 = 0.f;
        GAS f32x4* orow = (GAS f32x4*)(out + (size_t)m * D) + lane;
#pragma unroll
        for (int j = 0; j < 4; ++j) { const f32x4 g = gp[64 * j]; v[j] = bv[j] + v[j] * r * g; orow[64 * j] = v[j]; s2 += (v[j].x * v[j].x + v[j].y * v[j].y) + (v[j].z * v[j].z + v[j].w * v[j].w); }
        if (gnext) {
            const float r2 = 1.f / sqrtf(wave_sum(s2) * (1.f / D) + RMS_EPS);
            const GAS f32x4* gn = (const GAS f32x4*)gnext + lane;
            GAS unsigned long long* o8 = (GAS unsigned long long*)(XN + (size_t)m * D) + lane;
#pragma unroll
            for (int j = 0; j < 4; ++j) { const f32x4 g = gn[64 * j]; o8[64 * j] = (unsigned long long)pk2(v[j].x * r2 * g.x, v[j].y * r2 * g.y) | ((unsigned long long)pk2(v[j].z * r2 * g.z, v[j].w * r2 * g.w) << 32); }
        }
    }
}

namespace att {
typedef float f32x16 __attribute__((ext_vector_type(16)));
typedef short s16x4 __attribute__((ext_vector_type(4)));
typedef short v4i16_t __attribute__((ext_vector_type(4)));
constexpr float NEGV = -1.0e30f;
constexpr int TILE_B = 16384, SBUF = 2 * TILE_B;
enum { CLS_SKIP = 0, CLS_FULL = 1, CLS_PART = 2, CLS_CONST = 3 };
__device__ __forceinline__ constexpr int crow(int r, int hi) { return (r & 3) + 8 * (r >> 2) + 4 * hi; }
__device__ __forceinline__ unsigned cvtpk(float lo, float hi) { unsigned r; asm volatile("v_cvt_pk_bf16_f32 %0, %1, %2" : "=v"(r) : "v"(lo), "v"(hi)); return r; }
__device__ __forceinline__ float swapmax(float v) { auto rr = __builtin_amdgcn_permlane32_swap(__float_as_uint(v), __float_as_uint(v), false, false); return fmaxf(__uint_as_float(rr[0]), __uint_as_float(rr[1])); }
__device__ __forceinline__ float swapsum(float v) { auto rr = __builtin_amdgcn_permlane32_swap(__float_as_uint(v), __float_as_uint(v), false, false); return __uint_as_float(rr[0]) + __uint_as_float(rr[1]); }
__device__ __forceinline__ float quadsum(float v) {
    v += __int_as_float(__builtin_amdgcn_mov_dpp(__float_as_int(v), 0xB1, 0xF, 0xF, true));
    v += __int_as_float(__builtin_amdgcn_mov_dpp(__float_as_int(v), 0x4E, 0xF, 0xF, true));
    return v;
}
struct Stage { v4u k, v; };
struct Stage2 { Stage t[2]; };
__device__ __forceinline__ void tile_load(Stage& s, const bf16* Kp, const bf16* Vp, long row, int tid) {
    const int ch = tid & 7; s.k = *(const GAS v4u*)(Kp + row * 64 + ch * 8); s.v = *(const GAS v4u*)(Vp + row * 64 + ch * 8);
}
__device__ __forceinline__ void tile_store(LAS unsigned char* buf, const Stage& s, int tid) {
    const int key = tid >> 3, ch = tid & 7;
    *(LAS v4u*)(buf + ch * 1024 + key * 16) = s.k;
    *(LAS v4u*)(buf + 8192 + (ch >> 2) * 4096 + key * 64 + (ch & 3) * 16) = s.v;
}
#define ATT_BAR() asm volatile("s_waitcnt lgkmcnt(0)\n\ts_barrier" ::: "memory")
__device__ __forceinline__ void qk(f32x16& p0, f32x16& p1, const LAS unsigned char* kb, const bf16x8 (&qr)[4], float init) {
#pragma unroll
    for (int r = 0; r < 16; ++r) { p0[r] = init; p1[r] = init; }
#pragma unroll
    for (int d0 = 0; d0 < 4; ++d0) {
        const bf16x8 b0 = *(const LAS bf16x8*)(kb + d0 * 2048), b1 = *(const LAS bf16x8*)(kb + d0 * 2048 + 512);
        p0 = __builtin_amdgcn_mfma_f32_32x32x16_bf16(b0, qr[d0], p0, 0, 0, 0);
        p1 = __builtin_amdgcn_mfma_f32_32x32x16_bf16(b1, qr[d0], p1, 0, 0, 0);
    }
}
__device__ __forceinline__ s16x4 vtr(const LAS unsigned char* p) { return __builtin_bit_cast(s16x4, __builtin_amdgcn_ds_read_tr16_b64_v4i16((LAS v4i16_t*)p)); }
__device__ __forceinline__ void pv(f32x16 (&o)[2], const LAS unsigned char* vb, const f32x16& p0, const f32x16& p1) {
    v4u pw[4];
#pragma unroll
    for (int s = 0; s < 2; ++s) {
        pw[s]     = (v4u){cvtpk(p0[8 * s], p0[8 * s + 1]), cvtpk(p0[8 * s + 2], p0[8 * s + 3]), cvtpk(p0[8 * s + 4], p0[8 * s + 5]), cvtpk(p0[8 * s + 6], p0[8 * s + 7])};
        pw[2 + s] = (v4u){cvtpk(p1[8 * s], p1[8 * s + 1]), cvtpk(p1[8 * s + 2], p1[8 * s + 3]), cvtpk(p1[8 * s + 4], p1[8 * s + 5]), cvtpk(p1[8 * s + 6], p1[8 * s + 7])};
    }
#pragma unroll
    for (int dh = 0; dh < 2; ++dh)
#pragma unroll
        for (int kg = 0; kg < 4; ++kg) {
            const s16x4 lo = vtr(vb + dh * 4096 + kg * 1024), hi = vtr(vb + dh * 4096 + kg * 1024 + 512);
            const bf16x8 vf = (bf16x8){lo[0], lo[1], lo[2], lo[3], hi[0], hi[1], hi[2], hi[3]};
            o[dh] = __builtin_amdgcn_mfma_f32_32x32x16_bf16(__builtin_bit_cast(bf16x8, pw[kg]), vf, o[dh], 0, 0, 0);
        }
}
struct Soft { float mref, lsum; };
__device__ __forceinline__ void proc_tile(int cls, const LAS unsigned char* tile, const bf16x8 (&qr)[4], Soft& st, f32x16 (&o)[2], const LAS float* lut, int d0, int dlo, int dhi, float cbias, bool rowsel,
                                          LAS float* wsf, int r32, int hi, int trb) {
    const bool unset = st.mref < -1.0e29f;
    const float base = unset ? 0.f : st.mref;
    const float init = rowsel ? (((cls == CLS_CONST) ? cbias : 0.f) - base) : NEGV;
    f32x16 p0, p1; qk(p0, p1, tile + hi * 1024 + r32 * 16, qr, init);
    if (cls == CLS_FULL) {
        const LAS float* pb = lut + (d0 - 4 * hi - 59);
#pragma unroll
        for (int r = 0; r < 16; ++r) { p0[r] += pb[59 - crow(r, 0)]; p1[r] += pb[27 - crow(r, 0)]; }
    } else if (cls == CLS_PART) {
        const LAS float* pb = lut + (d0 - 4 * hi - 59); const int dq = d0 - 4 * hi; const unsigned span = (unsigned)(dhi - dlo);
#pragma unroll
        for (int r = 0; r < 16; ++r) { const int da = dq - crow(r, 0), db = da - 32;
            p0[r] = ((unsigned)(da - dlo) <= span) ? p0[r] + pb[59 - crow(r, 0)] : NEGV;
            p1[r] = ((unsigned)(db - dlo) <= span) ? p1[r] + pb[27 - crow(r, 0)] : NEGV; }
    }
    float rm = fmaxf(p0[0], p1[0]);
#pragma unroll
    for (int r = 1; r < 16; ++r) rm = fmaxf(rm, fmaxf(p0[r], p1[r]));
    rm = swapmax(rm);
    const bool upd = rowsel && (rm > -1.0e29f) && (unset || rm > 8.0f);
    if (__any(upd)) {
        const float delta = upd ? rm : 0.f;
#pragma unroll
        for (int r = 0; r < 16; ++r) { p0[r] -= delta; p1[r] -= delta; }
        const float f = (upd && !unset) ? __builtin_amdgcn_exp2f(-delta) : 1.0f;
        st.lsum *= f;
        if (upd) st.mref = base + delta;
        if (hi == 0) wsf[r32] = f;
        asm volatile("s_waitcnt lgkmcnt(0)" ::: "memory");
#pragma unroll
        for (int r = 0; r < 16; ++r) { const float fr = wsf[crow(r, hi)]; o[0][r] *= fr; o[1][r] *= fr; }
        asm volatile("s_waitcnt lgkmcnt(0)" ::: "memory");
    }
    float s = 0.f;
#pragma unroll
    for (int r = 0; r < 16; ++r) { p0[r] = __builtin_amdgcn_exp2f(p0[r]); p1[r] = __builtin_amdgcn_exp2f(p1[r]); s += p0[r] + p1[r]; }
    st.lsum += s;
    pv(o, tile + 8192 + trb, p0, p1);
}
__device__ __forceinline__ float soft_final_inv(const Soft& st, float& ltot) { ltot = swapsum(st.lsum); return (st.mref > -1.0e29f) ? 1.0f / ltot : 0.f; }
}

struct Mix {
    bf16 *QN, *PL, *QD, *KD, *VD, *YD, *KCMP, *VCMP, *OD; float* LSE; const float* GN; const float* LUT; const float* CB;
    const bf16 *WC1K, *WC1V, *WC2K, *WC2V;
};
__device__ __forceinline__ void lut_to_lds(Frame& F, int tid, const float* lutg, int nheads, int head0, int hstride, int width, int dmul, int maxd) {
    LAS float* L = (LAS float*)(F.lds + A_LUT);
    for (int e = tid; e < nheads * width; e += NWAVES * 64) { const int i = e / width, d = e % width - LUT_PAD;
        float v = 0.f; if (d >= 0 && d <= maxd) { int gd = d * dmul; gd = gd > 2048 ? 2048 : gd; v = lutg[(size_t)(head0 + i * hstride) * LUT_S + gd]; }
        L[e] = v; }
}
__device__ __forceinline__ bf16x8 ldq(const bf16* p) { return *(const GAS bf16x8*)p; }

__device__ __forceinline__ int next_sel(int j, int c, unsigned u0, unsigned u1, unsigned u2, unsigned u3) {
    while (j <= c) { const unsigned w = (j < 32) ? u0 : (j < 64) ? u1 : (j < 96) ? u2 : u3; if ((w >> (j & 31)) & 1u) break; ++j; }
    return j;
}
template <bool ADD> __device__ __forceinline__ void yn_rows(bf16* YN, const att::f32x16 (&o)[2], float fac, LAS float* wsf, int r32, int hi, size_t R0, int g, int lane) {
    if (hi == 0) wsf[r32] = fac;
    asm volatile("s_waitcnt lgkmcnt(0)" ::: "memory");
#pragma unroll
    for (int r = 0; r < 16; ++r) { const int q = att::crow(r, hi); const float fr = wsf[q];
        bf16* op = YN + (R0 + (q >> 2)) * 512 + (4 * g + (q & 3)) * 64 + (lane & 31);
        float a0 = o[0][r] * fr, a1 = o[1][r] * fr;
        if (ADD) { a0 += __uint_as_float((unsigned)op[0] << 16); a1 += __uint_as_float((unsigned)op[32] << 16); }
        op[0] = (bf16)f2bf(a0); op[32] = (bf16)f2bf(a1); }
    asm volatile("s_waitcnt lgkmcnt(0)" ::: "memory");
}
__device__ __forceinline__ void nsa_unit(Frame& F, const Mix& X, int b, int g, int c, int& buf) {
    using namespace att;
    const int tid = fresh_tid(), lane = tid & 63, wave = __builtin_amdgcn_readfirstlane(tid >> 6), r32 = lane & 31, hi = lane >> 5;
    LAS unsigned char* kv = F.lds + A_KV; LAS float* lutl = (LAS float*)(F.lds + A_LUT); LAS float* imp = (LAS float*)(F.lds + A_IMP);
    LAS unsigned* selm = (LAS unsigned*)(F.lds + A_SEL); LAS unsigned* um = (LAS unsigned*)(F.lds + A_UM); LAS float* wsf = (LAS float*)(F.lds + A_WSF) + wave * 128;
    const int trb = ((lane >> 4) & 1) * 32 + (lane & 3) * 8 + (4 * hi + ((lane & 15) >> 2)) * 64;
    const int t0 = 64 * c, tok = 8 * wave + (r32 >> 2), h = r32 & 3, t = t0 + tok;
    const size_t R = (size_t)b * SEQ + t, R0 = (size_t)b * SEQ + t0 + 8 * wave;
    const int plane = b * 2 + g;
    const bf16* KS = X.PL + 2 * PLSZ + (size_t)plane * SEQ * 64; const bf16* VS = X.PL + 3 * PLSZ + (size_t)plane * SEQ * 64;
    const bf16* KW = X.PL + 4 * PLSZ + (size_t)plane * SEQ * 64; const bf16* VW = X.PL + 5 * PLSZ + (size_t)plane * SEQ * 64;
    const bf16* KC = X.KCMP + (size_t)plane * 512 * 64; const bf16* VC = X.VCMP + (size_t)plane * 512 * 64;
    __syncthreads();
    lut_to_lds(F, tid, X.LUT, 4, 4 * g, 1, LUTW, 1, LUTW - LUT_PAD - 1);
    for (int e = tid; e < 64 * IMP_S; e += NWAVES * 64) imp[e] = 0.f;
    if (tid < 4) um[tid] = 0u;
    bf16x8 qr[4];
#pragma unroll
    for (int d0 = 0; d0 < 4; ++d0) qr[d0] = ldq(X.QN + R * 512 + (4 * g + h) * 64 + 16 * d0 + 8 * hi);
    const float g0 = X.GN[R * 32 + (4 * g + h) * 3 + 0], g1 = X.GN[R * 32 + (4 * g + h) * 3 + 1], g2 = X.GN[R * 32 + (4 * g + h) * 3 + 2];
    const LAS float* lrow = lutl + h * LUTW + LUT_PAD;
    __syncthreads();
    const int key = tid >> 3;
    Stage2 sg;
    {
        Soft st{NEGV, 0.f}; f32x16 o[2]; o[0] = f32x16{}; o[1] = f32x16{};
        const int it0 = (c >= 8) ? 0 : (8 - c), nt = 9 - it0, nss = (nt + 1) >> 1;
#pragma unroll
        for (int tt = 0; tt < 2; ++tt) { int it = it0 + tt; it = it > 8 ? 8 : it; tile_load(sg.t[tt], KW, VW, t0 - 512 + 64 * it + key, tid); }
        for (int ss = 0; ss < nss; ++ss) {
            LAS unsigned char* bp = kv + buf * SBUF;
            tile_store(bp, sg.t[0], tid); tile_store(bp + TILE_B, sg.t[1], tid); ATT_BAR();
            if (ss + 1 < nss) {
#pragma unroll
                for (int tt = 0; tt < 2; ++tt) { int it = it0 + 2 * (ss + 1) + tt; it = it > 8 ? 8 : it; tile_load(sg.t[tt], KW, VW, t0 - 512 + 64 * it + key, tid); } }
#pragma unroll
            for (int tt = 0; tt < 2; ++tt) { const int it = it0 + 2 * ss + tt;
                if (it <= 8) { const int kb = t0 - 512 + 64 * it; const int cls = (it == 0 || it == 8) ? CLS_PART : CLS_FULL;
                    proc_tile(cls, bp + tt * TILE_B, qr, st, o, lrow, t - kb, 0, 511, 0.f, true, wsf, r32, hi, trb); } }
            buf ^= 1;
        }
        float lt; const float inv = soft_final_inv(st, lt);
        yn_rows<false>(X.QN, o, g2 * inv, wsf, r32, hi, R0, g, lane);
    }
    {
        const int imax = (4 * c + 2 > 510) ? 510 : (4 * c + 2), ntc = imax / 64 + 1, nss = (ntc + 1) >> 1;
        const int dq = t - 31 - 16 * 4 * hi;
        float m = NEGV, l = 0.f;
#pragma unroll
        for (int tt = 0; tt < 2; ++tt) { int it = tt; it = it > ntc - 1 ? ntc - 1 : it; tile_load(sg.t[tt], KC, VC, 64 * it + key, tid); }
        for (int ss = 0; ss < nss; ++ss) {
            LAS unsigned char* bp = kv + buf * SBUF;
            tile_store(bp, sg.t[0], tid); tile_store(bp + TILE_B, sg.t[1], tid); ATT_BAR();
            if (ss + 1 < nss) {
#pragma unroll
                for (int tt = 0; tt < 2; ++tt) { int it = 2 * (ss + 1) + tt; it = it > ntc - 1 ? ntc - 1 : it; tile_load(sg.t[tt], KC, VC, 64 * it + key, tid); } }
#pragma unroll
            for (int tt = 0; tt < 2; ++tt) { const int it = 2 * ss + tt;
                if (it < ntc) {
                    f32x16 p0, p1; qk(p0, p1, bp + tt * TILE_B + hi * 1024 + r32 * 16, qr, 0.f);
                    const int dt = dq - 1024 * it;
#pragma unroll
                    for (int r = 0; r < 16; ++r) { const int da = dt - 16 * crow(r, 0), db = da - 512;
                        const int ia = da < -64 ? -64 : (da > 1599 ? 1599 : da), ib = db < -64 ? -64 : (db > 1599 ? 1599 : db);
                        p0[r] = (da >= 0) ? p0[r] + lrow[ia] : NEGV; p1[r] = (db >= 0) ? p1[r] + lrow[ib] : NEGV; }
                    float rm = fmaxf(p0[0], p1[0]);
#pragma unroll
                    for (int r = 1; r < 16; ++r) rm = fmaxf(rm, fmaxf(p0[r], p1[r]));
                    rm = swapmax(rm);
                    const float mn = fmaxf(m, rm); float s = 0.f;
#pragma unroll
                    for (int r = 0; r < 16; ++r) s += __builtin_amdgcn_exp2f(p0[r] - mn) + __builtin_amdgcn_exp2f(p1[r] - mn);
                    l = l * __builtin_amdgcn_exp2f(m - mn) + s; m = mn;
                } }
            buf ^= 1;
        }
        const float ltot = swapsum(l);
        const float invl = (m > -1.0e29f) ? 1.0f / ltot : 0.f;
        const float mz = (m > -1.0e29f) ? m : 0.f;
        f32x16 o[2]; o[0] = f32x16{}; o[1] = f32x16{};
        LAS float* improw = imp + tok * IMP_S;
#pragma unroll
        for (int tt = 0; tt < 2; ++tt) { int it = tt; it = it > ntc - 1 ? ntc - 1 : it; tile_load(sg.t[tt], KC, VC, 64 * it + key, tid); }
        for (int ss = 0; ss < nss; ++ss) {
            LAS unsigned char* bp = kv + buf * SBUF;
            tile_store(bp, sg.t[0], tid); tile_store(bp + TILE_B, sg.t[1], tid); ATT_BAR();
            if (ss + 1 < nss) {
#pragma unroll
                for (int tt = 0; tt < 2; ++tt) { int it = 2 * (ss + 1) + tt; it = it > ntc - 1 ? ntc - 1 : it; tile_load(sg.t[tt], KC, VC, 64 * it + key, tid); } }
#pragma unroll
            for (int tt = 0; tt < 2; ++tt) { const int it = 2 * ss + tt;
                if (it < ntc) {
                    f32x16 p0, p1; qk(p0, p1, bp + tt * TILE_B + hi * 1024 + r32 * 16, qr, -mz);
                    const int dt = dq - 1024 * it;
#pragma unroll
                    for (int r = 0; r < 16; ++r) { const int da = dt - 16 * crow(r, 0), db = da - 512;
                        const int ia = da < -64 ? -64 : (da > 1599 ? 1599 : da), ib = db < -64 ? -64 : (db > 1599 ? 1599 : db);
                        p0[r] = (da >= 0) ? __builtin_amdgcn_exp2f(p0[r] + lrow[ia]) * invl : 0.f; p1[r] = (db >= 0) ? __builtin_amdgcn_exp2f(p1[r] + lrow[ib]) * invl : 0.f; }
#pragma unroll
                    for (int q = 0; q < 4; ++q) {
                        float a = (p0[4 * q] + p0[4 * q + 1]) + (p0[4 * q + 2] + p0[4 * q + 3]), al = p0[4 * q + 3];
                        float e = (p1[4 * q] + p1[4 * q + 1]) + (p1[4 * q + 2] + p1[4 * q + 3]), el = p1[4 * q + 3];
                        a = quadsum(a); al = quadsum(al); e = quadsum(e); el = quadsum(el);
                        if (h == 0) { const int G = 16 * it + 2 * q + hi;
                            __hip_atomic_fetch_add(improw + G, a, __ATOMIC_RELAXED, __HIP_MEMORY_SCOPE_WORKGROUP); __hip_atomic_fetch_add(improw + G + 1, al, __ATOMIC_RELAXED, __HIP_MEMORY_SCOPE_WORKGROUP);
                            __hip_atomic_fetch_add(improw + G + 8, e, __ATOMIC_RELAXED, __HIP_MEMORY_SCOPE_WORKGROUP); __hip_atomic_fetch_add(improw + G + 9, el, __ATOMIC_RELAXED, __HIP_MEMORY_SCOPE_WORKGROUP); }
                    }
                    pv(o, bp + tt * TILE_B + 8192 + trb, p0, p1);
                } }
            buf ^= 1;
        }
        yn_rows<true>(X.QN, o, g0, wsf, r32, hi, R0, g, lane);
    }
    asm volatile("s_waitcnt lgkmcnt(0)" ::: "memory");
    unsigned msk[4] = {0u, 0u, 0u, 0u};
    if (c >= 16) {
        const int tl = lane >> 3, part = lane & 7;
        const LAS float* ir = imp + (8 * wave + tl) * IMP_S + part * 16;
        unsigned v[16];
#pragma unroll
        for (int r = 0; r < 16; ++r) { const int j = part * 16 + r; const unsigned bits = __float_as_uint(ir[r]); v[r] = (j >= 1 && j <= c - 2) ? ((bits & ~127u) | (unsigned)(127 - j)) : 0u; }
        unsigned sm[4] = {0u, 0u, 0u, 0u};
        for (int itn = 0; itn < 13; ++itn) {
            unsigned mx = v[0];
#pragma unroll
            for (int r = 1; r < 16; ++r) mx = mx > v[r] ? mx : v[r];
            { unsigned o1 = (unsigned)__shfl_xor((int)mx, 1); mx = mx > o1 ? mx : o1; o1 = (unsigned)__shfl_xor((int)mx, 2); mx = mx > o1 ? mx : o1; o1 = (unsigned)__shfl_xor((int)mx, 4); mx = mx > o1 ? mx : o1; }
            const int j = 127 - (int)(mx & 127u); const unsigned bit = 1u << (j & 31); const int w = j >> 5;
            if (mx != 0u) { sm[0] |= (w == 0) ? bit : 0u; sm[1] |= (w == 1) ? bit : 0u; sm[2] |= (w == 2) ? bit : 0u; sm[3] |= (w == 3) ? bit : 0u; }
#pragma unroll
            for (int r = 0; r < 16; ++r) v[r] = (v[r] == mx) ? 0u : v[r];
        }
        sm[0] |= 1u;
        { const int j = c - 1; const unsigned bit = 1u << (j & 31); const int w = j >> 5; sm[0] |= (w == 0) ? bit : 0u; sm[1] |= (w == 1) ? bit : 0u; sm[2] |= (w == 2) ? bit : 0u; sm[3] |= (w == 3) ? bit : 0u; }
        { const int j = c; const unsigned bit = 1u << (j & 31); const int w = j >> 5; sm[0] |= (w == 0) ? bit : 0u; sm[1] |= (w == 1) ? bit : 0u; sm[2] |= (w == 2) ? bit : 0u; sm[3] |= (w == 3) ? bit : 0u; }
        if (part == 0) {
#pragma unroll
            for (int w = 0; w < 4; ++w) { selm[(8 * wave + tl) * 4 + w] = sm[w]; __hip_atomic_fetch_or(um + w, sm[w], __ATOMIC_RELAXED, __HIP_MEMORY_SCOPE_WORKGROUP); }
        }
        __syncthreads();
#pragma unroll
        for (int w = 0; w < 4; ++w) msk[w] = selm[tok * 4 + w];
    } else {
        msk[0] = (2u << c) - 1u;
        __syncthreads();
    }
    unsigned umr[4];
#pragma unroll
    for (int w = 0; w < 4; ++w) umr[w] = (c >= 16) ? (unsigned)__builtin_amdgcn_readfirstlane((int)um[w]) : ((w == 0) ? ((2u << c) - 1u) : 0u);
    {
        Soft st{NEGV, 0.f}; f32x16 o[2]; o[0] = f32x16{}; o[1] = f32x16{};
        const float cfar = lrow[1599];
        int j0 = next_sel(0, c, umr[0], umr[1], umr[2], umr[3]);
        int j1 = (j0 <= c) ? next_sel(j0 + 1, c, umr[0], umr[1], umr[2], umr[3]) : j0;
        if (j0 <= c) { tile_load(sg.t[0], KS, VS, 64 * j0 + key, tid); tile_load(sg.t[1], KS, VS, 64 * (j1 <= c ? j1 : j0) + key, tid); }
        while (j0 <= c) {
            LAS unsigned char* bp = kv + buf * SBUF;
            tile_store(bp, sg.t[0], tid); tile_store(bp + TILE_B, sg.t[1], tid); ATT_BAR();
            const int n0 = (j1 <= c) ? next_sel(j1 + 1, c, umr[0], umr[1], umr[2], umr[3]) : j1;
            const int n1 = (n0 <= c) ? next_sel(n0 + 1, c, umr[0], umr[1], umr[2], umr[3]) : n0;
            if (n0 <= c) { tile_load(sg.t[0], KS, VS, 64 * n0 + key, tid); tile_load(sg.t[1], KS, VS, 64 * (n1 <= c ? n1 : n0) + key, tid); }
#pragma unroll
            for (int tt = 0; tt < 2; ++tt) { const int j = tt ? j1 : j0;
                if (j <= c) {
                    const unsigned mw = (j < 32) ? msk[0] : (j < 64) ? msk[1] : (j < 96) ? msk[2] : msk[3];
                    const bool sel = (mw >> (j & 31)) & 1u;
                    if (__any(sel)) { const int cls = (j == c) ? CLS_PART : ((c - j >= 25) ? CLS_CONST : CLS_FULL);
                        proc_tile(cls, bp + tt * TILE_B, qr, st, o, lrow, t - 64 * j, 0, 0x3fffffff, cfar, sel, wsf, r32, hi, trb); } } }
            buf ^= 1; j0 = n0; j1 = n1;
        }
        float lt; const float inv = soft_final_inv(st, lt);
        yn_rows<true>(X.QN, o, g1 * inv, wsf, r32, hi, R0, g, lane);
    }
}

__device__ __forceinline__ void dil_unit(Frame& F, const Mix& X, int gi, int b, int s, int rest, int& buf) {
    using namespace att;
    const int tid = fresh_tid(), lane = tid & 63, wave = __builtin_amdgcn_readfirstlane(tid >> 6), r32 = lane & 31, hi = lane >> 5;
    LAS unsigned char* kv = F.lds + A_KV; LAS float* lutl = (LAS float*)(F.lds + A_LUT); LAS float* wsf = (LAS float*)(F.lds + A_WSF) + wave * 128;
    const int trb = ((lane >> 4) & 1) * 32 + (lane & 3) * 8 + (4 * hi + ((lane & 15) >> 2)) * 64;
    const int dil = 1 << (2 * gi), lg = 2 * gi, nch = (SEQ >> lg) >> 8, res = rest / nch, ch = rest % nch;
    const int hd = 4 * gi + s, N0 = 256 * ch, Nw = N0 + 32 * wave, nq = Nw + r32, key = tid >> 3;
    const int t = (nq << lg) + res;
    const size_t R = (size_t)b * SEQ + t;
    __syncthreads();
    lut_to_lds(F, tid, X.LUT, 1, 8 + hd, 0, 320, dil, 128);
    bf16x8 qr[4];
#pragma unroll
    for (int d0 = 0; d0 < 4; ++d0) qr[d0] = ldq(X.QD + R * 768 + hd * 64 + 16 * d0 + 8 * hi);
    const bf16* Kp = X.KD + (size_t)(b * 12 + hd) * SEQ * 64; const bf16* Vp = X.VD + (size_t)(b * 12 + hd) * SEQ * 64;
    const LAS float* lrow = lutl + LUT_PAD;
    __syncthreads();
    Soft st{NEGV, 0.f}; f32x16 o[2]; o[0] = f32x16{}; o[1] = f32x16{};
    Stage2 sg;
    const int it0 = (ch == 0) ? 2 : 0, nss = (6 - it0) >> 1;
#pragma unroll
    for (int tt = 0; tt < 2; ++tt) { const int kb = N0 - 128 + 64 * (it0 + tt); tile_load(sg.t[tt], Kp, Vp, (long)((kb + key) << lg) + res, tid); }
    for (int ss = 0; ss < nss; ++ss) {
        LAS unsigned char* bp = kv + buf * SBUF;
        tile_store(bp, sg.t[0], tid); tile_store(bp + TILE_B, sg.t[1], tid); ATT_BAR();
        if (ss + 1 < nss) {
#pragma unroll
            for (int tt = 0; tt < 2; ++tt) { const int kb = N0 - 128 + 64 * (it0 + 2 * (ss + 1) + tt); tile_load(sg.t[tt], Kp, Vp, (long)((kb + key) << lg) + res, tid); } }
#pragma unroll
        for (int tt = 0; tt < 2; ++tt) { const int kb = N0 - 128 + 64 * (it0 + 2 * ss + tt);
            const int dmin = Nw - kb - 63, dmax = Nw + 31 - kb;
            if (dmax >= 0 && dmin <= 128) { const int cls = (dmin >= 0 && dmax <= 128) ? CLS_FULL : CLS_PART;
                proc_tile(cls, bp + tt * TILE_B, qr, st, o, lrow, nq - kb, 0, 128, 0.f, true, wsf, r32, hi, trb); } }
        buf ^= 1;
    }
    float ltot; const float inv = soft_final_inv(st, ltot);
    const float lse = st.mref + __builtin_amdgcn_logf(ltot);
    if (gi != 0) {
        bf16* OD = X.OD + (size_t)(gi - 1) * M * 256; float* LS = X.LSE + (size_t)(gi - 1) * M * 4;
        if (hi == 0) { wsf[r32] = inv; LS[R * 4 + s] = lse; }
        asm volatile("s_waitcnt lgkmcnt(0)" ::: "memory");
#pragma unroll
        for (int r = 0; r < 16; ++r) { const int q = crow(r, hi); const float fr = wsf[q]; const size_t Rq = (size_t)b * SEQ + ((size_t)(Nw + q) << lg) + res;
            bf16* op = OD + Rq * 256 + s * 64 + (lane & 31);
            op[0] = (bf16)f2bf(o[0][r] * fr); op[32] = (bf16)f2bf(o[1][r] * fr); }
        asm volatile("s_waitcnt lgkmcnt(0)" ::: "memory");
    } else {
        const float l4 = X.LSE[R * 4 + s], l16 = X.LSE[(size_t)M * 4 + R * 4 + s];
        const float mx = fmaxf(lse, fmaxf(l4, l16));
        const float w1 = __builtin_amdgcn_exp2f(lse - mx), w4 = __builtin_amdgcn_exp2f(l4 - mx), w16 = __builtin_amdgcn_exp2f(l16 - mx), iw = 1.0f / (w1 + w4 + w16);
        if (hi == 0) { wsf[r32] = w1 * iw * inv; wsf[32 + r32] = w4 * iw; wsf[64 + r32] = w16 * iw; }
        asm volatile("s_waitcnt lgkmcnt(0)" ::: "memory");
#pragma unroll
        for (int r = 0; r < 16; ++r) { const int q = crow(r, hi); const float a1 = wsf[q], a4 = wsf[32 + q], a16 = wsf[64 + q]; const size_t Rq = (size_t)b * SEQ + Nw + q;
            const bf16* p4 = X.OD + Rq * 256 + s * 64 + (lane & 31); const bf16* p16 = p4 + (size_t)M * 256;
            bf16* op = X.YD + Rq * 256 + s * 64 + (lane & 31);
            const float v0 = o[0][r] * a1 + __uint_as_float((unsigned)p4[0] << 16) * a4 + __uint_as_float((unsigned)p16[0] << 16) * a16;
            const float v1 = o[1][r] * a1 + __uint_as_float((unsigned)p4[32] << 16) * a4 + __uint_as_float((unsigned)p16[32] << 16) * a16;
            op[0] = (bf16)f2bf(v0); op[32] = (bf16)f2bf(v1); }
        asm volatile("s_waitcnt lgkmcnt(0)" ::: "memory");
    }
}

__device__ __forceinline__ void cmp_unit(Frame& F, const Mix& X, int cu) {
    using namespace att;
    const int tid = fresh_tid(), lane = tid & 63, wave = __builtin_amdgcn_readfirstlane(tid >> 6), r32 = lane & 31, hi = lane >> 5;
    const int ts = cu >> 5, rb = cu & 31, plane = rb >> 3, i0 = (rb & 7) * 64;
    const bf16* src = X.PL + (size_t)ts * PLSZ + (size_t)plane * SEQ * 64;
    const bf16* W1 = ts ? X.WC1V : X.WC1K; const bf16* W2 = ts ? X.WC2V : X.WC2K; const float* cb = X.CB + ts * 256;
    bf16* dst = (ts ? X.VCMP : X.KCMP) + (size_t)plane * 512 * 64;
    LAS unsigned char* hid = F.lds + A_KV;
    __syncthreads();
    f32x16 acc[2]; acc[0] = f32x16{}; acc[1] = f32x16{};
    int ia = i0 + r32, ib = i0 + 32 + r32; ia = ia > 510 ? 510 : ia; ib = ib > 510 ? 510 : ib;
    const bf16* a0p = src + (size_t)ia * 1024 + 8 * hi; const bf16* a1p = src + (size_t)ib * 1024 + 8 * hi;
    const bf16* bp = W1 + (size_t)(32 * wave + r32) * 2048 + 8 * hi;
#pragma unroll 8
    for (int k0 = 0; k0 < 2048; k0 += 16) {
        const bf16x8 a0 = ldq(a0p + k0), a1 = ldq(a1p + k0), bb = ldq(bp + k0);
        acc[0] = __builtin_amdgcn_mfma_f32_32x32x16_bf16(a0, bb, acc[0], 0, 0, 0);
        acc[1] = __builtin_amdgcn_mfma_f32_32x32x16_bf16(a1, bb, acc[1], 0, 0, 0);
    }
    { const int col = 32 * wave + r32; const float bias = cb[col];
#pragma unroll
      for (int mt = 0; mt < 2; ++mt)
#pragma unroll
        for (int r = 0; r < 16; ++r) { const float v = acc[mt][r] + bias; const float hv = v * __builtin_amdgcn_rcpf(1.0f + __builtin_amdgcn_exp2f(-LOG2E * v));
            *(LAS unsigned short*)(hid + (32 * mt + crow(r, hi)) * 528 + col * 2) = (unsigned short)f2bf(hv); } }
    __syncthreads();
    if (wave < 4) {
        const int mt = wave & 1, nt = wave >> 1;
        f32x16 o2 = f32x16{};
        const LAS unsigned char* ap = hid + (32 * mt + r32) * 528 + 16 * hi; const bf16* b2 = W2 + (size_t)(32 * nt + r32) * 256 + 8 * hi;
#pragma unroll
        for (int k0 = 0; k0 < 256; k0 += 16) { const bf16x8 a = *(const LAS bf16x8*)(ap + k0 * 2); const bf16x8 bb = ldq(b2 + k0); o2 = __builtin_amdgcn_mfma_f32_32x32x16_bf16(a, bb, o2, 0, 0, 0); }
#pragma unroll
        for (int r = 0; r < 16; ++r) { const int i = i0 + 32 * mt + crow(r, hi); dst[(size_t)i * 64 + 32 * nt + r32] = (bf16)f2bf(o2[r]); }
    }
}

#ifndef MK_N_LAUNCHES
#define MK_N_LAUNCHES 1
#endif
constexpr int N_PHASES = 13;
constexpr int N_LAUNCHES = MK_N_LAUNCHES;
struct Args { const float* in[22]; float* out; unsigned char* ws; int ph_lo, ph_hi, li, pad; };
__global__ void __launch_bounds__(NWAVES * 64, 2) mk_fwd(Args args) {
    extern __shared__ __attribute__((aligned(16))) unsigned char lds[];
    Frame F;
    F.lds = (LAS unsigned char*)lds;
    F.MISC = (volatile LAS unsigned*)(F.lds + MISC_OFF);
    F.G = gridDim.x; { const int bx = blockIdx.x; F.vcu = (F.G % 8 == 0) ? (bx % 8) * (F.G / 8) + bx / 8 : bx; }
    unsigned char* ws = args.ws;
    F.ctl = (gu32*)(ws + WS_CTL);
    In in;
    in.x = args.in[0]; in.f1_pre = args.in[1]; in.f1_wgu = args.in[2]; in.f1_wd = args.in[3]; in.f1_post = args.in[4]; in.mix_pre = args.in[5]; in.w_in = args.in[6];
    in.cpos_k = args.in[7]; in.cw1_k = args.in[8]; in.cw2_k = args.in[9]; in.cpos_v = args.in[10]; in.cw1_v = args.in[11]; in.cw2_v = args.in[12];
    in.w_bn = args.in[13]; in.w_bd = args.in[14]; in.w_out = args.in[15]; in.mix_post = args.in[16]; in.f2_pre = args.in[17]; in.f2_wgu = args.in[18]; in.f2_wd = args.in[19]; in.f2_post = args.in[20]; in.rel_bias = args.in[21];
    float* out = args.out;
    for (int u = threadIdx.x; u < (LDS_BYTES - LDSCTL_OFF) / 4; u += NWAVES * 64) ((LAS unsigned*)(F.lds + LDSCTL_OFF))[u] = 0u;
    __syncthreads();
    const bool use_bar = (args.ph_hi - args.ph_lo) > 1;
    XcdBarrier bar; bar.bar = (unsigned*)(F.ctl + CW_BAR) + args.li * XCD_BAR_WORDS; bar.x = 0; bar.st = nullptr;
    if (use_bar) bar = xcd_barrier_post((unsigned*)(F.ctl + CW_BAR) + args.li * XCD_BAR_WORDS, F.MISC + 8);
    const int lo = args.ph_lo, hi = args.ph_hi;
#define IN(k) (lo <= (k) && (k) < hi)
#define SEAM(k) do { if (IN(k) && IN((k) + 1)) xcd_barrier(bar); } while (0)
    bf16* XN = (bf16*)(ws + WS_XN); bf16* H = (bf16*)(ws + WS_H); float* Y = (float*)(ws + WS_Y); float* Y2 = (float*)(ws + WS_Y2); bf16* MG = (bf16*)(ws + WS_MG);
    Mix X; X.QN = (bf16*)(ws + WS_QN); X.PL = (bf16*)(ws + WS_PL); X.QD = (bf16*)(ws + WS_QD); X.KD = (bf16*)(ws + WS_KD); X.VD = (bf16*)(ws + WS_VD); X.YD = (bf16*)(ws + WS_YD); X.OD = (bf16*)(ws + WS_OD); X.LSE = (float*)(ws + WS_LSE);
    X.KCMP = (bf16*)(ws + WS_KCMP); X.VCMP = (bf16*)(ws + WS_VCMP); X.GN = (const float*)(ws + WS_GN); X.LUT = (const float*)(ws + WS_LUT); X.CB = (const float*)(ws + WS_CB);
    X.WC1K = (const bf16*)(ws + WS_WC1K); X.WC1V = (const bf16*)(ws + WS_WC1V); X.WC2K = (const bf16*)(ws + WS_WC2K); X.WC2V = (const bf16*)(ws + WS_WC2V);
    bf16* GA = (bf16*)(ws + WS_GA); bf16* GB = (bf16*)(ws + WS_GB);

    if (IN(0)) { p0_prologue(F, in, ws); }
    SEAM(0);
    if (IN(1)) { pg8::Gemm g{XN, (const bf16*)(ws + WS_WGU1), M, 2 * FF, D}; pg8::StaticOrder S; S.init(M, 2 * FF, F.G, (int)blockIdx.x);
        pg8::EpiSwiGLU E{H, FF}; pg8::gemm_phase<pg8::EpiSwiGLU, pg8::StaticOrder, true, true>(F.lds + RING_OFF, g, S, E); }
    SEAM(1);
    if (IN(2)) { pg8::Gemm g{H, (const bf16*)(ws + WS_WD1), M, D, FF}; pg8::StaticOrder S; S.init(M, D, F.G, (int)blockIdx.x);
        pg8::EpiF32 E{Y, D}; pg8::gemm_phase<pg8::EpiF32, pg8::StaticOrder, true, true>(F.lds + RING_OFF, g, S, E); }
    SEAM(2);
    if (IN(3)) { row_pass(F, Y, in.x, out, 0.5f, in.f1_post, in.mix_pre, XN); }
    SEAM(3);
    if (IN(4)) { pg8::Gemm g{XN, (const bf16*)(ws + WS_WIN), M, NPROJ, D}; pg8::StaticOrder S; S.init(M, NPROJ, F.G, (int)blockIdx.x);
        pg8::EpiProj E{X.QN, X.PL, X.QD, X.KD, X.VD, GA, GB, (float*)(ws + WS_GN), QSCALE};
        pg8::gemm_phase<pg8::EpiProj, pg8::StaticOrder, true, true>(F.lds + RING_OFF, g, S, E); }
    SEAM(4);
    if (IN(5)) { int buf = 0;
        for (int cu = F.vcu; cu < 64; cu += F.G) cmp_unit(F, X, cu);
#pragma unroll 1
        for (int w = F.vcu; w < 512; w += F.G) { const int gi = 2 - (w >> 8), du = w & 255; dil_unit(F, X, gi, du >> 7, (du >> 5) & 3, du & 31, buf); }
        __syncthreads(); }
    SEAM(5);
    if (IN(6)) { int buf = 0;
        for (int p = F.vcu; p < 256; p += F.G) { const int b = p >> 7, g = (p >> 6) & 1, cc = p & 63;
#pragma unroll 1
            for (int k = 0; k < 2; ++k) nsa_unit(F, X, b, g, k ? cc : 127 - cc, buf); }
#pragma unroll 1
        for (int du = F.vcu; du < 256; du += F.G) dil_unit(F, X, 0, du >> 7, (du >> 5) & 3, du & 31, buf);
        __syncthreads(); }
    SEAM(6);
    if (IN(7)) {
        { pg8::Gemm g{X.QN, (const bf16*)(ws + WS_WBN), M, D, 512}; pg8::StaticOrder S; S.init(M, D, F.G, (int)blockIdx.x);
          pg8::EpiBranchA E{GA, Y2}; pg8::gemm_phase<pg8::EpiBranchA, pg8::StaticOrder, true, true>(F.lds + RING_OFF, g, S, E); }
        { pg8::Gemm g{X.YD, (const bf16*)(ws + WS_WBD), M, D, 256}; pg8::StaticOrder S; S.init(M, D, F.G, (int)blockIdx.x);
          pg8::EpiBranchB E{GB, Y2, MG}; pg8::gemm_phase<pg8::EpiBranchB, pg8::StaticOrder, true, true>(F.lds + RING_OFF, g, S, E); }
    }
    SEAM(7);
    if (IN(8)) { pg8::Gemm g{MG, (const bf16*)(ws + WS_WOUT), M, D, D}; pg8::StaticOrder S; S.init(M, D, F.G, (int)blockIdx.x);
        pg8::EpiF32 E{Y2, D}; pg8::gemm_phase<pg8::EpiF32, pg8::StaticOrder, true, true>(F.lds + RING_OFF, g, S, E); }
    SEAM(8);
    if (IN(9)) { row_pass(F, Y2, out, out, 1.0f, in.mix_post, in.f2_pre, XN); }
    SEAM(9);
    if (IN(10)) { pg8::Gemm g{XN, (const bf16*)(ws + WS_WGU2), M, 2 * FF, D}; pg8::StaticOrder S; S.init(M, 2 * FF, F.G, (int)blockIdx.x);
        pg8::EpiSwiGLU E{H, FF}; pg8::gemm_phase<pg8::EpiSwiGLU, pg8::StaticOrder, true, true>(F.lds + RING_OFF, g, S, E); }
    SEAM(10);
    if (IN(11)) { pg8::Gemm g{H, (const bf16*)(ws + WS_WD2), M, D, FF}; pg8::StaticOrder S; S.init(M, D, F.G, (int)blockIdx.x);
        pg8::EpiF32 E{Y, D}; pg8::gemm_phase<pg8::EpiF32, pg8::StaticOrder, true, true>(F.lds + RING_OFF, g, S, E); }
    SEAM(11);
    if (IN(12)) { row_pass(F, Y, out, out, 0.5f, in.f2_post, nullptr, nullptr); }
#undef IN
#undef SEAM
}

extern "C" void kernel_launch(void* const* d_in, const int* in_sizes, int n_in, void* d_out, int out_size, void* d_ws, size_t ws_size, hipStream_t stream) {
    static int grid = 0;
    if (grid == 0) {
        if (n_in != 22 || in_sizes[0] != M * D || out_size != M * D || ws_size < WS_END) { fprintf(stderr, "kernel_launch: unexpected shapes (n_in %d, in0 %d, out %d, ws %zu); nothing launched\n", n_in, n_in > 0 ? in_sizes[0] : -1, out_size, ws_size); grid = -1; return; }
        int dev = 0, cus = 0, per_cu = 0;
        if (hipGetDevice(&dev) != hipSuccess || hipDeviceGetAttribute(&cus, hipDeviceAttributeMultiprocessorCount, dev) != hipSuccess) { grid = -1; return; }
        if (hipFuncSetAttribute((const void*)mk_fwd, hipFuncAttributeMaxDynamicSharedMemorySize, LDS_BYTES) != hipSuccess) { fprintf(stderr, "kernel_launch: hipFuncSetAttribute failed\n"); grid = -1; return; }
        if (hipOccupancyMaxActiveBlocksPerMultiprocessor(&per_cu, (const void*)mk_fwd, NWAVES * 64, LDS_BYTES) != hipSuccess || per_cu < 1)
            fprintf(stderr, "kernel_launch: note: occupancy query reports %d workgroups per CU\n", per_cu);
        (void)hipGetLastError();
        grid = cus;
    }
    if (grid < 0) return;
    if (hipMemsetAsync((char*)d_ws + WS_CTL, 0, CTL_ZERO_BYTES, stream) != hipSuccess) return;
    Args a{};
    for (int i = 0; i < 22; ++i) a.in[i] = (const float*)d_in[i];
    a.out = (float*)d_out; a.ws = (unsigned char*)d_ws;
#ifdef PROBE_RANGES
    { static const int rg[][2] = PROBE_RANGES;
      for (int li = 0; li < (int)(sizeof(rg) / sizeof(rg[0])); ++li) { a.ph_lo = rg[li][0]; a.ph_hi = rg[li][1]; a.li = li; hipLaunchKernelGGL(mk_fwd, dim3(grid), dim3(NWAVES * 64), LDS_BYTES, stream, a); } }
#else
    if (N_LAUNCHES == 1) { a.ph_lo = 0; a.ph_hi = N_PHASES; a.li = 0; hipLaunchKernelGGL(mk_fwd, dim3(grid), dim3(NWAVES * 64), LDS_BYTES, stream, a); }
    else { for (int li = 0; li < N_PHASES; ++li) { a.ph_lo = li; a.ph_hi = li + 1; a.li = 0; hipLaunchKernelGGL(mk_fwd, dim3(grid), dim3(NWAVES * 64), LDS_BYTES, stream, a); } }
#endif
}
```

```cpp
#include <hip/hip_runtime.h>
#include <cstdio>
#include <cstdint>
namespace pg8 {
#define PG8_LAS __attribute__((address_space(3)))
typedef unsigned short bf16_t;
typedef short bf16x8 __attribute__((ext_vector_type(8)));
typedef float f32x4 __attribute__((ext_vector_type(4)));
typedef unsigned u32x4 __attribute__((ext_vector_type(4)));
constexpr int BM = 256, BK = 64, HALF = 128, HTB = HALF * BK * 2  , STAGE_BYTES = 8 * HTB, NXCD = 8, WGM = 8;

__host__ __device__ __forceinline__ int lds_byte(int r, int c) { const int st = (r >> 4) * 2 + (c >> 5), rr = r & 15, cc = c & 31, ob = rr * 64 + cc * 2; return st * 1024 + (ob ^ (((ob >> 9) & 1) << 5)); }
__host__ __device__ __forceinline__ void stage_rc(int b, int& R, int& C) { const int st = b / 1024, sb = b % 1024, swz = sb ^ (((sb >> 9) & 1) << 5); R = (st >> 1) * 16 + swz / 64; C = (st & 1) * 32 + (swz % 64) / 2; }
__host__ __device__ __forceinline__ int perm32(int rho) { const int n = rho >> 4, i = rho & 15; return 8 * (i >> 2) + 4 * n + (i & 3); }

struct Unit { int pm, pn; };
struct Gemm { const bf16_t* A; const bf16_t* Bt; int M, N, K; };

struct StaticOrder {
    int nM, nN, nwg, G, c;
    __host__ __device__ void init(int M, int N, int G_, int c_) { nM = M / BM; nN = N / BM; nwg = nM * nN; G = G_; c = c_; }
    __host__ __device__ bool next(int i, Unit& u) const {
        const long L = (long)i * G + c; if (L >= nwg) return false;
        int wgid = (int)L; { const int q = nwg / NXCD, r = nwg % NXCD, xcd = wgid % NXCD, off = wgid / NXCD; wgid = (xcd < r ? xcd * (q + 1) : r * (q + 1) + (xcd - r) * q) + off; }
        const int nig = WGM * nN, gid = wgid / nig, fm = gid * WGM, gsz = (nM - fm) < WGM ? (nM - fm) : WGM;
        u.pm = fm + ((wgid % nig) % gsz); u.pn = (wgid % nig) / gsz; return true;
    }
    __device__ __forceinline__ void a_ready(const Unit&) const {}
    __device__ __forceinline__ void done(const Unit&) const {}
};

__device__ __forceinline__ unsigned cvt_pk_bf16(float lo, float hi) { unsigned r; asm volatile("v_cvt_pk_bf16_f32 %0, %1, %2" : "=v"(r) : "v"(lo), "v"(hi)); return r; }
typedef float f32x2 __attribute__((ext_vector_type(2)));
__device__ __forceinline__ float sigmoid_f(float v) { return __builtin_amdgcn_rcpf(1.0f + __builtin_amdgcn_exp2f(-1.4426950408889634f * v)); }
__device__ __forceinline__ float bf_lo(unsigned w) { return __uint_as_float(w << 16); }
__device__ __forceinline__ float bf_hi(unsigned w) { return __uint_as_float(w & 0xffff0000u); }

struct EpiSwiGLU {
    static constexpr bool PERM = true, AFTER_DRAIN = false;
    bf16_t* H; int ldh;
    __device__ __forceinline__ void operator()(const f32x4 (&acc)[2][2][4][2], const Unit& u, int wr, int wc, int fr, int fq) const {
        const int row0 = u.pm * BM + wr * 64 + fr, col0 = u.pn * HALF + wc * 32 + 8 * fq;
#pragma unroll
        for (int ai = 0; ai < 2; ++ai)
#pragma unroll
            for (int m = 0; m < 4; ++m) { bf16_t* rowp = H + (size_t)(row0 + ai * HALF + m * 16) * ldh + col0;
                const f32x4 g0 = acc[ai][0][m][0], g1 = acc[ai][0][m][1], u0 = acc[ai][1][m][0], u1 = acc[ai][1][m][1];
                float h[8];
#pragma unroll
                for (int i = 0; i < 4; ++i) { h[i] = g0[i] * sigmoid_f(g0[i]) * u0[i]; h[4 + i] = g1[i] * sigmoid_f(g1[i]) * u1[i]; }
                u32x4 w; w.x = cvt_pk_bf16(h[0], h[1]); w.y = cvt_pk_bf16(h[2], h[3]); w.z = cvt_pk_bf16(h[4], h[5]); w.w = cvt_pk_bf16(h[6], h[7]);
                *(u32x4*)rowp = w; }
    }
};
struct EpiF32 {
    static constexpr bool PERM = true, AFTER_DRAIN = false;
    float* Y; int ldc;
    __device__ __forceinline__ void operator()(const f32x4 (&acc)[2][2][4][2], const Unit& u, int wr, int wc, int fr, int fq) const {
        const int row0 = u.pm * BM + wr * 64 + fr, col0 = u.pn * BM + wc * 32 + 8 * fq;
#pragma unroll
        for (int ai = 0; ai < 2; ++ai)
#pragma unroll
            for (int m = 0; m < 4; ++m) { float* rowp = Y + (size_t)(row0 + ai * HALF + m * 16) * ldc + col0;
#pragma unroll
                for (int bj = 0; bj < 2; ++bj) { *(f32x4*)(rowp + bj * HALF) = acc[ai][bj][m][0]; *(f32x4*)(rowp + bj * HALF + 4) = acc[ai][bj][m][1]; } }
    }
};
struct EpiBranchA {
    static constexpr bool PERM = true, AFTER_DRAIN = false;
    const bf16_t* G; bf16_t* Y;
    __device__ __forceinline__ void operator()(const f32x4 (&acc)[2][2][4][2], const Unit& u, int wr, int wc, int fr, int fq) const {
        const int row0 = u.pm * BM + wr * 64 + fr, col0 = u.pn * BM + wc * 32 + 8 * fq;
#pragma unroll
        for (int ai = 0; ai < 2; ++ai)
#pragma unroll
            for (int m = 0; m < 4; ++m) { const size_t off = (size_t)(row0 + ai * HALF + m * 16) * 1024 + col0;
#pragma unroll
                for (int bj = 0; bj < 2; ++bj) { const u32x4 g = *(const u32x4*)(G + off + bj * HALF); const f32x4 a0 = acc[ai][bj][m][0], a1 = acc[ai][bj][m][1];
                    u32x4 w; w.x = cvt_pk_bf16(a0[0] * bf_lo(g.x), a0[1] * bf_hi(g.x)); w.y = cvt_pk_bf16(a0[2] * bf_lo(g.y), a0[3] * bf_hi(g.y));
                    w.z = cvt_pk_bf16(a1[0] * bf_lo(g.z), a1[1] * bf_hi(g.z)); w.w = cvt_pk_bf16(a1[2] * bf_lo(g.w), a1[3] * bf_hi(g.w));
                    *(u32x4*)(Y + off + bj * HALF) = w; } }
    }
};
struct EpiBranchB {
    static constexpr bool PERM = true, AFTER_DRAIN = false;
    const bf16_t* G; const bf16_t* Y; bf16_t* O;
    __device__ __forceinline__ void operator()(const f32x4 (&acc)[2][2][4][2], const Unit& u, int wr, int wc, int fr, int fq) const {
        const int row0 = u.pm * BM + wr * 64 + fr, col0 = u.pn * BM + wc * 32 + 8 * fq;
#pragma unroll
        for (int ai = 0; ai < 2; ++ai)
#pragma unroll
            for (int m = 0; m < 4; ++m) { const size_t off = (size_t)(row0 + ai * HALF + m * 16) * 1024 + col0;
#pragma unroll
                for (int bj = 0; bj < 2; ++bj) { const u32x4 g = *(const u32x4*)(G + off + bj * HALF), y = *(const u32x4*)(Y + off + bj * HALF); const f32x4 a0 = acc[ai][bj][m][0], a1 = acc[ai][bj][m][1];
                    u32x4 w; w.x = cvt_pk_bf16(bf_lo(y.x) + a0[0] * bf_lo(g.x), bf_hi(y.x) + a0[1] * bf_hi(g.x)); w.y = cvt_pk_bf16(bf_lo(y.y) + a0[2] * bf_lo(g.y), bf_hi(y.y) + a0[3] * bf_hi(g.y));
                    w.z = cvt_pk_bf16(bf_lo(y.z) + a1[0] * bf_lo(g.z), bf_hi(y.z) + a1[1] * bf_hi(g.z)); w.w = cvt_pk_bf16(bf_lo(y.w) + a1[2] * bf_lo(g.w), bf_hi(y.w) + a1[3] * bf_hi(g.w));
                    *(u32x4*)(O + off + bj * HALF) = w; } }
    }
};
struct EpiProj {
    static constexpr bool PERM = true, AFTER_DRAIN = false;
    bf16_t *QN, *PL, *QD, *KD, *VD, *GA, *GB; float* GN; float qscale;
    __device__ __forceinline__ void operator()(const f32x4 (&acc)[2][2][4][2], const Unit& u, int wr, int wc, int fr, int fq) const {
        const int sub = (wc & 1) * 32 + 8 * fq;
#pragma unroll
        for (int bj = 0; bj < 2; ++bj) {
            const int hidx = __builtin_amdgcn_readfirstlane(u.pn * 4 + bj * 2 + (wc >> 1));
            bf16_t* base = nullptr; long pitch = 0, bstride = 0; int mode = 0;
            if (hidx < 8) { base = QN + hidx * 64; pitch = 512; bstride = 8192L * 512; mode = 1; }
            else if (hidx < 20) { const int ti = (hidx - 8) >> 1, g = (hidx - 8) & 1; base = PL + (size_t)ti * (4u * 8192u * 64u) + (size_t)g * (8192u * 64u); pitch = 64; bstride = 2L * 8192 * 64; mode = 0; }
            else if (hidx < 32) { base = QD + (hidx - 20) * 64; pitch = 768; bstride = 8192L * 768; mode = 1; }
            else if (hidx < 44) { base = KD + (size_t)(hidx - 32) * (8192u * 64u); pitch = 64; bstride = 12L * 8192 * 64; mode = 0; }
            else if (hidx < 56) { base = VD + (size_t)(hidx - 44) * (8192u * 64u); pitch = 64; bstride = 12L * 8192 * 64; mode = 0; }
            else if (hidx < 72) { base = GA + (hidx - 56) * 64; pitch = 1024; bstride = 8192L * 1024; mode = 2; }
            else if (hidx < 88) { base = GB + (hidx - 72) * 64; pitch = 1024; bstride = 8192L * 1024; mode = 2; }
            else if (hidx == 88) mode = 3; else mode = 4;
            if (mode == 4) continue;
#pragma unroll
            for (int ai = 0; ai < 2; ++ai)
#pragma unroll
                for (int m = 0; m < 4; ++m) { const int R = u.pm * BM + ai * HALF + wr * 64 + m * 16 + fr, b = R >> 13, t = R & 8191;
                    f32x4 v0 = acc[ai][bj][m][0], v1 = acc[ai][bj][m][1];
                    if (mode == 3) { if (sub < 24) { float* p = GN + (size_t)R * 32 + sub;
#pragma unroll
                            for (int i = 0; i < 4; ++i) { v0[i] = sigmoid_f(v0[i]); v1[i] = sigmoid_f(v1[i]); }
                            *(f32x4*)p = v0; *(f32x4*)(p + 4) = v1; } }
                    else { if (mode == 1) { v0 = v0 * qscale; v1 = v1 * qscale; }
                        if (mode == 2) {
#pragma unroll
                            for (int i = 0; i < 4; ++i) { v0[i] = sigmoid_f(v0[i]); v1[i] = sigmoid_f(v1[i]); } }
                        u32x4 w; w.x = cvt_pk_bf16(v0[0], v0[1]); w.y = cvt_pk_bf16(v0[2], v0[3]); w.z = cvt_pk_bf16(v1[0], v1[1]); w.w = cvt_pk_bf16(v1[2], v1[3]);
                        *(u32x4*)(base + (size_t)b * bstride + (size_t)t * pitch + sub) = w; } }
        }
    }
};
template <class Epi, class Sched, bool ALIGN_EPI = false, bool SP2 = false>
__device__ __forceinline__ void gemm_phase(PG8_LAS unsigned char* lds, const Gemm g, const Sched& S, const Epi& E) {
    const int tid = threadIdx.x, wid = __builtin_amdgcn_readfirstlane(tid >> 6), lane = tid & 63, wr = wid >> 2, wc = wid & 3, fr = lane & 15, fq = lane >> 4;
    const int K = g.K, nt = K / BK;
    unsigned voffA[2], voffB[2];
#pragma unroll
    for (int i = 0; i < 2; ++i) { int R, C; stage_rc(tid * 16 + i * 8192, R, C); const int Rb = Epi::PERM ? ((R & ~31) + perm32(R & 31)) : R;
        voffA[i] = (unsigned)(R * K + C) * 2u; voffB[i] = (unsigned)(Rb * K + C) * 2u; }
    const size_t kstep = (size_t)(BK * 2);
    const size_t hstep = (size_t)HALF * K * 2;
    const size_t tstep = 2 * hstep;
    const unsigned ldsw = (unsigned)wid * 1024u;
    const int aoff = lds_byte(wr * 64 + fr, fq * 8), boff = lds_byte(wc * 32 + fr, fq * 8);
#define PG8_SA(b, h) (((b) * 2 + (h)) * HTB)
#define PG8_SB(b, h) ((4 + (b) * 2 + (h)) * HTB)
#define PG8_STAGE(bufoff, gbase, voff) do { _Pragma("unroll") for (int _i = 0; _i < 2; ++_i) \
        __builtin_amdgcn_global_load_lds((const unsigned*)((const char*)(gbase) + (voff)[_i]), (PG8_LAS unsigned*)(lds + (bufoff) + ldsw + _i * 8192), 16, 0, 0); } while (0)
#define PG8_LDA(dst, b, h) do { _Pragma("unroll") for (int m = 0; m < 4; ++m) _Pragma("unroll") for (int k = 0; k < 2; ++k) dst[m][k] = *(const PG8_LAS bf16x8*)(lds + PG8_SA(b, h) + aoff + m * 2048 + k * 1024); } while (0)
#define PG8_LDB(dst, b, h) do { _Pragma("unroll") for (int n = 0; n < 2; ++n) _Pragma("unroll") for (int k = 0; k < 2; ++k) dst[n][k] = *(const PG8_LAS bf16x8*)(lds + PG8_SB(b, h) + boff + n * 2048 + k * 1024); } while (0)
#define PG8_MMA(ai, bj, At, Bt) do { __builtin_amdgcn_s_setprio(1); _Pragma("unroll") for (int m = 0; m < 4; ++m) _Pragma("unroll") for (int n = 0; n < 2; ++n) _Pragma("unroll") for (int k = 0; k < 2; ++k) \
        acc[ai][bj][m][n] = __builtin_amdgcn_mfma_f32_16x16x32_bf16(Bt[n][k], At[m][k], acc[ai][bj][m][n], 0, 0, 0); __builtin_amdgcn_s_setprio(0); } while (0)
#define PG8_WAIT_V(n) asm volatile("s_waitcnt vmcnt(" #n ")" ::: "memory")
#define PG8_WAIT_L(n) asm volatile("s_waitcnt lgkmcnt(" #n ")" ::: "memory")
#define PG8_BAR __builtin_amdgcn_s_barrier()
#define PG8_SCHED __builtin_amdgcn_sched_barrier(0)
    Unit cur, nxt; int ui = 0;
    if (!S.next(0, cur)) return;
    f32x4 acc[2][2][4][2];
#pragma unroll
    for (int a = 0; a < 2; ++a)
#pragma unroll
        for (int b = 0; b < 2; ++b)
#pragma unroll
            for (int m = 0; m < 4; ++m)
#pragma unroll
                for (int n = 0; n < 2; ++n) acc[a][b][m][n] = (f32x4){0.f, 0.f, 0.f, 0.f};
    bf16x8 At[4][2], B0[2][2], B1[2][2];
    const char* cA = (const char*)g.A + (size_t)cur.pm * tstep; const char* cB = (const char*)g.Bt + (size_t)cur.pn * tstep;
    S.a_ready(cur);
    if constexpr (SP2) {
        PG8_STAGE(PG8_SB(0, 0), cB, voffB); PG8_STAGE(PG8_SB(0, 1), cB + hstep, voffB); PG8_STAGE(PG8_SA(0, 0), cA, voffA); PG8_STAGE(PG8_SA(0, 1), cA + hstep, voffA);
        if (wr == 1) PG8_BAR;
        PG8_WAIT_V(2); PG8_BAR;
        PG8_STAGE(PG8_SB(1, 0), cB + kstep, voffB); PG8_STAGE(PG8_SA(1, 0), cA + kstep, voffA); PG8_STAGE(PG8_SB(1, 1), cB + hstep + kstep, voffB);
        PG8_WAIT_V(6); PG8_BAR;
    } else {
        PG8_STAGE(PG8_SB(0, 0), cB, voffB); PG8_STAGE(PG8_SA(0, 0), cA, voffA); PG8_STAGE(PG8_SB(0, 1), cB + hstep, voffB); PG8_STAGE(PG8_SA(0, 1), cA + hstep, voffA);
        if (wr == 1) PG8_BAR;
        PG8_WAIT_V(4); PG8_BAR;
        PG8_STAGE(PG8_SB(1, 0), cB + kstep, voffB); PG8_STAGE(PG8_SA(1, 0), cA + kstep, voffA); PG8_STAGE(PG8_SB(1, 1), cB + hstep + kstep, voffB);
        PG8_WAIT_V(6); PG8_BAR;
    }
    for (;;) {
        const bool has_next = S.next(ui + 1, nxt);
        const char* nA = has_next ? (const char*)g.A + (size_t)nxt.pm * tstep : cA; const char* nB = has_next ? (const char*)g.Bt + (size_t)nxt.pn * tstep : cB;
        for (int t = 0; t < nt; t += 2) {
            const bool last = (t == nt - 2);
            const char* a1 = cA + (size_t)(t + 1) * kstep;
            const char* a2 = last ? nA : cA + (size_t)(t + 2) * kstep; const char* b2 = last ? nB : cB + (size_t)(t + 2) * kstep;
            const char* a3 = a2 + kstep; const char* b3 = b2 + kstep;
            if (last && has_next) S.a_ready(nxt);
            if constexpr (SP2) {
            PG8_LDB(B0, 0, 0); PG8_LDB(B1, 0, 1); PG8_SCHED; PG8_LDA(At, 0, 0); PG8_STAGE(PG8_SA(1, 1), a1 + hstep, voffA);
            PG8_WAIT_V(8); PG8_WAIT_L(0); PG8_BAR; PG8_MMA(0, 0, At, B0); PG8_MMA(0, 1, At, B1); PG8_BAR; PG8_SCHED;
            PG8_LDA(At, 0, 1); PG8_STAGE(PG8_SB(0, 0), b2, voffB); PG8_STAGE(PG8_SB(0, 1), b2 + hstep, voffB); PG8_STAGE(PG8_SA(0, 0), a2, voffA);
            PG8_WAIT_V(8); PG8_WAIT_L(0); PG8_BAR; PG8_MMA(1, 0, At, B0); PG8_MMA(1, 1, At, B1); PG8_BAR; PG8_SCHED;
            PG8_LDB(B0, 1, 0); PG8_LDB(B1, 1, 1); PG8_SCHED; PG8_LDA(At, 1, 0); PG8_STAGE(PG8_SA(0, 1), a2 + hstep, voffA);
            PG8_WAIT_V(8); PG8_WAIT_L(0); PG8_BAR; PG8_MMA(0, 0, At, B0); PG8_MMA(0, 1, At, B1); PG8_BAR; PG8_SCHED;
            PG8_LDA(At, 1, 1); PG8_STAGE(PG8_SB(1, 0), b3, voffB); PG8_STAGE(PG8_SB(1, 1), b3 + hstep, voffB); PG8_STAGE(PG8_SA(1, 0), a3, voffA);
            PG8_WAIT_V(8); PG8_WAIT_L(0); PG8_BAR; PG8_MMA(1, 0, At, B0); PG8_MMA(1, 1, At, B1); PG8_BAR; PG8_SCHED;
            } else {
            PG8_LDB(B0, 0, 0); PG8_SCHED; PG8_LDA(At, 0, 0); PG8_STAGE(PG8_SA(1, 1), a1 + hstep, voffA);
            PG8_WAIT_L(8); PG8_BAR; PG8_WAIT_L(0); PG8_MMA(0, 0, At, B0); PG8_BAR; PG8_SCHED;
            PG8_LDB(B1, 0, 1); PG8_STAGE(PG8_SB(0, 0), b2, voffB);
            PG8_BAR; PG8_WAIT_L(0); PG8_MMA(0, 1, At, B1); PG8_BAR;
            PG8_LDA(At, 0, 1); PG8_STAGE(PG8_SA(0, 0), a2, voffA);
            PG8_BAR; PG8_WAIT_L(0); PG8_MMA(1, 0, At, B0); PG8_BAR; PG8_SCHED;
            PG8_STAGE(PG8_SB(0, 1), b2 + hstep, voffB);
            PG8_WAIT_V(6); PG8_BAR; PG8_MMA(1, 1, At, B1); PG8_BAR;
            PG8_LDB(B0, 1, 0); PG8_SCHED; PG8_LDA(At, 1, 0); PG8_STAGE(PG8_SA(0, 1), a2 + hstep, voffA);
            PG8_WAIT_L(8); PG8_BAR; PG8_WAIT_L(0); PG8_MMA(0, 0, At, B0); PG8_BAR; PG8_SCHED;
            PG8_LDB(B1, 1, 1); PG8_STAGE(PG8_SB(1, 0), b3, voffB);
            PG8_BAR; PG8_WAIT_L(0); PG8_MMA(0, 1, At, B1); PG8_BAR;
            PG8_LDA(At, 1, 1); PG8_STAGE(PG8_SA(1, 0), a3, voffA);
            PG8_BAR; PG8_WAIT_L(0); PG8_MMA(1, 0, At, B0); PG8_BAR; PG8_SCHED;
            PG8_STAGE(PG8_SB(1, 1), b3 + hstep, voffB);
            PG8_WAIT_V(6); PG8_BAR; PG8_MMA(1, 1, At, B1); PG8_BAR;
            }
        }
        if constexpr (ALIGN_EPI) { if (wr == 0) PG8_BAR; }
        if constexpr (!Epi::AFTER_DRAIN) { E(acc, cur, wr, wc, fr, fq); S.done(cur); }
        if (!has_next) break;
#pragma unroll
        for (int a = 0; a < 2; ++a)
#pragma unroll
            for (int b = 0; b < 2; ++b)
#pragma unroll
                for (int m = 0; m < 4; ++m)
#pragma unroll
                    for (int n = 0; n < 2; ++n) acc[a][b][m][n] = (f32x4){0.f, 0.f, 0.f, 0.f};
        cur = nxt; cA = nA; cB = nB; ++ui;
        if constexpr (ALIGN_EPI) { if (wr == 1) PG8_BAR; }
    }
    PG8_WAIT_V(0);
    if constexpr (!ALIGN_EPI) { if (wr == 0) PG8_BAR; }
    PG8_BAR;
    if constexpr (Epi::AFTER_DRAIN) { E.fused(acc, cur, wr, wc, fr, fq, lds, wid, lane); S.done(cur); }
#undef PG8_SA
#undef PG8_SB
#undef PG8_STAGE
#undef PG8_LDA
#undef PG8_LDB
#undef PG8_MMA
#undef PG8_WAIT_V
#undef PG8_WAIT_L
#undef PG8_BAR
#undef PG8_SCHED
}
}
#define GAS __attribute__((address_space(1)))
#define LAS __attribute__((address_space(3)))
typedef unsigned short bf16;
typedef unsigned v4u __attribute__((ext_vector_type(4)));
typedef float f32x4 __attribute__((ext_vector_type(4)));
typedef short bf16x8 __attribute__((ext_vector_type(8)));
typedef GAS unsigned gu32;
typedef GAS unsigned long long gu64;
#define RLX_AGENT __ATOMIC_RELAXED, __HIP_MEMORY_SCOPE_AGENT
#define LDS_WAIT() asm volatile("s_waitcnt lgkmcnt(0)" ::: "memory")
#define VM_WAIT() asm volatile("s_waitcnt vmcnt(0)" ::: "memory")
__device__ __forceinline__ unsigned long long rt() { return __builtin_amdgcn_s_memrealtime(); }
__device__ __forceinline__ unsigned f2bf(float f) { unsigned u = __builtin_bit_cast(unsigned, f); return (u + 0x7fffu + ((u >> 16) & 1u)) >> 16; }
__device__ __forceinline__ unsigned pk2(float lo, float hi) { return f2bf(lo) | (f2bf(hi) << 16); }

#define XB_TMO      128
#define XB_XCNT(j)  (256  + 64 * (j))
#define XB_XSUB(j)  (1280 + 64 * (j))
#define XB_XGEN(j)  (2304 + 64 * (j))
#define XB_TOP      3328
#define XB_TOPGEN   3392
#define XCD_BAR_WORDS 3456
#define XB_SPIN_CAP (1u << 18)

__device__ __forceinline__ unsigned xb_ld(unsigned* p)              { return __hip_atomic_load(p, __ATOMIC_RELAXED, __HIP_MEMORY_SCOPE_AGENT); }
__device__ __forceinline__ unsigned xb_add(unsigned* p, unsigned v) { return __hip_atomic_fetch_add(p, v, __ATOMIC_RELAXED, __HIP_MEMORY_SCOPE_AGENT); }
__device__ __forceinline__ unsigned xb_xcc_id() { return (unsigned)__builtin_amdgcn_s_getreg((3 << 11) | 20) & 0xFu; }
#define XB_SPIN(cond, bar) do { unsigned _sp = 0; while (cond) { __builtin_amdgcn_s_sleep(1); \
    if ((++_sp & 255u) == 0u) { if (xb_ld(&(bar)[XB_TMO])) break; if (_sp > XB_SPIN_CAP) { atomicAdd(&(bar)[XB_TMO], 1u); break; } } } } while (0)

struct XcdBarrier {
    unsigned* bar; unsigned x;
    volatile LAS unsigned* st;
};

__device__ __forceinline__ XcdBarrier xcd_barrier_post(unsigned* bar, volatile LAS unsigned* st) {
    XcdBarrier b; b.bar = bar; b.x = xb_xcc_id(); b.st = st;
    if (threadIdx.x == 0) (void)xb_add(&bar[XB_XCNT(b.x)], 1u);
    return b;
}
__device__ __forceinline__ void xcd_barrier_complete(unsigned* bar, unsigned x, unsigned& nloc, unsigned& nx) {
    const unsigned G = gridDim.x * gridDim.y * gridDim.z;
    unsigned sum, cnt, mine, sp = 0u;
    for (;;) {
        sum = 0u; cnt = 0u; mine = 0u;
#pragma unroll
        for (unsigned j = 0; j < 16; ++j) { const unsigned c = xb_ld(&bar[XB_XCNT(j)]); sum += c; cnt += (c > 0u) ? 1u : 0u; mine = (j == x) ? c : mine; }
        if (sum == G) break;
        __builtin_amdgcn_s_sleep(1);
        if ((++sp & 255u) == 0u) { if (xb_ld(&bar[XB_TMO])) break; if (sp > XB_SPIN_CAP) { atomicAdd(&bar[XB_TMO], 1u); break; } }
    }
    nloc = mine > 0u ? mine : 1u; nx = cnt > 0u ? cnt : 1u;
}

__device__ __forceinline__ void xcd_barrier(const XcdBarrier& b) {
    asm volatile("s_waitcnt vmcnt(0)" ::: "memory");
    __syncthreads();
    if (threadIdx.x == 0) {
        unsigned* bar = b.bar;
        __builtin_amdgcn_s_waitcnt(0);
        unsigned nloc = b.st[0], nx = b.st[1];
        if (nloc == 0u) { xcd_barrier_complete(bar, b.x, nloc, nx); b.st[0] = nloc; b.st[1] = nx; }
        const unsigned old = xb_add(&bar[XB_XSUB(b.x)], 1u);
        const unsigned gen = old / nloc;
        if (old + 1u == (gen + 1u) * nloc) {
            __builtin_amdgcn_fence(__ATOMIC_RELEASE, "agent");
            asm volatile("s_waitcnt vmcnt(0)" ::: "memory");
            const unsigned og = xb_add(&bar[XB_TOP], 1u);
            const unsigned tg = og / nx;
            if (og + 1u == (tg + 1u) * nx) xb_add(&bar[XB_TOPGEN], 1u);
            else XB_SPIN(xb_ld(&bar[XB_TOPGEN]) == tg, bar);
            __builtin_amdgcn_fence(__ATOMIC_ACQUIRE, "agent");
            xb_add(&bar[XB_XGEN(b.x)], 1u);
            asm volatile("s_waitcnt vmcnt(0)" ::: "memory");
        } else {
            XB_SPIN(xb_ld(&bar[XB_XGEN(b.x)]) == gen, bar);
            __builtin_amdgcn_fence(__ATOMIC_ACQUIRE, "agent");
            asm volatile("s_waitcnt vmcnt(0)" ::: "memory");
        }
    }
    __syncthreads();
}

constexpr int NWAVES = 8;
constexpr int BATCH = 2, SEQ = 8192, D = 1024, FF = 2816, M = BATCH * SEQ;
constexpr int NPROJ_SRC = 5656, NPROJ = 5888;
constexpr float RMS_EPS = 1e-6f;
constexpr float LOG2E = 1.4426950408889634f;
constexpr float QSCALE = 0.125f * LOG2E;

constexpr size_t MiB = 1u << 20;
constexpr size_t WS_CTL = 0, CTL_ZERO_BYTES = 64 * 1024;
constexpr size_t WS_LUTN = 1 * MiB;
constexpr size_t WS_LUTD = WS_LUTN + 64 * 1024;
constexpr size_t WS_CB = WS_LUTD + 16 * 1024;
constexpr size_t WS_KCMP = 1 * MiB + 256 * 1024, WS_VCMP = WS_KCMP + 256 * 1024;
constexpr size_t WS_WIN = 2 * MiB;
constexpr size_t WS_WC1K = WS_WIN + (size_t)NPROJ * D * 2;
constexpr size_t WS_WC1V = WS_WC1K + 1 * MiB;
constexpr size_t WS_WC2K = WS_WC1V + 1 * MiB;
constexpr size_t WS_WC2V = WS_WC2K + 32 * 1024;
constexpr size_t WS_WBN = WS_WC2V + 32 * 1024;
constexpr size_t WS_WBD = WS_WBN + 1 * MiB;
constexpr size_t WS_WOUT = WS_WBD + MiB / 2;
constexpr size_t WS_WGU2 = WS_WOUT + 2 * MiB;
constexpr size_t WS_WD2 = WS_WGU2 + (size_t)2 * FF * D * 2;
constexpr size_t WS_WGU1 = 36 * MiB;
constexpr size_t WS_WD1 = WS_WGU1 + (size_t)2 * FF * D * 2;
static_assert(WS_WD2 + (size_t)D * FF * 2 <= WS_WGU1, "weights A");
static_assert(WS_WD1 + (size_t)D * FF * 2 <= 53 * MiB, "weights B");
constexpr size_t WS_QN = 36 * MiB;
constexpr size_t WS_XN = 53 * MiB;
constexpr size_t WS_MG = 141 * MiB;
constexpr size_t WS_YN = 69 * MiB;
constexpr size_t WS_H = 85 * MiB;
constexpr size_t WS_Y = 173 * MiB;
constexpr size_t WS_PL = 85 * MiB;
constexpr size_t WS_QD = 109 * MiB;
constexpr size_t WS_KD = 133 * MiB, WS_VD = 157 * MiB;
constexpr size_t WS_GA = 181 * MiB, WS_GB = 213 * MiB;
constexpr size_t WS_GN = 245 * MiB;
constexpr size_t WS_YD = 247 * MiB;
constexpr size_t WS_Y2P = 109 * MiB;
constexpr size_t WS_END = 256 * MiB;
static_assert(WS_H + (size_t)M * FF * 2 <= WS_Y && WS_Y + (size_t)M * D * 4 <= WS_END, "ffn map");
static_assert(WS_YD + (size_t)M * 256 * 2 <= WS_END && WS_GN + (size_t)M * 32 * 4 <= WS_YD && WS_Y2P + (size_t)M * D * 2 <= WS_MG && WS_MG + (size_t)M * D * 2 <= WS_GA, "mixer map");
constexpr size_t PLSZ = (size_t)4 * 8192 * 64;
constexpr int CW_TMO = 0, CW_BAR = 1024;

constexpr int RING_OFF = 0, RING_BYTES = 131072;
constexpr int LDSCTL_OFF = 143360, MISC_OFF = LDSCTL_OFF + 320;
constexpr int LDS_BYTES = 147456;
constexpr int LUT_PAD = 64, LUTW = 1672;
constexpr int A_KV = 0;
constexpr int A_LUT = 65536;
constexpr int A_IMP = A_LUT + 4 * LUTW * 4;
constexpr int IMP_S = 132;
constexpr int A_SEL = A_IMP + 64 * IMP_S * 4;
constexpr int A_UM = A_SEL + 64 * 16;
constexpr int A_WSF = A_UM + 64;
constexpr int A_END = A_WSF + 8 * 512;
static_assert(A_END <= LDSCTL_OFF, "attention LDS");
constexpr size_t WS_OD = 53 * MiB;
constexpr size_t WS_LSE = 255 * MiB;

__device__ __forceinline__ int fresh_tid() { int t = threadIdx.x; asm volatile("" : "+v"(t)); return t; }
struct Frame {
    LAS unsigned char* lds;
    volatile LAS unsigned* MISC;
    gu32* ctl;
    int vcu, G;
};

__device__ __forceinline__ float wave_sum(float v) {
#pragma unroll
    for (int o = 1; o < 64; o <<= 1) v += __shfl_xor(v, o);
    return v;
}
template <bool FRAG = false> __device__ __forceinline__ void tr_item(const float* W, int K, int Nsrc, int sc0, int nvalid, bf16* WT, int dr0, int kb, LAS float* scr, int lane) {
    const int k0 = 64 * kb;
#pragma unroll 8
    for (int i = 0; i < 32; ++i) { const int kk = 2 * i + (lane >> 5), n = lane & 31; scr[kk * 33 + n] = (n < nvalid) ? W[(size_t)(k0 + kk) * Nsrc + sc0 + n] : 0.f; }
    LDS_WAIT(); asm volatile("" ::: "memory");
    const int c = lane & 7;
#pragma unroll
    for (int j = 0; j < 4; ++j) { const int n = (lane >> 3) + 8 * j; const LAS float* s = scr + (8 * c) * 33 + n;
        v4u o; o.x = pk2(s[0 * 33], s[1 * 33]); o.y = pk2(s[2 * 33], s[3 * 33]); o.z = pk2(s[4 * 33], s[5 * 33]); o.w = pk2(s[6 * 33], s[7 * 33]);
        const int ng = dr0 + n, kk = k0 + 8 * c;
        const size_t off = FRAG ? ((size_t)(((ng >> 5) * (K >> 4) + (kk >> 4)) * 64 + ((kk >> 3) & 1) * 32 + (ng & 31)) * 8) : ((size_t)ng * K + kk);
        *(GAS v4u*)(WT + off) = o; }
    LDS_WAIT(); asm volatile("" ::: "memory");
}
__device__ __forceinline__ void win_map(int dblk, int& sc0, int& nvalid) {
    const int hidx = dblk >> 1, half = dblk & 1; nvalid = 32;
    if (hidx < 8) sc0 = hidx * 64 + half * 32;
    else if (hidx < 20) sc0 = 512 + (hidx - 8) * 64 + half * 32;
    else if (hidx < 32) sc0 = 1304 + (hidx - 20) * 64 + half * 32;
    else if (hidx < 44) sc0 = 2072 + (hidx - 32) * 64 + half * 32;
    else if (hidx < 56) sc0 = 2840 + (hidx - 44) * 64 + half * 32;
    else if (hidx < 72) sc0 = 3608 + (hidx - 56) * 64 + half * 32;
    else if (hidx < 88) sc0 = 4632 + (hidx - 72) * 64 + half * 32;
    else if (hidx == 88 && half == 0) { sc0 = 1280; nvalid = 24; }
    else { sc0 = 0; nvalid = 0; }
}
__device__ __forceinline__ void gu_map(int dblk, int& sc0) { const int pn = dblk >> 3, q = dblk & 7; sc0 = (q < 4) ? (128 * pn + 32 * q) : (FF + 128 * pn + 32 * (q - 4)); }
__device__ __forceinline__ int t5_bucket(int d) {
    if (d < 16) return d;
    int b = 16;
    b += (d >= 22); b += (d >= 30); b += (d >= 40); b += (d >= 54); b += (d >= 73); b += (d >= 99); b += (d >= 134); b += (d >= 182);
    b += (d >= 246); b += (d >= 332); b += (d >= 450); b += (d >= 609); b += (d >= 825); b += (d >= 1117); b += (d >= 1513);
    return b;
}
struct In {
    const float *x, *f1_pre, *f1_wgu, *f1_wd, *f1_post, *mix_pre, *w_in, *cpos_k, *cw1_k, *cw2_k, *cpos_v, *cw1_v, *cw2_v, *w_bn, *w_bd, *w_out, *mix_post, *f2_pre, *f2_wgu, *f2_wd, *f2_post, *rel_bias;
};
__device__ __forceinline__ void rms_row_to_bf16(const float* xrow, const float* gain, bf16* orow, int lane) {
    const GAS f32x4* xr = (const GAS f32x4*)xrow + lane; const GAS f32x4* gr = (const GAS f32x4*)gain + lane;
    f32x4 v[4]; float s = 0.f;
#pragma unroll
    for (int j = 0; j < 4; ++j) { v[j] = xr[64 * j]; s += (v[j].x * v[j].x + v[j].y * v[j].y) + (v[j].z * v[j].z + v[j].w * v[j].w); }
    const float r = 1.f / sqrtf(wave_sum(s) * (1.f / D) + RMS_EPS);
    GAS unsigned long long* o8 = (GAS unsigned long long*)orow + lane;
#pragma unroll
    for (int j = 0; j < 4; ++j) { const f32x4 g = gr[64 * j]; o8[64 * j] = (unsigned long long)pk2(v[j].x * r * g.x, v[j].y * r * g.y) | ((unsigned long long)pk2(v[j].z * r * g.z, v[j].w * r * g.w) << 32); }
}
__device__ __forceinline__ void p0_prologue(Frame& F, const In& in, unsigned char* ws) {
    const int tid = fresh_tid(), lane = tid & 63, wave = __builtin_amdgcn_readfirstlane(tid >> 6);
    LAS float* scr = (LAS float*)(F.lds + RING_OFF + wave * 16384);
    const int gw = F.vcu * NWAVES + wave, NGW = F.G * NWAVES;
    constexpr int I_GU = 176 * 16, I_D = 32 * 44, I_IN = 184 * 16, I_C1 = 8 * 32, I_C2 = 2 * 4, I_BN = 32 * 8, I_BD = 32 * 4, I_O = 32 * 16;
    constexpr int NITEMS = 2 * I_GU + 2 * I_D + I_IN + 2 * I_C1 + 2 * I_C2 + I_BN + I_BD + I_O;
    for (int it = gw; it < NITEMS; it += NGW) {
        int r = it, sc0, nv = 32;
        if (r < I_GU) { const int dblk = r / 16, kb = r % 16; gu_map(dblk, sc0); tr_item(in.f1_wgu, D, 2 * FF, sc0, 32, (bf16*)(ws + WS_WGU1), dblk * 32, kb, scr, lane); continue; } r -= I_GU;
        if (r < I_GU) { const int dblk = r / 16, kb = r % 16; gu_map(dblk, sc0); tr_item(in.f2_wgu, D, 2 * FF, sc0, 32, (bf16*)(ws + WS_WGU2), dblk * 32, kb, scr, lane); continue; } r -= I_GU;
        if (r < I_D) { const int dblk = r / 44, kb = r % 44; tr_item(in.f1_wd, FF, D, dblk * 32, 32, (bf16*)(ws + WS_WD1), dblk * 32, kb, scr, lane); continue; } r -= I_D;
        if (r < I_D) { const int dblk = r / 44, kb = r % 44; tr_item(in.f2_wd, FF, D, dblk * 32, 32, (bf16*)(ws + WS_WD2), dblk * 32, kb, scr, lane); continue; } r -= I_D;
        if (r < I_IN) { const int dblk = r / 16, kb = r % 16; win_map(dblk, sc0, nv); tr_item(in.w_in, D, NPROJ_SRC, sc0, nv, (bf16*)(ws + WS_WIN), dblk * 32, kb, scr, lane); continue; } r -= I_IN;
        if (r < I_C1) { const int dblk = r / 32, kb = r % 32; tr_item<true>(in.cw1_k, 2048, 256, dblk * 32, 32, (bf16*)(ws + WS_WC1K), dblk * 32, kb, scr, lane); continue; } r -= I_C1;
        if (r < I_C1) { const int dblk = r / 32, kb = r % 32; tr_item<true>(in.cw1_v, 2048, 256, dblk * 32, 32, (bf16*)(ws + WS_WC1V), dblk * 32, kb, scr, lane); continue; } r -= I_C1;
        if (r < I_C2) { const int dblk = r / 4, kb = r % 4; tr_item(in.cw2_k, 256, 64, dblk * 32, 32, (bf16*)(ws + WS_WC2K), dblk * 32, kb, scr, lane); continue; } r -= I_C2;
        if (r < I_C2) { const int dblk = r / 4, kb = r % 4; tr_item(in.cw2_v, 256, 64, dblk * 32, 32, (bf16*)(ws + WS_WC2V), dblk * 32, kb, scr, lane); continue; } r -= I_C2;
        if (r < I_BN) { const int dblk = r / 8, kb = r % 8; tr_item(in.w_bn, 512, D, dblk * 32, 32, (bf16*)(ws + WS_WBN), dblk * 32, kb, scr, lane); continue; } r -= I_BN;
        if (r < I_BD) { const int dblk = r / 4, kb = r % 4; tr_item(in.w_bd, 256, D, dblk * 32, 32, (bf16*)(ws + WS_WBD), dblk * 32, kb, scr, lane); continue; } r -= I_BD;
        { const int dblk = r / 16, kb = r % 16; tr_item(in.w_out, D, D, dblk * 32, 32, (bf16*)(ws + WS_WOUT), dblk * 32, kb, scr, lane); }
    }
    { float* ln = (float*)(ws + WS_LUTN); float* ld = (float*)(ws + WS_LUTD); const int gt = F.vcu * (NWAVES * 64) + tid, NGT = F.G * NWAVES * 64;
      for (int e = gt; e < 8 * LUTW; e += NGT) { const int hd = e / LUTW, d = e % LUTW - LUT_PAD; ln[e] = (d >= 0) ? in.rel_bias[t5_bucket(d) * 20 + hd] * LOG2E : 0.f; }
      for (int e = gt; e < 12 * 320; e += NGT) { const int hd = e / 320, st = e % 320 - LUT_PAD; const int dil = 1 << (2 * (hd >> 2)); ld[e] = (st >= 0 && st <= 128) ? in.rel_bias[t5_bucket(st * dil) * 20 + 8 + hd] * LOG2E : 0.f; } }
    { float* cb = (float*)(ws + WS_CB);
      for (int o = gw; o < 512; o += NGW) { const int ts = o >> 8, n = o & 255; const float* pos = ts ? in.cpos_v : in.cpos_k; const float* w1 = ts ? in.cw1_v : in.cw1_k;
          float s = 0.f; for (int k = lane; k < 2048; k += 64) s += pos[k] * w1[(size_t)k * 256 + n];
          s = wave_sum(s); if (lane == 0) cb[o] = s; } }
    for (int m = gw; m < M; m += NGW) rms_row_to_bf16(in.x + (size_t)m * D, in.f1_pre, (bf16*)(ws + WS_XN) + (size_t)m * D, lane);
}
__device__ __forceinline__ void row_pass(Frame& F, const float* Y, const float* base, float* out, float alpha, const float* gpost, const float* gnext, bf16* XN) {
    const int tid = fresh_tid(), lane = tid & 63, wave = __builtin_amdgcn_readfirstlane(tid >> 6);
    const int gw = F.vcu * NWAVES + wave, NGW = F.G * NWAVES;
    for (int m = gw; m < M; m += NGW) {
        const GAS f32x4* yr = (const GAS f32x4*)(Y + (size_t)m * D) + lane; const GAS f32x4* br = (const GAS f32x4*)(base + (size_t)m * D) + lane;
        const GAS f32x4* gp = (const GAS f32x4*)gpost + lane;
        f32x4 v[4], bv[4]; float s = 0.f;
#pragma unroll
        for (int j = 0; j < 4; ++j) { v[j] = yr[64 * j]; bv[j] = br[64 * j]; s += (v[j].x * v[j].x + v[j].y * v[j].y) + (v[j].z * v[j].z + v[j].w * v[j].w); }
        const float r = alpha / sqrtf(wave_sum(s) * (1.f / D) + RMS_EPS);
        float s2 = 0.f;
        GAS f32x4* orow = (GAS f32x4*)(out + (size_t)m * D) + lane;
#pragma unroll
        for (int j = 0; j < 4; ++j) { const f32x4 g = gp[64 * j]; v[j] = bv[j] + v[j] * r * g; orow[64 * j] = v[j]; s2 += (v[j].x * v[j].x + v[j].y * v[j].y) + (v[j].z * v[j].z + v[j].w * v[j].w); }
        if (gnext) {
            const float r2 = 1.f / sqrtf(wave_sum(s2) * (1.f / D) + RMS_EPS);
            const GAS f32x4* gn = (const GAS f32x4*)gnext + lane;
            GAS unsigned long long* o8 = (GAS unsigned long long*)(XN + (size_t)m * D) + lane;
#pragma unroll
            for (int j = 0; j < 4; ++j) { const f32x4 g = gn[64 * j]; o8[64 * j] = (unsigned long long)pk2(v[j].x * r2 * g.x, v[j].y * r2 * g.y) | ((unsigned long long)pk2(v[j].z * r2 * g.z, v[j].w * r2 * g.w) << 32); }
        }
    }
}

namespace att {
typedef float f32x16 __attribute__((ext_vector_type(16)));
typedef short s16x4 __attribute__((ext_vector_type(4)));
typedef short v4i16_t __attribute__((ext_vector_type(4)));
constexpr float NEGV = -1.0e30f;
constexpr int TILE_B = 16384, SBUF = 2 * TILE_B;
enum { CLS_SKIP = 0, CLS_FULL = 1, CLS_PART = 2, CLS_CONST = 3 };
__device__ __forceinline__ constexpr int crow(int r, int hi) { return (r & 3) + 8 * (r >> 2) + 4 * hi; }
__device__ __forceinline__ unsigned cvtpk(float lo, float hi) { unsigned r; asm volatile("v_cvt_pk_bf16_f32 %0, %1, %2" : "=v"(r) : "v"(lo), "v"(hi)); return r; }
__device__ __forceinline__ float swapmax(float v) { auto rr = __builtin_amdgcn_permlane32_swap(__float_as_uint(v), __float_as_uint(v), false, false); return fmaxf(__uint_as_float(rr[0]), __uint_as_float(rr[1])); }
__device__ __forceinline__ float swapsum(float v) { auto rr = __builtin_amdgcn_permlane32_swap(__float_as_uint(v), __float_as_uint(v), false, false); return __uint_as_float(rr[0]) + __uint_as_float(rr[1]); }
__device__ __forceinline__ float quadsum(float v) {
    v += __int_as_float(__builtin_amdgcn_mov_dpp(__float_as_int(v), 0xB1, 0xF, 0xF, true));
    v += __int_as_float(__builtin_amdgcn_mov_dpp(__float_as_int(v), 0x4E, 0xF, 0xF, true));
    return v;
}
struct Stage { v4u k, v; };
struct Stage2 { Stage t[2]; };
__device__ __forceinline__ void tile_load(Stage& s, const bf16* Kp, const bf16* Vp, long row, int tid) {
    const int ch = tid & 7; s.k = *(const GAS v4u*)(Kp + row * 64 + ch * 8); s.v = *(const GAS v4u*)(Vp + row * 64 + ch * 8);
}
__device__ __forceinline__ void tile_store(LAS unsigned char* buf, const Stage& s, int tid) {
    const int key = tid >> 3, ch = tid & 7;
    *(LAS v4u*)(buf + ch * 1024 + key * 16) = s.k;
    *(LAS v4u*)(buf + 8192 + (ch >> 2) * 4096 + key * 64 + (ch & 3) * 16) = s.v;
}
#define ATT_BAR() asm volatile("s_waitcnt lgkmcnt(0)\n\ts_barrier" ::: "memory")
__device__ __forceinline__ void qk(f32x16& p0, f32x16& p1, const LAS unsigned char* kb, const bf16x8 (&qr)[4]) {
#pragma unroll
    for (int d0 = 0; d0 < 4; ++d0) {
        const bf16x8 b0 = *(const LAS bf16x8*)(kb + d0 * 2048), b1 = *(const LAS bf16x8*)(kb + d0 * 2048 + 512);
        p0 = __builtin_amdgcn_mfma_f32_32x32x16_bf16(b0, qr[d0], p0, 0, 0, 0);
        p1 = __builtin_amdgcn_mfma_f32_32x32x16_bf16(b1, qr[d0], p1, 0, 0, 0);
    }
}
__device__ __forceinline__ float max3f(float a, float b, float c) { float r; asm("v_max3_f32 %0, %1, %2, %3" : "=v"(r) : "v"(a), "v"(b), "v"(c)); return r; }
__device__ __forceinline__ float rowmax32(const f32x16& p0, const f32x16& p1) {
    float a = max3f(p0[0], p1[0], p0[1]), b = max3f(p1[1], p0[2], p1[2]);
#pragma unroll
    for (int r = 3; r < 15; r += 2) { a = max3f(a, p0[r], p1[r]); b = max3f(b, p0[r + 1], p1[r + 1]); }
    a = max3f(a, p0[15], p1[15]);
    return swapmax(fmaxf(a, b));
}
__device__ __forceinline__ s16x4 vtr(const LAS unsigned char* p) { return __builtin_bit_cast(s16x4, __builtin_amdgcn_ds_read_tr16_b64_v4i16((LAS v4i16_t*)p)); }
__device__ __forceinline__ void pv(f32x16 (&o)[2], const LAS unsigned char* vb, const f32x16& p0, const f32x16& p1) {
    v4u pw[4];
#pragma unroll
    for (int s = 0; s < 2; ++s) {
        pw[s]     = (v4u){cvtpk(p0[8 * s], p0[8 * s + 1]), cvtpk(p0[8 * s + 2], p0[8 * s + 3]), cvtpk(p0[8 * s + 4], p0[8 * s + 5]), cvtpk(p0[8 * s + 6], p0[8 * s + 7])};
        pw[2 + s] = (v4u){cvtpk(p1[8 * s], p1[8 * s + 1]), cvtpk(p1[8 * s + 2], p1[8 * s + 3]), cvtpk(p1[8 * s + 4], p1[8 * s + 5]), cvtpk(p1[8 * s + 6], p1[8 * s + 7])};
    }
#pragma unroll
    for (int dh = 0; dh < 2; ++dh)
#pragma unroll
        for (int kg = 0; kg < 4; ++kg) {
            const s16x4 lo = vtr(vb + dh * 4096 + kg * 1024), hi = vtr(vb + dh * 4096 + kg * 1024 + 512);
            const bf16x8 vf = (bf16x8){lo[0], lo[1], lo[2], lo[3], hi[0], hi[1], hi[2], hi[3]};
            o[dh] = __builtin_amdgcn_mfma_f32_32x32x16_bf16(__builtin_bit_cast(bf16x8, pw[kg]), vf, o[dh], 0, 0, 0);
        }
}
struct Soft { float mref, lsum; };
__device__ __forceinline__ void proc_tile(int cls, const LAS unsigned char* tile, const bf16x8 (&qr)[4], Soft& st, f32x16 (&o)[2], const LAS float* lut, int d0, int dlo, int dhi, float cbias, bool rowsel,
                                          LAS float* wsf, int r32, int hi, int trb) {
    const bool unset = st.mref < -1.0e29f;
    const float base = unset ? 0.f : st.mref;
    const float negb = rowsel ? -base : NEGV;
    f32x16 p0, p1;
    if (cls == CLS_CONST) { const float iv = negb + cbias;
#pragma unroll
        for (int r = 0; r < 16; ++r) { p0[r] = iv; p1[r] = iv; }
    } else { const LAS float* pb = lut + (d0 - 4 * hi - 59);
#pragma unroll
        for (int r = 0; r < 16; ++r) { p0[r] = pb[59 - crow(r, 0)] + negb; p1[r] = pb[27 - crow(r, 0)] + negb; }
    }
    qk(p0, p1, tile + hi * 1024 + r32 * 16, qr);
    if (cls == CLS_PART) { const int dq = d0 - 4 * hi; const unsigned span = (unsigned)(dhi - dlo);
#pragma unroll
        for (int r = 0; r < 16; ++r) { const int da = dq - crow(r, 0), db = da - 32;
            p0[r] = ((unsigned)(da - dlo) <= span) ? p0[r] : NEGV; p1[r] = ((unsigned)(db - dlo) <= span) ? p1[r] : NEGV; }
    }
    const float rm = rowmax32(p0, p1);
    const bool upd = rowsel && (rm > -1.0e29f) && (unset || rm > 8.0f);
    if (__any(upd)) {
        const float delta = upd ? rm : 0.f;
#pragma unroll
        for (int r = 0; r < 16; ++r) { p0[r] -= delta; p1[r] -= delta; }
        const float f = (upd && !unset) ? __builtin_amdgcn_exp2f(-delta) : 1.0f;
        st.lsum *= f;
        if (upd) st.mref = base + delta;
        if (hi == 0) wsf[r32] = f;
        asm volatile("s_waitcnt lgkmcnt(0)" ::: "memory");
#pragma unroll
        for (int r = 0; r < 16; ++r) { const float fr = wsf[crow(r, hi)]; o[0][r] *= fr; o[1][r] *= fr; }
        asm volatile("s_waitcnt lgkmcnt(0)" ::: "memory");
    }
    float s = 0.f;
#pragma unroll
    for (int r = 0; r < 16; ++r) { p0[r] = __builtin_amdgcn_exp2f(p0[r]); p1[r] = __builtin_amdgcn_exp2f(p1[r]); s += p0[r] + p1[r]; }
    st.lsum += s;
    pv(o, tile + 8192 + trb, p0, p1);
}
__device__ __forceinline__ float soft_final_inv(const Soft& st, float& ltot) { ltot = swapsum(st.lsum); return (st.mref > -1.0e29f) ? 1.0f / ltot : 0.f; }
}

struct Mix {
    bf16 *QN, *YN, *PL, *QD, *KD, *VD, *YD, *KCMP, *VCMP, *OD; float* LSE; const float* GN; const float* LUTN; const float* LUTD; const float* CB;
    const bf16 *WC1K, *WC1V, *WC2K, *WC2V;
};
__device__ __forceinline__ void lut_to_lds(Frame& F, int tid, const float* img, int nf) {
    LAS f32x4* L = (LAS f32x4*)(F.lds + A_LUT); const GAS f32x4* G = (const GAS f32x4*)img;
    for (int e = tid; e < nf / 4; e += NWAVES * 64) L[e] = G[e];
}
__device__ __forceinline__ bf16x8 ldq(const bf16* p) { return *(const GAS bf16x8*)p; }

__device__ __forceinline__ int next_sel(int j, int c, unsigned u0, unsigned u1, unsigned u2, unsigned u3) {
    while (j <= c) { const unsigned w = (j < 32) ? u0 : (j < 64) ? u1 : (j < 96) ? u2 : u3; if ((w >> (j & 31)) & 1u) break; ++j; }
    return j;
}
template <bool ADD> __device__ __forceinline__ void yn_rows(bf16* YN, const att::f32x16 (&o)[2], float fac, LAS float* wsf, int r32, int hi, size_t R0, int g, int lane) {
    if (hi == 0) wsf[r32] = fac;
    asm volatile("s_waitcnt lgkmcnt(0)" ::: "memory");
#pragma unroll
    for (int r = 0; r < 16; ++r) { const int q = att::crow(r, hi); const float fr = wsf[q];
        bf16* op = YN + (R0 + (q >> 2)) * 512 + (4 * g + (q & 3)) * 64 + (lane & 31);
        float a0 = o[0][r] * fr, a1 = o[1][r] * fr;
        if (ADD) { a0 += __uint_as_float((unsigned)op[0] << 16); a1 += __uint_as_float((unsigned)op[32] << 16); }
        op[0] = (bf16)f2bf(a0); op[32] = (bf16)f2bf(a1); }
    asm volatile("s_waitcnt lgkmcnt(0)" ::: "memory");
}
__device__ __forceinline__ void nsa_unit(Frame& F, const Mix& X, int b, int g, int c, int& buf) {
    using namespace att;
    const int tid = fresh_tid(), lane = tid & 63, wave = __builtin_amdgcn_readfirstlane(tid >> 6), r32 = lane & 31, hi = lane >> 5;
    LAS unsigned char* kv = F.lds + A_KV; LAS float* lutl = (LAS float*)(F.lds + A_LUT); LAS float* imp = (LAS float*)(F.lds + A_IMP);
    LAS unsigned* selm = (LAS unsigned*)(F.lds + A_SEL); LAS unsigned* um = (LAS unsigned*)(F.lds + A_UM); LAS float* wsf = (LAS float*)(F.lds + A_WSF) + wave * 128;
    const int trb = ((lane >> 4) & 1) * 32 + (lane & 3) * 8 + (4 * hi + ((lane & 15) >> 2)) * 64;
    const int t0 = 64 * c, tok = 8 * wave + (r32 >> 2), h = r32 & 3, t = t0 + tok;
    const size_t R = (size_t)b * SEQ + t, R0 = (size_t)b * SEQ + t0 + 8 * wave;
    const int plane = b * 2 + g;
    const bf16* KS = X.PL + 2 * PLSZ + (size_t)plane * SEQ * 64; const bf16* VS = X.PL + 3 * PLSZ + (size_t)plane * SEQ * 64;
    const bf16* KW = X.PL + 4 * PLSZ + (size_t)plane * SEQ * 64; const bf16* VW = X.PL + 5 * PLSZ + (size_t)plane * SEQ * 64;
    const bf16* KC = X.KCMP + (size_t)plane * 512 * 64; const bf16* VC = X.VCMP + (size_t)plane * 512 * 64;
    __syncthreads();
    lut_to_lds(F, tid, X.LUTN + (size_t)g * 4 * LUTW, 4 * LUTW);
    for (int e = tid; e < 64 * IMP_S / 4; e += NWAVES * 64) ((LAS f32x4*)imp)[e] = (f32x4){0.f, 0.f, 0.f, 0.f};
    if (tid < 4) um[tid] = 0u;
    bf16x8 qr[4];
#pragma unroll
    for (int d0 = 0; d0 < 4; ++d0) qr[d0] = ldq(X.QN + R * 512 + (4 * g + h) * 64 + 16 * d0 + 8 * hi);
    const float g0 = X.GN[R * 32 + (4 * g + h) * 3 + 0], g1 = X.GN[R * 32 + (4 * g + h) * 3 + 1], g2 = X.GN[R * 32 + (4 * g + h) * 3 + 2];
    const LAS float* lrow = lutl + h * LUTW + LUT_PAD;
    __syncthreads();
    const int key = tid >> 3;
    Stage2 sg;
    {
        Soft st{NEGV, 0.f}; f32x16 o[2]; o[0] = f32x16{}; o[1] = f32x16{};
        const int it0 = (c >= 8) ? 0 : (8 - c), nt = 9 - it0, nss = (nt + 1) >> 1;
#pragma unroll
        for (int tt = 0; tt < 2; ++tt) { int it = it0 + tt; it = it > 8 ? 8 : it; tile_load(sg.t[tt], KW, VW, t0 - 512 + 64 * it + key, tid); }
        for (int ss = 0; ss < nss; ++ss) {
            LAS unsigned char* bp = kv + buf * SBUF;
            tile_store(bp, sg.t[0], tid); tile_store(bp + TILE_B, sg.t[1], tid); ATT_BAR();
            if (ss + 1 < nss) {
#pragma unroll
                for (int tt = 0; tt < 2; ++tt) { int it = it0 + 2 * (ss + 1) + tt; it = it > 8 ? 8 : it; tile_load(sg.t[tt], KW, VW, t0 - 512 + 64 * it + key, tid); } }
#pragma unroll
            for (int tt = 0; tt < 2; ++tt) { const int it = it0 + 2 * ss + tt;
                if (it <= 8) { const int kb = t0 - 512 + 64 * it; const int cls = (it == 0 || it == 8) ? CLS_PART : CLS_FULL;
                    proc_tile(cls, bp + tt * TILE_B, qr, st, o, lrow, t - kb, 0, 511, 0.f, true, wsf, r32, hi, trb); } }
            buf ^= 1;
        }
        float lt; const float inv = soft_final_inv(st, lt);
        yn_rows<false>(X.YN, o, g2 * inv, wsf, r32, hi, R0, g, lane);
    }
    {
        const int imax = (4 * c + 2 > 510) ? 510 : (4 * c + 2), ntc = imax / 64 + 1, nss = (ntc + 1) >> 1;
        const int dq = t - 31 - 16 * 4 * hi;
        const float cfar = lrow[1599];
        float m = NEGV, l = 0.f;
#pragma unroll
        for (int tt = 0; tt < 2; ++tt) { int it = tt; it = it > ntc - 1 ? ntc - 1 : it; tile_load(sg.t[tt], KC, VC, 64 * it + key, tid); }
        for (int ss = 0; ss < nss; ++ss) {
            LAS unsigned char* bp = kv + buf * SBUF;
            tile_store(bp, sg.t[0], tid); tile_store(bp + TILE_B, sg.t[1], tid); ATT_BAR();
            if (ss + 1 < nss) {
#pragma unroll
                for (int tt = 0; tt < 2; ++tt) { int it = 2 * (ss + 1) + tt; it = it > ntc - 1 ? ntc - 1 : it; tile_load(sg.t[tt], KC, VC, 64 * it + key, tid); } }
#pragma unroll
            for (int tt = 0; tt < 2; ++tt) { const int it = 2 * ss + tt;
                if (it < ntc) {
                    f32x16 p0, p1; const int dt = dq - 1024 * it;
                    const bool far = (t0 - 31 - 1024 * it - 1008) >= 1513;
                    if (far) {
#pragma unroll
                        for (int r = 0; r < 16; ++r) { p0[r] = cfar; p1[r] = cfar; }
                    } else {
#pragma unroll
                        for (int r = 0; r < 16; ++r) { const int da = dt - 16 * crow(r, 0), db = da - 512;
                            const int ia = da < -64 ? -64 : (da > 1599 ? 1599 : da), ib = db < -64 ? -64 : (db > 1599 ? 1599 : db);
                            p0[r] = lrow[ia]; p1[r] = lrow[ib]; }
                    }
                    qk(p0, p1, bp + tt * TILE_B + hi * 1024 + r32 * 16, qr);
                    if (!far) {
#pragma unroll
                        for (int r = 0; r < 16; ++r) { const int da = dt - 16 * crow(r, 0), db = da - 512; p0[r] = (da >= 0) ? p0[r] : NEGV; p1[r] = (db >= 0) ? p1[r] : NEGV; }
                    }
                    const float rm = rowmax32(p0, p1);
                    const float mn = fmaxf(m, rm); float s = 0.f;
#pragma unroll
                    for (int r = 0; r < 16; ++r) s += __builtin_amdgcn_exp2f(p0[r] - mn) + __builtin_amdgcn_exp2f(p1[r] - mn);
                    l = l * __builtin_amdgcn_exp2f(m - mn) + s; m = mn;
                } }
            buf ^= 1;
        }
        const float ltot = swapsum(l);
        const float invl = (m > -1.0e29f) ? 1.0f / ltot : 0.f;
        const float mz = (m > -1.0e29f) ? m : 0.f;
        f32x16 o[2]; o[0] = f32x16{}; o[1] = f32x16{};
        LAS float* improw = imp + tok * IMP_S;
#pragma unroll
        for (int tt = 0; tt < 2; ++tt) { int it = tt; it = it > ntc - 1 ? ntc - 1 : it; tile_load(sg.t[tt], KC, VC, 64 * it + key, tid); }
        for (int ss = 0; ss < nss; ++ss) {
            LAS unsigned char* bp = kv + buf * SBUF;
            tile_store(bp, sg.t[0], tid); tile_store(bp + TILE_B, sg.t[1], tid); ATT_BAR();
            if (ss + 1 < nss) {
#pragma unroll
                for (int tt = 0; tt < 2; ++tt) { int it = 2 * (ss + 1) + tt; it = it > ntc - 1 ? ntc - 1 : it; tile_load(sg.t[tt], KC, VC, 64 * it + key, tid); } }
#pragma unroll
            for (int tt = 0; tt < 2; ++tt) { const int it = 2 * ss + tt;
                if (it < ntc) {
                    f32x16 p0, p1; const int dt = dq - 1024 * it;
                    const bool far = (t0 - 31 - 1024 * it - 1008) >= 1513;
                    if (far) { const float iv = cfar - mz;
#pragma unroll
                        for (int r = 0; r < 16; ++r) { p0[r] = iv; p1[r] = iv; }
                    } else {
#pragma unroll
                        for (int r = 0; r < 16; ++r) { const int da = dt - 16 * crow(r, 0), db = da - 512;
                            const int ia = da < -64 ? -64 : (da > 1599 ? 1599 : da), ib = db < -64 ? -64 : (db > 1599 ? 1599 : db);
                            p0[r] = lrow[ia] - mz; p1[r] = lrow[ib] - mz; }
                    }
                    qk(p0, p1, bp + tt * TILE_B + hi * 1024 + r32 * 16, qr);
#pragma unroll
                    for (int r = 0; r < 16; ++r) { p0[r] = __builtin_amdgcn_exp2f(p0[r]) * invl; p1[r] = __builtin_amdgcn_exp2f(p1[r]) * invl; }
                    if (!far) {
#pragma unroll
                        for (int r = 0; r < 16; ++r) { const int da = dt - 16 * crow(r, 0), db = da - 512; p0[r] = (da >= 0) ? p0[r] : 0.f; p1[r] = (db >= 0) ? p1[r] : 0.f; }
                    }
#pragma unroll
                    for (int q = 0; q < 4; ++q) {
                        float a = (p0[4 * q] + p0[4 * q + 1]) + (p0[4 * q + 2] + p0[4 * q + 3]), al = p0[4 * q + 3];
                        float e = (p1[4 * q] + p1[4 * q + 1]) + (p1[4 * q + 2] + p1[4 * q + 3]), el = p1[4 * q + 3];
                        a = quadsum(a); al = quadsum(al); e = quadsum(e); el = quadsum(el);
                        if (h == 0) { const int G = 16 * it + 2 * q + hi;
                            __hip_atomic_fetch_add(improw + G, a, __ATOMIC_RELAXED, __HIP_MEMORY_SCOPE_WORKGROUP); __hip_atomic_fetch_add(improw + G + 1, al, __ATOMIC_RELAXED, __HIP_MEMORY_SCOPE_WORKGROUP);
                            __hip_atomic_fetch_add(improw + G + 8, e, __ATOMIC_RELAXED, __HIP_MEMORY_SCOPE_WORKGROUP); __hip_atomic_fetch_add(improw + G + 9, el, __ATOMIC_RELAXED, __HIP_MEMORY_SCOPE_WORKGROUP); }
                    }
                    pv(o, bp + tt * TILE_B + 8192 + trb, p0, p1);
                } }
            buf ^= 1;
        }
        yn_rows<true>(X.YN, o, g0, wsf, r32, hi, R0, g, lane);
    }
    asm volatile("s_waitcnt lgkmcnt(0)" ::: "memory");
    unsigned msk[4] = {0u, 0u, 0u, 0u};
    if (c >= 16) {
        const int tl = lane >> 3, part = lane & 7;
        const LAS float* ir = imp + (8 * wave + tl) * IMP_S + part * 16;
        unsigned v[16];
#pragma unroll
        for (int r = 0; r < 16; ++r) { const int j = part * 16 + r; const unsigned bits = __float_as_uint(ir[r]); v[r] = (j >= 1 && j <= c - 2) ? ((bits & ~127u) | (unsigned)(127 - j)) : 0u; }
        unsigned sm[4] = {0u, 0u, 0u, 0u};
        for (int itn = 0; itn < 13; ++itn) {
            unsigned mx = v[0];
#pragma unroll
            for (int r = 1; r < 16; ++r) mx = mx > v[r] ? mx : v[r];
            { unsigned o1 = (unsigned)__shfl_xor((int)mx, 1); mx = mx > o1 ? mx : o1; o1 = (unsigned)__shfl_xor((int)mx, 2); mx = mx > o1 ? mx : o1; o1 = (unsigned)__shfl_xor((int)mx, 4); mx = mx > o1 ? mx : o1; }
            const int j = 127 - (int)(mx & 127u); const unsigned bit = 1u << (j & 31); const int w = j >> 5;
            if (mx != 0u) { sm[0] |= (w == 0) ? bit : 0u; sm[1] |= (w == 1) ? bit : 0u; sm[2] |= (w == 2) ? bit : 0u; sm[3] |= (w == 3) ? bit : 0u; }
#pragma unroll
            for (int r = 0; r < 16; ++r) v[r] = (v[r] == mx) ? 0u : v[r];
        }
        sm[0] |= 1u;
        { const int j = c - 1; const unsigned bit = 1u << (j & 31); const int w = j >> 5; sm[0] |= (w == 0) ? bit : 0u; sm[1] |= (w == 1) ? bit : 0u; sm[2] |= (w == 2) ? bit : 0u; sm[3] |= (w == 3) ? bit : 0u; }
        { const int j = c; const unsigned bit = 1u << (j & 31); const int w = j >> 5; sm[0] |= (w == 0) ? bit : 0u; sm[1] |= (w == 1) ? bit : 0u; sm[2] |= (w == 2) ? bit : 0u; sm[3] |= (w == 3) ? bit : 0u; }
        if (part == 0) {
#pragma unroll
            for (int w = 0; w < 4; ++w) { selm[(8 * wave + tl) * 4 + w] = sm[w]; __hip_atomic_fetch_or(um + w, sm[w], __ATOMIC_RELAXED, __HIP_MEMORY_SCOPE_WORKGROUP); }
        }
        __syncthreads();
#pragma unroll
        for (int w = 0; w < 4; ++w) msk[w] = selm[tok * 4 + w];
    } else {
        msk[0] = (2u << c) - 1u;
        __syncthreads();
    }
    unsigned umr[4];
#pragma unroll
    for (int w = 0; w < 4; ++w) umr[w] = (c >= 16) ? (unsigned)__builtin_amdgcn_readfirstlane((int)um[w]) : ((w == 0) ? ((2u << c) - 1u) : 0u);
    {
        Soft st{NEGV, 0.f}; f32x16 o[2]; o[0] = f32x16{}; o[1] = f32x16{};
        const float cfar = lrow[1599];
        int j0 = next_sel(0, c, umr[0], umr[1], umr[2], umr[3]);
        int j1 = (j0 <= c) ? next_sel(j0 + 1, c, umr[0], umr[1], umr[2], umr[3]) : j0;
        if (j0 <= c) { tile_load(sg.t[0], KS, VS, 64 * j0 + key, tid); tile_load(sg.t[1], KS, VS, 64 * (j1 <= c ? j1 : j0) + key, tid); }
        while (j0 <= c) {
            LAS unsigned char* bp = kv + buf * SBUF;
            tile_store(bp, sg.t[0], tid); tile_store(bp + TILE_B, sg.t[1], tid); ATT_BAR();
            const int n0 = (j1 <= c) ? next_sel(j1 + 1, c, umr[0], umr[1], umr[2], umr[3]) : j1;
            const int n1 = (n0 <= c) ? next_sel(n0 + 1, c, umr[0], umr[1], umr[2], umr[3]) : n0;
            if (n0 <= c) { tile_load(sg.t[0], KS, VS, 64 * n0 + key, tid); tile_load(sg.t[1], KS, VS, 64 * (n1 <= c ? n1 : n0) + key, tid); }
#pragma unroll
            for (int tt = 0; tt < 2; ++tt) { const int j = tt ? j1 : j0;
                if (j <= c) {
                    const unsigned mw = (j < 32) ? msk[0] : (j < 64) ? msk[1] : (j < 96) ? msk[2] : msk[3];
                    const bool sel = (mw >> (j & 31)) & 1u;
                    if (__any(sel)) { const int cls = (j == c) ? CLS_PART : ((c - j >= 25) ? CLS_CONST : CLS_FULL);
                        proc_tile(cls, bp + tt * TILE_B, qr, st, o, lrow, t - 64 * j, 0, 0x3fffffff, cfar, sel, wsf, r32, hi, trb); } } }
            buf ^= 1; j0 = n0; j1 = n1;
        }
        float lt; const float inv = soft_final_inv(st, lt);
        yn_rows<true>(X.YN, o, g1 * inv, wsf, r32, hi, R0, g, lane);
    }
}

__device__ __forceinline__ void dil_unit(Frame& F, const Mix& X, int gi, int b, int s, int rest, int& buf) {
    using namespace att;
    const int tid = fresh_tid(), lane = tid & 63, wave = __builtin_amdgcn_readfirstlane(tid >> 6), r32 = lane & 31, hi = lane >> 5;
    LAS unsigned char* kv = F.lds + A_KV; LAS float* lutl = (LAS float*)(F.lds + A_LUT); LAS float* wsf = (LAS float*)(F.lds + A_WSF) + wave * 128;
    const int trb = ((lane >> 4) & 1) * 32 + (lane & 3) * 8 + (4 * hi + ((lane & 15) >> 2)) * 64;
    const int dil = 1 << (2 * gi), lg = 2 * gi, nch = (SEQ >> lg) >> 8, res = rest / nch, ch = rest % nch;
    const int hd = 4 * gi + s, N0 = 256 * ch, Nw = N0 + 32 * wave, nq = Nw + r32, key = tid >> 3;
    const int t = (nq << lg) + res;
    const size_t R = (size_t)b * SEQ + t;
    __syncthreads();
    lut_to_lds(F, tid, X.LUTD + hd * 320, 320);
    bf16x8 qr[4];
#pragma unroll
    for (int d0 = 0; d0 < 4; ++d0) qr[d0] = ldq(X.QD + R * 768 + hd * 64 + 16 * d0 + 8 * hi);
    const bf16* Kp = X.KD + (size_t)(b * 12 + hd) * SEQ * 64; const bf16* Vp = X.VD + (size_t)(b * 12 + hd) * SEQ * 64;
    const LAS float* lrow = lutl + LUT_PAD;
    __syncthreads();
    Soft st{NEGV, 0.f}; f32x16 o[2]; o[0] = f32x16{}; o[1] = f32x16{};
    Stage2 sg;
    const int it0 = (ch == 0) ? 2 : 0, nss = (6 - it0) >> 1;
#pragma unroll
    for (int tt = 0; tt < 2; ++tt) { const int kb = N0 - 128 + 64 * (it0 + tt); tile_load(sg.t[tt], Kp, Vp, (long)((kb + key) << lg) + res, tid); }
    for (int ss = 0; ss < nss; ++ss) {
        LAS unsigned char* bp = kv + buf * SBUF;
        tile_store(bp, sg.t[0], tid); tile_store(bp + TILE_B, sg.t[1], tid); ATT_BAR();
        if (ss + 1 < nss) {
#pragma unroll
            for (int tt = 0; tt < 2; ++tt) { const int kb = N0 - 128 + 64 * (it0 + 2 * (ss + 1) + tt); tile_load(sg.t[tt], Kp, Vp, (long)((kb + key) << lg) + res, tid); } }
#pragma unroll
        for (int tt = 0; tt < 2; ++tt) { const int kb = N0 - 128 + 64 * (it0 + 2 * ss + tt);
            const int dmin = Nw - kb - 63, dmax = Nw + 31 - kb;
            if (dmax >= 0 && dmin <= 128) { const int cls = (dmin >= 0 && dmax <= 128) ? CLS_FULL : CLS_PART;
                proc_tile(cls, bp + tt * TILE_B, qr, st, o, lrow, nq - kb, 0, 128, 0.f, true, wsf, r32, hi, trb); } }
        buf ^= 1;
    }
    float ltot; const float inv = soft_final_inv(st, ltot);
    const float lse = st.mref + __builtin_amdgcn_logf(ltot);
    if (gi != 0) {
        bf16* OD = X.OD + (size_t)(gi - 1) * M * 256; float* LS = X.LSE + (size_t)(gi - 1) * M * 4;
        if (hi == 0) { wsf[r32] = inv; LS[R * 4 + s] = lse; }
        asm volatile("s_waitcnt lgkmcnt(0)" ::: "memory");
#pragma unroll
        for (int r = 0; r < 16; ++r) { const int q = crow(r, hi); const float fr = wsf[q]; const size_t Rq = (size_t)b * SEQ + ((size_t)(Nw + q) << lg) + res;
            bf16* op = OD + Rq * 256 + s * 64 + (lane & 31);
            op[0] = (bf16)f2bf(o[0][r] * fr); op[32] = (bf16)f2bf(o[1][r] * fr); }
        asm volatile("s_waitcnt lgkmcnt(0)" ::: "memory");
    } else {
        const float l4 = X.LSE[R * 4 + s], l16 = X.LSE[(size_t)M * 4 + R * 4 + s];
        const float mx = fmaxf(lse, fmaxf(l4, l16));
        const float w1 = __builtin_amdgcn_exp2f(lse - mx), w4 = __builtin_amdgcn_exp2f(l4 - mx), w16 = __builtin_amdgcn_exp2f(l16 - mx), iw = 1.0f / (w1 + w4 + w16);
        if (hi == 0) { wsf[r32] = w1 * iw * inv; wsf[32 + r32] = w4 * iw; wsf[64 + r32] = w16 * iw; }
        asm volatile("s_waitcnt lgkmcnt(0)" ::: "memory");
#pragma unroll
        for (int r = 0; r < 16; ++r) { const int q = crow(r, hi); const float a1 = wsf[q], a4 = wsf[32 + q], a16 = wsf[64 + q]; const size_t Rq = (size_t)b * SEQ + Nw + q;
            const bf16* p4 = X.OD + Rq * 256 + s * 64 + (lane & 31); const bf16* p16 = p4 + (size_t)M * 256;
            bf16* op = X.YD + Rq * 256 + s * 64 + (lane & 31);
            const float v0 = o[0][r] * a1 + __uint_as_float((unsigned)p4[0] << 16) * a4 + __uint_as_float((unsigned)p16[0] << 16) * a16;
            const float v1 = o[1][r] * a1 + __uint_as_float((unsigned)p4[32] << 16) * a4 + __uint_as_float((unsigned)p16[32] << 16) * a16;
            op[0] = (bf16)f2bf(v0); op[32] = (bf16)f2bf(v1); }
        asm volatile("s_waitcnt lgkmcnt(0)" ::: "memory");
    }
}

__device__ __forceinline__ void cmp_unit(Frame& F, const Mix& X, int cu) {
    using namespace att;
    const int tid = fresh_tid(), lane = tid & 63, wave = __builtin_amdgcn_readfirstlane(tid >> 6), r32 = lane & 31, hi = lane >> 5;
    const int ts = cu >> 6, rb = cu & 63, plane = rb >> 4, i0 = (rb & 15) * 32;
    const bf16* src = X.PL + (size_t)ts * PLSZ + (size_t)plane * SEQ * 64;
    const bf16* W1 = ts ? X.WC1V : X.WC1K; const bf16* W2 = ts ? X.WC2V : X.WC2K; const float* cb = X.CB + ts * 256;
    bf16* dst = (ts ? X.VCMP : X.KCMP) + (size_t)plane * 512 * 64;
    LAS unsigned char* aimg = F.lds;
    LAS unsigned char* hid = F.lds + 69632;
    __syncthreads();
    for (int chn = tid; chn < 528 * 8; chn += NWAVES * 64) { const int tau = chn >> 3, c8 = chn & 7; int tk = 16 * i0 + tau; tk = tk > SEQ - 1 ? SEQ - 1 : tk;
        *(LAS v4u*)(aimg + tau * 128 + 16 * (tau >> 4) + c8 * 16) = *(const GAS v4u*)(src + (size_t)tk * 64 + c8 * 8); }
    __syncthreads();
    f32x16 acc = f32x16{};
    const LAS unsigned char* ap = aimg + r32 * 2064 + 16 * hi;
    const bf16* bp = W1 + ((size_t)wave * 128 * 64 + lane) * 8;
#pragma unroll 16
    for (int ks = 0; ks < 128; ++ks) {
        const int l = ks >> 2;
        const bf16x8 a = *(const LAS bf16x8*)(ap + 128 * l + 16 * (l >> 4) + 32 * (ks & 3));
        const bf16x8 bb = ldq(bp + (size_t)ks * 512);
        acc = __builtin_amdgcn_mfma_f32_32x32x16_bf16(a, bb, acc, 0, 0, 0);
    }
    { const int col = 32 * wave + r32; const float bias = cb[col];
#pragma unroll
      for (int r = 0; r < 16; ++r) { const float v = acc[r] + bias; const float hv = v * __builtin_amdgcn_rcpf(1.0f + __builtin_amdgcn_exp2f(-LOG2E * v));
          *(LAS unsigned short*)(hid + crow(r, hi) * 528 + col * 2) = (unsigned short)f2bf(hv); } }
    __syncthreads();
    if (wave < 2) {
        const int nt = wave;
        f32x16 o2 = f32x16{};
        const LAS unsigned char* hp = hid + r32 * 528 + 16 * hi; const bf16* b2 = W2 + (size_t)(32 * nt + r32) * 256 + 8 * hi;
#pragma unroll
        for (int k0 = 0; k0 < 256; k0 += 16) { const bf16x8 a = *(const LAS bf16x8*)(hp + k0 * 2); const bf16x8 bb = ldq(b2 + k0); o2 = __builtin_amdgcn_mfma_f32_32x32x16_bf16(a, bb, o2, 0, 0, 0); }
#pragma unroll
        for (int r = 0; r < 16; ++r) { const int i = i0 + crow(r, hi); dst[(size_t)i * 64 + 32 * nt + r32] = (bf16)f2bf(o2[r]); }
    }
}

#ifndef MK_N_LAUNCHES
#define MK_N_LAUNCHES 1
#endif
constexpr int N_PHASES = 13;
constexpr int N_LAUNCHES = MK_N_LAUNCHES;
struct Args { const float* in[22]; float* out; unsigned char* ws; int ph_lo, ph_hi, li, pad; };
__global__ void __launch_bounds__(NWAVES * 64, 2) mk_fwd(Args args) {
    extern __shared__ __attribute__((aligned(16))) unsigned char lds[];
    Frame F;
    F.lds = (LAS unsigned char*)lds;
    F.MISC = (volatile LAS unsigned*)(F.lds + MISC_OFF);
    F.G = gridDim.x; { const int bx = blockIdx.x; F.vcu = (F.G % 8 == 0) ? (bx % 8) * (F.G / 8) + bx / 8 : bx; }
    unsigned char* ws = args.ws;
    F.ctl = (gu32*)(ws + WS_CTL);
    In in;
    in.x = args.in[0]; in.f1_pre = args.in[1]; in.f1_wgu = args.in[2]; in.f1_wd = args.in[3]; in.f1_post = args.in[4]; in.mix_pre = args.in[5]; in.w_in = args.in[6];
    in.cpos_k = args.in[7]; in.cw1_k = args.in[8]; in.cw2_k = args.in[9]; in.cpos_v = args.in[10]; in.cw1_v = args.in[11]; in.cw2_v = args.in[12];
    in.w_bn = args.in[13]; in.w_bd = args.in[14]; in.w_out = args.in[15]; in.mix_post = args.in[16]; in.f2_pre = args.in[17]; in.f2_wgu = args.in[18]; in.f2_wd = args.in[19]; in.f2_post = args.in[20]; in.rel_bias = args.in[21];
    float* out = args.out;
    for (int u = threadIdx.x; u < (LDS_BYTES - LDSCTL_OFF) / 4; u += NWAVES * 64) ((LAS unsigned*)(F.lds + LDSCTL_OFF))[u] = 0u;
    __syncthreads();
    const bool use_bar = (args.ph_hi - args.ph_lo) > 1;
    XcdBarrier bar; bar.bar = (unsigned*)(F.ctl + CW_BAR) + args.li * XCD_BAR_WORDS; bar.x = 0; bar.st = nullptr;
    if (use_bar) bar = xcd_barrier_post((unsigned*)(F.ctl + CW_BAR) + args.li * XCD_BAR_WORDS, F.MISC + 8);
    const int lo = args.ph_lo, hi = args.ph_hi;
#define IN(k) (lo <= (k) && (k) < hi)
#define SEAM(k) do { if (IN(k) && IN((k) + 1)) xcd_barrier(bar); } while (0)
    bf16* XN = (bf16*)(ws + WS_XN); bf16* H = (bf16*)(ws + WS_H); float* Y = (float*)(ws + WS_Y); bf16* Y2P = (bf16*)(ws + WS_Y2P); bf16* MG = (bf16*)(ws + WS_MG);
    Mix X; X.QN = (bf16*)(ws + WS_QN); X.YN = (bf16*)(ws + WS_YN); X.PL = (bf16*)(ws + WS_PL); X.QD = (bf16*)(ws + WS_QD); X.KD = (bf16*)(ws + WS_KD); X.VD = (bf16*)(ws + WS_VD); X.YD = (bf16*)(ws + WS_YD); X.OD = (bf16*)(ws + WS_OD); X.LSE = (float*)(ws + WS_LSE);
    X.KCMP = (bf16*)(ws + WS_KCMP); X.VCMP = (bf16*)(ws + WS_VCMP); X.GN = (const float*)(ws + WS_GN); X.LUTN = (const float*)(ws + WS_LUTN); X.LUTD = (const float*)(ws + WS_LUTD); X.CB = (const float*)(ws + WS_CB);
    X.WC1K = (const bf16*)(ws + WS_WC1K); X.WC1V = (const bf16*)(ws + WS_WC1V); X.WC2K = (const bf16*)(ws + WS_WC2K); X.WC2V = (const bf16*)(ws + WS_WC2V);
    bf16* GA = (bf16*)(ws + WS_GA); bf16* GB = (bf16*)(ws + WS_GB);

    if (IN(0)) { p0_prologue(F, in, ws); }
    SEAM(0);
    if (IN(1)) { pg8::Gemm g{XN, (const bf16*)(ws + WS_WGU1), M, 2 * FF, D}; pg8::StaticOrder S; S.init(M, 2 * FF, F.G, (int)blockIdx.x);
        pg8::EpiSwiGLU E{H, FF}; pg8::gemm_phase<pg8::EpiSwiGLU, pg8::StaticOrder, true, true>(F.lds + RING_OFF, g, S, E); }
    SEAM(1);
    if (IN(2)) { pg8::Gemm g{H, (const bf16*)(ws + WS_WD1), M, D, FF}; pg8::StaticOrder S; S.init(M, D, F.G, (int)blockIdx.x);
        pg8::EpiF32 E{Y, D}; pg8::gemm_phase<pg8::EpiF32, pg8::StaticOrder, true, true>(F.lds + RING_OFF, g, S, E); }
    SEAM(2);
    if (IN(3)) { row_pass(F, Y, in.x, out, 0.5f, in.f1_post, in.mix_pre, XN); }
    SEAM(3);
    if (IN(4)) { pg8::Gemm g{XN, (const bf16*)(ws + WS_WIN), M, NPROJ, D}; pg8::StaticOrder S; S.init(M, NPROJ, F.G, (int)blockIdx.x);
        pg8::EpiProj E{X.QN, X.PL, X.QD, X.KD, X.VD, GA, GB, (float*)(ws + WS_GN), QSCALE};
        pg8::gemm_phase<pg8::EpiProj, pg8::StaticOrder, true, true>(F.lds + RING_OFF, g, S, E); }
    SEAM(4);
    if (IN(5)) { int buf = 0;
        for (int cu = F.vcu; cu < 128; cu += F.G) cmp_unit(F, X, cu);
#pragma unroll 1
        for (int w = F.vcu; w < 512; w += F.G) { const int gi = 2 - (w >> 8), du = w & 255; dil_unit(F, X, gi, du >> 7, (du >> 5) & 3, du & 31, buf); }
        __syncthreads(); }
    SEAM(5);
    if (IN(6)) { int buf = 0;
        for (int p = F.vcu; p < 256; p += F.G) { const int b = p >> 7, g = (p >> 6) & 1, cc = p & 63;
#pragma unroll 1
            for (int k = 0; k < 2; ++k) nsa_unit(F, X, b, g, k ? cc : 127 - cc, buf); }
#pragma unroll 1
        for (int du = F.vcu; du < 256; du += F.G) dil_unit(F, X, 0, du >> 7, (du >> 5) & 3, du & 31, buf);
        __syncthreads(); }
    SEAM(6);
    if (IN(7)) {
        { pg8::Gemm g{X.YN, (const bf16*)(ws + WS_WBN), M, D, 512}; pg8::StaticOrder S; S.init(M, D, F.G, (int)blockIdx.x);
          pg8::EpiBranchA E{GA, Y2P}; pg8::gemm_phase<pg8::EpiBranchA, pg8::StaticOrder, true, true>(F.lds + RING_OFF, g, S, E); }
        { pg8::Gemm g{X.YD, (const bf16*)(ws + WS_WBD), M, D, 256}; pg8::StaticOrder S; S.init(M, D, F.G, (int)blockIdx.x);
          pg8::EpiBranchB E{GB, Y2P, MG}; pg8::gemm_phase<pg8::EpiBranchB, pg8::StaticOrder, true, true>(F.lds + RING_OFF, g, S, E); }
    }
    SEAM(7);
    if (IN(8)) { pg8::Gemm g{MG, (const bf16*)(ws + WS_WOUT), M, D, D}; pg8::StaticOrder S; S.init(M, D, F.G, (int)blockIdx.x);
        pg8::EpiF32 E{Y, D}; pg8::gemm_phase<pg8::EpiF32, pg8::StaticOrder, true, true>(F.lds + RING_OFF, g, S, E); }
    SEAM(8);
    if (IN(9)) { row_pass(F, Y, out, out, 1.0f, in.mix_post, in.f2_pre, XN); }
    SEAM(9);
    if (IN(10)) { pg8::Gemm g{XN, (const bf16*)(ws + WS_WGU2), M, 2 * FF, D}; pg8::StaticOrder S; S.init(M, 2 * FF, F.G, (int)blockIdx.x);
        pg8::EpiSwiGLU E{H, FF}; pg8::gemm_phase<pg8::EpiSwiGLU, pg8::StaticOrder, true, true>(F.lds + RING_OFF, g, S, E); }
    SEAM(10);
    if (IN(11)) { pg8::Gemm g{H, (const bf16*)(ws + WS_WD2), M, D, FF}; pg8::StaticOrder S; S.init(M, D, F.G, (int)blockIdx.x);
        pg8::EpiF32 E{Y, D}; pg8::gemm_phase<pg8::EpiF32, pg8::StaticOrder, true, true>(F.lds + RING_OFF, g, S, E); }
    SEAM(11);
    if (IN(12)) { row_pass(F, Y, out, out, 0.5f, in.f2_post, nullptr, nullptr); }
#undef IN
#undef SEAM
}

extern "C" void kernel_launch(void* const* d_in, const int* in_sizes, int n_in, void* d_out, int out_size, void* d_ws, size_t ws_size, hipStream_t stream) {
    static int grid = 0;
    if (grid == 0) {
        if (n_in != 22 || in_sizes[0] != M * D || out_size != M * D || ws_size < WS_END) { fprintf(stderr, "kernel_launch: unexpected shapes (n_in %d, in0 %d, out %d, ws %zu); nothing launched\n", n_in, n_in > 0 ? in_sizes[0] : -1, out_size, ws_size); grid = -1; return; }
        int dev = 0, cus = 0, per_cu = 0;
        if (hipGetDevice(&dev) != hipSuccess || hipDeviceGetAttribute(&cus, hipDeviceAttributeMultiprocessorCount, dev) != hipSuccess) { grid = -1; return; }
        if (hipFuncSetAttribute((const void*)mk_fwd, hipFuncAttributeMaxDynamicSharedMemorySize, LDS_BYTES) != hipSuccess) { fprintf(stderr, "kernel_launch: hipFuncSetAttribute failed\n"); grid = -1; return; }
        if (hipOccupancyMaxActiveBlocksPerMultiprocessor(&per_cu, (const void*)mk_fwd, NWAVES * 64, LDS_BYTES) != hipSuccess || per_cu < 1)
            fprintf(stderr, "kernel_launch: note: occupancy query reports %d workgroups per CU\n", per_cu);
        (void)hipGetLastError();
        grid = cus;
    }
    if (grid < 0) return;
    if (hipMemsetAsync((char*)d_ws + WS_CTL, 0, CTL_ZERO_BYTES, stream) != hipSuccess) return;
    Args a{};
    for (int i = 0; i < 22; ++i) a.in[i] = (const float*)d_in[i];
    a.out = (float*)d_out; a.ws = (unsigned char*)d_ws;
#ifdef PROBE_RANGES
    { static const int rg[][2] = PROBE_RANGES;
      for (int li = 0; li < (int)(sizeof(rg) / sizeof(rg[0])); ++li) { a.ph_lo = rg[li][0]; a.ph_hi = rg[li][1]; a.li = li; hipLaunchKernelGGL(mk_fwd, dim3(grid), dim3(NWAVES * 64), LDS_BYTES, stream, a); } }
#else
    if (N_LAUNCHES == 1) { a.ph_lo = 0; a.ph_hi = N_PHASES; a.li = 0; hipLaunchKernelGGL(mk_fwd, dim3(grid), dim3(NWAVES * 64), LDS_BYTES, stream, a); }
    else { for (int li = 0; li < N_PHASES; ++li) { a.ph_lo = li; a.ph_hi = li + 1; a.li = 0; hipLaunchKernelGGL(mk_fwd, dim3(grid), dim3(NWAVES * 64), LDS_BYTES, stream, a); } }
#endif
}
```

```cpp
#include <hip/hip_runtime.h>
#include <cstdio>
#include <cstdint>
namespace pg8 {
#define PG8_LAS __attribute__((address_space(3)))
typedef unsigned short bf16_t;
typedef short bf16x8 __attribute__((ext_vector_type(8)));
typedef float f32x4 __attribute__((ext_vector_type(4)));
typedef unsigned u32x4 __attribute__((ext_vector_type(4)));
constexpr int BM = 256, BK = 64, HALF = 128, HTB = HALF * BK * 2  , STAGE_BYTES = 8 * HTB, NXCD = 8, WGM = 8;

__host__ __device__ __forceinline__ int lds_byte(int r, int c) { const int st = (r >> 4) * 2 + (c >> 5), rr = r & 15, cc = c & 31, ob = rr * 64 + cc * 2; return st * 1024 + (ob ^ (((ob >> 9) & 1) << 5)); }
__host__ __device__ __forceinline__ void stage_rc(int b, int& R, int& C) { const int st = b / 1024, sb = b % 1024, swz = sb ^ (((sb >> 9) & 1) << 5); R = (st >> 1) * 16 + swz / 64; C = (st & 1) * 32 + (swz % 64) / 2; }
__host__ __device__ __forceinline__ int perm32(int rho) { const int n = rho >> 4, i = rho & 15; return 8 * (i >> 2) + 4 * n + (i & 3); }

struct Unit { int pm, pn; };
struct Gemm { const bf16_t* A; const bf16_t* Bt; int M, N, K; };

struct StaticOrder {
    int nM, nN, nwg, G, c;
    __host__ __device__ void init(int M, int N, int G_, int c_) { nM = M / BM; nN = N / BM; nwg = nM * nN; G = G_; c = c_; }
    __host__ __device__ bool next(int i, Unit& u) const {
        const long L = (long)i * G + c; if (L >= nwg) return false;
        int wgid = (int)L; { const int q = nwg / NXCD, r = nwg % NXCD, xcd = wgid % NXCD, off = wgid / NXCD; wgid = (xcd < r ? xcd * (q + 1) : r * (q + 1) + (xcd - r) * q) + off; }
        const int nig = WGM * nN, gid = wgid / nig, fm = gid * WGM, gsz = (nM - fm) < WGM ? (nM - fm) : WGM;
        u.pm = fm + ((wgid % nig) % gsz); u.pn = (wgid % nig) / gsz; return true;
    }
    __device__ __forceinline__ void a_ready(const Unit&) const {}
    __device__ __forceinline__ void done(const Unit&) const {}
};

__device__ __forceinline__ unsigned cvt_pk_bf16(float lo, float hi) { unsigned r; asm volatile("v_cvt_pk_bf16_f32 %0, %1, %2" : "=v"(r) : "v"(lo), "v"(hi)); return r; }
typedef float f32x2 __attribute__((ext_vector_type(2)));
__device__ __forceinline__ float sigmoid_f(float v) { return __builtin_amdgcn_rcpf(1.0f + __builtin_amdgcn_exp2f(-1.4426950408889634f * v)); }
__device__ __forceinline__ float bf_lo(unsigned w) { return __uint_as_float(w << 16); }
__device__ __forceinline__ float bf_hi(unsigned w) { return __uint_as_float(w & 0xffff0000u); }

struct EpiSwiGLU {
    static constexpr bool PERM = true, AFTER_DRAIN = false;
    bf16_t* H; int ldh;
    __device__ __forceinline__ void operator()(const f32x4 (&acc)[2][2][4][2], const Unit& u, int wr, int wc, int fr, int fq) const {
        const int row0 = u.pm * BM + wr * 64 + fr, col0 = u.pn * HALF + wc * 32 + 8 * fq;
#pragma unroll
        for (int ai = 0; ai < 2; ++ai)
#pragma unroll
            for (int m = 0; m < 4; ++m) { bf16_t* rowp = H + (size_t)(row0 + ai * HALF + m * 16) * ldh + col0;
                const f32x4 g0 = acc[ai][0][m][0], g1 = acc[ai][0][m][1], u0 = acc[ai][1][m][0], u1 = acc[ai][1][m][1];
                float h[8];
#pragma unroll
                for (int i = 0; i < 4; ++i) { h[i] = g0[i] * sigmoid_f(g0[i]) * u0[i]; h[4 + i] = g1[i] * sigmoid_f(g1[i]) * u1[i]; }
                u32x4 w; w.x = cvt_pk_bf16(h[0], h[1]); w.y = cvt_pk_bf16(h[2], h[3]); w.z = cvt_pk_bf16(h[4], h[5]); w.w = cvt_pk_bf16(h[6], h[7]);
                *(u32x4*)rowp = w; }
    }
};
struct EpiF32 {
    static constexpr bool PERM = true, AFTER_DRAIN = false;
    float* Y; int ldc;
    __device__ __forceinline__ void operator()(const f32x4 (&acc)[2][2][4][2], const Unit& u, int wr, int wc, int fr, int fq) const {
        const int row0 = u.pm * BM + wr * 64 + fr, col0 = u.pn * BM + wc * 32 + 8 * fq;
#pragma unroll
        for (int ai = 0; ai < 2; ++ai)
#pragma unroll
            for (int m = 0; m < 4; ++m) { float* rowp = Y + (size_t)(row0 + ai * HALF + m * 16) * ldc + col0;
#pragma unroll
                for (int bj = 0; bj < 2; ++bj) { *(f32x4*)(rowp + bj * HALF) = acc[ai][bj][m][0]; *(f32x4*)(rowp + bj * HALF + 4) = acc[ai][bj][m][1]; } }
    }
};
struct EpiBf16 {
    static constexpr bool PERM = true, AFTER_DRAIN = false;
    bf16_t* Y; int ldc;
    __device__ __forceinline__ void operator()(const f32x4 (&acc)[2][2][4][2], const Unit& u, int wr, int wc, int fr, int fq) const {
        const int row0 = u.pm * BM + wr * 64 + fr, col0 = u.pn * BM + wc * 32 + 8 * fq;
#pragma unroll
        for (int ai = 0; ai < 2; ++ai)
#pragma unroll
            for (int m = 0; m < 4; ++m) { bf16_t* rowp = Y + (size_t)(row0 + ai * HALF + m * 16) * ldc + col0;
#pragma unroll
                for (int bj = 0; bj < 2; ++bj) { const f32x4 a0 = acc[ai][bj][m][0], a1 = acc[ai][bj][m][1];
                    u32x4 w; w.x = cvt_pk_bf16(a0[0], a0[1]); w.y = cvt_pk_bf16(a0[2], a0[3]); w.z = cvt_pk_bf16(a1[0], a1[1]); w.w = cvt_pk_bf16(a1[2], a1[3]);
                    *(u32x4*)(rowp + bj * HALF) = w; } }
    }
};
struct EpiBranchA {
    static constexpr bool PERM = true, AFTER_DRAIN = false;
    const bf16_t* G; bf16_t* Y;
    __device__ __forceinline__ void operator()(const f32x4 (&acc)[2][2][4][2], const Unit& u, int wr, int wc, int fr, int fq) const {
        const int row0 = u.pm * BM + wr * 64 + fr, col0 = u.pn * BM + wc * 32 + 8 * fq;
#pragma unroll
        for (int ai = 0; ai < 2; ++ai)
#pragma unroll
            for (int m = 0; m < 4; ++m) { const size_t off = (size_t)(row0 + ai * HALF + m * 16) * 1024 + col0;
#pragma unroll
                for (int bj = 0; bj < 2; ++bj) { const u32x4 g = *(const u32x4*)(G + off + bj * HALF); const f32x4 a0 = acc[ai][bj][m][0], a1 = acc[ai][bj][m][1];
                    u32x4 w; w.x = cvt_pk_bf16(a0[0] * bf_lo(g.x), a0[1] * bf_hi(g.x)); w.y = cvt_pk_bf16(a0[2] * bf_lo(g.y), a0[3] * bf_hi(g.y));
                    w.z = cvt_pk_bf16(a1[0] * bf_lo(g.z), a1[1] * bf_hi(g.z)); w.w = cvt_pk_bf16(a1[2] * bf_lo(g.w), a1[3] * bf_hi(g.w));
                    *(u32x4*)(Y + off + bj * HALF) = w; } }
    }
};
struct EpiBranchB {
    static constexpr bool PERM = true, AFTER_DRAIN = false;
    const bf16_t* G; const bf16_t* Y; bf16_t* O;
    __device__ __forceinline__ void operator()(const f32x4 (&acc)[2][2][4][2], const Unit& u, int wr, int wc, int fr, int fq) const {
        const int row0 = u.pm * BM + wr * 64 + fr, col0 = u.pn * BM + wc * 32 + 8 * fq;
#pragma unroll
        for (int ai = 0; ai < 2; ++ai)
#pragma unroll
            for (int m = 0; m < 4; ++m) { const size_t off = (size_t)(row0 + ai * HALF + m * 16) * 1024 + col0;
#pragma unroll
                for (int bj = 0; bj < 2; ++bj) { const u32x4 g = *(const u32x4*)(G + off + bj * HALF), y = *(const u32x4*)(Y + off + bj * HALF); const f32x4 a0 = acc[ai][bj][m][0], a1 = acc[ai][bj][m][1];
                    u32x4 w; w.x = cvt_pk_bf16(bf_lo(y.x) + a0[0] * bf_lo(g.x), bf_hi(y.x) + a0[1] * bf_hi(g.x)); w.y = cvt_pk_bf16(bf_lo(y.y) + a0[2] * bf_lo(g.y), bf_hi(y.y) + a0[3] * bf_hi(g.y));
                    w.z = cvt_pk_bf16(bf_lo(y.z) + a1[0] * bf_lo(g.z), bf_hi(y.z) + a1[1] * bf_hi(g.z)); w.w = cvt_pk_bf16(bf_lo(y.w) + a1[2] * bf_lo(g.w), bf_hi(y.w) + a1[3] * bf_hi(g.w));
                    *(u32x4*)(O + off + bj * HALF) = w; } }
    }
};
struct EpiProj {
    static constexpr bool PERM = true, AFTER_DRAIN = false;
    bf16_t *QN, *PL, *QD, *KD, *VD, *GA, *GB; float* GN; float qscale;
    __device__ __forceinline__ void operator()(const f32x4 (&acc)[2][2][4][2], const Unit& u, int wr, int wc, int fr, int fq) const {
        const int sub = (wc & 1) * 32 + 8 * fq;
#pragma unroll
        for (int bj = 0; bj < 2; ++bj) {
            const int hidx = __builtin_amdgcn_readfirstlane(u.pn * 4 + bj * 2 + (wc >> 1));
            bf16_t* base = nullptr; long pitch = 0, bstride = 0; int mode = 0;
            if (hidx < 8) { base = QN + hidx * 64; pitch = 512; bstride = 8192L * 512; mode = 1; }
            else if (hidx < 20) { const int ti = (hidx - 8) >> 1, g = (hidx - 8) & 1; base = PL + (size_t)ti * (4u * 8192u * 64u) + (size_t)g * (8192u * 64u); pitch = 64; bstride = 2L * 8192 * 64; mode = 0; }
            else if (hidx < 32) { base = QD + (hidx - 20) * 64; pitch = 768; bstride = 8192L * 768; mode = 1; }
            else if (hidx < 44) { base = KD + (size_t)(hidx - 32) * (8192u * 64u); pitch = 64; bstride = 12L * 8192 * 64; mode = 0; }
            else if (hidx < 56) { base = VD + (size_t)(hidx - 44) * (8192u * 64u); pitch = 64; bstride = 12L * 8192 * 64; mode = 0; }
            else if (hidx < 72) { base = GA + (hidx - 56) * 64; pitch = 1024; bstride = 8192L * 1024; mode = 2; }
            else if (hidx < 88) { base = GB + (hidx - 72) * 64; pitch = 1024; bstride = 8192L * 1024; mode = 2; }
            else if (hidx == 88) mode = 3; else mode = 4;
            if (mode == 4) continue;
#pragma unroll
            for (int ai = 0; ai < 2; ++ai)
#pragma unroll
                for (int m = 0; m < 4; ++m) { const int R = u.pm * BM + ai * HALF + wr * 64 + m * 16 + fr, b = R >> 13, t = R & 8191;
                    f32x4 v0 = acc[ai][bj][m][0], v1 = acc[ai][bj][m][1];
                    if (mode == 3) { if (sub < 24) { float* p = GN + (size_t)R * 32 + sub;
#pragma unroll
                            for (int i = 0; i < 4; ++i) { v0[i] = sigmoid_f(v0[i]); v1[i] = sigmoid_f(v1[i]); }
                            *(f32x4*)p = v0; *(f32x4*)(p + 4) = v1; } }
                    else { if (mode == 1) { v0 = v0 * qscale; v1 = v1 * qscale; }
                        if (mode == 2) {
#pragma unroll
                            for (int i = 0; i < 4; ++i) { v0[i] = sigmoid_f(v0[i]); v1[i] = sigmoid_f(v1[i]); } }
                        u32x4 w; w.x = cvt_pk_bf16(v0[0], v0[1]); w.y = cvt_pk_bf16(v0[2], v0[3]); w.z = cvt_pk_bf16(v1[0], v1[1]); w.w = cvt_pk_bf16(v1[2], v1[3]);
                        *(u32x4*)(base + (size_t)b * bstride + (size_t)t * pitch + sub) = w; } }
        }
    }
};
template <class Epi, class Sched, bool ALIGN_EPI = false, bool SP2 = false>
__device__ __forceinline__ void gemm_phase(PG8_LAS unsigned char* lds, const Gemm g, const Sched& S, const Epi& E) {
    const int tid = threadIdx.x, wid = __builtin_amdgcn_readfirstlane(tid >> 6), lane = tid & 63, wr = wid >> 2, wc = wid & 3, fr = lane & 15, fq = lane >> 4;
    const int K = g.K, nt = K / BK;
    unsigned voffA[2], voffB[2];
#pragma unroll
    for (int i = 0; i < 2; ++i) { int R, C; stage_rc(tid * 16 + i * 8192, R, C); const int Rb = Epi::PERM ? ((R & ~31) + perm32(R & 31)) : R;
        voffA[i] = (unsigned)(R * K + C) * 2u; voffB[i] = (unsigned)(Rb * K + C) * 2u; }
    const size_t kstep = (size_t)(BK * 2);
    const size_t hstep = (size_t)HALF * K * 2;
    const size_t tstep = 2 * hstep;
    const unsigned ldsw = (unsigned)wid * 1024u;
    const int aoff = lds_byte(wr * 64 + fr, fq * 8), boff = lds_byte(wc * 32 + fr, fq * 8);
#define PG8_SA(b, h) (((b) * 2 + (h)) * HTB)
#define PG8_SB(b, h) ((4 + (b) * 2 + (h)) * HTB)
#define PG8_STAGE(bufoff, gbase, voff) do { _Pragma("unroll") for (int _i = 0; _i < 2; ++_i) \
        __builtin_amdgcn_global_load_lds((const unsigned*)((const char*)(gbase) + (voff)[_i]), (PG8_LAS unsigned*)(lds + (bufoff) + ldsw + _i * 8192), 16, 0, 0); } while (0)
#define PG8_LDA(dst, b, h) do { _Pragma("unroll") for (int m = 0; m < 4; ++m) _Pragma("unroll") for (int k = 0; k < 2; ++k) dst[m][k] = *(const PG8_LAS bf16x8*)(lds + PG8_SA(b, h) + aoff + m * 2048 + k * 1024); } while (0)
#define PG8_LDB(dst, b, h) do { _Pragma("unroll") for (int n = 0; n < 2; ++n) _Pragma("unroll") for (int k = 0; k < 2; ++k) dst[n][k] = *(const PG8_LAS bf16x8*)(lds + PG8_SB(b, h) + boff + n * 2048 + k * 1024); } while (0)
#define PG8_MMA(ai, bj, At, Bt) do { __builtin_amdgcn_s_setprio(1); _Pragma("unroll") for (int m = 0; m < 4; ++m) _Pragma("unroll") for (int n = 0; n < 2; ++n) _Pragma("unroll") for (int k = 0; k < 2; ++k) \
        acc[ai][bj][m][n] = __builtin_amdgcn_mfma_f32_16x16x32_bf16(Bt[n][k], At[m][k], acc[ai][bj][m][n], 0, 0, 0); __builtin_amdgcn_s_setprio(0); } while (0)
#define PG8_WAIT_V(n) asm volatile("s_waitcnt vmcnt(" #n ")" ::: "memory")
#define PG8_WAIT_L(n) asm volatile("s_waitcnt lgkmcnt(" #n ")" ::: "memory")
#define PG8_BAR __builtin_amdgcn_s_barrier()
#define PG8_SCHED __builtin_amdgcn_sched_barrier(0)
    Unit cur, nxt; int ui = 0;
    if (!S.next(0, cur)) return;
    f32x4 acc[2][2][4][2];
#pragma unroll
    for (int a = 0; a < 2; ++a)
#pragma unroll
        for (int b = 0; b < 2; ++b)
#pragma unroll
            for (int m = 0; m < 4; ++m)
#pragma unroll
                for (int n = 0; n < 2; ++n) acc[a][b][m][n] = (f32x4){0.f, 0.f, 0.f, 0.f};
    bf16x8 At[4][2], B0[2][2], B1[2][2];
    const char* cA = (const char*)g.A + (size_t)cur.pm * tstep; const char* cB = (const char*)g.Bt + (size_t)cur.pn * tstep;
    S.a_ready(cur);
    if constexpr (SP2) {
        PG8_STAGE(PG8_SB(0, 0), cB, voffB); PG8_STAGE(PG8_SB(0, 1), cB + hstep, voffB); PG8_STAGE(PG8_SA(0, 0), cA, voffA); PG8_STAGE(PG8_SA(0, 1), cA + hstep, voffA);
        if (wr == 1) PG8_BAR;
        PG8_WAIT_V(2); PG8_BAR;
        PG8_STAGE(PG8_SB(1, 0), cB + kstep, voffB); PG8_STAGE(PG8_SA(1, 0), cA + kstep, voffA); PG8_STAGE(PG8_SB(1, 1), cB + hstep + kstep, voffB);
        PG8_WAIT_V(6); PG8_BAR;
    } else {
        PG8_STAGE(PG8_SB(0, 0), cB, voffB); PG8_STAGE(PG8_SA(0, 0), cA, voffA); PG8_STAGE(PG8_SB(0, 1), cB + hstep, voffB); PG8_STAGE(PG8_SA(0, 1), cA + hstep, voffA);
        if (wr == 1) PG8_BAR;
        PG8_WAIT_V(4); PG8_BAR;
        PG8_STAGE(PG8_SB(1, 0), cB + kstep, voffB); PG8_STAGE(PG8_SA(1, 0), cA + kstep, voffA); PG8_STAGE(PG8_SB(1, 1), cB + hstep + kstep, voffB);
        PG8_WAIT_V(6); PG8_BAR;
    }
    for (;;) {
        const bool has_next = S.next(ui + 1, nxt);
        const char* nA = has_next ? (const char*)g.A + (size_t)nxt.pm * tstep : cA; const char* nB = has_next ? (const char*)g.Bt + (size_t)nxt.pn * tstep : cB;
        for (int t = 0; t < nt; t += 2) {
            const bool last = (t == nt - 2);
            const char* a1 = cA + (size_t)(t + 1) * kstep;
            const char* a2 = last ? nA : cA + (size_t)(t + 2) * kstep; const char* b2 = last ? nB : cB + (size_t)(t + 2) * kstep;
            const char* a3 = a2 + kstep; const char* b3 = b2 + kstep;
            if (last && has_next) S.a_ready(nxt);
            if constexpr (SP2) {
            PG8_LDB(B0, 0, 0); PG8_LDB(B1, 0, 1); PG8_SCHED; PG8_LDA(At, 0, 0); PG8_STAGE(PG8_SA(1, 1), a1 + hstep, voffA);
            PG8_WAIT_V(8); PG8_WAIT_L(0); PG8_BAR; PG8_MMA(0, 0, At, B0); PG8_MMA(0, 1, At, B1); PG8_BAR; PG8_SCHED;
            PG8_LDA(At, 0, 1); PG8_STAGE(PG8_SB(0, 0), b2, voffB); PG8_STAGE(PG8_SB(0, 1), b2 + hstep, voffB); PG8_STAGE(PG8_SA(0, 0), a2, voffA);
            PG8_WAIT_V(8); PG8_WAIT_L(0); PG8_BAR; PG8_MMA(1, 0, At, B0); PG8_MMA(1, 1, At, B1); PG8_BAR; PG8_SCHED;
            PG8_LDB(B0, 1, 0); PG8_LDB(B1, 1, 1); PG8_SCHED; PG8_LDA(At, 1, 0); PG8_STAGE(PG8_SA(0, 1), a2 + hstep, voffA);
            PG8_WAIT_V(8); PG8_WAIT_L(0); PG8_BAR; PG8_MMA(0, 0, At, B0); PG8_MMA(0, 1, At, B1); PG8_BAR; PG8_SCHED;
            PG8_LDA(At, 1, 1); PG8_STAGE(PG8_SB(1, 0), b3, voffB); PG8_STAGE(PG8_SB(1, 1), b3 + hstep, voffB); PG8_STAGE(PG8_SA(1, 0), a3, voffA);
            PG8_WAIT_V(8); PG8_WAIT_L(0); PG8_BAR; PG8_MMA(1, 0, At, B0); PG8_MMA(1, 1, At, B1); PG8_BAR; PG8_SCHED;
            } else {
            PG8_LDB(B0, 0, 0); PG8_SCHED; PG8_LDA(At, 0, 0); PG8_STAGE(PG8_SA(1, 1), a1 + hstep, voffA);
            PG8_WAIT_L(8); PG8_BAR; PG8_WAIT_L(0); PG8_MMA(0, 0, At, B0); PG8_BAR; PG8_SCHED;
            PG8_LDB(B1, 0, 1); PG8_STAGE(PG8_SB(0, 0), b2, voffB);
            PG8_BAR; PG8_WAIT_L(0); PG8_MMA(0, 1, At, B1); PG8_BAR;
            PG8_LDA(At, 0, 1); PG8_STAGE(PG8_SA(0, 0), a2, voffA);
            PG8_BAR; PG8_WAIT_L(0); PG8_MMA(1, 0, At, B0); PG8_BAR; PG8_SCHED;
            PG8_STAGE(PG8_SB(0, 1), b2 + hstep, voffB);
            PG8_WAIT_V(6); PG8_BAR; PG8_MMA(1, 1, At, B1); PG8_BAR;
            PG8_LDB(B0, 1, 0); PG8_SCHED; PG8_LDA(At, 1, 0); PG8_STAGE(PG8_SA(0, 1), a2 + hstep, voffA);
            PG8_WAIT_L(8); PG8_BAR; PG8_WAIT_L(0); PG8_MMA(0, 0, At, B0); PG8_BAR; PG8_SCHED;
            PG8_LDB(B1, 1, 1); PG8_STAGE(PG8_SB(1, 0), b3, voffB);
            PG8_BAR; PG8_WAIT_L(0); PG8_MMA(0, 1, At, B1); PG8_BAR;
            PG8_LDA(At, 1, 1); PG8_STAGE(PG8_SA(1, 0), a3, voffA);
            PG8_BAR; PG8_WAIT_L(0); PG8_MMA(1, 0, At, B0); PG8_BAR; PG8_SCHED;
            PG8_STAGE(PG8_SB(1, 1), b3 + hstep, voffB);
            PG8_WAIT_V(6); PG8_BAR; PG8_MMA(1, 1, At, B1); PG8_BAR;
            }
        }
        if constexpr (ALIGN_EPI) { if (wr == 0) PG8_BAR; }
        if constexpr (!Epi::AFTER_DRAIN) { E(acc, cur, wr, wc, fr, fq); S.done(cur); }
        if (!has_next) break;
#pragma unroll
        for (int a = 0; a < 2; ++a)
#pragma unroll
            for (int b = 0; b < 2; ++b)
#pragma unroll
                for (int m = 0; m < 4; ++m)
#pragma unroll
                    for (int n = 0; n < 2; ++n) acc[a][b][m][n] = (f32x4){0.f, 0.f, 0.f, 0.f};
        cur = nxt; cA = nA; cB = nB; ++ui;
        if constexpr (ALIGN_EPI) { if (wr == 1) PG8_BAR; }
    }
    PG8_WAIT_V(0);
    if constexpr (!ALIGN_EPI) { if (wr == 0) PG8_BAR; }
    PG8_BAR;
    if constexpr (Epi::AFTER_DRAIN) { E.fused(acc, cur, wr, wc, fr, fq, lds, wid, lane); S.done(cur); }
#undef PG8_SA
#undef PG8_SB
#undef PG8_STAGE
#undef PG8_LDA
#undef PG8_LDB
#undef PG8_MMA
#undef PG8_WAIT_V
#undef PG8_WAIT_L
#undef PG8_BAR
#undef PG8_SCHED
}
}
#define GAS __attribute__((address_space(1)))
#define LAS __attribute__((address_space(3)))
typedef unsigned short bf16;
typedef unsigned v4u __attribute__((ext_vector_type(4)));
typedef float f32x4 __attribute__((ext_vector_type(4)));
typedef short bf16x8 __attribute__((ext_vector_type(8)));
typedef GAS unsigned gu32;
typedef GAS unsigned long long gu64;
#define RLX_AGENT __ATOMIC_RELAXED, __HIP_MEMORY_SCOPE_AGENT
#define LDS_WAIT() asm volatile("s_waitcnt lgkmcnt(0)" ::: "memory")
#define VM_WAIT() asm volatile("s_waitcnt vmcnt(0)" ::: "memory")
__device__ __forceinline__ unsigned long long rt() { return __builtin_amdgcn_s_memrealtime(); }
__device__ __forceinline__ unsigned f2bf(float f) { unsigned u = __builtin_bit_cast(unsigned, f); return (u + 0x7fffu + ((u >> 16) & 1u)) >> 16; }
__device__ __forceinline__ unsigned pk2(float lo, float hi) { return f2bf(lo) | (f2bf(hi) << 16); }

#define XB_TMO      128
#define XB_XCNT(j)  (256  + 64 * (j))
#define XB_XSUB(j)  (1280 + 64 * (j))
#define XB_XGEN(j)  (2304 + 64 * (j))
#define XB_TOP      3328
#define XB_TOPGEN   3392
#define XCD_BAR_WORDS 3456
#define XB_SPIN_CAP (1u << 18)

__device__ __forceinline__ unsigned xb_ld(unsigned* p)              { return __hip_atomic_load(p, __ATOMIC_RELAXED, __HIP_MEMORY_SCOPE_AGENT); }
__device__ __forceinline__ unsigned xb_add(unsigned* p, unsigned v) { return __hip_atomic_fetch_add(p, v, __ATOMIC_RELAXED, __HIP_MEMORY_SCOPE_AGENT); }
__device__ __forceinline__ unsigned xb_xcc_id() { return (unsigned)__builtin_amdgcn_s_getreg((3 << 11) | 20) & 0xFu; }
#define XB_SPIN(cond, bar) do { unsigned _sp = 0; while (cond) { __builtin_amdgcn_s_sleep(1); \
    if ((++_sp & 255u) == 0u) { if (xb_ld(&(bar)[XB_TMO])) break; if (_sp > XB_SPIN_CAP) { atomicAdd(&(bar)[XB_TMO], 1u); break; } } } } while (0)

struct XcdBarrier {
    unsigned* bar; unsigned x;
    volatile LAS unsigned* st;
};

__device__ __forceinline__ XcdBarrier xcd_barrier_post(unsigned* bar, volatile LAS unsigned* st) {
    XcdBarrier b; b.bar = bar; b.x = xb_xcc_id(); b.st = st;
    if (threadIdx.x == 0) (void)xb_add(&bar[XB_XCNT(b.x)], 1u);
    return b;
}
__device__ __forceinline__ void xcd_barrier_complete(unsigned* bar, unsigned x, unsigned& nloc, unsigned& nx) {
    const unsigned G = gridDim.x * gridDim.y * gridDim.z;
    unsigned sum, cnt, mine, sp = 0u;
    for (;;) {
        sum = 0u; cnt = 0u; mine = 0u;
#pragma unroll
        for (unsigned j = 0; j < 16; ++j) { const unsigned c = xb_ld(&bar[XB_XCNT(j)]); sum += c; cnt += (c > 0u) ? 1u : 0u; mine = (j == x) ? c : mine; }
        if (sum == G) break;
        __builtin_amdgcn_s_sleep(1);
        if ((++sp & 255u) == 0u) { if (xb_ld(&bar[XB_TMO])) break; if (sp > XB_SPIN_CAP) { atomicAdd(&bar[XB_TMO], 1u); break; } }
    }
    nloc = mine > 0u ? mine : 1u; nx = cnt > 0u ? cnt : 1u;
}

__device__ __forceinline__ void xcd_barrier(const XcdBarrier& b) {
    asm volatile("s_waitcnt vmcnt(0)" ::: "memory");
    __syncthreads();
    if (threadIdx.x == 0) {
        unsigned* bar = b.bar;
        __builtin_amdgcn_s_waitcnt(0);
        unsigned nloc = b.st[0], nx = b.st[1];
        if (nloc == 0u) { xcd_barrier_complete(bar, b.x, nloc, nx); b.st[0] = nloc; b.st[1] = nx; }
        const unsigned old = xb_add(&bar[XB_XSUB(b.x)], 1u);
        const unsigned gen = old / nloc;
        if (old + 1u == (gen + 1u) * nloc) {
            __builtin_amdgcn_fence(__ATOMIC_RELEASE, "agent");
            asm volatile("s_waitcnt vmcnt(0)" ::: "memory");
            const unsigned og = xb_add(&bar[XB_TOP], 1u);
            const unsigned tg = og / nx;
            if (og + 1u == (tg + 1u) * nx) xb_add(&bar[XB_TOPGEN], 1u);
            else XB_SPIN(xb_ld(&bar[XB_TOPGEN]) == tg, bar);
            __builtin_amdgcn_fence(__ATOMIC_ACQUIRE, "agent");
            xb_add(&bar[XB_XGEN(b.x)], 1u);
            asm volatile("s_waitcnt vmcnt(0)" ::: "memory");
        } else {
            XB_SPIN(xb_ld(&bar[XB_XGEN(b.x)]) == gen, bar);
            __builtin_amdgcn_fence(__ATOMIC_ACQUIRE, "agent");
            asm volatile("s_waitcnt vmcnt(0)" ::: "memory");
        }
    }
    __syncthreads();
}

constexpr int NWAVES = 8;
constexpr int BATCH = 2, SEQ = 8192, D = 1024, FF = 2816, M = BATCH * SEQ;
constexpr int NPROJ_SRC = 5656, NPROJ = 5888;
constexpr float RMS_EPS = 1e-6f;
constexpr float LOG2E = 1.4426950408889634f;
constexpr float QSCALE = 0.125f * LOG2E;

constexpr size_t MiB = 1u << 20;
constexpr size_t WS_CTL = 0, CTL_ZERO_BYTES = 64 * 1024;
constexpr size_t WS_LUTN = 1 * MiB;
constexpr size_t WS_LUTD = WS_LUTN + 64 * 1024;
constexpr size_t WS_CB = WS_LUTD + 16 * 1024;
constexpr size_t WS_KCMP = 1 * MiB + 256 * 1024, WS_VCMP = WS_KCMP + 256 * 1024;
constexpr size_t WS_WIN = 2 * MiB;
constexpr size_t WS_WC1K = WS_WIN + (size_t)NPROJ * D * 2;
constexpr size_t WS_WC1V = WS_WC1K + 1 * MiB;
constexpr size_t WS_WC2K = WS_WC1V + 1 * MiB;
constexpr size_t WS_WC2V = WS_WC2K + 32 * 1024;
constexpr size_t WS_WBN = WS_WC2V + 32 * 1024;
constexpr size_t WS_WBD = WS_WBN + 1 * MiB;
constexpr size_t WS_WOUT = WS_WBD + MiB / 2;
constexpr size_t WS_WGU2 = WS_WOUT + 2 * MiB;
constexpr size_t WS_WD2 = WS_WGU2 + (size_t)2 * FF * D * 2;
constexpr size_t WS_WGU1 = 36 * MiB;
constexpr size_t WS_WD1 = WS_WGU1 + (size_t)2 * FF * D * 2;
static_assert(WS_WD2 + (size_t)D * FF * 2 <= WS_WGU1, "weights A");
static_assert(WS_WD1 + (size_t)D * FF * 2 <= 53 * MiB, "weights B");
constexpr size_t WS_QN = 36 * MiB;
constexpr size_t WS_XN = 53 * MiB;
constexpr size_t WS_MG = 141 * MiB;
constexpr size_t WS_YN = 69 * MiB;
constexpr size_t WS_H = 85 * MiB;
constexpr size_t WS_Y = 173 * MiB;
constexpr size_t WS_PL = 85 * MiB;
constexpr size_t WS_QD = 109 * MiB;
constexpr size_t WS_KD = 133 * MiB, WS_VD = 157 * MiB;
constexpr size_t WS_GA = 181 * MiB, WS_GB = 213 * MiB;
constexpr size_t WS_GN = 245 * MiB;
constexpr size_t WS_YD = 247 * MiB;
constexpr size_t WS_Y2P = 109 * MiB;
constexpr size_t WS_END = 256 * MiB;
static_assert(WS_H + (size_t)M * FF * 2 <= WS_Y && WS_Y + (size_t)M * D * 4 <= WS_END, "ffn map");
static_assert(WS_YD + (size_t)M * 256 * 2 <= WS_END && WS_GN + (size_t)M * 32 * 4 <= WS_YD && WS_Y2P + (size_t)M * D * 2 <= WS_MG && WS_MG + (size_t)M * D * 2 <= WS_GA, "mixer map");
constexpr size_t PLSZ = (size_t)4 * 8192 * 64;
constexpr int CW_TMO = 0, CW_BAR = 1024;

constexpr int RING_OFF = 0, RING_BYTES = 131072;
constexpr int LDSCTL_OFF = 143360, MISC_OFF = LDSCTL_OFF + 320;
constexpr int LDS_BYTES = 147456;
constexpr int LUT_PAD = 64, LUTW = 1672;
constexpr int A_KV = 0;
constexpr int A_LUT = 65536;
constexpr int A_IMP = A_LUT + 4 * LUTW * 4;
constexpr int IMP_S = 132;
constexpr int A_SEL = A_IMP + 64 * IMP_S * 4;
constexpr int A_UM = A_SEL + 64 * 16;
constexpr int A_WSF = A_UM + 64;
constexpr int A_END = A_WSF + 8 * 512;
static_assert(A_END <= LDSCTL_OFF, "attention LDS");
constexpr size_t WS_OD = 53 * MiB;
constexpr size_t WS_LSE = 255 * MiB;

__device__ __forceinline__ int fresh_tid() { int t = threadIdx.x; asm volatile("" : "+v"(t)); return t; }
struct Frame {
    LAS unsigned char* lds;
    volatile LAS unsigned* MISC;
    gu32* ctl;
    int vcu, G;
};

__device__ __forceinline__ float wave_sum(float v) {
#pragma unroll
    for (int o = 1; o < 64; o <<= 1) v += __shfl_xor(v, o);
    return v;
}
template <bool FRAG = false> __device__ __forceinline__ void tr_item(const float* W, int K, int Nsrc, int sc0, int nvalid, bf16* WT, int dr0, int kb, LAS float* scr, int lane) {
    const int k0 = 64 * kb;
#pragma unroll 8
    for (int i = 0; i < 32; ++i) { const int kk = 2 * i + (lane >> 5), n = lane & 31; scr[kk * 33 + n] = (n < nvalid) ? W[(size_t)(k0 + kk) * Nsrc + sc0 + n] : 0.f; }
    LDS_WAIT(); asm volatile("" ::: "memory");
    const int c = lane & 7;
#pragma unroll
    for (int j = 0; j < 4; ++j) { const int n = (lane >> 3) + 8 * j; const LAS float* s = scr + (8 * c) * 33 + n;
        v4u o; o.x = pk2(s[0 * 33], s[1 * 33]); o.y = pk2(s[2 * 33], s[3 * 33]); o.z = pk2(s[4 * 33], s[5 * 33]); o.w = pk2(s[6 * 33], s[7 * 33]);
        const int ng = dr0 + n, kk = k0 + 8 * c;
        const size_t off = FRAG ? ((size_t)(((ng >> 5) * (K >> 4) + (kk >> 4)) * 64 + ((kk >> 3) & 1) * 32 + (ng & 31)) * 8) : ((size_t)ng * K + kk);
        *(GAS v4u*)(WT + off) = o; }
    LDS_WAIT(); asm volatile("" ::: "memory");
}
__device__ __forceinline__ void win_map(int dblk, int& sc0, int& nvalid) {
    const int hidx = dblk >> 1, half = dblk & 1; nvalid = 32;
    if (hidx < 8) sc0 = hidx * 64 + half * 32;
    else if (hidx < 20) sc0 = 512 + (hidx - 8) * 64 + half * 32;
    else if (hidx < 32) sc0 = 1304 + (hidx - 20) * 64 + half * 32;
    else if (hidx < 44) sc0 = 2072 + (hidx - 32) * 64 + half * 32;
    else if (hidx < 56) sc0 = 2840 + (hidx - 44) * 64 + half * 32;
    else if (hidx < 72) sc0 = 3608 + (hidx - 56) * 64 + half * 32;
    else if (hidx < 88) sc0 = 4632 + (hidx - 72) * 64 + half * 32;
    else if (hidx == 88 && half == 0) { sc0 = 1280; nvalid = 24; }
    else { sc0 = 0; nvalid = 0; }
}
__device__ __forceinline__ void gu_map(int dblk, int& sc0) { const int pn = dblk >> 3, q = dblk & 7; sc0 = (q < 4) ? (128 * pn + 32 * q) : (FF + 128 * pn + 32 * (q - 4)); }
__device__ __forceinline__ int t5_bucket(int d) {
    if (d < 16) return d;
    int b = 16;
    b += (d >= 22); b += (d >= 30); b += (d >= 40); b += (d >= 54); b += (d >= 73); b += (d >= 99); b += (d >= 134); b += (d >= 182);
    b += (d >= 246); b += (d >= 332); b += (d >= 450); b += (d >= 609); b += (d >= 825); b += (d >= 1117); b += (d >= 1513);
    return b;
}
struct In {
    const float *x, *f1_pre, *f1_wgu, *f1_wd, *f1_post, *mix_pre, *w_in, *cpos_k, *cw1_k, *cw2_k, *cpos_v, *cw1_v, *cw2_v, *w_bn, *w_bd, *w_out, *mix_post, *f2_pre, *f2_wgu, *f2_wd, *f2_post, *rel_bias;
};
__device__ __forceinline__ void rms_row_to_bf16(const float* xrow, const float* gain, bf16* orow, int lane) {
    const GAS f32x4* xr = (const GAS f32x4*)xrow + lane; const GAS f32x4* gr = (const GAS f32x4*)gain + lane;
    f32x4 v[4]; float s = 0.f;
#pragma unroll
    for (int j = 0; j < 4; ++j) { v[j] = xr[64 * j]; s += (v[j].x * v[j].x + v[j].y * v[j].y) + (v[j].z * v[j].z + v[j].w * v[j].w); }
    const float r = 1.f / sqrtf(wave_sum(s) * (1.f / D) + RMS_EPS);
    GAS unsigned long long* o8 = (GAS unsigned long long*)orow + lane;
#pragma unroll
    for (int j = 0; j < 4; ++j) { const f32x4 g = gr[64 * j]; o8[64 * j] = (unsigned long long)pk2(v[j].x * r * g.x, v[j].y * r * g.y) | ((unsigned long long)pk2(v[j].z * r * g.z, v[j].w * r * g.w) << 32); }
}
__device__ __forceinline__ void p0_prologue(Frame& F, const In& in, unsigned char* ws) {
    const int tid = fresh_tid(), lane = tid & 63, wave = __builtin_amdgcn_readfirstlane(tid >> 6);
    LAS float* scr = (LAS float*)(F.lds + RING_OFF + wave * 16384);
    const int gw = F.vcu * NWAVES + wave, NGW = F.G * NWAVES;
    constexpr int I_GU = 176 * 16, I_D = 32 * 44, I_IN = 184 * 16, I_C1 = 8 * 32, I_C2 = 2 * 4, I_BN = 32 * 8, I_BD = 32 * 4, I_O = 32 * 16;
    constexpr int NITEMS = 2 * I_GU + 2 * I_D + I_IN + 2 * I_C1 + 2 * I_C2 + I_BN + I_BD + I_O;
    for (int it = gw; it < NITEMS; it += NGW) {
        int r = it, sc0, nv = 32;
        if (r < I_GU) { const int dblk = r / 16, kb = r % 16; gu_map(dblk, sc0); tr_item(in.f1_wgu, D, 2 * FF, sc0, 32, (bf16*)(ws + WS_WGU1), dblk * 32, kb, scr, lane); continue; } r -= I_GU;
        if (r < I_GU) { const int dblk = r / 16, kb = r % 16; gu_map(dblk, sc0); tr_item(in.f2_wgu, D, 2 * FF, sc0, 32, (bf16*)(ws + WS_WGU2), dblk * 32, kb, scr, lane); continue; } r -= I_GU;
        if (r < I_D) { const int dblk = r / 44, kb = r % 44; tr_item(in.f1_wd, FF, D, dblk * 32, 32, (bf16*)(ws + WS_WD1), dblk * 32, kb, scr, lane); continue; } r -= I_D;
        if (r < I_D) { const int dblk = r / 44, kb = r % 44; tr_item(in.f2_wd, FF, D, dblk * 32, 32, (bf16*)(ws + WS_WD2), dblk * 32, kb, scr, lane); continue; } r -= I_D;
        if (r < I_IN) { const int dblk = r / 16, kb = r % 16; win_map(dblk, sc0, nv); tr_item(in.w_in, D, NPROJ_SRC, sc0, nv, (bf16*)(ws + WS_WIN), dblk * 32, kb, scr, lane); continue; } r -= I_IN;
        if (r < I_C1) { const int dblk = r / 32, kb = r % 32; tr_item<true>(in.cw1_k, 2048, 256, dblk * 32, 32, (bf16*)(ws + WS_WC1K), dblk * 32, kb, scr, lane); continue; } r -= I_C1;
        if (r < I_C1) { const int dblk = r / 32, kb = r % 32; tr_item<true>(in.cw1_v, 2048, 256, dblk * 32, 32, (bf16*)(ws + WS_WC1V), dblk * 32, kb, scr, lane); continue; } r -= I_C1;
        if (r < I_C2) { const int dblk = r / 4, kb = r % 4; tr_item(in.cw2_k, 256, 64, dblk * 32, 32, (bf16*)(ws + WS_WC2K), dblk * 32, kb, scr, lane); continue; } r -= I_C2;
        if (r < I_C2) { const int dblk = r / 4, kb = r % 4; tr_item(in.cw2_v, 256, 64, dblk * 32, 32, (bf16*)(ws + WS_WC2V), dblk * 32, kb, scr, lane); continue; } r -= I_C2;
        if (r < I_BN) { const int dblk = r / 8, kb = r % 8; tr_item(in.w_bn, 512, D, dblk * 32, 32, (bf16*)(ws + WS_WBN), dblk * 32, kb, scr, lane); continue; } r -= I_BN;
        if (r < I_BD) { const int dblk = r / 4, kb = r % 4; tr_item(in.w_bd, 256, D, dblk * 32, 32, (bf16*)(ws + WS_WBD), dblk * 32, kb, scr, lane); continue; } r -= I_BD;
        { const int dblk = r / 16, kb = r % 16; tr_item(in.w_out, D, D, dblk * 32, 32, (bf16*)(ws + WS_WOUT), dblk * 32, kb, scr, lane); }
    }
    { float* ln = (float*)(ws + WS_LUTN); float* ld = (float*)(ws + WS_LUTD); const int gt = F.vcu * (NWAVES * 64) + tid, NGT = F.G * NWAVES * 64;
      for (int e = gt; e < 8 * LUTW; e += NGT) { const int hd = e / LUTW, d = e % LUTW - LUT_PAD; ln[e] = (d >= 0) ? in.rel_bias[t5_bucket(d) * 20 + hd] * LOG2E : 0.f; }
      for (int e = gt; e < 12 * 320; e += NGT) { const int hd = e / 320, st = e % 320 - LUT_PAD; const int dil = 1 << (2 * (hd >> 2)); ld[e] = (st >= 0 && st <= 128) ? in.rel_bias[t5_bucket(st * dil) * 20 + 8 + hd] * LOG2E : 0.f; } }
    { float* cb = (float*)(ws + WS_CB);
      for (int o = gw; o < 512; o += NGW) { const int ts = o >> 8, n = o & 255; const float* pos = ts ? in.cpos_v : in.cpos_k; const float* w1 = ts ? in.cw1_v : in.cw1_k;
          float s = 0.f; for (int k = lane; k < 2048; k += 64) s += pos[k] * w1[(size_t)k * 256 + n];
          s = wave_sum(s); if (lane == 0) cb[o] = s; } }
    for (int m = gw; m < M; m += NGW) rms_row_to_bf16(in.x + (size_t)m * D, in.f1_pre, (bf16*)(ws + WS_XN) + (size_t)m * D, lane);
}
__device__ __forceinline__ void row_pass(Frame& F, const bf16* Y, const float* base, float* out, float alpha, const float* gpost, const float* gnext, bf16* XN) {
    const int tid = fresh_tid(), lane = tid & 63, wave = __builtin_amdgcn_readfirstlane(tid >> 6);
    const int gw = F.vcu * NWAVES + wave, NGW = F.G * NWAVES;
    for (int m = gw; m < M; m += NGW) {
        const GAS unsigned long long* yr = (const GAS unsigned long long*)(Y + (size_t)m * D) + lane; const GAS f32x4* br = (const GAS f32x4*)(base + (size_t)m * D) + lane;
        const GAS f32x4* gp = (const GAS f32x4*)gpost + lane;
        f32x4 v[4], bv[4]; float s = 0.f;
#pragma unroll
        for (int j = 0; j < 4; ++j) { const unsigned long long w = yr[64 * j]; const unsigned lo = (unsigned)w, hi = (unsigned)(w >> 32);
            v[j].x = __uint_as_float(lo << 16); v[j].y = __uint_as_float(lo & 0xffff0000u); v[j].z = __uint_as_float(hi << 16); v[j].w = __uint_as_float(hi & 0xffff0000u);
            bv[j] = br[64 * j]; s += (v[j].x * v[j].x + v[j].y * v[j].y) + (v[j].z * v[j].z + v[j].w * v[j].w); }
        const float r = alpha / sqrtf(wave_sum(s) * (1.f / D) + RMS_EPS);
        float s2 = 0.f;
        GAS f32x4* orow = (GAS f32x4*)(out + (size_t)m * D) + lane;
#pragma unroll
        for (int j = 0; j < 4; ++j) { const f32x4 g = gp[64 * j]; v[j] = bv[j] + v[j] * r * g; orow[64 * j] = v[j]; s2 += (v[j].x * v[j].x + v[j].y * v[j].y) + (v[j].z * v[j].z + v[j].w * v[j].w); }
        if (gnext) {
            const float r2 = 1.f / sqrtf(wave_sum(s2) * (1.f / D) + RMS_EPS);
            const GAS f32x4* gn = (const GAS f32x4*)gnext + lane;
            GAS unsigned long long* o8 = (GAS unsigned long long*)(XN + (size_t)m * D) + lane;
#pragma unroll
            for (int j = 0; j < 4; ++j) { const f32x4 g = gn[64 * j]; o8[64 * j] = (unsigned long long)pk2(v[j].x * r2 * g.x, v[j].y * r2 * g.y) | ((unsigned long long)pk2(v[j].z * r2 * g.z, v[j].w * r2 * g.w) << 32); }
        }
    }
}

namespace att {
typedef float f32x16 __attribute__((ext_vector_type(16)));
typedef short s16x4 __attribute__((ext_vector_type(4)));
typedef short v4i16_t __attribute__((ext_vector_type(4)));
constexpr float NEGV = -1.0e30f;
constexpr int TILE_B = 16384, SBUF = 2 * TILE_B;
enum { CLS_SKIP = 0, CLS_FULL = 1, CLS_PART = 2, CLS_CONST = 3 };
__device__ __forceinline__ constexpr int crow(int r, int hi) { return (r & 3) + 8 * (r >> 2) + 4 * hi; }
__device__ __forceinline__ unsigned cvtpk(float lo, float hi) { unsigned r; asm volatile("v_cvt_pk_bf16_f32 %0, %1, %2" : "=v"(r) : "v"(lo), "v"(hi)); return r; }
__device__ __forceinline__ float swapmax(float v) { auto rr = __builtin_amdgcn_permlane32_swap(__float_as_uint(v), __float_as_uint(v), false, false); return fmaxf(__uint_as_float(rr[0]), __uint_as_float(rr[1])); }
__device__ __forceinline__ float swapsum(float v) { auto rr = __builtin_amdgcn_permlane32_swap(__float_as_uint(v), __float_as_uint(v), false, false); return __uint_as_float(rr[0]) + __uint_as_float(rr[1]); }
__device__ __forceinline__ float quadsum(float v) {
    v += __int_as_float(__builtin_amdgcn_mov_dpp(__float_as_int(v), 0xB1, 0xF, 0xF, true));
    v += __int_as_float(__builtin_amdgcn_mov_dpp(__float_as_int(v), 0x4E, 0xF, 0xF, true));
    return v;
}
struct Stage { v4u k, v; };
struct Stage2 { Stage t[2]; };
__device__ __forceinline__ void tile_load(Stage& s, const bf16* Kp, const bf16* Vp, long row, int tid) {
    const int ch = tid & 7; s.k = *(const GAS v4u*)(Kp + row * 64 + ch * 8); s.v = *(const GAS v4u*)(Vp + row * 64 + ch * 8);
}
__device__ __forceinline__ void tile_store(LAS unsigned char* buf, const Stage& s, int tid) {
    const int key = tid >> 3, ch = tid & 7;
    *(LAS v4u*)(buf + ch * 1024 + key * 16) = s.k;
    *(LAS v4u*)(buf + 8192 + (ch >> 2) * 4096 + key * 64 + (ch & 3) * 16) = s.v;
}
#define ATT_BAR() asm volatile("s_waitcnt lgkmcnt(0)\n\ts_barrier" ::: "memory")
__device__ __forceinline__ void qk(f32x16& p0, f32x16& p1, const LAS unsigned char* kb, const bf16x8 (&qr)[4]) {
#pragma unroll
    for (int d0 = 0; d0 < 4; ++d0) {
        const bf16x8 b0 = *(const LAS bf16x8*)(kb + d0 * 2048), b1 = *(const LAS bf16x8*)(kb + d0 * 2048 + 512);
        p0 = __builtin_amdgcn_mfma_f32_32x32x16_bf16(b0, qr[d0], p0, 0, 0, 0);
        p1 = __builtin_amdgcn_mfma_f32_32x32x16_bf16(b1, qr[d0], p1, 0, 0, 0);
    }
}
__device__ __forceinline__ float max3f(float a, float b, float c) { float r; asm("v_max3_f32 %0, %1, %2, %3" : "=v"(r) : "v"(a), "v"(b), "v"(c)); return r; }
__device__ __forceinline__ float rowmax32(const f32x16& p0, const f32x16& p1) {
    float a = max3f(p0[0], p1[0], p0[1]), b = max3f(p1[1], p0[2], p1[2]);
#pragma unroll
    for (int r = 3; r < 15; r += 2) { a = max3f(a, p0[r], p1[r]); b = max3f(b, p0[r + 1], p1[r + 1]); }
    a = max3f(a, p0[15], p1[15]);
    return swapmax(fmaxf(a, b));
}
__device__ __forceinline__ s16x4 vtr(const LAS unsigned char* p) { return __builtin_bit_cast(s16x4, __builtin_amdgcn_ds_read_tr16_b64_v4i16((LAS v4i16_t*)p)); }
__device__ __forceinline__ void pv(f32x16 (&o)[2], const LAS unsigned char* vb, const f32x16& p0, const f32x16& p1) {
    v4u pw[4];
#pragma unroll
    for (int s = 0; s < 2; ++s) {
        pw[s]     = (v4u){cvtpk(p0[8 * s], p0[8 * s + 1]), cvtpk(p0[8 * s + 2], p0[8 * s + 3]), cvtpk(p0[8 * s + 4], p0[8 * s + 5]), cvtpk(p0[8 * s + 6], p0[8 * s + 7])};
        pw[2 + s] = (v4u){cvtpk(p1[8 * s], p1[8 * s + 1]), cvtpk(p1[8 * s + 2], p1[8 * s + 3]), cvtpk(p1[8 * s + 4], p1[8 * s + 5]), cvtpk(p1[8 * s + 6], p1[8 * s + 7])};
    }
#pragma unroll
    for (int dh = 0; dh < 2; ++dh)
#pragma unroll
        for (int kg = 0; kg < 4; ++kg) {
            const s16x4 lo = vtr(vb + dh * 4096 + kg * 1024), hi = vtr(vb + dh * 4096 + kg * 1024 + 512);
            const bf16x8 vf = (bf16x8){lo[0], lo[1], lo[2], lo[3], hi[0], hi[1], hi[2], hi[3]};
            o[dh] = __builtin_amdgcn_mfma_f32_32x32x16_bf16(__builtin_bit_cast(bf16x8, pw[kg]), vf, o[dh], 0, 0, 0);
        }
}
struct Soft { float mref, lsum; };
__device__ __forceinline__ void proc_tile(int cls, const LAS unsigned char* tile, const bf16x8 (&qr)[4], Soft& st, f32x16 (&o)[2], const LAS float* lut, int d0, int dlo, int dhi, float cbias, bool rowsel,
                                          LAS float* wsf, int r32, int hi, int trb) {
    const bool unset = st.mref < -1.0e29f;
    const float base = unset ? 0.f : st.mref;
    const float negb = rowsel ? -base : NEGV;
    f32x16 p0, p1;
    if (cls == CLS_CONST) { const float iv = negb + cbias;
#pragma unroll
        for (int r = 0; r < 16; ++r) { p0[r] = iv; p1[r] = iv; }
    } else { const LAS float* pb = lut + (d0 - 4 * hi - 59);
#pragma unroll
        for (int r = 0; r < 16; ++r) { p0[r] = pb[59 - crow(r, 0)] + negb; p1[r] = pb[27 - crow(r, 0)] + negb; }
    }
    qk(p0, p1, tile + hi * 1024 + r32 * 16, qr);
    if (cls == CLS_PART) { const int dq = d0 - 4 * hi; const unsigned span = (unsigned)(dhi - dlo);
#pragma unroll
        for (int r = 0; r < 16; ++r) { const int da = dq - crow(r, 0), db = da - 32;
            p0[r] = ((unsigned)(da - dlo) <= span) ? p0[r] : NEGV; p1[r] = ((unsigned)(db - dlo) <= span) ? p1[r] : NEGV; }
    }
    const float rm = rowmax32(p0, p1);
    const bool upd = rowsel && (rm > -1.0e29f) && (unset || rm > 8.0f);
    if (__any(upd)) {
        const float delta = upd ? rm : 0.f;
#pragma unroll
        for (int r = 0; r < 16; ++r) { p0[r] -= delta; p1[r] -= delta; }
        const float f = (upd && !unset) ? __builtin_amdgcn_exp2f(-delta) : 1.0f;
        st.lsum *= f;
        if (upd) st.mref = base + delta;
        if (hi == 0) wsf[r32] = f;
        asm volatile("s_waitcnt lgkmcnt(0)" ::: "memory");
#pragma unroll
        for (int r = 0; r < 16; ++r) { const float fr = wsf[crow(r, hi)]; o[0][r] *= fr; o[1][r] *= fr; }
        asm volatile("s_waitcnt lgkmcnt(0)" ::: "memory");
    }
    float s = 0.f;
#pragma unroll
    for (int r = 0; r < 16; ++r) { p0[r] = __builtin_amdgcn_exp2f(p0[r]); p1[r] = __builtin_amdgcn_exp2f(p1[r]); s += p0[r] + p1[r]; }
    st.lsum += s;
    pv(o, tile + 8192 + trb, p0, p1);
}
__device__ __forceinline__ float soft_final_inv(const Soft& st, float& ltot) { ltot = swapsum(st.lsum); return (st.mref > -1.0e29f) ? 1.0f / ltot : 0.f; }
}

struct Mix {
    bf16 *QN, *YN, *PL, *QD, *KD, *VD, *YD, *KCMP, *VCMP, *OD; float* LSE; const float* GN; const float* LUTN; const float* LUTD; const float* CB;
    const bf16 *WC1K, *WC1V, *WC2K, *WC2V;
};
__device__ __forceinline__ void lut_to_lds(Frame& F, int tid, const float* img, int nf) {
    LAS f32x4* L = (LAS f32x4*)(F.lds + A_LUT); const GAS f32x4* G = (const GAS f32x4*)img;
    for (int e = tid; e < nf / 4; e += NWAVES * 64) L[e] = G[e];
}
__device__ __forceinline__ bf16x8 ldq(const bf16* p) { return *(const GAS bf16x8*)p; }

__device__ __forceinline__ int next_sel(int j, int c, unsigned u0, unsigned u1, unsigned u2, unsigned u3) {
    while (j <= c) { const unsigned w = (j < 32) ? u0 : (j < 64) ? u1 : (j < 96) ? u2 : u3; if ((w >> (j & 31)) & 1u) break; ++j; }
    return j;
}
template <bool ADD> __device__ __forceinline__ void yn_rows(bf16* YN, const att::f32x16 (&o)[2], float fac, LAS float* wsf, int r32, int hi, size_t R0, int g, int lane) {
    if (hi == 0) wsf[r32] = fac;
    asm volatile("s_waitcnt lgkmcnt(0)" ::: "memory");
#pragma unroll
    for (int r = 0; r < 16; ++r) { const int q = att::crow(r, hi); const float fr = wsf[q];
        bf16* op = YN + (R0 + (q >> 2)) * 512 + (4 * g + (q & 3)) * 64 + (lane & 31);
        float a0 = o[0][r] * fr, a1 = o[1][r] * fr;
        if (ADD) { a0 += __uint_as_float((unsigned)op[0] << 16); a1 += __uint_as_float((unsigned)op[32] << 16); }
        op[0] = (bf16)f2bf(a0); op[32] = (bf16)f2bf(a1); }
    asm volatile("s_waitcnt lgkmcnt(0)" ::: "memory");
}
__device__ __forceinline__ void nsa_unit(Frame& F, const Mix& X, int b, int g, int c, int& buf) {
    using namespace att;
    const int tid = fresh_tid(), lane = tid & 63, wave = __builtin_amdgcn_readfirstlane(tid >> 6), r32 = lane & 31, hi = lane >> 5;
    LAS unsigned char* kv = F.lds + A_KV; LAS float* lutl = (LAS float*)(F.lds + A_LUT); LAS float* imp = (LAS float*)(F.lds + A_IMP);
    LAS unsigned* selm = (LAS unsigned*)(F.lds + A_SEL); LAS unsigned* um = (LAS unsigned*)(F.lds + A_UM); LAS float* wsf = (LAS float*)(F.lds + A_WSF) + wave * 128;
    const int trb = ((lane >> 4) & 1) * 32 + (lane & 3) * 8 + (4 * hi + ((lane & 15) >> 2)) * 64;
    const int t0 = 64 * c, tok = 8 * wave + (r32 >> 2), h = r32 & 3, t = t0 + tok;
    const size_t R = (size_t)b * SEQ + t, R0 = (size_t)b * SEQ + t0 + 8 * wave;
    const int plane = b * 2 + g;
    const bf16* KS = X.PL + 2 * PLSZ + (size_t)plane * SEQ * 64; const bf16* VS = X.PL + 3 * PLSZ + (size_t)plane * SEQ * 64;
    const bf16* KW = X.PL + 4 * PLSZ + (size_t)plane * SEQ * 64; const bf16* VW = X.PL + 5 * PLSZ + (size_t)plane * SEQ * 64;
    const bf16* KC = X.KCMP + (size_t)plane * 512 * 64; const bf16* VC = X.VCMP + (size_t)plane * 512 * 64;
    __syncthreads();
    lut_to_lds(F, tid, X.LUTN + (size_t)g * 4 * LUTW, 4 * LUTW);
    for (int e = tid; e < 64 * IMP_S / 4; e += NWAVES * 64) ((LAS f32x4*)imp)[e] = (f32x4){0.f, 0.f, 0.f, 0.f};
    if (tid < 4) um[tid] = 0u;
    bf16x8 qr[4];
#pragma unroll
    for (int d0 = 0; d0 < 4; ++d0) qr[d0] = ldq(X.QN + R * 512 + (4 * g + h) * 64 + 16 * d0 + 8 * hi);
    const float g0 = X.GN[R * 32 + (4 * g + h) * 3 + 0], g1 = X.GN[R * 32 + (4 * g + h) * 3 + 1], g2 = X.GN[R * 32 + (4 * g + h) * 3 + 2];
    const LAS float* lrow = lutl + h * LUTW + LUT_PAD;
    __syncthreads();
    const int key = tid >> 3;
    Stage2 sg;
    {
        Soft st{NEGV, 0.f}; f32x16 o[2]; o[0] = f32x16{}; o[1] = f32x16{};
        const int it0 = (c >= 8) ? 0 : (8 - c), nt = 9 - it0, nss = (nt + 1) >> 1;
#pragma unroll
        for (int tt = 0; tt < 2; ++tt) { int it = it0 + tt; it = it > 8 ? 8 : it; tile_load(sg.t[tt], KW, VW, t0 - 512 + 64 * it + key, tid); }
        for (int ss = 0; ss < nss; ++ss) {
            LAS unsigned char* bp = kv + buf * SBUF;
            tile_store(bp, sg.t[0], tid); tile_store(bp + TILE_B, sg.t[1], tid); ATT_BAR();
            if (ss + 1 < nss) {
#pragma unroll
                for (int tt = 0; tt < 2; ++tt) { int it = it0 + 2 * (ss + 1) + tt; it = it > 8 ? 8 : it; tile_load(sg.t[tt], KW, VW, t0 - 512 + 64 * it + key, tid); } }
#pragma unroll
            for (int tt = 0; tt < 2; ++tt) { const int it = it0 + 2 * ss + tt;
                if (it <= 8) { const int kb = t0 - 512 + 64 * it; const int cls = (it == 0 || it == 8) ? CLS_PART : CLS_FULL;
                    proc_tile(cls, bp + tt * TILE_B, qr, st, o, lrow, t - kb, 0, 511, 0.f, true, wsf, r32, hi, trb); } }
            buf ^= 1;
        }
        float lt; const float inv = soft_final_inv(st, lt);
        yn_rows<false>(X.YN, o, g2 * inv, wsf, r32, hi, R0, g, lane);
    }
    {
        const int imax = (4 * c + 2 > 510) ? 510 : (4 * c + 2), ntc = imax / 64 + 1, nss = (ntc + 1) >> 1;
        const int dq = t - 31 - 16 * 4 * hi;
        const float cfar = lrow[1599];
        float m = NEGV, l = 0.f;
#pragma unroll
        for (int tt = 0; tt < 2; ++tt) { int it = tt; it = it > ntc - 1 ? ntc - 1 : it; tile_load(sg.t[tt], KC, VC, 64 * it + key, tid); }
        for (int ss = 0; ss < nss; ++ss) {
            LAS unsigned char* bp = kv + buf * SBUF;
            tile_store(bp, sg.t[0], tid); tile_store(bp + TILE_B, sg.t[1], tid); ATT_BAR();
            if (ss + 1 < nss) {
#pragma unroll
                for (int tt = 0; tt < 2; ++tt) { int it = 2 * (ss + 1) + tt; it = it > ntc - 1 ? ntc - 1 : it; tile_load(sg.t[tt], KC, VC, 64 * it + key, tid); } }
#pragma unroll
            for (int tt = 0; tt < 2; ++tt) { const int it = 2 * ss + tt;
                if (it < ntc) {
                    f32x16 p0, p1; const int dt = dq - 1024 * it;
                    const bool far = (t0 - 31 - 1024 * it - 1008) >= 1513;
                    if (far) {
#pragma unroll
                        for (int r = 0; r < 16; ++r) { p0[r] = cfar; p1[r] = cfar; }
                    } else {
#pragma unroll
                        for (int r = 0; r < 16; ++r) { const int da = dt - 16 * crow(r, 0), db = da - 512;
                            const int ia = da < -64 ? -64 : (da > 1599 ? 1599 : da), ib = db < -64 ? -64 : (db > 1599 ? 1599 : db);
                            p0[r] = lrow[ia]; p1[r] = lrow[ib]; }
                    }
                    qk(p0, p1, bp + tt * TILE_B + hi * 1024 + r32 * 16, qr);
                    if (!far) {
#pragma unroll
                        for (int r = 0; r < 16; ++r) { const int da = dt - 16 * crow(r, 0), db = da - 512; p0[r] = (da >= 0) ? p0[r] : NEGV; p1[r] = (db >= 0) ? p1[r] : NEGV; }
                    }
                    const float rm = rowmax32(p0, p1);
                    const float mn = fmaxf(m, rm); float s = 0.f;
#pragma unroll
                    for (int r = 0; r < 16; ++r) s += __builtin_amdgcn_exp2f(p0[r] - mn) + __builtin_amdgcn_exp2f(p1[r] - mn);
                    l = l * __builtin_amdgcn_exp2f(m - mn) + s; m = mn;
                } }
            buf ^= 1;
        }
        const float ltot = swapsum(l);
        const float invl = (m > -1.0e29f) ? 1.0f / ltot : 0.f;
        const float mz = (m > -1.0e29f) ? m : 0.f;
        f32x16 o[2]; o[0] = f32x16{}; o[1] = f32x16{};
        LAS float* improw = imp + tok * IMP_S;
#pragma unroll
        for (int tt = 0; tt < 2; ++tt) { int it = tt; it = it > ntc - 1 ? ntc - 1 : it; tile_load(sg.t[tt], KC, VC, 64 * it + key, tid); }
        for (int ss = 0; ss < nss; ++ss) {
            LAS unsigned char* bp = kv + buf * SBUF;
            tile_store(bp, sg.t[0], tid); tile_store(bp + TILE_B, sg.t[1], tid); ATT_BAR();
            if (ss + 1 < nss) {
#pragma unroll
                for (int tt = 0; tt < 2; ++tt) { int it = 2 * (ss + 1) + tt; it = it > ntc - 1 ? ntc - 1 : it; tile_load(sg.t[tt], KC, VC, 64 * it + key, tid); } }
#pragma unroll
            for (int tt = 0; tt < 2; ++tt) { const int it = 2 * ss + tt;
                if (it < ntc) {
                    f32x16 p0, p1; const int dt = dq - 1024 * it;
                    const bool far = (t0 - 31 - 1024 * it - 1008) >= 1513;
                    if (far) { const float iv = cfar - mz;
#pragma unroll
                        for (int r = 0; r < 16; ++r) { p0[r] = iv; p1[r] = iv; }
                    } else {
#pragma unroll
                        for (int r = 0; r < 16; ++r) { const int da = dt - 16 * crow(r, 0), db = da - 512;
                            const int ia = da < -64 ? -64 : (da > 1599 ? 1599 : da), ib = db < -64 ? -64 : (db > 1599 ? 1599 : db);
                            p0[r] = lrow[ia] - mz; p1[r] = lrow[ib] - mz; }
                    }
                    qk(p0, p1, bp + tt * TILE_B + hi * 1024 + r32 * 16, qr);
#pragma unroll
                    for (int r = 0; r < 16; ++r) { p0[r] = __builtin_amdgcn_exp2f(p0[r]) * invl; p1[r] = __builtin_amdgcn_exp2f(p1[r]) * invl; }
                    if (!far) {
#pragma unroll
                        for (int r = 0; r < 16; ++r) { const int da = dt - 16 * crow(r, 0), db = da - 512; p0[r] = (da >= 0) ? p0[r] : 0.f; p1[r] = (db >= 0) ? p1[r] : 0.f; }
                    }
#pragma unroll
                    for (int q = 0; q < 4; ++q) {
                        float a = (p0[4 * q] + p0[4 * q + 1]) + (p0[4 * q + 2] + p0[4 * q + 3]), al = p0[4 * q + 3];
                        float e = (p1[4 * q] + p1[4 * q + 1]) + (p1[4 * q + 2] + p1[4 * q + 3]), el = p1[4 * q + 3];
                        a = quadsum(a); al = quadsum(al); e = quadsum(e); el = quadsum(el);
                        if (h == 0) { const int G = 16 * it + 2 * q + hi;
                            __hip_atomic_fetch_add(improw + G, a, __ATOMIC_RELAXED, __HIP_MEMORY_SCOPE_WORKGROUP); __hip_atomic_fetch_add(improw + G + 1, al, __ATOMIC_RELAXED, __HIP_MEMORY_SCOPE_WORKGROUP);
                            __hip_atomic_fetch_add(improw + G + 8, e, __ATOMIC_RELAXED, __HIP_MEMORY_SCOPE_WORKGROUP); __hip_atomic_fetch_add(improw + G + 9, el, __ATOMIC_RELAXED, __HIP_MEMORY_SCOPE_WORKGROUP); }
                    }
                    pv(o, bp + tt * TILE_B + 8192 + trb, p0, p1);
                } }
            buf ^= 1;
        }
        yn_rows<true>(X.YN, o, g0, wsf, r32, hi, R0, g, lane);
    }
    asm volatile("s_waitcnt lgkmcnt(0)" ::: "memory");
    unsigned msk[4] = {0u, 0u, 0u, 0u};
    if (c >= 16) {
        const int tl = lane >> 3, part = lane & 7;
        const LAS float* ir = imp + (8 * wave + tl) * IMP_S + part * 16;
        unsigned v[16];
#pragma unroll
        for (int r = 0; r < 16; ++r) { const int j = part * 16 + r; const unsigned bits = __float_as_uint(ir[r]); v[r] = (j >= 1 && j <= c - 2) ? ((bits & ~127u) | (unsigned)(127 - j)) : 0u; }
        unsigned sm[4] = {0u, 0u, 0u, 0u};
        for (int itn = 0; itn < 13; ++itn) {
            unsigned mx = v[0];
#pragma unroll
            for (int r = 1; r < 16; ++r) mx = mx > v[r] ? mx : v[r];
            { unsigned o1 = (unsigned)__shfl_xor((int)mx, 1); mx = mx > o1 ? mx : o1; o1 = (unsigned)__shfl_xor((int)mx, 2); mx = mx > o1 ? mx : o1; o1 = (unsigned)__shfl_xor((int)mx, 4); mx = mx > o1 ? mx : o1; }
            const int j = 127 - (int)(mx & 127u); const unsigned bit = 1u << (j & 31); const int w = j >> 5;
            if (mx != 0u) { sm[0] |= (w == 0) ? bit : 0u; sm[1] |= (w == 1) ? bit : 0u; sm[2] |= (w == 2) ? bit : 0u; sm[3] |= (w == 3) ? bit : 0u; }
#pragma unroll
            for (int r = 0; r < 16; ++r) v[r] = (v[r] == mx) ? 0u : v[r];
        }
        sm[0] |= 1u;
        { const int j = c - 1; const unsigned bit = 1u << (j & 31); const int w = j >> 5; sm[0] |= (w == 0) ? bit : 0u; sm[1] |= (w == 1) ? bit : 0u; sm[2] |= (w == 2) ? bit : 0u; sm[3] |= (w == 3) ? bit : 0u; }
        { const int j = c; const unsigned bit = 1u << (j & 31); const int w = j >> 5; sm[0] |= (w == 0) ? bit : 0u; sm[1] |= (w == 1) ? bit : 0u; sm[2] |= (w == 2) ? bit : 0u; sm[3] |= (w == 3) ? bit : 0u; }
        if (part == 0) {
#pragma unroll
            for (int w = 0; w < 4; ++w) { selm[(8 * wave + tl) * 4 + w] = sm[w]; __hip_atomic_fetch_or(um + w, sm[w], __ATOMIC_RELAXED, __HIP_MEMORY_SCOPE_WORKGROUP); }
        }
        __syncthreads();
#pragma unroll
        for (int w = 0; w < 4; ++w) msk[w] = selm[tok * 4 + w];
    } else {
        msk[0] = (2u << c) - 1u;
        __syncthreads();
    }
    unsigned umr[4];
#pragma unroll
    for (int w = 0; w < 4; ++w) umr[w] = (c >= 16) ? (unsigned)__builtin_amdgcn_readfirstlane((int)um[w]) : ((w == 0) ? ((2u << c) - 1u) : 0u);
    {
        Soft st{NEGV, 0.f}; f32x16 o[2]; o[0] = f32x16{}; o[1] = f32x16{};
        const float cfar = lrow[1599];
        int j0 = next_sel(0, c, umr[0], umr[1], umr[2], umr[3]);
        int j1 = (j0 <= c) ? next_sel(j0 + 1, c, umr[0], umr[1], umr[2], umr[3]) : j0;
        if (j0 <= c) { tile_load(sg.t[0], KS, VS, 64 * j0 + key, tid); tile_load(sg.t[1], KS, VS, 64 * (j1 <= c ? j1 : j0) + key, tid); }
        while (j0 <= c) {
            LAS unsigned char* bp = kv + buf * SBUF;
            tile_store(bp, sg.t[0], tid); tile_store(bp + TILE_B, sg.t[1], tid); ATT_BAR();
            const int n0 = (j1 <= c) ? next_sel(j1 + 1, c, umr[0], umr[1], umr[2], umr[3]) : j1;
            const int n1 = (n0 <= c) ? next_sel(n0 + 1, c, umr[0], umr[1], umr[2], umr[3]) : n0;
            if (n0 <= c) { tile_load(sg.t[0], KS, VS, 64 * n0 + key, tid); tile_load(sg.t[1], KS, VS, 64 * (n1 <= c ? n1 : n0) + key, tid); }
#pragma unroll
            for (int tt = 0; tt < 2; ++tt) { const int j = tt ? j1 : j0;
                if (j <= c) {
                    const unsigned mw = (j < 32) ? msk[0] : (j < 64) ? msk[1] : (j < 96) ? msk[2] : msk[3];
                    const bool sel = (mw >> (j & 31)) & 1u;
                    if (__any(sel)) { const int cls = (j == c) ? CLS_PART : ((c - j >= 25) ? CLS_CONST : CLS_FULL);
                        proc_tile(cls, bp + tt * TILE_B, qr, st, o, lrow, t - 64 * j, 0, 0x3fffffff, cfar, sel, wsf, r32, hi, trb); } } }
            buf ^= 1; j0 = n0; j1 = n1;
        }
        float lt; const float inv = soft_final_inv(st, lt);
        yn_rows<true>(X.YN, o, g1 * inv, wsf, r32, hi, R0, g, lane);
    }
}

__device__ __forceinline__ void dil_unit(Frame& F, const Mix& X, int gi, int b, int s, int rest, int& buf) {
    using namespace att;
    const int tid = fresh_tid(), lane = tid & 63, wave = __builtin_amdgcn_readfirstlane(tid >> 6), r32 = lane & 31, hi = lane >> 5;
    LAS unsigned char* kv = F.lds + A_KV; LAS float* lutl = (LAS float*)(F.lds + A_LUT); LAS float* wsf = (LAS float*)(F.lds + A_WSF) + wave * 128;
    const int trb = ((lane >> 4) & 1) * 32 + (lane & 3) * 8 + (4 * hi + ((lane & 15) >> 2)) * 64;
    const int dil = 1 << (2 * gi), lg = 2 * gi, nch = (SEQ >> lg) >> 8, res = rest / nch, ch = rest % nch;
    const int hd = 4 * gi + s, N0 = 256 * ch, Nw = N0 + 32 * wave, nq = Nw + r32, key = tid >> 3;
    const int t = (nq << lg) + res;
    const size_t R = (size_t)b * SEQ + t;
    __syncthreads();
    lut_to_lds(F, tid, X.LUTD + hd * 320, 320);
    bf16x8 qr[4];
#pragma unroll
    for (int d0 = 0; d0 < 4; ++d0) qr[d0] = ldq(X.QD + R * 768 + hd * 64 + 16 * d0 + 8 * hi);
    const bf16* Kp = X.KD + (size_t)(b * 12 + hd) * SEQ * 64; const bf16* Vp = X.VD + (size_t)(b * 12 + hd) * SEQ * 64;
    const LAS float* lrow = lutl + LUT_PAD;
    __syncthreads();
    Soft st{NEGV, 0.f}; f32x16 o[2]; o[0] = f32x16{}; o[1] = f32x16{};
    Stage2 sg;
    const int it0 = (ch == 0) ? 2 : 0, nss = (6 - it0) >> 1;
#pragma unroll
    for (int tt = 0; tt < 2; ++tt) { const int kb = N0 - 128 + 64 * (it0 + tt); tile_load(sg.t[tt], Kp, Vp, (long)((kb + key) << lg) + res, tid); }
    for (int ss = 0; ss < nss; ++ss) {
        LAS unsigned char* bp = kv + buf * SBUF;
        tile_store(bp, sg.t[0], tid); tile_store(bp + TILE_B, sg.t[1], tid); ATT_BAR();
        if (ss + 1 < nss) {
#pragma unroll
            for (int tt = 0; tt < 2; ++tt) { const int kb = N0 - 128 + 64 * (it0 + 2 * (ss + 1) + tt); tile_load(sg.t[tt], Kp, Vp, (long)((kb + key) << lg) + res, tid); } }
#pragma unroll
        for (int tt = 0; tt < 2; ++tt) { const int kb = N0 - 128 + 64 * (it0 + 2 * ss + tt);
            const int dmin = Nw - kb - 63, dmax = Nw + 31 - kb;
            if (dmax >= 0 && dmin <= 128) { const int cls = (dmin >= 0 && dmax <= 128) ? CLS_FULL : CLS_PART;
                proc_tile(cls, bp + tt * TILE_B, qr, st, o, lrow, nq - kb, 0, 128, 0.f, true, wsf, r32, hi, trb); } }
        buf ^= 1;
    }
    float ltot; const float inv = soft_final_inv(st, ltot);
    const float lse = st.mref + __builtin_amdgcn_logf(ltot);
    if (gi != 0) {
        bf16* OD = X.OD + (size_t)(gi - 1) * M * 256; float* LS = X.LSE + (size_t)(gi - 1) * M * 4;
        if (hi == 0) { wsf[r32] = inv; LS[R * 4 + s] = lse; }
        asm volatile("s_waitcnt lgkmcnt(0)" ::: "memory");
#pragma unroll
        for (int r = 0; r < 16; ++r) { const int q = crow(r, hi); const float fr = wsf[q]; const size_t Rq = (size_t)b * SEQ + ((size_t)(Nw + q) << lg) + res;
            bf16* op = OD + Rq * 256 + s * 64 + (lane & 31);
            op[0] = (bf16)f2bf(o[0][r] * fr); op[32] = (bf16)f2bf(o[1][r] * fr); }
        asm volatile("s_waitcnt lgkmcnt(0)" ::: "memory");
    } else {
        const float l4 = X.LSE[R * 4 + s], l16 = X.LSE[(size_t)M * 4 + R * 4 + s];
        const float mx = fmaxf(lse, fmaxf(l4, l16));
        const float w1 = __builtin_amdgcn_exp2f(lse - mx), w4 = __builtin_amdgcn_exp2f(l4 - mx), w16 = __builtin_amdgcn_exp2f(l16 - mx), iw = 1.0f / (w1 + w4 + w16);
        if (hi == 0) { wsf[r32] = w1 * iw * inv; wsf[32 + r32] = w4 * iw; wsf[64 + r32] = w16 * iw; }
        asm volatile("s_waitcnt lgkmcnt(0)" ::: "memory");
#pragma unroll
        for (int r = 0; r < 16; ++r) { const int q = crow(r, hi); const float a1 = wsf[q], a4 = wsf[32 + q], a16 = wsf[64 + q]; const size_t Rq = (size_t)b * SEQ + Nw + q;
            const bf16* p4 = X.OD + Rq * 256 + s * 64 + (lane & 31); const bf16* p16 = p4 + (size_t)M * 256;
            bf16* op = X.YD + Rq * 256 + s * 64 + (lane & 31);
            const float v0 = o[0][r] * a1 + __uint_as_float((unsigned)p4[0] << 16) * a4 + __uint_as_float((unsigned)p16[0] << 16) * a16;
            const float v1 = o[1][r] * a1 + __uint_as_float((unsigned)p4[32] << 16) * a4 + __uint_as_float((unsigned)p16[32] << 16) * a16;
            op[0] = (bf16)f2bf(v0); op[32] = (bf16)f2bf(v1); }
        asm volatile("s_waitcnt lgkmcnt(0)" ::: "memory");
    }
}

__device__ __forceinline__ void cmp_unit(Frame& F, const Mix& X, int cu) {
    using namespace att;
    const int tid = fresh_tid(), lane = tid & 63, wave = __builtin_amdgcn_readfirstlane(tid >> 6), r32 = lane & 31, hi = lane >> 5;
    const int ts = cu >> 6, rb = cu & 63, plane = rb >> 4, i0 = (rb & 15) * 32;
    const bf16* src = X.PL + (size_t)ts * PLSZ + (size_t)plane * SEQ * 64;
    const bf16* W1 = ts ? X.WC1V : X.WC1K; const bf16* W2 = ts ? X.WC2V : X.WC2K; const float* cb = X.CB + ts * 256;
    bf16* dst = (ts ? X.VCMP : X.KCMP) + (size_t)plane * 512 * 64;
    LAS unsigned char* aimg = F.lds;
    LAS unsigned char* hid = F.lds + 69632;
    __syncthreads();
    for (int chn = tid; chn < 528 * 8; chn += NWAVES * 64) { const int tau = chn >> 3, c8 = chn & 7; int tk = 16 * i0 + tau; tk = tk > SEQ - 1 ? SEQ - 1 : tk;
        *(LAS v4u*)(aimg + tau * 128 + 16 * (tau >> 4) + c8 * 16) = *(const GAS v4u*)(src + (size_t)tk * 64 + c8 * 8); }
    __syncthreads();
    f32x16 acc = f32x16{};
    const LAS unsigned char* ap = aimg + r32 * 2064 + 16 * hi;
    const bf16* bp = W1 + ((size_t)wave * 128 * 64 + lane) * 8;
#pragma unroll 16
    for (int ks = 0; ks < 128; ++ks) {
        const int l = ks >> 2;
        const bf16x8 a = *(const LAS bf16x8*)(ap + 128 * l + 16 * (l >> 4) + 32 * (ks & 3));
        const bf16x8 bb = ldq(bp + (size_t)ks * 512);
        acc = __builtin_amdgcn_mfma_f32_32x32x16_bf16(a, bb, acc, 0, 0, 0);
    }
    { const int col = 32 * wave + r32; const float bias = cb[col];
#pragma unroll
      for (int r = 0; r < 16; ++r) { const float v = acc[r] + bias; const float hv = v * __builtin_amdgcn_rcpf(1.0f + __builtin_amdgcn_exp2f(-LOG2E * v));
          *(LAS unsigned short*)(hid + crow(r, hi) * 528 + col * 2) = (unsigned short)f2bf(hv); } }
    __syncthreads();
    if (wave < 2) {
        const int nt = wave;
        f32x16 o2 = f32x16{};
        const LAS unsigned char* hp = hid + r32 * 528 + 16 * hi; const bf16* b2 = W2 + (size_t)(32 * nt + r32) * 256 + 8 * hi;
#pragma unroll
        for (int k0 = 0; k0 < 256; k0 += 16) { const bf16x8 a = *(const LAS bf16x8*)(hp + k0 * 2); const bf16x8 bb = ldq(b2 + k0); o2 = __builtin_amdgcn_mfma_f32_32x32x16_bf16(a, bb, o2, 0, 0, 0); }
#pragma unroll
        for (int r = 0; r < 16; ++r) { const int i = i0 + crow(r, hi); dst[(size_t)i * 64 + 32 * nt + r32] = (bf16)f2bf(o2[r]); }
    }
}

#ifndef MK_N_LAUNCHES
#define MK_N_LAUNCHES 1
#endif
constexpr int N_PHASES = 13;
constexpr int N_LAUNCHES = MK_N_LAUNCHES;
struct Args { const float* in[22]; float* out; unsigned char* ws; int ph_lo, ph_hi, li, pad; };
__global__ void __launch_bounds__(NWAVES * 64, 2) mk_fwd(Args args) {
    extern __shared__ __attribute__((aligned(16))) unsigned char lds[];
    Frame F;
    F.lds = (LAS unsigned char*)lds;
    F.MISC = (volatile LAS unsigned*)(F.lds + MISC_OFF);
    F.G = gridDim.x; { const int bx = blockIdx.x; F.vcu = (F.G % 8 == 0) ? (bx % 8) * (F.G / 8) + bx / 8 : bx; }
    unsigned char* ws = args.ws;
    F.ctl = (gu32*)(ws + WS_CTL);
    In in;
    in.x = args.in[0]; in.f1_pre = args.in[1]; in.f1_wgu = args.in[2]; in.f1_wd = args.in[3]; in.f1_post = args.in[4]; in.mix_pre = args.in[5]; in.w_in = args.in[6];
    in.cpos_k = args.in[7]; in.cw1_k = args.in[8]; in.cw2_k = args.in[9]; in.cpos_v = args.in[10]; in.cw1_v = args.in[11]; in.cw2_v = args.in[12];
    in.w_bn = args.in[13]; in.w_bd = args.in[14]; in.w_out = args.in[15]; in.mix_post = args.in[16]; in.f2_pre = args.in[17]; in.f2_wgu = args.in[18]; in.f2_wd = args.in[19]; in.f2_post = args.in[20]; in.rel_bias = args.in[21];
    float* out = args.out;
    for (int u = threadIdx.x; u < (LDS_BYTES - LDSCTL_OFF) / 4; u += NWAVES * 64) ((LAS unsigned*)(F.lds + LDSCTL_OFF))[u] = 0u;
    __syncthreads();
    const bool use_bar = (args.ph_hi - args.ph_lo) > 1;
    XcdBarrier bar; bar.bar = (unsigned*)(F.ctl + CW_BAR) + args.li * XCD_BAR_WORDS; bar.x = 0; bar.st = nullptr;
    if (use_bar) bar = xcd_barrier_post((unsigned*)(F.ctl + CW_BAR) + args.li * XCD_BAR_WORDS, F.MISC + 8);
    const int lo = args.ph_lo, hi = args.ph_hi;
#define IN(k) (lo <= (k) && (k) < hi)
#define SEAM(k) do { if (IN(k) && IN((k) + 1)) xcd_barrier(bar); } while (0)
    bf16* XN = (bf16*)(ws + WS_XN); bf16* H = (bf16*)(ws + WS_H); bf16* Y = (bf16*)(ws + WS_Y); bf16* Y2P = (bf16*)(ws + WS_Y2P); bf16* MG = (bf16*)(ws + WS_MG);
    Mix X; X.QN = (bf16*)(ws + WS_QN); X.YN = (bf16*)(ws + WS_YN); X.PL = (bf16*)(ws + WS_PL); X.QD = (bf16*)(ws + WS_QD); X.KD = (bf16*)(ws + WS_KD); X.VD = (bf16*)(ws + WS_VD); X.YD = (bf16*)(ws + WS_YD); X.OD = (bf16*)(ws + WS_OD); X.LSE = (float*)(ws + WS_LSE);
    X.KCMP = (bf16*)(ws + WS_KCMP); X.VCMP = (bf16*)(ws + WS_VCMP); X.GN = (const float*)(ws + WS_GN); X.LUTN = (const float*)(ws + WS_LUTN); X.LUTD = (const float*)(ws + WS_LUTD); X.CB = (const float*)(ws + WS_CB);
    X.WC1K = (const bf16*)(ws + WS_WC1K); X.WC1V = (const bf16*)(ws + WS_WC1V); X.WC2K = (const bf16*)(ws + WS_WC2K); X.WC2V = (const bf16*)(ws + WS_WC2V);
    bf16* GA = (bf16*)(ws + WS_GA); bf16* GB = (bf16*)(ws + WS_GB);

    if (IN(0)) { p0_prologue(F, in, ws); }
    SEAM(0);
    if (IN(1)) { pg8::Gemm g{XN, (const bf16*)(ws + WS_WGU1), M, 2 * FF, D}; pg8::StaticOrder S; S.init(M, 2 * FF, F.G, (int)blockIdx.x);
        pg8::EpiSwiGLU E{H, FF}; pg8::gemm_phase<pg8::EpiSwiGLU, pg8::StaticOrder, true, true>(F.lds + RING_OFF, g, S, E); }
    SEAM(1);
    if (IN(2)) { pg8::Gemm g{H, (const bf16*)(ws + WS_WD1), M, D, FF}; pg8::StaticOrder S; S.init(M, D, F.G, (int)blockIdx.x);
        pg8::EpiBf16 E{Y, D}; pg8::gemm_phase<pg8::EpiBf16, pg8::StaticOrder, true, true>(F.lds + RING_OFF, g, S, E); }
    SEAM(2);
    if (IN(3)) { row_pass(F, Y, in.x, out, 0.5f, in.f1_post, in.mix_pre, XN); }
    SEAM(3);
    if (IN(4)) { pg8::Gemm g{XN, (const bf16*)(ws + WS_WIN), M, NPROJ, D}; pg8::StaticOrder S; S.init(M, NPROJ, F.G, (int)blockIdx.x);
        pg8::EpiProj E{X.QN, X.PL, X.QD, X.KD, X.VD, GA, GB, (float*)(ws + WS_GN), QSCALE};
        pg8::gemm_phase<pg8::EpiProj, pg8::StaticOrder, true, true>(F.lds + RING_OFF, g, S, E); }
    SEAM(4);
    if (IN(5)) { int buf = 0;
        for (int cu = F.vcu; cu < 128; cu += F.G) cmp_unit(F, X, cu);
#pragma unroll 1
        for (int w = F.vcu; w < 512; w += F.G) { const int gi = 2 - (w >> 8), du = w & 255; dil_unit(F, X, gi, du >> 7, (du >> 5) & 3, du & 31, buf); }
        __syncthreads(); }
    SEAM(5);
    if (IN(6)) { int buf = 0;
        for (int p = F.vcu; p < 256; p += F.G) { const int b = p >> 7, g = (p >> 6) & 1, cc = p & 63;
#pragma unroll 1
            for (int k = 0; k < 2; ++k) nsa_unit(F, X, b, g, k ? cc : 127 - cc, buf); }
#pragma unroll 1
        for (int du = F.vcu; du < 256; du += F.G) dil_unit(F, X, 0, du >> 7, (du >> 5) & 3, du & 31, buf);
        __syncthreads(); }
    SEAM(6);
    if (IN(7)) {
        { pg8::Gemm g{X.YN, (const bf16*)(ws + WS_WBN), M, D, 512}; pg8::StaticOrder S; S.init(M, D, F.G, (int)blockIdx.x);
          pg8::EpiBranchA E{GA, Y2P}; pg8::gemm_phase<pg8::EpiBranchA, pg8::StaticOrder, true, true>(F.lds + RING_OFF, g, S, E); }
        { pg8::Gemm g{X.YD, (const bf16*)(ws + WS_WBD), M, D, 256}; pg8::StaticOrder S; S.init(M, D, F.G, (int)blockIdx.x);
          pg8::EpiBranchB E{GB, Y2P, MG}; pg8::gemm_phase<pg8::EpiBranchB, pg8::StaticOrder, true, true>(F.lds + RING_OFF, g, S, E); }
    }
    SEAM(7);
    if (IN(8)) { pg8::Gemm g{MG, (const bf16*)(ws + WS_WOUT), M, D, D}; pg8::StaticOrder S; S.init(M, D, F.G, (int)blockIdx.x);
        pg8::EpiBf16 E{Y, D}; pg8::gemm_phase<pg8::EpiBf16, pg8::StaticOrder, true, true>(F.lds + RING_OFF, g, S, E); }
    SEAM(8);
    if (IN(9)) { row_pass(F, Y, out, out, 1.0f, in.mix_post, in.f2_pre, XN); }
    SEAM(9);
    if (IN(10)) { pg8::Gemm g{XN, (const bf16*)(ws + WS_WGU2), M, 2 * FF, D}; pg8::StaticOrder S; S.init(M, 2 * FF, F.G, (int)blockIdx.x);
        pg8::EpiSwiGLU E{H, FF}; pg8::gemm_phase<pg8::EpiSwiGLU, pg8::StaticOrder, true, true>(F.lds + RING_OFF, g, S, E); }
    SEAM(10);
    if (IN(11)) { pg8::Gemm g{H, (const bf16*)(ws + WS_WD2), M, D, FF}; pg8::StaticOrder S; S.init(M, D, F.G, (int)blockIdx.x);
        pg8::EpiBf16 E{Y, D}; pg8::gemm_phase<pg8::EpiBf16, pg8::StaticOrder, true, true>(F.lds + RING_OFF, g, S, E); }
    SEAM(11);
    if (IN(12)) { row_pass(F, Y, out, out, 0.5f, in.f2_post, nullptr, nullptr); }
#undef IN
#undef SEAM
}

extern "C" void kernel_launch(void* const* d_in, const int* in_sizes, int n_in, void* d_out, int out_size, void* d_ws, size_t ws_size, hipStream_t stream) {
    static int grid = 0;
    if (grid == 0) {
        if (n_in != 22 || in_sizes[0] != M * D || out_size != M * D || ws_size < WS_END) { fprintf(stderr, "kernel_launch: unexpected shapes (n_in %d, in0 %d, out %d, ws %zu); nothing launched\n", n_in, n_in > 0 ? in_sizes[0] : -1, out_size, ws_size); grid = -1; return; }
        int dev = 0, cus = 0, per_cu = 0;
        if (hipGetDevice(&dev) != hipSuccess || hipDeviceGetAttribute(&cus, hipDeviceAttributeMultiprocessorCount, dev) != hipSuccess) { grid = -1; return; }
        if (hipFuncSetAttribute((const void*)mk_fwd, hipFuncAttributeMaxDynamicSharedMemorySize, LDS_BYTES) != hipSuccess) { fprintf(stderr, "kernel_launch: hipFuncSetAttribute failed\n"); grid = -1; return; }
        if (hipOccupancyMaxActiveBlocksPerMultiprocessor(&per_cu, (const void*)mk_fwd, NWAVES * 64, LDS_BYTES) != hipSuccess || per_cu < 1)
            fprintf(stderr, "kernel_launch: note: occupancy query reports %d workgroups per CU\n", per_cu);
        (void)hipGetLastError();
        grid = cus;
    }
    if (grid < 0) return;
    if (hipMemsetAsync((char*)d_ws + WS_CTL, 0, CTL_ZERO_BYTES, stream) != hipSuccess) return;
    Args a{};
    for (int i = 0; i < 22; ++i) a.in[i] = (const float*)d_in[i];
    a.out = (float*)d_out; a.ws = (unsigned char*)d_ws;
#ifdef PROBE_RANGES
    { static const int rg[][2] = PROBE_RANGES;
      for (int li = 0; li < (int)(sizeof(rg) / sizeof(rg[0])); ++li) { a.ph_lo = rg[li][0]; a.ph_hi = rg[li][1]; a.li = li; hipLaunchKernelGGL(mk_fwd, dim3(grid), dim3(NWAVES * 64), LDS_BYTES, stream, a); } }
#else
    if (N_LAUNCHES == 1) { a.ph_lo = 0; a.ph_hi = N_PHASES; a.li = 0; hipLaunchKernelGGL(mk_fwd, dim3(grid), dim3(NWAVES * 64), LDS_BYTES, stream, a); }
    else { for (int li = 0; li < N_PHASES; ++li) { a.ph_lo = li; a.ph_hi = li + 1; a.li = 0; hipLaunchKernelGGL(mk_fwd, dim3(grid), dim3(NWAVES * 64), LDS_BYTES, stream, a); } }
#endif
}
```

```cpp
#include <hip/hip_runtime.h>
#include <cstdio>
#include <cstdint>
namespace pg8 {
#define PG8_LAS __attribute__((address_space(3)))
typedef unsigned short bf16_t;
typedef short bf16x8 __attribute__((ext_vector_type(8)));
typedef float f32x4 __attribute__((ext_vector_type(4)));
typedef unsigned u32x4 __attribute__((ext_vector_type(4)));
constexpr int BM = 256, BK = 64, HALF = 128, HTB = HALF * BK * 2  , STAGE_BYTES = 8 * HTB, NXCD = 8, WGM = 8;

__host__ __device__ __forceinline__ int lds_byte(int r, int c) { const int st = (r >> 4) * 2 + (c >> 5), rr = r & 15, cc = c & 31, ob = rr * 64 + cc * 2; return st * 1024 + (ob ^ (((ob >> 9) & 1) << 5)); }
__host__ __device__ __forceinline__ void stage_rc(int b, int& R, int& C) { const int st = b / 1024, sb = b % 1024, swz = sb ^ (((sb >> 9) & 1) << 5); R = (st >> 1) * 16 + swz / 64; C = (st & 1) * 32 + (swz % 64) / 2; }
__host__ __device__ __forceinline__ int perm32(int rho) { const int n = rho >> 4, i = rho & 15; return 8 * (i >> 2) + 4 * n + (i & 3); }

struct Unit { int pm, pn; };
struct Gemm { const bf16_t* A; const bf16_t* Bt; int M, N, K; };

struct StaticOrder {
    int nM, nN, nwg, G, c;
    __host__ __device__ void init(int M, int N, int G_, int c_) { nM = M / BM; nN = N / BM; nwg = nM * nN; G = G_; c = c_; }
    __host__ __device__ bool next(int i, Unit& u) const {
        const long L = (long)i * G + c; if (L >= nwg) return false;
        int wgid = (int)L; { const int q = nwg / NXCD, r = nwg % NXCD, xcd = wgid % NXCD, off = wgid / NXCD; wgid = (xcd < r ? xcd * (q + 1) : r * (q + 1) + (xcd - r) * q) + off; }
        const int nig = WGM * nN, gid = wgid / nig, fm = gid * WGM, gsz = (nM - fm) < WGM ? (nM - fm) : WGM;
        u.pm = fm + ((wgid % nig) % gsz); u.pn = (wgid % nig) / gsz; return true;
    }
    __device__ __forceinline__ void a_ready(const Unit&) const {}
    __device__ __forceinline__ void done(const Unit&) const {}
};

__device__ __forceinline__ unsigned cvt_pk_bf16(float lo, float hi) { unsigned r; asm volatile("v_cvt_pk_bf16_f32 %0, %1, %2" : "=v"(r) : "v"(lo), "v"(hi)); return r; }
typedef float f32x2 __attribute__((ext_vector_type(2)));
__device__ __forceinline__ float sigmoid_f(float v) { return __builtin_amdgcn_rcpf(1.0f + __builtin_amdgcn_exp2f(-1.4426950408889634f * v)); }
__device__ __forceinline__ float bf_lo(unsigned w) { return __uint_as_float(w << 16); }
__device__ __forceinline__ float bf_hi(unsigned w) { return __uint_as_float(w & 0xffff0000u); }

struct EpiSwiGLU {
    static constexpr bool PERM = true, AFTER_DRAIN = false;
    bf16_t* H; int ldh;
    __device__ __forceinline__ void operator()(const f32x4 (&acc)[2][2][4][2], const Unit& u, int wr, int wc, int fr, int fq) const {
        const int row0 = u.pm * BM + wr * 64 + fr, col0 = u.pn * HALF + wc * 32 + 8 * fq;
#pragma unroll
        for (int ai = 0; ai < 2; ++ai)
#pragma unroll
            for (int m = 0; m < 4; ++m) { bf16_t* rowp = H + (size_t)(row0 + ai * HALF + m * 16) * ldh + col0;
                const f32x4 g0 = acc[ai][0][m][0], g1 = acc[ai][0][m][1], u0 = acc[ai][1][m][0], u1 = acc[ai][1][m][1];
                float h[8];
#pragma unroll
                for (int i = 0; i < 4; ++i) { h[i] = g0[i] * sigmoid_f(g0[i]) * u0[i]; h[4 + i] = g1[i] * sigmoid_f(g1[i]) * u1[i]; }
                u32x4 w; w.x = cvt_pk_bf16(h[0], h[1]); w.y = cvt_pk_bf16(h[2], h[3]); w.z = cvt_pk_bf16(h[4], h[5]); w.w = cvt_pk_bf16(h[6], h[7]);
                *(u32x4*)rowp = w; }
    }
};
struct EpiF32 {
    static constexpr bool PERM = true, AFTER_DRAIN = false;
    float* Y; int ldc;
    __device__ __forceinline__ void operator()(const f32x4 (&acc)[2][2][4][2], const Unit& u, int wr, int wc, int fr, int fq) const {
        const int row0 = u.pm * BM + wr * 64 + fr, col0 = u.pn * BM + wc * 32 + 8 * fq;
#pragma unroll
        for (int ai = 0; ai < 2; ++ai)
#pragma unroll
            for (int m = 0; m < 4; ++m) { float* rowp = Y + (size_t)(row0 + ai * HALF + m * 16) * ldc + col0;
#pragma unroll
                for (int bj = 0; bj < 2; ++bj) { *(f32x4*)(rowp + bj * HALF) = acc[ai][bj][m][0]; *(f32x4*)(rowp + bj * HALF + 4) = acc[ai][bj][m][1]; } }
    }
};
struct EpiBf16 {
    static constexpr bool PERM = true, AFTER_DRAIN = false;
    bf16_t* Y; int ldc;
    __device__ __forceinline__ void operator()(const f32x4 (&acc)[2][2][4][2], const Unit& u, int wr, int wc, int fr, int fq) const {
        const int row0 = u.pm * BM + wr * 64 + fr, col0 = u.pn * BM + wc * 32 + 8 * fq;
#pragma unroll
        for (int ai = 0; ai < 2; ++ai)
#pragma unroll
            for (int m = 0; m < 4; ++m) { bf16_t* rowp = Y + (size_t)(row0 + ai * HALF + m * 16) * ldc + col0;
#pragma unroll
                for (int bj = 0; bj < 2; ++bj) { const f32x4 a0 = acc[ai][bj][m][0], a1 = acc[ai][bj][m][1];
                    u32x4 w; w.x = cvt_pk_bf16(a0[0], a0[1]); w.y = cvt_pk_bf16(a0[2], a0[3]); w.z = cvt_pk_bf16(a1[0], a1[1]); w.w = cvt_pk_bf16(a1[2], a1[3]);
                    *(u32x4*)(rowp + bj * HALF) = w; } }
    }
};
struct EpiBranchA {
    static constexpr bool PERM = true, AFTER_DRAIN = false;
    const bf16_t* G; bf16_t* Y;
    __device__ __forceinline__ void operator()(const f32x4 (&acc)[2][2][4][2], const Unit& u, int wr, int wc, int fr, int fq) const {
        const int row0 = u.pm * BM + wr * 64 + fr, col0 = u.pn * BM + wc * 32 + 8 * fq;
#pragma unroll
        for (int ai = 0; ai < 2; ++ai)
#pragma unroll
            for (int m = 0; m < 4; ++m) { const size_t off = (size_t)(row0 + ai * HALF + m * 16) * 1024 + col0;
#pragma unroll
                for (int bj = 0; bj < 2; ++bj) { const u32x4 g = *(const u32x4*)(G + off + bj * HALF); const f32x4 a0 = acc[ai][bj][m][0], a1 = acc[ai][bj][m][1];
                    u32x4 w; w.x = cvt_pk_bf16(a0[0] * bf_lo(g.x), a0[1] * bf_hi(g.x)); w.y = cvt_pk_bf16(a0[2] * bf_lo(g.y), a0[3] * bf_hi(g.y));
                    w.z = cvt_pk_bf16(a1[0] * bf_lo(g.z), a1[1] * bf_hi(g.z)); w.w = cvt_pk_bf16(a1[2] * bf_lo(g.w), a1[3] * bf_hi(g.w));
                    *(u32x4*)(Y + off + bj * HALF) = w; } }
    }
};
struct EpiBranchB {
    static constexpr bool PERM = true, AFTER_DRAIN = false;
    const bf16_t* G; const bf16_t* Y; bf16_t* O;
    __device__ __forceinline__ void operator()(const f32x4 (&acc)[2][2][4][2], const Unit& u, int wr, int wc, int fr, int fq) const {
        const int row0 = u.pm * BM + wr * 64 + fr, col0 = u.pn * BM + wc * 32 + 8 * fq;
#pragma unroll
        for (int ai = 0; ai < 2; ++ai)
#pragma unroll
            for (int m = 0; m < 4; ++m) { const size_t off = (size_t)(row0 + ai * HALF + m * 16) * 1024 + col0;
#pragma unroll
                for (int bj = 0; bj < 2; ++bj) { const u32x4 g = *(const u32x4*)(G + off + bj * HALF), y = *(const u32x4*)(Y + off + bj * HALF); const f32x4 a0 = acc[ai][bj][m][0], a1 = acc[ai][bj][m][1];
                    u32x4 w; w.x = cvt_pk_bf16(bf_lo(y.x) + a0[0] * bf_lo(g.x), bf_hi(y.x) + a0[1] * bf_hi(g.x)); w.y = cvt_pk_bf16(bf_lo(y.y) + a0[2] * bf_lo(g.y), bf_hi(y.y) + a0[3] * bf_hi(g.y));
                    w.z = cvt_pk_bf16(bf_lo(y.z) + a1[0] * bf_lo(g.z), bf_hi(y.z) + a1[1] * bf_hi(g.z)); w.w = cvt_pk_bf16(bf_lo(y.w) + a1[2] * bf_lo(g.w), bf_hi(y.w) + a1[3] * bf_hi(g.w));
                    *(u32x4*)(O + off + bj * HALF) = w; } }
    }
};
struct EpiProj {
    static constexpr bool PERM = true, AFTER_DRAIN = false;
    bf16_t *QN, *PL, *QD, *KD, *VD, *GA, *GB; float* GN; float qscale;
    __device__ __forceinline__ void operator()(const f32x4 (&acc)[2][2][4][2], const Unit& u, int wr, int wc, int fr, int fq) const {
        const int sub = (wc & 1) * 32 + 8 * fq;
#pragma unroll
        for (int bj = 0; bj < 2; ++bj) {
            const int hidx = __builtin_amdgcn_readfirstlane(u.pn * 4 + bj * 2 + (wc >> 1));
            bf16_t* base = nullptr; long pitch = 0, bstride = 0; int mode = 0;
            if (hidx < 8) { base = QN + hidx * 64; pitch = 512; bstride = 8192L * 512; mode = 1; }
            else if (hidx < 20) { const int ti = (hidx - 8) >> 1, g = (hidx - 8) & 1; base = PL + (size_t)ti * (4u * 8192u * 64u) + (size_t)g * (8192u * 64u); pitch = 64; bstride = 2L * 8192 * 64; mode = 0; }
            else if (hidx < 32) { base = QD + (hidx - 20) * 64; pitch = 768; bstride = 8192L * 768; mode = 1; }
            else if (hidx < 44) { base = KD + (size_t)(hidx - 32) * (8192u * 64u); pitch = 64; bstride = 12L * 8192 * 64; mode = 0; }
            else if (hidx < 56) { base = VD + (size_t)(hidx - 44) * (8192u * 64u); pitch = 64; bstride = 12L * 8192 * 64; mode = 0; }
            else if (hidx < 72) { base = GA + (hidx - 56) * 64; pitch = 1024; bstride = 8192L * 1024; mode = 2; }
            else if (hidx < 88) { base = GB + (hidx - 72) * 64; pitch = 1024; bstride = 8192L * 1024; mode = 2; }
            else if (hidx == 88) mode = 3; else mode = 4;
            if (mode == 4) continue;
#pragma unroll
            for (int ai = 0; ai < 2; ++ai)
#pragma unroll
                for (int m = 0; m < 4; ++m) { const int R = u.pm * BM + ai * HALF + wr * 64 + m * 16 + fr, b = R >> 13, t = R & 8191;
                    f32x4 v0 = acc[ai][bj][m][0], v1 = acc[ai][bj][m][1];
                    if (mode == 3) { if (sub < 24) { float* p = GN + (size_t)R * 32 + sub;
#pragma unroll
                            for (int i = 0; i < 4; ++i) { v0[i] = sigmoid_f(v0[i]); v1[i] = sigmoid_f(v1[i]); }
                            *(f32x4*)p = v0; *(f32x4*)(p + 4) = v1; } }
                    else { if (mode == 1) { v0 = v0 * qscale; v1 = v1 * qscale; }
                        if (mode == 2) {
#pragma unroll
                            for (int i = 0; i < 4; ++i) { v0[i] = sigmoid_f(v0[i]); v1[i] = sigmoid_f(v1[i]); } }
                        u32x4 w; w.x = cvt_pk_bf16(v0[0], v0[1]); w.y = cvt_pk_bf16(v0[2], v0[3]); w.z = cvt_pk_bf16(v1[0], v1[1]); w.w = cvt_pk_bf16(v1[2], v1[3]);
                        *(u32x4*)(base + (size_t)b * bstride + (size_t)t * pitch + sub) = w; } }
        }
    }
};
template <class Epi, class Sched, bool ALIGN_EPI = false, bool SP2 = false>
__device__ __forceinline__ void gemm_phase(PG8_LAS unsigned char* lds, const Gemm g, const Sched& S, const Epi& E) {
    const int tid = threadIdx.x, wid = __builtin_amdgcn_readfirstlane(tid >> 6), lane = tid & 63, wr = wid >> 2, wc = wid & 3, fr = lane & 15, fq = lane >> 4;
    const int K = g.K, nt = K / BK;
    unsigned voffA[2], voffB[2];
#pragma unroll
    for (int i = 0; i < 2; ++i) { int R, C; stage_rc(tid * 16 + i * 8192, R, C); const int Rb = Epi::PERM ? ((R & ~31) + perm32(R & 31)) : R;
        voffA[i] = (unsigned)(R * K + C) * 2u; voffB[i] = (unsigned)(Rb * K + C) * 2u; }
    const size_t kstep = (size_t)(BK * 2);
    const size_t hstep = (size_t)HALF * K * 2;
    const size_t tstep = 2 * hstep;
    const unsigned ldsw = (unsigned)wid * 1024u;
    const int aoff = lds_byte(wr * 64 + fr, fq * 8), boff = lds_byte(wc * 32 + fr, fq * 8);
#define PG8_SA(b, h) (((b) * 2 + (h)) * HTB)
#define PG8_SB(b, h) ((4 + (b) * 2 + (h)) * HTB)
#define PG8_STAGE(bufoff, gbase, voff) do { _Pragma("unroll") for (int _i = 0; _i < 2; ++_i) \
        __builtin_amdgcn_global_load_lds((const unsigned*)((const char*)(gbase) + (voff)[_i]), (PG8_LAS unsigned*)(lds + (bufoff) + ldsw + _i * 8192), 16, 0, 0); } while (0)
#define PG8_LDA(dst, b, h) do { _Pragma("unroll") for (int m = 0; m < 4; ++m) _Pragma("unroll") for (int k = 0; k < 2; ++k) dst[m][k] = *(const PG8_LAS bf16x8*)(lds + PG8_SA(b, h) + aoff + m * 2048 + k * 1024); } while (0)
#define PG8_LDB(dst, b, h) do { _Pragma("unroll") for (int n = 0; n < 2; ++n) _Pragma("unroll") for (int k = 0; k < 2; ++k) dst[n][k] = *(const PG8_LAS bf16x8*)(lds + PG8_SB(b, h) + boff + n * 2048 + k * 1024); } while (0)
#define PG8_MMA(ai, bj, At, Bt) do { __builtin_amdgcn_s_setprio(1); _Pragma("unroll") for (int m = 0; m < 4; ++m) _Pragma("unroll") for (int n = 0; n < 2; ++n) _Pragma("unroll") for (int k = 0; k < 2; ++k) \
        acc[ai][bj][m][n] = __builtin_amdgcn_mfma_f32_16x16x32_bf16(Bt[n][k], At[m][k], acc[ai][bj][m][n], 0, 0, 0); __builtin_amdgcn_s_setprio(0); } while (0)
#define PG8_WAIT_V(n) asm volatile("s_waitcnt vmcnt(" #n ")" ::: "memory")
#define PG8_WAIT_L(n) asm volatile("s_waitcnt lgkmcnt(" #n ")" ::: "memory")
#define PG8_BAR __builtin_amdgcn_s_barrier()
#define PG8_SCHED __builtin_amdgcn_sched_barrier(0)
    Unit cur, nxt; int ui = 0;
    if (!S.next(0, cur)) return;
    f32x4 acc[2][2][4][2];
#pragma unroll
    for (int a = 0; a < 2; ++a)
#pragma unroll
        for (int b = 0; b < 2; ++b)
#pragma unroll
            for (int m = 0; m < 4; ++m)
#pragma unroll
                for (int n = 0; n < 2; ++n) acc[a][b][m][n] = (f32x4){0.f, 0.f, 0.f, 0.f};
    bf16x8 At[4][2], B0[2][2], B1[2][2];
    const char* cA = (const char*)g.A + (size_t)cur.pm * tstep; const char* cB = (const char*)g.Bt + (size_t)cur.pn * tstep;
    S.a_ready(cur);
    if constexpr (SP2) {
        PG8_STAGE(PG8_SB(0, 0), cB, voffB); PG8_STAGE(PG8_SB(0, 1), cB + hstep, voffB); PG8_STAGE(PG8_SA(0, 0), cA, voffA); PG8_STAGE(PG8_SA(0, 1), cA + hstep, voffA);
        if (wr == 1) PG8_BAR;
        PG8_WAIT_V(2); PG8_BAR;
        PG8_STAGE(PG8_SB(1, 0), cB + kstep, voffB); PG8_STAGE(PG8_SA(1, 0), cA + kstep, voffA); PG8_STAGE(PG8_SB(1, 1), cB + hstep + kstep, voffB);
        PG8_WAIT_V(6); PG8_BAR;
    } else {
        PG8_STAGE(PG8_SB(0, 0), cB, voffB); PG8_STAGE(PG8_SA(0, 0), cA, voffA); PG8_STAGE(PG8_SB(0, 1), cB + hstep, voffB); PG8_STAGE(PG8_SA(0, 1), cA + hstep, voffA);
        if (wr == 1) PG8_BAR;
        PG8_WAIT_V(4); PG8_BAR;
        PG8_STAGE(PG8_SB(1, 0), cB + kstep, voffB); PG8_STAGE(PG8_SA(1, 0), cA + kstep, voffA); PG8_STAGE(PG8_SB(1, 1), cB + hstep + kstep, voffB);
        PG8_WAIT_V(6); PG8_BAR;
    }
    for (;;) {
        const bool has_next = S.next(ui + 1, nxt);
        const char* nA = has_next ? (const char*)g.A + (size_t)nxt.pm * tstep : cA; const char* nB = has_next ? (const char*)g.Bt + (size_t)nxt.pn * tstep : cB;
        for (int t = 0; t < nt; t += 2) {
            const bool last = (t == nt - 2);
            const char* a1 = cA + (size_t)(t + 1) * kstep;
            const char* a2 = last ? nA : cA + (size_t)(t + 2) * kstep; const char* b2 = last ? nB : cB + (size_t)(t + 2) * kstep;
            const char* a3 = a2 + kstep; const char* b3 = b2 + kstep;
            if (last && has_next) S.a_ready(nxt);
            if constexpr (SP2) {
            PG8_LDB(B0, 0, 0); PG8_LDB(B1, 0, 1); PG8_SCHED; PG8_LDA(At, 0, 0); PG8_STAGE(PG8_SA(1, 1), a1 + hstep, voffA);
            PG8_WAIT_V(8); PG8_WAIT_L(0); PG8_BAR; PG8_MMA(0, 0, At, B0); PG8_MMA(0, 1, At, B1); PG8_BAR; PG8_SCHED;
            PG8_LDA(At, 0, 1); PG8_STAGE(PG8_SB(0, 0), b2, voffB); PG8_STAGE(PG8_SB(0, 1), b2 + hstep, voffB); PG8_STAGE(PG8_SA(0, 0), a2, voffA);
            PG8_WAIT_V(8); PG8_WAIT_L(0); PG8_BAR; PG8_MMA(1, 0, At, B0); PG8_MMA(1, 1, At, B1); PG8_BAR; PG8_SCHED;
            PG8_LDB(B0, 1, 0); PG8_LDB(B1, 1, 1); PG8_SCHED; PG8_LDA(At, 1, 0); PG8_STAGE(PG8_SA(0, 1), a2 + hstep, voffA);
            PG8_WAIT_V(8); PG8_WAIT_L(0); PG8_BAR; PG8_MMA(0, 0, At, B0); PG8_MMA(0, 1, At, B1); PG8_BAR; PG8_SCHED;
            PG8_LDA(At, 1, 1); PG8_STAGE(PG8_SB(1, 0), b3, voffB); PG8_STAGE(PG8_SB(1, 1), b3 + hstep, voffB); PG8_STAGE(PG8_SA(1, 0), a3, voffA);
            PG8_WAIT_V(8); PG8_WAIT_L(0); PG8_BAR; PG8_MMA(1, 0, At, B0); PG8_MMA(1, 1, At, B1); PG8_BAR; PG8_SCHED;
            } else {
            PG8_LDB(B0, 0, 0); PG8_SCHED; PG8_LDA(At, 0, 0); PG8_STAGE(PG8_SA(1, 1), a1 + hstep, voffA);
            PG8_WAIT_L(8); PG8_BAR; PG8_WAIT_L(0); PG8_MMA(0, 0, At, B0); PG8_BAR; PG8_SCHED;
            PG8_LDB(B1, 0, 1); PG8_STAGE(PG8_SB(0, 0), b2, voffB);
            PG8_BAR; PG8_WAIT_L(0); PG8_MMA(0, 1, At, B1); PG8_BAR;
            PG8_LDA(At, 0, 1); PG8_STAGE(PG8_SA(0, 0), a2, voffA);
            PG8_BAR; PG8_WAIT_L(0); PG8_MMA(1, 0, At, B0); PG8_BAR; PG8_SCHED;
            PG8_STAGE(PG8_SB(0, 1), b2 + hstep, voffB);
            PG8_WAIT_V(6); PG8_BAR; PG8_MMA(1, 1, At, B1); PG8_BAR;
            PG8_LDB(B0, 1, 0); PG8_SCHED; PG8_LDA(At, 1, 0); PG8_STAGE(PG8_SA(0, 1), a2 + hstep, voffA);
            PG8_WAIT_L(8); PG8_BAR; PG8_WAIT_L(0); PG8_MMA(0, 0, At, B0); PG8_BAR; PG8_SCHED;
            PG8_LDB(B1, 1, 1); PG8_STAGE(PG8_SB(1, 0), b3, voffB);
            PG8_BAR; PG8_WAIT_L(0); PG8_MMA(0, 1, At, B1); PG8_BAR;
            PG8_LDA(At, 1, 1); PG8_STAGE(PG8_SA(1, 0), a3, voffA);
            PG8_BAR; PG8_WAIT_L(0); PG8_MMA(1, 0, At, B0); PG8_BAR; PG8_SCHED;
            PG8_STAGE(PG8_SB(1, 1), b3 + hstep, voffB);
            PG8_WAIT_V(6); PG8_BAR; PG8_MMA(1, 1, At, B1); PG8_BAR;
            }
        }
        if constexpr (ALIGN_EPI) { if (wr == 0) PG8_BAR; }
        if constexpr (!Epi::AFTER_DRAIN) { E(acc, cur, wr, wc, fr, fq); S.done(cur); }
        if (!has_next) break;
#pragma unroll
        for (int a = 0; a < 2; ++a)
#pragma unroll
            for (int b = 0; b < 2; ++b)
#pragma unroll
                for (int m = 0; m < 4; ++m)
#pragma unroll
                    for (int n = 0; n < 2; ++n) acc[a][b][m][n] = (f32x4){0.f, 0.f, 0.f, 0.f};
        cur = nxt; cA = nA; cB = nB; ++ui;
        if constexpr (ALIGN_EPI) { if (wr == 1) PG8_BAR; }
    }
    PG8_WAIT_V(0);
    if constexpr (!ALIGN_EPI) { if (wr == 0) PG8_BAR; }
    PG8_BAR;
    if constexpr (Epi::AFTER_DRAIN) { E.fused(acc, cur, wr, wc, fr, fq, lds, wid, lane); S.done(cur); }
#undef PG8_SA
#undef PG8_SB
#undef PG8_STAGE
#undef PG8_LDA
#undef PG8_LDB
#undef PG8_MMA
#undef PG8_WAIT_V
#undef PG8_WAIT_L
#undef PG8_BAR
#undef PG8_SCHED
}
}
#define GAS __attribute__((address_space(1)))
#define LAS __attribute__((address_space(3)))
typedef unsigned short bf16;
typedef unsigned v4u __attribute__((ext_vector_type(4)));
typedef float f32x4 __attribute__((ext_vector_type(4)));
typedef short bf16x8 __attribute__((ext_vector_type(8)));
typedef GAS unsigned gu32;
typedef GAS unsigned long long gu64;
#define RLX_AGENT __ATOMIC_RELAXED, __HIP_MEMORY_SCOPE_AGENT
#define LDS_WAIT() asm volatile("s_waitcnt lgkmcnt(0)" ::: "memory")
#define VM_WAIT() asm volatile("s_waitcnt vmcnt(0)" ::: "memory")
__device__ __forceinline__ unsigned long long rt() { return __builtin_amdgcn_s_memrealtime(); }
__device__ __forceinline__ unsigned f2bf(float f) { unsigned u = __builtin_bit_cast(unsigned, f); return (u + 0x7fffu + ((u >> 16) & 1u)) >> 16; }
__device__ __forceinline__ unsigned pk2(float lo, float hi) { return f2bf(lo) | (f2bf(hi) << 16); }

#define XB_TMO      128
#define XB_XCNT(j)  (256  + 64 * (j))
#define XB_XSUB(j)  (1280 + 64 * (j))
#define XB_XGEN(j)  (2304 + 64 * (j))
#define XB_TOP      3328
#define XB_TOPGEN   3392
#define XCD_BAR_WORDS 3456
#define XB_SPIN_CAP (1u << 18)

__device__ __forceinline__ unsigned xb_ld(unsigned* p)              { return __hip_atomic_load(p, __ATOMIC_RELAXED, __HIP_MEMORY_SCOPE_AGENT); }
__device__ __forceinline__ unsigned xb_add(unsigned* p, unsigned v) { return __hip_atomic_fetch_add(p, v, __ATOMIC_RELAXED, __HIP_MEMORY_SCOPE_AGENT); }
__device__ __forceinline__ unsigned xb_xcc_id() { return (unsigned)__builtin_amdgcn_s_getreg((3 << 11) | 20) & 0xFu; }
#define XB_SPIN(cond, bar) do { unsigned _sp = 0; while (cond) { __builtin_amdgcn_s_sleep(1); \
    if ((++_sp & 255u) == 0u) { if (xb_ld(&(bar)[XB_TMO])) break; if (_sp > XB_SPIN_CAP) { atomicAdd(&(bar)[XB_TMO], 1u); break; } } } } while (0)

struct XcdBarrier {
    unsigned* bar; unsigned x;
    volatile LAS unsigned* st;
};

__device__ __forceinline__ XcdBarrier xcd_barrier_post(unsigned* bar, volatile LAS unsigned* st) {
    XcdBarrier b; b.bar = bar; b.x = xb_xcc_id(); b.st = st;
    if (threadIdx.x == 0) (void)xb_add(&bar[XB_XCNT(b.x)], 1u);
    return b;
}
__device__ __forceinline__ void xcd_barrier_complete(unsigned* bar, unsigned x, unsigned& nloc, unsigned& nx) {
    const unsigned G = gridDim.x * gridDim.y * gridDim.z;
    unsigned sum, cnt, mine, sp = 0u;
    for (;;) {
        sum = 0u; cnt = 0u; mine = 0u;
#pragma unroll
        for (unsigned j = 0; j < 16; ++j) { const unsigned c = xb_ld(&bar[XB_XCNT(j)]); sum += c; cnt += (c > 0u) ? 1u : 0u; mine = (j == x) ? c : mine; }
        if (sum == G) break;
        __builtin_amdgcn_s_sleep(1);
        if ((++sp & 255u) == 0u) { if (xb_ld(&bar[XB_TMO])) break; if (sp > XB_SPIN_CAP) { atomicAdd(&bar[XB_TMO], 1u); break; } }
    }
    nloc = mine > 0u ? mine : 1u; nx = cnt > 0u ? cnt : 1u;
}

__device__ __forceinline__ void xcd_barrier(const XcdBarrier& b) {
    asm volatile("s_waitcnt vmcnt(0)" ::: "memory");
    __syncthreads();
    if (threadIdx.x == 0) {
        unsigned* bar = b.bar;
        __builtin_amdgcn_s_waitcnt(0);
        unsigned nloc = b.st[0], nx = b.st[1];
        if (nloc == 0u) { xcd_barrier_complete(bar, b.x, nloc, nx); b.st[0] = nloc; b.st[1] = nx; }
        const unsigned old = xb_add(&bar[XB_XSUB(b.x)], 1u);
        const unsigned gen = old / nloc;
        if (old + 1u == (gen + 1u) * nloc) {
            __builtin_amdgcn_fence(__ATOMIC_RELEASE, "agent");
            asm volatile("s_waitcnt vmcnt(0)" ::: "memory");
            const unsigned og = xb_add(&bar[XB_TOP], 1u);
            const unsigned tg = og / nx;
            if (og + 1u == (tg + 1u) * nx) xb_add(&bar[XB_TOPGEN], 1u);
            else XB_SPIN(xb_ld(&bar[XB_TOPGEN]) == tg, bar);
            __builtin_amdgcn_fence(__ATOMIC_ACQUIRE, "agent");
            xb_add(&bar[XB_XGEN(b.x)], 1u);
            asm volatile("s_waitcnt vmcnt(0)" ::: "memory");
        } else {
            XB_SPIN(xb_ld(&bar[XB_XGEN(b.x)]) == gen, bar);
            __builtin_amdgcn_fence(__ATOMIC_ACQUIRE, "agent");
            asm volatile("s_waitcnt vmcnt(0)" ::: "memory");
        }
    }
    __syncthreads();
}

constexpr int NWAVES = 8;
constexpr int BATCH = 2, SEQ = 8192, D = 1024, FF = 2816, M = BATCH * SEQ;
constexpr int NPROJ_SRC = 5656, NPROJ = 5888;
constexpr float RMS_EPS = 1e-6f;
constexpr float LOG2E = 1.4426950408889634f;
constexpr float QSCALE = 0.125f * LOG2E;

constexpr size_t MiB = 1u << 20;
constexpr size_t WS_CTL = 0, CTL_ZERO_BYTES = 64 * 1024;
constexpr size_t WS_LUTN = 1 * MiB;
constexpr size_t WS_LUTD = WS_LUTN + 64 * 1024;
constexpr size_t WS_CB = WS_LUTD + 16 * 1024;
constexpr size_t WS_KCMP = 1 * MiB + 256 * 1024, WS_VCMP = WS_KCMP + 256 * 1024;
constexpr size_t WS_WIN = 2 * MiB;
constexpr size_t WS_WC1K = WS_WIN + (size_t)NPROJ * D * 2;
constexpr size_t WS_WC1V = WS_WC1K + 1 * MiB;
constexpr size_t WS_WC2K = WS_WC1V + 1 * MiB;
constexpr size_t WS_WC2V = WS_WC2K + 32 * 1024;
constexpr size_t WS_WBN = WS_WC2V + 32 * 1024;
constexpr size_t WS_WBD = WS_WBN + 1 * MiB;
constexpr size_t WS_WOUT = WS_WBD + MiB / 2;
constexpr size_t WS_WGU2 = WS_WOUT + 2 * MiB;
constexpr size_t WS_WD2 = WS_WGU2 + (size_t)2 * FF * D * 2;
constexpr size_t WS_WGU1 = 36 * MiB;
constexpr size_t WS_WD1 = WS_WGU1 + (size_t)2 * FF * D * 2;
static_assert(WS_WD2 + (size_t)D * FF * 2 <= WS_WGU1, "weights A");
static_assert(WS_WD1 + (size_t)D * FF * 2 <= 53 * MiB, "weights B");
constexpr size_t WS_QN = 36 * MiB;
constexpr size_t WS_XN = 53 * MiB;
constexpr size_t WS_MG = 141 * MiB;
constexpr size_t WS_YN = 69 * MiB;
constexpr size_t WS_H = 85 * MiB;
constexpr size_t WS_Y = 173 * MiB;
constexpr size_t WS_PL = 85 * MiB;
constexpr size_t WS_QD = 109 * MiB;
constexpr size_t WS_KD = 133 * MiB, WS_VD = 157 * MiB;
constexpr size_t WS_GA = 181 * MiB, WS_GB = 213 * MiB;
constexpr size_t WS_GN = 245 * MiB;
constexpr size_t WS_YD = 247 * MiB;
constexpr size_t WS_Y2P = 109 * MiB;
constexpr size_t WS_END = 256 * MiB;
static_assert(WS_H + (size_t)M * FF * 2 <= WS_Y && WS_Y + (size_t)M * D * 4 <= WS_END, "ffn map");
static_assert(WS_YD + (size_t)M * 256 * 2 <= WS_END && WS_GN + (size_t)M * 32 * 4 <= WS_YD && WS_Y2P + (size_t)M * D * 2 <= WS_MG && WS_MG + (size_t)M * D * 2 <= WS_GA, "mixer map");
constexpr size_t PLSZ = (size_t)4 * 8192 * 64;
constexpr int CW_TMO = 0, CW_BAR = 1024;

constexpr int RING_OFF = 0, RING_BYTES = 131072;
constexpr int LDSCTL_OFF = 143360, MISC_OFF = LDSCTL_OFF + 320;
constexpr int LDS_BYTES = 147456;
constexpr int LUT_PAD = 64, LUTW = 1672;
constexpr int A_KV = 0;
constexpr int A_LUT = 65536;
constexpr int A_IMP = A_LUT + 4 * LUTW * 4;
constexpr int IMP_S = 132;
constexpr int A_SEL = A_IMP + 64 * IMP_S * 4;
constexpr int A_UM = A_SEL + 64 * 16;
constexpr int A_WSF = A_UM + 64;
constexpr int A_BL = A_WSF + 8 * 512;
constexpr int A_END = A_BL + 256;
static_assert(A_END <= LDSCTL_OFF, "attention LDS");
constexpr size_t WS_OD = 53 * MiB;
constexpr size_t WS_LSE = 255 * MiB;

__device__ __forceinline__ int fresh_tid() { int t = threadIdx.x; asm volatile("" : "+v"(t)); return t; }
struct Frame {
    LAS unsigned char* lds;
    volatile LAS unsigned* MISC;
    gu32* ctl;
    int vcu, G, nrep;
};

__device__ __forceinline__ float wave_sum(float v) {
#pragma unroll
    for (int o = 1; o < 64; o <<= 1) v += __shfl_xor(v, o);
    return v;
}
struct TrItem { const float* W; bf16* WT; int K, Nsrc, sc0, nvalid, dr0, kb, frag; };
__device__ __forceinline__ void tr_load(const TrItem& t, f32x4 (&v)[8], int lane) {
    const int c4 = (lane & 7) * 4, rr = lane >> 3;
#pragma unroll
    for (int i = 0; i < 8; ++i) v[i] = (c4 < t.nvalid) ? *(const GAS f32x4*)(t.W + (size_t)(64 * t.kb + rr + 8 * i) * t.Nsrc + t.sc0 + c4) : (f32x4){0.f, 0.f, 0.f, 0.f};
}
__device__ __forceinline__ void tr_finish(const TrItem& t, const f32x4 (&v)[8], LAS float* scr, int lane) {
    const int k0 = 64 * t.kb, c4 = (lane & 7) * 4, rr = lane >> 3;
#pragma unroll
    for (int i = 0; i < 8; ++i) { LAS float* d = scr + (rr + 8 * i) * 33 + c4; d[0] = v[i].x; d[1] = v[i].y; d[2] = v[i].z; d[3] = v[i].w; }
    LDS_WAIT(); asm volatile("" ::: "memory");
    const int c = lane & 7;
#pragma unroll
    for (int j = 0; j < 4; ++j) { const int n = (lane >> 3) + 8 * j; const LAS float* s = scr + (8 * c) * 33 + n;
        v4u o; o.x = pk2(s[0 * 33], s[1 * 33]); o.y = pk2(s[2 * 33], s[3 * 33]); o.z = pk2(s[4 * 33], s[5 * 33]); o.w = pk2(s[6 * 33], s[7 * 33]);
        const int ng = t.dr0 + n, kk = k0 + 8 * c;
        const size_t off = t.frag ? ((size_t)(((ng >> 5) * (t.K >> 4) + (kk >> 4)) * 64 + ((kk >> 3) & 1) * 32 + (ng & 31)) * 8) : ((size_t)ng * t.K + kk);
        *(GAS v4u*)(t.WT + off) = o; }
    LDS_WAIT(); asm volatile("" ::: "memory");
}
__device__ __forceinline__ void win_map(int dblk, int& sc0, int& nvalid) {
    const int hidx = dblk >> 1, half = dblk & 1; nvalid = 32;
    if (hidx < 8) sc0 = hidx * 64 + half * 32;
    else if (hidx < 20) sc0 = 512 + (hidx - 8) * 64 + half * 32;
    else if (hidx < 32) sc0 = 1304 + (hidx - 20) * 64 + half * 32;
    else if (hidx < 44) sc0 = 2072 + (hidx - 32) * 64 + half * 32;
    else if (hidx < 56) sc0 = 2840 + (hidx - 44) * 64 + half * 32;
    else if (hidx < 72) sc0 = 3608 + (hidx - 56) * 64 + half * 32;
    else if (hidx < 88) sc0 = 4632 + (hidx - 72) * 64 + half * 32;
    else if (hidx == 88 && half == 0) { sc0 = 1280; nvalid = 24; }
    else { sc0 = 0; nvalid = 0; }
}
__device__ __forceinline__ void gu_map(int dblk, int& sc0) { const int pn = dblk >> 3, q = dblk & 7; sc0 = (q < 4) ? (128 * pn + 32 * q) : (FF + 128 * pn + 32 * (q - 4)); }
__device__ __forceinline__ int t5_bucket(int d) {
    if (d < 16) return d;
    int b = 16;
    b += (d >= 22); b += (d >= 30); b += (d >= 40); b += (d >= 54); b += (d >= 73); b += (d >= 99); b += (d >= 134); b += (d >= 182);
    b += (d >= 246); b += (d >= 332); b += (d >= 450); b += (d >= 609); b += (d >= 825); b += (d >= 1117); b += (d >= 1513);
    return b;
}
struct In {
    const float *x, *f1_pre, *f1_wgu, *f1_wd, *f1_post, *mix_pre, *w_in, *cpos_k, *cw1_k, *cw2_k, *cpos_v, *cw1_v, *cw2_v, *w_bn, *w_bd, *w_out, *mix_post, *f2_pre, *f2_wgu, *f2_wd, *f2_post, *rel_bias;
};
__device__ __forceinline__ void rms_row_to_bf16(const float* xrow, const float* gain, bf16* orow, int lane) {
    const GAS f32x4* xr = (const GAS f32x4*)xrow + lane; const GAS f32x4* gr = (const GAS f32x4*)gain + lane;
    f32x4 v[4]; float s = 0.f;
#pragma unroll
    for (int j = 0; j < 4; ++j) { v[j] = xr[64 * j]; s += (v[j].x * v[j].x + v[j].y * v[j].y) + (v[j].z * v[j].z + v[j].w * v[j].w); }
    const float r = 1.f / sqrtf(wave_sum(s) * (1.f / D) + RMS_EPS);
    GAS unsigned long long* o8 = (GAS unsigned long long*)orow + lane;
#pragma unroll
    for (int j = 0; j < 4; ++j) { const f32x4 g = gr[64 * j]; o8[64 * j] = (unsigned long long)pk2(v[j].x * r * g.x, v[j].y * r * g.y) | ((unsigned long long)pk2(v[j].z * r * g.z, v[j].w * r * g.w) << 32); }
}
__device__ __forceinline__ void p0_prologue(Frame& F, const In& in, unsigned char* ws) {
    const int tid = fresh_tid(), lane = tid & 63, wave = __builtin_amdgcn_readfirstlane(tid >> 6);
    LAS float* scr = (LAS float*)(F.lds + RING_OFF + wave * 16384);
    const int gw = F.vcu * NWAVES + wave, NGW = F.G * NWAVES;
    constexpr int I_GU = 176 * 16, I_D = 32 * 44, I_IN = 184 * 16, I_C1 = 8 * 32, I_C2 = 2 * 4, I_BN = 32 * 8, I_BD = 32 * 4, I_O = 32 * 16;
    constexpr int NITEMS = 2 * I_GU + 2 * I_D + I_IN + 2 * I_C1 + 2 * I_C2 + I_BN + I_BD + I_O;
    auto decode = [&](int it) -> TrItem {
        TrItem t; int r = it, sc0 = 0, nv = 32; t.frag = 0;
        if (r < I_GU) { const int dblk = r / 16; gu_map(dblk, sc0); t = TrItem{in.f1_wgu, (bf16*)(ws + WS_WGU1), D, 2 * FF, sc0, 32, dblk * 32, r % 16, 0}; return t; } r -= I_GU;
        if (r < I_GU) { const int dblk = r / 16; gu_map(dblk, sc0); t = TrItem{in.f2_wgu, (bf16*)(ws + WS_WGU2), D, 2 * FF, sc0, 32, dblk * 32, r % 16, 0}; return t; } r -= I_GU;
        if (r < I_D) { const int dblk = r / 44; t = TrItem{in.f1_wd, (bf16*)(ws + WS_WD1), FF, D, dblk * 32, 32, dblk * 32, r % 44, 0}; return t; } r -= I_D;
        if (r < I_D) { const int dblk = r / 44; t = TrItem{in.f2_wd, (bf16*)(ws + WS_WD2), FF, D, dblk * 32, 32, dblk * 32, r % 44, 0}; return t; } r -= I_D;
        if (r < I_IN) { const int dblk = r / 16; win_map(dblk, sc0, nv); t = TrItem{in.w_in, (bf16*)(ws + WS_WIN), D, NPROJ_SRC, sc0, nv, dblk * 32, r % 16, 0}; return t; } r -= I_IN;
        if (r < I_C1) { const int dblk = r / 32; t = TrItem{in.cw1_k, (bf16*)(ws + WS_WC1K), 2048, 256, dblk * 32, 32, dblk * 32, r % 32, 1}; return t; } r -= I_C1;
        if (r < I_C1) { const int dblk = r / 32; t = TrItem{in.cw1_v, (bf16*)(ws + WS_WC1V), 2048, 256, dblk * 32, 32, dblk * 32, r % 32, 1}; return t; } r -= I_C1;
        if (r < I_C2) { const int dblk = r / 4; t = TrItem{in.cw2_k, (bf16*)(ws + WS_WC2K), 256, 64, dblk * 32, 32, dblk * 32, r % 4, 0}; return t; } r -= I_C2;
        if (r < I_C2) { const int dblk = r / 4; t = TrItem{in.cw2_v, (bf16*)(ws + WS_WC2V), 256, 64, dblk * 32, 32, dblk * 32, r % 4, 0}; return t; } r -= I_C2;
        if (r < I_BN) { const int dblk = r / 8; t = TrItem{in.w_bn, (bf16*)(ws + WS_WBN), 512, D, dblk * 32, 32, dblk * 32, r % 8, 0}; return t; } r -= I_BN;
        if (r < I_BD) { const int dblk = r / 4; t = TrItem{in.w_bd, (bf16*)(ws + WS_WBD), 256, D, dblk * 32, 32, dblk * 32, r % 4, 0}; return t; } r -= I_BD;
        { const int dblk = r / 16; t = TrItem{in.w_out, (bf16*)(ws + WS_WOUT), D, D, dblk * 32, 32, dblk * 32, r % 16, 0}; return t; }
    };
    {
        f32x4 va[8], vb[8]; TrItem ta, tb;
        int it = gw; if (it < NITEMS) { ta = decode(it); tr_load(ta, va, lane); }
        while (it < NITEMS) {
            const int itn = it + NGW; if (itn < NITEMS) { tb = decode(itn); tr_load(tb, vb, lane); }
            tr_finish(ta, va, scr, lane);
            it = itn; if (it >= NITEMS) break;
            const int itm = it + NGW; if (itm < NITEMS) { ta = decode(itm); tr_load(ta, va, lane); }
            tr_finish(tb, vb, scr, lane);
            it = itm;
        }
    }
    { float* ln = (float*)(ws + WS_LUTN); float* ld = (float*)(ws + WS_LUTD); const int gt = F.vcu * (NWAVES * 64) + tid, NGT = F.G * NWAVES * 64;
      for (int e = gt; e < 8 * LUTW; e += NGT) { const int hd = e / LUTW, d = e % LUTW - LUT_PAD; ln[e] = (d >= 0) ? in.rel_bias[t5_bucket(d) * 20 + hd] * LOG2E : 0.f; }
      for (int e = gt; e < 12 * 320; e += NGT) { const int hd = e / 320, st = e % 320 - LUT_PAD; const int dil = 1 << (2 * (hd >> 2)); ld[e] = (st >= 0 && st <= 128) ? in.rel_bias[t5_bucket(st * dil) * 20 + 8 + hd] * LOG2E : 0.f; } }
    { float* cb = (float*)(ws + WS_CB);
      for (int o = gw; o < 512; o += NGW) { const int ts = o >> 8, n = o & 255; const float* pos = ts ? in.cpos_v : in.cpos_k; const float* w1 = ts ? in.cw1_v : in.cw1_k;
          float s = 0.f; for (int k = lane; k < 2048; k += 64) s += pos[k] * w1[(size_t)k * 256 + n];
          s = wave_sum(s); if (lane == 0) cb[o] = s; } }
    for (int m = gw; m < M; m += 2 * NGW) {
        const int m2 = m + NGW;
        const GAS f32x4* xa = (const GAS f32x4*)(in.x + (size_t)m * D) + lane; const GAS f32x4* xb = (const GAS f32x4*)(in.x + (size_t)(m2 < M ? m2 : m) * D) + lane;
        const GAS f32x4* gr = (const GAS f32x4*)in.f1_pre + lane;
        f32x4 va[4], vb[4]; float sa = 0.f, sb = 0.f;
#pragma unroll
        for (int j = 0; j < 4; ++j) { va[j] = xa[64 * j]; vb[j] = xb[64 * j]; }
#pragma unroll
        for (int j = 0; j < 4; ++j) { sa += (va[j].x * va[j].x + va[j].y * va[j].y) + (va[j].z * va[j].z + va[j].w * va[j].w); sb += (vb[j].x * vb[j].x + vb[j].y * vb[j].y) + (vb[j].z * vb[j].z + vb[j].w * vb[j].w); }
        const float ra = 1.f / sqrtf(wave_sum(sa) * (1.f / D) + RMS_EPS), rb = 1.f / sqrtf(wave_sum(sb) * (1.f / D) + RMS_EPS);
        GAS unsigned long long* oa = (GAS unsigned long long*)((bf16*)(ws + WS_XN) + (size_t)m * D) + lane; GAS unsigned long long* ob = (GAS unsigned long long*)((bf16*)(ws + WS_XN) + (size_t)(m2 < M ? m2 : m) * D) + lane;
#pragma unroll
        for (int j = 0; j < 4; ++j) { const f32x4 g = gr[64 * j];
            oa[64 * j] = (unsigned long long)pk2(va[j].x * ra * g.x, va[j].y * ra * g.y) | ((unsigned long long)pk2(va[j].z * ra * g.z, va[j].w * ra * g.w) << 32);
            if (m2 < M) ob[64 * j] = (unsigned long long)pk2(vb[j].x * rb * g.x, vb[j].y * rb * g.y) | ((unsigned long long)pk2(vb[j].z * rb * g.z, vb[j].w * rb * g.w) << 32); }
    }
}
__device__ __forceinline__ void row_pass(Frame& F, const bf16* Y, const float* base, float* out, float alpha, const float* gpost, const float* gnext, bf16* XN) {
    const int tid = fresh_tid(), lane = tid & 63, wave = __builtin_amdgcn_readfirstlane(tid >> 6);
    const int gw = F.vcu * NWAVES + wave, NGW = F.G * NWAVES;
    for (int m = gw; m < M; m += NGW) {
        const GAS unsigned long long* yr = (const GAS unsigned long long*)(Y + (size_t)m * D) + lane; const GAS f32x4* br = (const GAS f32x4*)(base + (size_t)m * D) + lane;
        const GAS f32x4* gp = (const GAS f32x4*)gpost + lane;
        f32x4 v[4], bv[4]; float s = 0.f;
#pragma unroll
        for (int j = 0; j < 4; ++j) { const unsigned long long w = yr[64 * j]; const unsigned lo = (unsigned)w, hi = (unsigned)(w >> 32);
            v[j].x = __uint_as_float(lo << 16); v[j].y = __uint_as_float(lo & 0xffff0000u); v[j].z = __uint_as_float(hi << 16); v[j].w = __uint_as_float(hi & 0xffff0000u);
            bv[j] = br[64 * j]; s += (v[j].x * v[j].x + v[j].y * v[j].y) + (v[j].z * v[j].z + v[j].w * v[j].w); }
        const float r = alpha / sqrtf(wave_sum(s) * (1.f / D) + RMS_EPS);
        float s2 = 0.f;
        GAS f32x4* orow = (GAS f32x4*)(out + (size_t)m * D) + lane;
#pragma unroll
        for (int j = 0; j < 4; ++j) { const f32x4 g = gp[64 * j]; v[j] = bv[j] + v[j] * r * g; orow[64 * j] = v[j]; s2 += (v[j].x * v[j].x + v[j].y * v[j].y) + (v[j].z * v[j].z + v[j].w * v[j].w); }
        if (gnext) {
            const float r2 = 1.f / sqrtf(wave_sum(s2) * (1.f / D) + RMS_EPS);
            const GAS f32x4* gn = (const GAS f32x4*)gnext + lane;
            GAS unsigned long long* o8 = (GAS unsigned long long*)(XN + (size_t)m * D) + lane;
#pragma unroll
            for (int j = 0; j < 4; ++j) { const f32x4 g = gn[64 * j]; o8[64 * j] = (unsigned long long)pk2(v[j].x * r2 * g.x, v[j].y * r2 * g.y) | ((unsigned long long)pk2(v[j].z * r2 * g.z, v[j].w * r2 * g.w) << 32); }
        }
    }
}

namespace att {
typedef float f32x16 __attribute__((ext_vector_type(16)));
typedef short s16x4 __attribute__((ext_vector_type(4)));
typedef short v4i16_t __attribute__((ext_vector_type(4)));
constexpr float NEGV = -1.0e30f;
constexpr int TILE_B = 16384, SBUF = 2 * TILE_B;
enum { CLS_SKIP = 0, CLS_FULL = 1, CLS_PART = 2, CLS_CONST = 3 };
__device__ __forceinline__ constexpr int crow(int r, int hi) { return (r & 3) + 8 * (r >> 2) + 4 * hi; }
__device__ __forceinline__ unsigned cvtpk(float lo, float hi) { unsigned r; asm volatile("v_cvt_pk_bf16_f32 %0, %1, %2" : "=v"(r) : "v"(lo), "v"(hi)); return r; }
__device__ __forceinline__ float swapmax(float v) { auto rr = __builtin_amdgcn_permlane32_swap(__float_as_uint(v), __float_as_uint(v), false, false); return fmaxf(__uint_as_float(rr[0]), __uint_as_float(rr[1])); }
__device__ __forceinline__ float swapsum(float v) { auto rr = __builtin_amdgcn_permlane32_swap(__float_as_uint(v), __float_as_uint(v), false, false); return __uint_as_float(rr[0]) + __uint_as_float(rr[1]); }
__device__ __forceinline__ float quadsum(float v) {
    v += __int_as_float(__builtin_amdgcn_mov_dpp(__float_as_int(v), 0xB1, 0xF, 0xF, true));
    v += __int_as_float(__builtin_amdgcn_mov_dpp(__float_as_int(v), 0x4E, 0xF, 0xF, true));
    return v;
}
struct Stage { v4u k, v; };
struct Stage2 { Stage t[2]; };
__device__ __forceinline__ void tile_load(Stage& s, const bf16* Kp, const bf16* Vp, long row, int tid) {
    const int ch = tid & 7; s.k = *(const GAS v4u*)(Kp + row * 64 + ch * 8); s.v = *(const GAS v4u*)(Vp + row * 64 + ch * 8);
}
__device__ __forceinline__ void tile_store(LAS unsigned char* buf, const Stage& s, int tid) {
    const int key = tid >> 3, ch = tid & 7;
    *(LAS v4u*)(buf + ch * 1024 + key * 16) = s.k;
    *(LAS v4u*)(buf + 8192 + (ch >> 2) * 4096 + key * 64 + (ch & 3) * 16) = s.v;
}
#define SBAR() __builtin_amdgcn_sched_barrier(0)
#ifndef ATT_SHIFT
#define ATT_SHIFT 8
#endif
#define ATT_BAR() asm volatile("s_waitcnt lgkmcnt(0)\n\ts_barrier" ::: "memory")
__device__ __forceinline__ void qk(f32x16& p0, f32x16& p1, const LAS unsigned char* kb, const bf16x8 (&qr)[4]) {
#pragma unroll
    for (int d0 = 0; d0 < 4; ++d0) {
        const bf16x8 b0 = *(const LAS bf16x8*)(kb + d0 * 2048), b1 = *(const LAS bf16x8*)(kb + d0 * 2048 + 512);
        p0 = __builtin_amdgcn_mfma_f32_32x32x16_bf16(b0, qr[d0], p0, 0, 0, 0);
        p1 = __builtin_amdgcn_mfma_f32_32x32x16_bf16(b1, qr[d0], p1, 0, 0, 0);
    }
}
__device__ __forceinline__ float max3f(float a, float b, float c) { float r; asm("v_max3_f32 %0, %1, %2, %3" : "=v"(r) : "v"(a), "v"(b), "v"(c)); return r; }
__device__ __forceinline__ float rowmax32(const f32x16& p0, const f32x16& p1) {
    float a = max3f(p0[0], p1[0], p0[1]), b = max3f(p1[1], p0[2], p1[2]);
#pragma unroll
    for (int r = 3; r < 15; r += 2) { a = max3f(a, p0[r], p1[r]); b = max3f(b, p0[r + 1], p1[r + 1]); }
    a = max3f(a, p0[15], p1[15]);
    return swapmax(fmaxf(a, b));
}
__device__ __forceinline__ s16x4 vtr(const LAS unsigned char* p) { return __builtin_bit_cast(s16x4, __builtin_amdgcn_ds_read_tr16_b64_v4i16((LAS v4i16_t*)p)); }
__device__ __forceinline__ void pv(f32x16 (&o)[2], const LAS unsigned char* vb, const f32x16& p0, const f32x16& p1) {
    v4u pw[4];
#pragma unroll
    for (int s = 0; s < 2; ++s) {
        pw[s]     = (v4u){cvtpk(p0[8 * s], p0[8 * s + 1]), cvtpk(p0[8 * s + 2], p0[8 * s + 3]), cvtpk(p0[8 * s + 4], p0[8 * s + 5]), cvtpk(p0[8 * s + 6], p0[8 * s + 7])};
        pw[2 + s] = (v4u){cvtpk(p1[8 * s], p1[8 * s + 1]), cvtpk(p1[8 * s + 2], p1[8 * s + 3]), cvtpk(p1[8 * s + 4], p1[8 * s + 5]), cvtpk(p1[8 * s + 6], p1[8 * s + 7])};
    }
#pragma unroll
    for (int dh = 0; dh < 2; ++dh)
#pragma unroll
        for (int kg = 0; kg < 4; ++kg) {
            const s16x4 lo = vtr(vb + dh * 4096 + kg * 1024), hi = vtr(vb + dh * 4096 + kg * 1024 + 512);
            const bf16x8 vf = (bf16x8){lo[0], lo[1], lo[2], lo[3], hi[0], hi[1], hi[2], hi[3]};
            o[dh] = __builtin_amdgcn_mfma_f32_32x32x16_bf16(__builtin_bit_cast(bf16x8, pw[kg]), vf, o[dh], 0, 0, 0);
        }
}
struct Soft { float mref, lsum; };
__device__ __forceinline__ void proc_tile(int cls, const LAS unsigned char* tile, const bf16x8 (&qr)[4], Soft& st, f32x16 (&o)[2], const LAS float* lut, int d0, int dlo, int dhi, float cbias, bool rowsel,
                                          LAS float* wsf, int r32, int hi, int trb) {
    const bool unset = st.mref < -1.0e29f;
    const float base = unset ? 0.f : st.mref;
    const float negb = rowsel ? -base : NEGV;
    f32x16 p0, p1; bf16x8 kf0[4], kf1[4];
    { const LAS unsigned char* kb = tile + hi * 1024 + r32 * 16;
#pragma unroll
      for (int q = 0; q < 4; ++q) { kf0[q] = *(const LAS bf16x8*)(kb + q * 2048); kf1[q] = *(const LAS bf16x8*)(kb + q * 2048 + 512); } }
    if (cls == CLS_CONST) { const float iv = negb + cbias;
#pragma unroll
        for (int r = 0; r < 16; ++r) { p0[r] = iv; p1[r] = iv; }
    } else { const LAS float* pb = lut + (d0 - 4 * hi - 59);
#pragma unroll
        for (int r = 0; r < 16; ++r) { p0[r] = pb[59 - crow(r, 0)]; p1[r] = pb[27 - crow(r, 0)]; }
        SBAR();
#pragma unroll
        for (int r = 0; r < 16; ++r) { p0[r] += negb; p1[r] += negb; }
    }
    SBAR();
#pragma unroll
    for (int q = 0; q < 4; ++q) { p0 = __builtin_amdgcn_mfma_f32_32x32x16_bf16(kf0[q], qr[q], p0, 0, 0, 0); p1 = __builtin_amdgcn_mfma_f32_32x32x16_bf16(kf1[q], qr[q], p1, 0, 0, 0); }
    SBAR();
    s16x4 vlo[8], vhi[8];
    { const LAS unsigned char* vb = tile + 8192 + trb;
#pragma unroll
      for (int i = 0; i < 8; ++i) { vlo[i] = vtr(vb + (i >> 2) * 4096 + (i & 3) * 1024); vhi[i] = vtr(vb + (i >> 2) * 4096 + (i & 3) * 1024 + 512); } }
    SBAR();
    if (cls == CLS_PART) { const int dq = d0 - 4 * hi; const unsigned span = (unsigned)(dhi - dlo);
#pragma unroll
        for (int r = 0; r < 16; ++r) { const int da = dq - crow(r, 0), db = da - 32;
            p0[r] = ((unsigned)(da - dlo) <= span) ? p0[r] : NEGV; p1[r] = ((unsigned)(db - dlo) <= span) ? p1[r] : NEGV; }
    }
    const float rm = rowmax32(p0, p1);
    const bool upd = rowsel && (rm > -1.0e29f) && (unset || rm > 8.0f);
    if (__any(upd)) {
        const float delta = upd ? rm : 0.f;
#pragma unroll
        for (int r = 0; r < 16; ++r) { p0[r] -= delta; p1[r] -= delta; }
        const float f = (upd && !unset) ? __builtin_amdgcn_exp2f(-delta) : 1.0f;
        st.lsum *= f;
        if (upd) st.mref = base + delta;
        if (hi == 0) wsf[r32] = f;
        asm volatile("s_waitcnt lgkmcnt(0)" ::: "memory");
#pragma unroll
        for (int r = 0; r < 16; ++r) { const float fr = wsf[crow(r, hi)]; o[0][r] *= fr; o[1][r] *= fr; }
        asm volatile("s_waitcnt lgkmcnt(0)" ::: "memory");
    }
    float s = 0.f;
#pragma unroll
    for (int r = 0; r < 16; ++r) { p0[r] = __builtin_amdgcn_exp2f(p0[r]); p1[r] = __builtin_amdgcn_exp2f(p1[r]); s += p0[r] + p1[r]; }
    st.lsum += s;
    v4u pw[4];
#pragma unroll
    for (int q = 0; q < 2; ++q) {
        pw[q]     = (v4u){cvtpk(p0[8 * q], p0[8 * q + 1]), cvtpk(p0[8 * q + 2], p0[8 * q + 3]), cvtpk(p0[8 * q + 4], p0[8 * q + 5]), cvtpk(p0[8 * q + 6], p0[8 * q + 7])};
        pw[2 + q] = (v4u){cvtpk(p1[8 * q], p1[8 * q + 1]), cvtpk(p1[8 * q + 2], p1[8 * q + 3]), cvtpk(p1[8 * q + 4], p1[8 * q + 5]), cvtpk(p1[8 * q + 6], p1[8 * q + 7])};
    }
    SBAR();
#pragma unroll
    for (int kg = 0; kg < 4; ++kg)
#pragma unroll
        for (int dh = 0; dh < 2; ++dh) { const int i = dh * 4 + kg;
            const bf16x8 vf = (bf16x8){vlo[i][0], vlo[i][1], vlo[i][2], vlo[i][3], vhi[i][0], vhi[i][1], vhi[i][2], vhi[i][3]};
            o[dh] = __builtin_amdgcn_mfma_f32_32x32x16_bf16(__builtin_bit_cast(bf16x8, pw[kg]), vf, o[dh], 0, 0, 0); }
}
__device__ __forceinline__ float soft_final_inv(const Soft& st, float& ltot) { ltot = swapsum(st.lsum); return (st.mref > -1.0e29f) ? 1.0f / ltot : 0.f; }
}

struct Mix {
    bf16 *QN, *YN, *SCR, *PL, *QD, *KD, *VD, *YD, *KCMP, *VCMP, *OD; float* LSE; const float* GN; const float* LUTN; const float* LUTD; const float* CB;
    const bf16 *WC1K, *WC1V, *WC2K, *WC2V;
};
__device__ __forceinline__ void lut_to_lds(Frame& F, int tid, const float* img, int nf) {
    LAS f32x4* L = (LAS f32x4*)(F.lds + A_LUT); const GAS f32x4* G = (const GAS f32x4*)img;
    for (int e = tid; e < nf / 4; e += NWAVES * 64) L[e] = G[e];
}
__device__ __forceinline__ bf16x8 ldq(const bf16* p) { return *(const GAS bf16x8*)p; }

__device__ __forceinline__ int next_sel(int j, int c, unsigned u0, unsigned u1, unsigned u2, unsigned u3) {
    while (j <= c) { const unsigned w = (j < 32) ? u0 : (j < 64) ? u1 : (j < 96) ? u2 : u3; if ((w >> (j & 31)) & 1u) break; ++j; }
    return j;
}
template <bool ADD> __device__ __forceinline__ void yn_rows(bf16* YN, const att::f32x16 (&o)[2], float fac, LAS float* wsf, int r32, int hi, size_t R0, int g, int lane) {
    if (hi == 0) wsf[r32] = fac;
    asm volatile("s_waitcnt lgkmcnt(0)" ::: "memory");
#pragma unroll
    for (int r = 0; r < 16; ++r) { const int q = att::crow(r, hi); const float fr = wsf[q];
        bf16* op = YN + (R0 + (q >> 2)) * 512 + (4 * g + (q & 3)) * 64 + (lane & 31);
        float a0 = o[0][r] * fr, a1 = o[1][r] * fr;
        if (ADD) { a0 += __uint_as_float((unsigned)op[0] << 16); a1 += __uint_as_float((unsigned)op[32] << 16); }
        op[0] = (bf16)f2bf(a0); op[32] = (bf16)f2bf(a1); }
    asm volatile("s_waitcnt lgkmcnt(0)" ::: "memory");
}
__device__ __forceinline__ void nsa_unit(Frame& F, const Mix& X, int b, int g, int c, int& buf) {
    using namespace att;
    const int tid = fresh_tid(), lane = tid & 63, wave = __builtin_amdgcn_readfirstlane(tid >> 6), r32 = lane & 31, hi = lane >> 5;
    LAS unsigned char* kv = F.lds + A_KV; LAS float* lutl = (LAS float*)(F.lds + A_LUT); LAS float* imp = (LAS float*)(F.lds + A_IMP);
    LAS unsigned* selm = (LAS unsigned*)(F.lds + A_SEL); LAS unsigned* um = (LAS unsigned*)(F.lds + A_UM); LAS float* wsf = (LAS float*)(F.lds + A_WSF) + wave * 128;
    const int trb = ((lane >> 4) & 1) * 32 + (lane & 3) * 8 + (4 * hi + ((lane & 15) >> 2)) * 64;
    const int t0 = 64 * c, tok = 8 * wave + (r32 >> 2), h = r32 & 3, t = t0 + tok;
    const size_t R = (size_t)b * SEQ + t, R0 = (size_t)b * SEQ + t0 + 8 * wave;
    const int plane = b * 2 + g;
    const bf16* KS = X.PL + 2 * PLSZ + (size_t)plane * SEQ * 64; const bf16* VS = X.PL + 3 * PLSZ + (size_t)plane * SEQ * 64;
    const bf16* KW = X.PL + 4 * PLSZ + (size_t)plane * SEQ * 64; const bf16* VW = X.PL + 5 * PLSZ + (size_t)plane * SEQ * 64;
    const bf16* KC = X.KCMP + (size_t)plane * 512 * 64; const bf16* VC = X.VCMP + (size_t)plane * 512 * 64;
    __syncthreads();
    lut_to_lds(F, tid, X.LUTN + (size_t)g * 4 * LUTW, 4 * LUTW);
    for (int e = tid; e < 64 * IMP_S / 4; e += NWAVES * 64) ((LAS f32x4*)imp)[e] = (f32x4){0.f, 0.f, 0.f, 0.f};
    if (tid < 4) um[tid] = 0u;
    bf16x8 qr[4];
#pragma unroll
    for (int d0 = 0; d0 < 4; ++d0) qr[d0] = ldq(X.QN + R * 512 + (4 * g + h) * 64 + 16 * d0 + 8 * hi);
    const float g0 = X.GN[R * 32 + (4 * g + h) * 3 + 0], g1 = X.GN[R * 32 + (4 * g + h) * 3 + 1], g2 = X.GN[R * 32 + (4 * g + h) * 3 + 2];
    const LAS float* lrow = lutl + h * LUTW + LUT_PAD;
    __syncthreads();
    const int key = tid >> 3;
    Stage2 sg;
    {
        Soft st{NEGV, 0.f}; f32x16 o[2]; o[0] = f32x16{}; o[1] = f32x16{};
        const int it0 = (c >= 8) ? 0 : (8 - c), nt = 9 - it0, nss = (nt + 1) >> 1;
#pragma unroll
        for (int tt = 0; tt < 2; ++tt) { int it = it0 + tt; it = it > 8 ? 8 : it; tile_load(sg.t[tt], KW, VW, t0 - 512 + 64 * it + key, tid); }
        for (int ss = 0; ss < nss; ++ss) {
            LAS unsigned char* bp = kv + buf * SBUF;
            tile_store(bp, sg.t[0], tid); tile_store(bp + TILE_B, sg.t[1], tid); ATT_BAR();
            if (ss + 1 < nss) {
#pragma unroll
                for (int tt = 0; tt < 2; ++tt) { int it = it0 + 2 * (ss + 1) + tt; it = it > 8 ? 8 : it; tile_load(sg.t[tt], KW, VW, t0 - 512 + 64 * it + key, tid); } }
#pragma unroll
            for (int tt = 0; tt < 2; ++tt) { const int it = it0 + 2 * ss + tt;
                if (it <= 8) { const int kb = t0 - 512 + 64 * it; const int cls = (it == 0 || it == 8) ? CLS_PART : CLS_FULL;
                    proc_tile(cls, bp + tt * TILE_B, qr, st, o, lrow, t - kb, 0, 511, 0.f, true, wsf, r32, hi, trb); } }
            buf ^= 1;
        }
        float lt; const float inv = soft_final_inv(st, lt);
        yn_rows<false>(X.YN, o, g2 * inv, wsf, r32, hi, R0, g, lane);
    }
    {
        const int imax = (4 * c + 2 > 510) ? 510 : (4 * c + 2), ntc = imax / 64 + 1, nss = (ntc + 1) >> 1;
        const int dq = t - 31 - 16 * 4 * hi;
        const float cfar = lrow[1599];
        float m = NEGV, l = 0.f;
#pragma unroll
        for (int tt = 0; tt < 2; ++tt) { int it = tt; it = it > ntc - 1 ? ntc - 1 : it; tile_load(sg.t[tt], KC, VC, 64 * it + key, tid); }
        for (int ss = 0; ss < nss; ++ss) {
            LAS unsigned char* bp = kv + buf * SBUF;
            tile_store(bp, sg.t[0], tid); tile_store(bp + TILE_B, sg.t[1], tid); ATT_BAR();
            if (ss + 1 < nss) {
#pragma unroll
                for (int tt = 0; tt < 2; ++tt) { int it = 2 * (ss + 1) + tt; it = it > ntc - 1 ? ntc - 1 : it; tile_load(sg.t[tt], KC, VC, 64 * it + key, tid); } }
#pragma unroll
            for (int tt = 0; tt < 2; ++tt) { const int it = 2 * ss + tt;
                if (it < ntc) {
                    f32x16 p0, p1; const int dt = dq - 1024 * it;
                    const bool far = (t0 - 31 - 1024 * it - 1008) >= 1513;
                    if (far) {
#pragma unroll
                        for (int r = 0; r < 16; ++r) { p0[r] = cfar; p1[r] = cfar; }
                    } else {
#pragma unroll
                        for (int r = 0; r < 16; ++r) { const int da = dt - 16 * crow(r, 0), db = da - 512;
                            const int ia = da < -64 ? -64 : (da > 1599 ? 1599 : da), ib = db < -64 ? -64 : (db > 1599 ? 1599 : db);
                            p0[r] = lrow[ia]; p1[r] = lrow[ib]; }
                    }
                    qk(p0, p1, bp + tt * TILE_B + hi * 1024 + r32 * 16, qr);
                    if (!far) {
#pragma unroll
                        for (int r = 0; r < 16; ++r) { const int da = dt - 16 * crow(r, 0), db = da - 512; p0[r] = (da >= 0) ? p0[r] : NEGV; p1[r] = (db >= 0) ? p1[r] : NEGV; }
                    }
                    const float rm = rowmax32(p0, p1);
                    const float mn = fmaxf(m, rm); float s = 0.f;
#pragma unroll
                    for (int r = 0; r < 16; ++r) s += __builtin_amdgcn_exp2f(p0[r] - mn) + __builtin_amdgcn_exp2f(p1[r] - mn);
                    l = l * __builtin_amdgcn_exp2f(m - mn) + s; m = mn;
                } }
            buf ^= 1;
        }
        const float ltot = swapsum(l);
        const float invl = (m > -1.0e29f) ? 1.0f / ltot : 0.f;
        const float mz = (m > -1.0e29f) ? m : 0.f;
        f32x16 o[2]; o[0] = f32x16{}; o[1] = f32x16{};
        LAS float* improw = imp + tok * IMP_S; float icarry = 0.f;
#pragma unroll
        for (int tt = 0; tt < 2; ++tt) { int it = tt; it = it > ntc - 1 ? ntc - 1 : it; tile_load(sg.t[tt], KC, VC, 64 * it + key, tid); }
        for (int ss = 0; ss < nss; ++ss) {
            LAS unsigned char* bp = kv + buf * SBUF;
            tile_store(bp, sg.t[0], tid); tile_store(bp + TILE_B, sg.t[1], tid); ATT_BAR();
            if (ss + 1 < nss) {
#pragma unroll
                for (int tt = 0; tt < 2; ++tt) { int it = 2 * (ss + 1) + tt; it = it > ntc - 1 ? ntc - 1 : it; tile_load(sg.t[tt], KC, VC, 64 * it + key, tid); } }
#pragma unroll
            for (int tt = 0; tt < 2; ++tt) { const int it = 2 * ss + tt;
                if (it < ntc) {
                    f32x16 p0, p1; const int dt = dq - 1024 * it;
                    const bool far = (t0 - 31 - 1024 * it - 1008) >= 1513;
                    if (far) { const float iv = cfar - mz;
#pragma unroll
                        for (int r = 0; r < 16; ++r) { p0[r] = iv; p1[r] = iv; }
                    } else {
#pragma unroll
                        for (int r = 0; r < 16; ++r) { const int da = dt - 16 * crow(r, 0), db = da - 512;
                            const int ia = da < -64 ? -64 : (da > 1599 ? 1599 : da), ib = db < -64 ? -64 : (db > 1599 ? 1599 : db);
                            p0[r] = lrow[ia] - mz; p1[r] = lrow[ib] - mz; }
                    }
                    qk(p0, p1, bp + tt * TILE_B + hi * 1024 + r32 * 16, qr);
#pragma unroll
                    for (int r = 0; r < 16; ++r) { p0[r] = __builtin_amdgcn_exp2f(p0[r]) * invl; p1[r] = __builtin_amdgcn_exp2f(p1[r]) * invl; }
                    if (!far) {
#pragma unroll
                        for (int r = 0; r < 16; ++r) { const int da = dt - 16 * crow(r, 0), db = da - 512; p0[r] = (da >= 0) ? p0[r] : 0.f; p1[r] = (db >= 0) ? p1[r] : 0.f; }
                    }
                    { float a0[4], l0[4], a1[4], l1[4], x0[4], x1[4];
#pragma unroll
                      for (int q = 0; q < 4; ++q) { a0[q] = quadsum((p0[4 * q] + p0[4 * q + 1]) + (p0[4 * q + 2] + p0[4 * q + 3])); l0[q] = quadsum(p0[4 * q + 3]);
                                                    a1[q] = quadsum((p1[4 * q] + p1[4 * q + 1]) + (p1[4 * q + 2] + p1[4 * q + 3])); l1[q] = quadsum(p1[4 * q + 3]); }
#pragma unroll
                      for (int q = 0; q < 4; ++q) { auto ra = __builtin_amdgcn_permlane32_swap(__float_as_uint(l0[q]), __float_as_uint(l0[q]), false, false); x0[q] = __uint_as_float(hi ? ra[0] : ra[1]);
                                                    auto rb = __builtin_amdgcn_permlane32_swap(__float_as_uint(l1[q]), __float_as_uint(l1[q]), false, false); x1[q] = __uint_as_float(hi ? rb[0] : rb[1]); }
                      if (h == 0) {
#pragma unroll
                          for (int q = 0; q < 4; ++q) { const float pv0 = hi ? x0[q] : (q ? x0[q ? q - 1 : 0] : icarry), pv1 = hi ? x1[q] : (q ? x1[q ? q - 1 : 0] : x0[3]);
                              improw[16 * it + 2 * q + hi] = a0[q] + pv0; improw[16 * it + 2 * q + hi + 8] = a1[q] + pv1; } }
                      icarry = x1[3]; }
                    pv(o, bp + tt * TILE_B + 8192 + trb, p0, p1);
                } }
            buf ^= 1;
        }
        yn_rows<true>(X.YN, o, g0, wsf, r32, hi, R0, g, lane);
    }
    asm volatile("s_waitcnt lgkmcnt(0)" ::: "memory");
    unsigned msk[4] = {0u, 0u, 0u, 0u};
    if (c >= 16) {
        const int tl = lane >> 3, part = lane & 7;
        const LAS float* ir = imp + (8 * wave + tl) * IMP_S + part * 16;
        unsigned v[16];
#pragma unroll
        for (int r = 0; r < 16; ++r) { const int j = part * 16 + r; const unsigned bits = __float_as_uint(ir[r]); v[r] = (j >= 1 && j <= c - 2) ? ((bits & ~127u) | (unsigned)(127 - j)) : 0u; }
        unsigned sm[4] = {0u, 0u, 0u, 0u};
        for (int itn = 0; itn < 13; ++itn) {
            unsigned mx = v[0];
#pragma unroll
            for (int r = 1; r < 16; ++r) mx = mx > v[r] ? mx : v[r];
            { unsigned o1 = (unsigned)__shfl_xor((int)mx, 1); mx = mx > o1 ? mx : o1; o1 = (unsigned)__shfl_xor((int)mx, 2); mx = mx > o1 ? mx : o1; o1 = (unsigned)__shfl_xor((int)mx, 4); mx = mx > o1 ? mx : o1; }
            const int j = 127 - (int)(mx & 127u); const unsigned bit = 1u << (j & 31); const int w = j >> 5;
            if (mx != 0u) { sm[0] |= (w == 0) ? bit : 0u; sm[1] |= (w == 1) ? bit : 0u; sm[2] |= (w == 2) ? bit : 0u; sm[3] |= (w == 3) ? bit : 0u; }
#pragma unroll
            for (int r = 0; r < 16; ++r) v[r] = (v[r] == mx) ? 0u : v[r];
        }
        sm[0] |= 1u;
        { const int j = c - 1; const unsigned bit = 1u << (j & 31); const int w = j >> 5; sm[0] |= (w == 0) ? bit : 0u; sm[1] |= (w == 1) ? bit : 0u; sm[2] |= (w == 2) ? bit : 0u; sm[3] |= (w == 3) ? bit : 0u; }
        { const int j = c; const unsigned bit = 1u << (j & 31); const int w = j >> 5; sm[0] |= (w == 0) ? bit : 0u; sm[1] |= (w == 1) ? bit : 0u; sm[2] |= (w == 2) ? bit : 0u; sm[3] |= (w == 3) ? bit : 0u; }
        if (part == 0) {
#pragma unroll
            for (int w = 0; w < 4; ++w) { selm[(8 * wave + tl) * 4 + w] = sm[w]; __hip_atomic_fetch_or(um + w, sm[w], __ATOMIC_RELAXED, __HIP_MEMORY_SCOPE_WORKGROUP); }
        }
        __syncthreads();
#pragma unroll
        for (int w = 0; w < 4; ++w) msk[w] = selm[tok * 4 + w];
    } else {
        msk[0] = (2u << c) - 1u;
        __syncthreads();
    }
    unsigned umr[4];
#pragma unroll
    for (int w = 0; w < 4; ++w) umr[w] = (c >= 16) ? (unsigned)__builtin_amdgcn_readfirstlane((int)um[w]) : ((w == 0) ? ((2u << c) - 1u) : 0u);
    {
        Soft st{NEGV, 0.f}; f32x16 o[2]; o[0] = f32x16{}; o[1] = f32x16{};
        const float cfar = lrow[1599];
        LAS unsigned char* blist = (LAS unsigned char*)(F.lds + A_BL);
        if (tid == 0) { int n = 0; for (int j = 0; j <= c; ++j) { const unsigned w = (j < 32) ? umr[0] : (j < 64) ? umr[1] : (j < 96) ? umr[2] : umr[3]; if ((w >> (j & 31)) & 1u) blist[n++] = (unsigned char)j; }
                        blist[160] = (unsigned char)n; blist[n] = blist[n - 1]; blist[n + 1] = blist[n - 1]; blist[n + 2] = blist[n - 1]; blist[n + 3] = blist[n - 1]; }
        __syncthreads();
        const int nb = blist[160], nss = (nb + 1) >> 1;
        Stage2 sh;
#define SEL_LOAD(SG, ss_) do { const int ja_ = blist[2 * (ss_)], jb_ = blist[2 * (ss_) + 1]; tile_load((SG).t[0], KS, VS, 64 * ja_ + key, tid); tile_load((SG).t[1], KS, VS, 64 * jb_ + key, tid); } while (0)
#define SEL_STEP(SG, ss_) do { LAS unsigned char* bp = kv + buf * SBUF; \
            tile_store(bp, (SG).t[0], tid); tile_store(bp + TILE_B, (SG).t[1], tid); ATT_BAR(); \
            if ((ss_) + 2 < nss) SEL_LOAD(SG, (ss_) + 2); \
            _Pragma("unroll") for (int tt = 0; tt < 2; ++tt) { const int bi = 2 * (ss_) + tt; \
                if (bi < nb) { const int j = blist[bi]; \
                    const unsigned mw = (j < 32) ? msk[0] : (j < 64) ? msk[1] : (j < 96) ? msk[2] : msk[3]; \
                    const bool sel = (mw >> (j & 31)) & 1u; \
                    if (__any(sel)) { const int cls = (j == c) ? CLS_PART : ((c - j >= 25) ? CLS_CONST : CLS_FULL); \
                        proc_tile(cls, bp + tt * TILE_B, qr, st, o, lrow, t - 64 * j, 0, 0x3fffffff, cfar, sel, wsf, r32, hi, trb); } } } \
            buf ^= 1; } while (0)
        SEL_LOAD(sg, 0); if (nss > 1) SEL_LOAD(sh, 1);
        for (int ss = 0; ss < nss; ss += 2) { SEL_STEP(sg, ss); if (ss + 1 < nss) SEL_STEP(sh, ss + 1); }
#undef SEL_LOAD
#undef SEL_STEP
        float lt; const float inv = soft_final_inv(st, lt);
#ifdef PROBE_SEL_TWICE
        if (rep_) yn_rows<false>(X.SCR, o, g1 * inv, wsf, r32, hi, R0 & 8191, g, lane); else
#endif
        yn_rows<true>(X.YN, o, g1 * inv, wsf, r32, hi, R0, g, lane);
    }
}

__device__ __forceinline__ void dil_unit(Frame& F, const Mix& X, int gi, int b, int s, int rest, int& buf) {
    using namespace att;
    const int tid = fresh_tid(), lane = tid & 63, wave = __builtin_amdgcn_readfirstlane(tid >> 6), r32 = lane & 31, hi = lane >> 5;
    LAS unsigned char* kv = F.lds + A_KV; LAS float* lutl = (LAS float*)(F.lds + A_LUT); LAS float* wsf = (LAS float*)(F.lds + A_WSF) + wave * 128;
    const int trb = ((lane >> 4) & 1) * 32 + (lane & 3) * 8 + (4 * hi + ((lane & 15) >> 2)) * 64;
    const int dil = 1 << (2 * gi), lg = 2 * gi, nch = (SEQ >> lg) >> 8, res = rest / nch, ch = rest % nch;
    const int hd = 4 * gi + s, N0 = 256 * ch, Nw = N0 + 32 * wave, nq = Nw + r32, key = tid >> 3;
    const int t = (nq << lg) + res;
    const size_t R = (size_t)b * SEQ + t;
    __syncthreads();
    lut_to_lds(F, tid, X.LUTD + hd * 320, 320);
    bf16x8 qr[4];
#pragma unroll
    for (int d0 = 0; d0 < 4; ++d0) qr[d0] = ldq(X.QD + R * 768 + hd * 64 + 16 * d0 + 8 * hi);
    const bf16* Kp = X.KD + (size_t)(b * 12 + hd) * SEQ * 64; const bf16* Vp = X.VD + (size_t)(b * 12 + hd) * SEQ * 64;
    const LAS float* lrow = lutl + LUT_PAD;
    __syncthreads();
    Soft st{NEGV, 0.f}; f32x16 o[2]; o[0] = f32x16{}; o[1] = f32x16{};
    Stage2 sg;
    const int it0 = (ch == 0) ? 2 : 0, nss = (6 - it0) >> 1;
#pragma unroll
    for (int tt = 0; tt < 2; ++tt) { const int kb = N0 - 128 + 64 * (it0 + tt); tile_load(sg.t[tt], Kp, Vp, (long)((kb + key) << lg) + res, tid); }
    for (int ss = 0; ss < nss; ++ss) {
        LAS unsigned char* bp = kv + buf * SBUF;
        tile_store(bp, sg.t[0], tid); tile_store(bp + TILE_B, sg.t[1], tid); ATT_BAR();
        if (ss + 1 < nss) {
#pragma unroll
            for (int tt = 0; tt < 2; ++tt) { const int kb = N0 - 128 + 64 * (it0 + 2 * (ss + 1) + tt); tile_load(sg.t[tt], Kp, Vp, (long)((kb + key) << lg) + res, tid); } }
#pragma unroll
        for (int tt = 0; tt < 2; ++tt) { const int kb = N0 - 128 + 64 * (it0 + 2 * ss + tt);
            const int dmin = Nw - kb - 63, dmax = Nw + 31 - kb;
            if (dmax >= 0 && dmin <= 128) { const int cls = (dmin >= 0 && dmax <= 128) ? CLS_FULL : CLS_PART;
                proc_tile(cls, bp + tt * TILE_B, qr, st, o, lrow, nq - kb, 0, 128, 0.f, true, wsf, r32, hi, trb); } }
        buf ^= 1;
    }
    float ltot; const float inv = soft_final_inv(st, ltot);
    const float lse = st.mref + __builtin_amdgcn_logf(ltot);
    if (gi != 0) {
        bf16* OD = X.OD + (size_t)(gi - 1) * M * 256; float* LS = X.LSE + (size_t)(gi - 1) * M * 4;
        if (hi == 0) { wsf[r32] = inv; LS[R * 4 + s] = lse; }
        asm volatile("s_waitcnt lgkmcnt(0)" ::: "memory");
#pragma unroll
        for (int r = 0; r < 16; ++r) { const int q = crow(r, hi); const float fr = wsf[q]; const size_t Rq = (size_t)b * SEQ + ((size_t)(Nw + q) << lg) + res;
            bf16* op = OD + Rq * 256 + s * 64 + (lane & 31);
            op[0] = (bf16)f2bf(o[0][r] * fr); op[32] = (bf16)f2bf(o[1][r] * fr); }
        asm volatile("s_waitcnt lgkmcnt(0)" ::: "memory");
    } else {
        const float l4 = X.LSE[R * 4 + s], l16 = X.LSE[(size_t)M * 4 + R * 4 + s];
        const float mx = fmaxf(lse, fmaxf(l4, l16));
        const float w1 = __builtin_amdgcn_exp2f(lse - mx), w4 = __builtin_amdgcn_exp2f(l4 - mx), w16 = __builtin_amdgcn_exp2f(l16 - mx), iw = 1.0f / (w1 + w4 + w16);
        if (hi == 0) { wsf[r32] = w1 * iw * inv; wsf[32 + r32] = w4 * iw; wsf[64 + r32] = w16 * iw; }
        asm volatile("s_waitcnt lgkmcnt(0)" ::: "memory");
#pragma unroll
        for (int r = 0; r < 16; ++r) { const int q = crow(r, hi); const float a1 = wsf[q], a4 = wsf[32 + q], a16 = wsf[64 + q]; const size_t Rq = (size_t)b * SEQ + Nw + q;
            const bf16* p4 = X.OD + Rq * 256 + s * 64 + (lane & 31); const bf16* p16 = p4 + (size_t)M * 256;
            bf16* op = X.YD + Rq * 256 + s * 64 + (lane & 31);
            const float v0 = o[0][r] * a1 + __uint_as_float((unsigned)p4[0] << 16) * a4 + __uint_as_float((unsigned)p16[0] << 16) * a16;
            const float v1 = o[1][r] * a1 + __uint_as_float((unsigned)p4[32] << 16) * a4 + __uint_as_float((unsigned)p16[32] << 16) * a16;
            op[0] = (bf16)f2bf(v0); op[32] = (bf16)f2bf(v1); }
        asm volatile("s_waitcnt lgkmcnt(0)" ::: "memory");
    }
}

__device__ __forceinline__ void cmp_unit(Frame& F, const Mix& X, int cu) {
    using namespace att;
    const int tid = fresh_tid(), lane = tid & 63, wave = __builtin_amdgcn_readfirstlane(tid >> 6), r32 = lane & 31, hi = lane >> 5;
    const int ts = cu >> 6, rb = cu & 63, plane = rb >> 4, i0 = (rb & 15) * 32;
    const bf16* src = X.PL + (size_t)ts * PLSZ + (size_t)plane * SEQ * 64;
    const bf16* W1 = ts ? X.WC1V : X.WC1K; const bf16* W2 = ts ? X.WC2V : X.WC2K; const float* cb = X.CB + ts * 256;
    bf16* dst = (ts ? X.VCMP : X.KCMP) + (size_t)plane * 512 * 64;
    LAS unsigned char* aimg = F.lds;
    LAS unsigned char* hid = F.lds + 69632;
    __syncthreads();
    for (int chn = tid; chn < 528 * 8; chn += NWAVES * 64) { const int tau = chn >> 3, c8 = chn & 7; int tk = 16 * i0 + tau; tk = tk > SEQ - 1 ? SEQ - 1 : tk;
        *(LAS v4u*)(aimg + tau * 128 + 16 * (tau >> 4) + c8 * 16) = *(const GAS v4u*)(src + (size_t)tk * 64 + c8 * 8); }
    __syncthreads();
    f32x16 acc = f32x16{};
    const LAS unsigned char* ap = aimg + r32 * 2064 + 16 * hi;
    const bf16* bp = W1 + ((size_t)wave * 128 * 64 + lane) * 8;
#pragma unroll 16
    for (int ks = 0; ks < 128; ++ks) {
        const int l = ks >> 2;
        const bf16x8 a = *(const LAS bf16x8*)(ap + 128 * l + 16 * (l >> 4) + 32 * (ks & 3));
        const bf16x8 bb = ldq(bp + (size_t)ks * 512);
        acc = __builtin_amdgcn_mfma_f32_32x32x16_bf16(a, bb, acc, 0, 0, 0);
    }
    { const int col = 32 * wave + r32; const float bias = cb[col];
#pragma unroll
      for (int r = 0; r < 16; ++r) { const float v = acc[r] + bias; const float hv = v * __builtin_amdgcn_rcpf(1.0f + __builtin_amdgcn_exp2f(-LOG2E * v));
          *(LAS unsigned short*)(hid + crow(r, hi) * 528 + col * 2) = (unsigned short)f2bf(hv); } }
    __syncthreads();
    if (wave < 2) {
        const int nt = wave;
        f32x16 o2 = f32x16{};
        const LAS unsigned char* hp = hid + r32 * 528 + 16 * hi; const bf16* b2 = W2 + (size_t)(32 * nt + r32) * 256 + 8 * hi;
#pragma unroll
        for (int k0 = 0; k0 < 256; k0 += 16) { const bf16x8 a = *(const LAS bf16x8*)(hp + k0 * 2); const bf16x8 bb = ldq(b2 + k0); o2 = __builtin_amdgcn_mfma_f32_32x32x16_bf16(a, bb, o2, 0, 0, 0); }
#pragma unroll
        for (int r = 0; r < 16; ++r) { const int i = i0 + crow(r, hi); dst[(size_t)i * 64 + 32 * nt + r32] = (bf16)f2bf(o2[r]); }
    }
}

#ifndef MK_N_LAUNCHES
#define MK_N_LAUNCHES 1
#endif
constexpr int N_PHASES = 13;
constexpr int N_LAUNCHES = MK_N_LAUNCHES;
struct Args { const float* in[22]; float* out; unsigned char* ws; int ph_lo, ph_hi, li, pad; };
__global__ void __launch_bounds__(NWAVES * 64, 2) mk_fwd(Args args) {
    extern __shared__ __attribute__((aligned(16))) unsigned char lds[];
    Frame F;
    F.lds = (LAS unsigned char*)lds;
    F.MISC = (volatile LAS unsigned*)(F.lds + MISC_OFF);
    F.G = gridDim.x; { const int bx = blockIdx.x; F.vcu = (F.G % 8 == 0) ? (bx % 8) * (F.G / 8) + bx / 8 : bx; }
    unsigned char* ws = args.ws;
    F.ctl = (gu32*)(ws + WS_CTL);
    In in;
    in.x = args.in[0]; in.f1_pre = args.in[1]; in.f1_wgu = args.in[2]; in.f1_wd = args.in[3]; in.f1_post = args.in[4]; in.mix_pre = args.in[5]; in.w_in = args.in[6];
    in.cpos_k = args.in[7]; in.cw1_k = args.in[8]; in.cw2_k = args.in[9]; in.cpos_v = args.in[10]; in.cw1_v = args.in[11]; in.cw2_v = args.in[12];
    in.w_bn = args.in[13]; in.w_bd = args.in[14]; in.w_out = args.in[15]; in.mix_post = args.in[16]; in.f2_pre = args.in[17]; in.f2_wgu = args.in[18]; in.f2_wd = args.in[19]; in.f2_post = args.in[20]; in.rel_bias = args.in[21];
    float* out = args.out;
    for (int u = threadIdx.x; u < (LDS_BYTES - LDSCTL_OFF) / 4; u += NWAVES * 64) ((LAS unsigned*)(F.lds + LDSCTL_OFF))[u] = 0u;
    __syncthreads();
    const bool use_bar = (args.ph_hi - args.ph_lo) > 1;
    XcdBarrier bar; bar.bar = (unsigned*)(F.ctl + CW_BAR) + args.li * XCD_BAR_WORDS; bar.x = 0; bar.st = nullptr;
    if (use_bar) bar = xcd_barrier_post((unsigned*)(F.ctl + CW_BAR) + args.li * XCD_BAR_WORDS, F.MISC + 8);
    const int lo = args.ph_lo, hi = args.ph_hi;
#define IN(k) (lo <= (k) && (k) < hi)
#define SEAM(k) do { if (IN(k) && IN((k) + 1)) xcd_barrier(bar); } while (0)
    bf16* XN = (bf16*)(ws + WS_XN); bf16* H = (bf16*)(ws + WS_H); bf16* Y = (bf16*)(ws + WS_Y); bf16* Y2P = (bf16*)(ws + WS_Y2P); bf16* MG = (bf16*)(ws + WS_MG);
    Mix X; X.QN = (bf16*)(ws + WS_QN); X.YN = (bf16*)(ws + WS_YN); X.SCR = (bf16*)(ws + WS_Y); F.nrep = args.pad; X.PL = (bf16*)(ws + WS_PL); X.QD = (bf16*)(ws + WS_QD); X.KD = (bf16*)(ws + WS_KD); X.VD = (bf16*)(ws + WS_VD); X.YD = (bf16*)(ws + WS_YD); X.OD = (bf16*)(ws + WS_OD); X.LSE = (float*)(ws + WS_LSE);
    X.KCMP = (bf16*)(ws + WS_KCMP); X.VCMP = (bf16*)(ws + WS_VCMP); X.GN = (const float*)(ws + WS_GN); X.LUTN = (const float*)(ws + WS_LUTN); X.LUTD = (const float*)(ws + WS_LUTD); X.CB = (const float*)(ws + WS_CB);
    X.WC1K = (const bf16*)(ws + WS_WC1K); X.WC1V = (const bf16*)(ws + WS_WC1V); X.WC2K = (const bf16*)(ws + WS_WC2K); X.WC2V = (const bf16*)(ws + WS_WC2V);
    bf16* GA = (bf16*)(ws + WS_GA); bf16* GB = (bf16*)(ws + WS_GB);

    if (IN(0)) { p0_prologue(F, in, ws); }
    SEAM(0);
    if (IN(1)) { pg8::Gemm g{XN, (const bf16*)(ws + WS_WGU1), M, 2 * FF, D}; pg8::StaticOrder S; S.init(M, 2 * FF, F.G, (int)blockIdx.x);
        pg8::EpiSwiGLU E{H, FF}; pg8::gemm_phase<pg8::EpiSwiGLU, pg8::StaticOrder, true, true>(F.lds + RING_OFF, g, S, E); }
    SEAM(1);
    if (IN(2)) { pg8::Gemm g{H, (const bf16*)(ws + WS_WD1), M, D, FF}; pg8::StaticOrder S; S.init(M, D, F.G, (int)blockIdx.x);
        pg8::EpiBf16 E{Y, D}; pg8::gemm_phase<pg8::EpiBf16, pg8::StaticOrder, true, true>(F.lds + RING_OFF, g, S, E); }
    SEAM(2);
    if (IN(3)) { row_pass(F, Y, in.x, out, 0.5f, in.f1_post, in.mix_pre, XN); }
    SEAM(3);
    if (IN(4)) { pg8::Gemm g{XN, (const bf16*)(ws + WS_WIN), M, NPROJ, D}; pg8::StaticOrder S; S.init(M, NPROJ, F.G, (int)blockIdx.x);
        pg8::EpiProj E{X.QN, X.PL, X.QD, X.KD, X.VD, GA, GB, (float*)(ws + WS_GN), QSCALE};
        pg8::gemm_phase<pg8::EpiProj, pg8::StaticOrder, true, true>(F.lds + RING_OFF, g, S, E); }
    SEAM(4);
    if (IN(5)) { int buf = 0;
        for (int cu = F.vcu; cu < 128; cu += F.G) cmp_unit(F, X, cu);
#pragma unroll 1
        for (int w = F.vcu; w < 512; w += F.G) { const int gi = 2 - (w >> 8), du = w & 255; dil_unit(F, X, gi, du >> 7, (du >> 5) & 3, du & 31, buf); }
        __syncthreads(); }
    SEAM(5);
    if (IN(6)) { int buf = 0;
        for (int p = F.vcu; p < 256; p += F.G) { const int b = p >> 7, g = (p >> 6) & 1, cc = p & 63;
#pragma unroll 1
            for (int k = 0; k < 2; ++k) nsa_unit(F, X, b, g, k ? cc : 127 - cc, buf); }
#pragma unroll 1
        for (int du = F.vcu; du < 256; du += F.G) dil_unit(F, X, 0, du >> 7, (du >> 5) & 3, du & 31, buf);
        __syncthreads(); }
    SEAM(6);
    if (IN(7)) {
        { pg8::Gemm g{X.YN, (const bf16*)(ws + WS_WBN), M, D, 512}; pg8::StaticOrder S; S.init(M, D, F.G, (int)blockIdx.x);
          pg8::EpiBranchA E{GA, Y2P}; pg8::gemm_phase<pg8::EpiBranchA, pg8::StaticOrder, true, true>(F.lds + RING_OFF, g, S, E); }
        { pg8::Gemm g{X.YD, (const bf16*)(ws + WS_WBD), M, D, 256}; pg8::StaticOrder S; S.init(M, D, F.G, (int)blockIdx.x);
          pg8::EpiBranchB E{GB, Y2P, MG}; pg8::gemm_phase<pg8::EpiBranchB, pg8::StaticOrder, true, true>(F.lds + RING_OFF, g, S, E); }
    }
    SEAM(7);
    if (IN(8)) { pg8::Gemm g{MG, (const bf16*)(ws + WS_WOUT), M, D, D}; pg8::StaticOrder S; S.init(M, D, F.G, (int)blockIdx.x);
        pg8::EpiBf16 E{Y, D}; pg8::gemm_phase<pg8::EpiBf16, pg8::StaticOrder, true, true>(F.lds + RING_OFF, g, S, E); }
    SEAM(8);
    if (IN(9)) { row_pass(F, Y, out, out, 1.0f, in.mix_post, in.f2_pre, XN); }
    SEAM(9);
    if (IN(10)) { pg8::Gemm g{XN, (const bf16*)(ws + WS_WGU2), M, 2 * FF, D}; pg8::StaticOrder S; S.init(M, 2 * FF, F.G, (int)blockIdx.x);
        pg8::EpiSwiGLU E{H, FF}; pg8::gemm_phase<pg8::EpiSwiGLU, pg8::StaticOrder, true, true>(F.lds + RING_OFF, g, S, E); }
    SEAM(10);
    if (IN(11)) { pg8::Gemm g{H, (const bf16*)(ws + WS_WD2), M, D, FF}; pg8::StaticOrder S; S.init(M, D, F.G, (int)blockIdx.x);
        pg8::EpiBf16 E{Y, D}; pg8::gemm_phase<pg8::EpiBf16, pg8::StaticOrder, true, true>(F.lds + RING_OFF, g, S, E); }
    SEAM(11);
    if (IN(12)) { row_pass(F, Y, out, out, 0.5f, in.f2_post, nullptr, nullptr); }
#undef IN
#undef SEAM
}

extern "C" void kernel_launch(void* const* d_in, const int* in_sizes, int n_in, void* d_out, int out_size, void* d_ws, size_t ws_size, hipStream_t stream) {
    static int grid = 0;
    if (grid == 0) {
        if (n_in != 22 || in_sizes[0] != M * D || out_size != M * D || ws_size < WS_END) { fprintf(stderr, "kernel_launch: unexpected shapes (n_in %d, in0 %d, out %d, ws %zu); nothing launched\n", n_in, n_in > 0 ? in_sizes[0] : -1, out_size, ws_size); grid = -1; return; }
        int dev = 0, cus = 0, per_cu = 0;
        if (hipGetDevice(&dev) != hipSuccess || hipDeviceGetAttribute(&cus, hipDeviceAttributeMultiprocessorCount, dev) != hipSuccess) { grid = -1; return; }
        if (hipFuncSetAttribute((const void*)mk_fwd, hipFuncAttributeMaxDynamicSharedMemorySize, LDS_BYTES) != hipSuccess) { fprintf(stderr, "kernel_launch: hipFuncSetAttribute failed\n"); grid = -1; return; }
        if (hipOccupancyMaxActiveBlocksPerMultiprocessor(&per_cu, (const void*)mk_fwd, NWAVES * 64, LDS_BYTES) != hipSuccess || per_cu < 1)
            fprintf(stderr, "kernel_launch: note: occupancy query reports %d workgroups per CU\n", per_cu);
        (void)hipGetLastError();
        grid = cus;
    }
    if (grid < 0) return;
    if (hipMemsetAsync((char*)d_ws + WS_CTL, 0, CTL_ZERO_BYTES, stream) != hipSuccess) return;
    Args a{};
    for (int i = 0; i < 22; ++i) a.in[i] = (const float*)d_in[i];
    a.out = (float*)d_out; a.ws = (unsigned char*)d_ws; a.pad = 2;
#ifdef PROBE_RANGES
    { static const int rg[][2] = PROBE_RANGES;
      for (int li = 0; li < (int)(sizeof(rg) / sizeof(rg[0])); ++li) { a.ph_lo = rg[li][0]; a.ph_hi = rg[li][1]; a.li = li; hipLaunchKernelGGL(mk_fwd, dim3(grid), dim3(NWAVES * 64), LDS_BYTES, stream, a); } }
#else
    if (N_LAUNCHES == 1) { a.ph_lo = 0; a.ph_hi = N_PHASES; a.li = 0; hipLaunchKernelGGL(mk_fwd, dim3(grid), dim3(NWAVES * 64), LDS_BYTES, stream, a); }
    else { for (int li = 0; li < N_PHASES; ++li) { a.ph_lo = li; a.ph_hi = li + 1; a.li = 0; hipLaunchKernelGGL(mk_fwd, dim3(grid), dim3(NWAVES * 64), LDS_BYTES, stream, a); } }
#endif
}
```

```cpp
#include <hip/hip_runtime.h>
#include <cstdio>
#include <cstdint>
namespace pg8 {
#define PG8_LAS __attribute__((address_space(3)))
typedef unsigned short bf16_t;
typedef short bf16x8 __attribute__((ext_vector_type(8)));
typedef float f32x4 __attribute__((ext_vector_type(4)));
typedef unsigned u32x4 __attribute__((ext_vector_type(4)));
constexpr int BM = 256, BK = 64, HALF = 128, HTB = HALF * BK * 2  , STAGE_BYTES = 8 * HTB, NXCD = 8, WGM = 8;

__host__ __device__ __forceinline__ int lds_byte(int r, int c) { const int st = (r >> 4) * 2 + (c >> 5), rr = r & 15, cc = c & 31, ob = rr * 64 + cc * 2; return st * 1024 + (ob ^ (((ob >> 9) & 1) << 5)); }
__host__ __device__ __forceinline__ void stage_rc(int b, int& R, int& C) { const int st = b / 1024, sb = b % 1024, swz = sb ^ (((sb >> 9) & 1) << 5); R = (st >> 1) * 16 + swz / 64; C = (st & 1) * 32 + (swz % 64) / 2; }
__host__ __device__ __forceinline__ int perm32(int rho) { const int n = rho >> 4, i = rho & 15; return 8 * (i >> 2) + 4 * n + (i & 3); }

struct Unit { int pm, pn; };
struct Gemm { const bf16_t* A; const bf16_t* Bt; int M, N, K; };

struct StaticOrder {
    int nM, nN, nwg, G, c;
    __host__ __device__ void init(int M, int N, int G_, int c_) { nM = M / BM; nN = N / BM; nwg = nM * nN; G = G_; c = c_; }
    __host__ __device__ bool next(int i, Unit& u) const {
        const long L = (long)i * G + c; if (L >= nwg) return false;
        int wgid = (int)L; { const int q = nwg / NXCD, r = nwg % NXCD, xcd = wgid % NXCD, off = wgid / NXCD; wgid = (xcd < r ? xcd * (q + 1) : r * (q + 1) + (xcd - r) * q) + off; }
        const int nig = WGM * nN, gid = wgid / nig, fm = gid * WGM, gsz = (nM - fm) < WGM ? (nM - fm) : WGM;
        u.pm = fm + ((wgid % nig) % gsz); u.pn = (wgid % nig) / gsz; return true;
    }
    __device__ __forceinline__ void a_ready(const Unit&) const {}
    __device__ __forceinline__ void done(const Unit&) const {}
};

__device__ __forceinline__ unsigned cvt_pk_bf16(float lo, float hi) { unsigned r; asm volatile("v_cvt_pk_bf16_f32 %0, %1, %2" : "=v"(r) : "v"(lo), "v"(hi)); return r; }
typedef float f32x2 __attribute__((ext_vector_type(2)));
__device__ __forceinline__ float sigmoid_f(float v) { return __builtin_amdgcn_rcpf(1.0f + __builtin_amdgcn_exp2f(-1.4426950408889634f * v)); }
__device__ __forceinline__ float bf_lo(unsigned w) { return __uint_as_float(w << 16); }
__device__ __forceinline__ float bf_hi(unsigned w) { return __uint_as_float(w & 0xffff0000u); }

struct EpiSwiGLU {
    static constexpr bool PERM = true, AFTER_DRAIN = false;
    bf16_t* H; int ldh;
    __device__ __forceinline__ void operator()(const f32x4 (&acc)[2][2][4][2], const Unit& u, int wr, int wc, int fr, int fq) const {
        const int row0 = u.pm * BM + wr * 64 + fr, col0 = u.pn * HALF + wc * 32 + 8 * fq;
#pragma unroll
        for (int ai = 0; ai < 2; ++ai)
#pragma unroll
            for (int m = 0; m < 4; ++m) { bf16_t* rowp = H + (size_t)(row0 + ai * HALF + m * 16) * ldh + col0;
                const f32x4 g0 = acc[ai][0][m][0], g1 = acc[ai][0][m][1], u0 = acc[ai][1][m][0], u1 = acc[ai][1][m][1];
                float h[8];
#pragma unroll
                for (int i = 0; i < 4; ++i) { h[i] = g0[i] * sigmoid_f(g0[i]) * u0[i]; h[4 + i] = g1[i] * sigmoid_f(g1[i]) * u1[i]; }
                u32x4 w; w.x = cvt_pk_bf16(h[0], h[1]); w.y = cvt_pk_bf16(h[2], h[3]); w.z = cvt_pk_bf16(h[4], h[5]); w.w = cvt_pk_bf16(h[6], h[7]);
                *(u32x4*)rowp = w; }
    }
};
struct EpiF32 {
    static constexpr bool PERM = true, AFTER_DRAIN = false;
    float* Y; int ldc;
    __device__ __forceinline__ void operator()(const f32x4 (&acc)[2][2][4][2], const Unit& u, int wr, int wc, int fr, int fq) const {
        const int row0 = u.pm * BM + wr * 64 + fr, col0 = u.pn * BM + wc * 32 + 8 * fq;
#pragma unroll
        for (int ai = 0; ai < 2; ++ai)
#pragma unroll
            for (int m = 0; m < 4; ++m) { float* rowp = Y + (size_t)(row0 + ai * HALF + m * 16) * ldc + col0;
#pragma unroll
                for (int bj = 0; bj < 2; ++bj) { *(f32x4*)(rowp + bj * HALF) = acc[ai][bj][m][0]; *(f32x4*)(rowp + bj * HALF + 4) = acc[ai][bj][m][1]; } }
    }
};
struct EpiBf16 {
    static constexpr bool PERM = true, AFTER_DRAIN = false;
    bf16_t* Y; int ldc;
    __device__ __forceinline__ void operator()(const f32x4 (&acc)[2][2][4][2], const Unit& u, int wr, int wc, int fr, int fq) const {
        const int row0 = u.pm * BM + wr * 64 + fr, col0 = u.pn * BM + wc * 32 + 8 * fq;
#pragma unroll
        for (int ai = 0; ai < 2; ++ai)
#pragma unroll
            for (int m = 0; m < 4; ++m) { bf16_t* rowp = Y + (size_t)(row0 + ai * HALF + m * 16) * ldc + col0;
#pragma unroll
                for (int bj = 0; bj < 2; ++bj) { const f32x4 a0 = acc[ai][bj][m][0], a1 = acc[ai][bj][m][1];
                    u32x4 w; w.x = cvt_pk_bf16(a0[0], a0[1]); w.y = cvt_pk_bf16(a0[2], a0[3]); w.z = cvt_pk_bf16(a1[0], a1[1]); w.w = cvt_pk_bf16(a1[2], a1[3]);
                    *(u32x4*)(rowp + bj * HALF) = w; } }
    }
};
struct EpiBranchA {
    static constexpr bool PERM = true, AFTER_DRAIN = false;
    const bf16_t* G; bf16_t* Y;
    __device__ __forceinline__ void operator()(const f32x4 (&acc)[2][2][4][2], const Unit& u, int wr, int wc, int fr, int fq) const {
        const int row0 = u.pm * BM + wr * 64 + fr, col0 = u.pn * BM + wc * 32 + 8 * fq;
#pragma unroll
        for (int ai = 0; ai < 2; ++ai)
#pragma unroll
            for (int m = 0; m < 4; ++m) { const size_t off = (size_t)(row0 + ai * HALF + m * 16) * 1024 + col0;
#pragma unroll
                for (int bj = 0; bj < 2; ++bj) { const u32x4 g = *(const u32x4*)(G + off + bj * HALF); const f32x4 a0 = acc[ai][bj][m][0], a1 = acc[ai][bj][m][1];
                    u32x4 w; w.x = cvt_pk_bf16(a0[0] * bf_lo(g.x), a0[1] * bf_hi(g.x)); w.y = cvt_pk_bf16(a0[2] * bf_lo(g.y), a0[3] * bf_hi(g.y));
                    w.z = cvt_pk_bf16(a1[0] * bf_lo(g.z), a1[1] * bf_hi(g.z)); w.w = cvt_pk_bf16(a1[2] * bf_lo(g.w), a1[3] * bf_hi(g.w));
                    *(u32x4*)(Y + off + bj * HALF) = w; } }
    }
};
struct EpiBranchB {
    static constexpr bool PERM = true, AFTER_DRAIN = false;
    const bf16_t* G; const bf16_t* Y; bf16_t* O;
    __device__ __forceinline__ void operator()(const f32x4 (&acc)[2][2][4][2], const Unit& u, int wr, int wc, int fr, int fq) const {
        const int row0 = u.pm * BM + wr * 64 + fr, col0 = u.pn * BM + wc * 32 + 8 * fq;
#pragma unroll
        for (int ai = 0; ai < 2; ++ai)
#pragma unroll
            for (int m = 0; m < 4; ++m) { const size_t off = (size_t)(row0 + ai * HALF + m * 16) * 1024 + col0;
#pragma unroll
                for (int bj = 0; bj < 2; ++bj) { const u32x4 g = *(const u32x4*)(G + off + bj * HALF), y = *(const u32x4*)(Y + off + bj * HALF); const f32x4 a0 = acc[ai][bj][m][0], a1 = acc[ai][bj][m][1];
                    u32x4 w; w.x = cvt_pk_bf16(bf_lo(y.x) + a0[0] * bf_lo(g.x), bf_hi(y.x) + a0[1] * bf_hi(g.x)); w.y = cvt_pk_bf16(bf_lo(y.y) + a0[2] * bf_lo(g.y), bf_hi(y.y) + a0[3] * bf_hi(g.y));
                    w.z = cvt_pk_bf16(bf_lo(y.z) + a1[0] * bf_lo(g.z), bf_hi(y.z) + a1[1] * bf_hi(g.z)); w.w = cvt_pk_bf16(bf_lo(y.w) + a1[2] * bf_lo(g.w), bf_hi(y.w) + a1[3] * bf_hi(g.w));
                    *(u32x4*)(O + off + bj * HALF) = w; } }
    }
};
struct EpiProj {
    static constexpr bool PERM = true, AFTER_DRAIN = false;
    bf16_t *QN, *PL, *QD, *KD, *VD, *GA, *GB; float* GN; float qscale;
    __device__ __forceinline__ void operator()(const f32x4 (&acc)[2][2][4][2], const Unit& u, int wr, int wc, int fr, int fq) const {
        const int sub = (wc & 1) * 32 + 8 * fq;
#pragma unroll
        for (int bj = 0; bj < 2; ++bj) {
            const int hidx = __builtin_amdgcn_readfirstlane(u.pn * 4 + bj * 2 + (wc >> 1));
            bf16_t* base = nullptr; long pitch = 0, bstride = 0; int mode = 0;
            if (hidx < 8) { base = QN + hidx * 64; pitch = 512; bstride = 8192L * 512; mode = 1; }
            else if (hidx < 20) { const int ti = (hidx - 8) >> 1, g = (hidx - 8) & 1; base = PL + (size_t)ti * (4u * 8192u * 64u) + (size_t)g * (8192u * 64u); pitch = 64; bstride = 2L * 8192 * 64; mode = 0; }
            else if (hidx < 32) { base = QD + (hidx - 20) * 64; pitch = 768; bstride = 8192L * 768; mode = 1; }
            else if (hidx < 44) { base = KD + (size_t)(hidx - 32) * (8192u * 64u); pitch = 64; bstride = 12L * 8192 * 64; mode = 0; }
            else if (hidx < 56) { base = VD + (size_t)(hidx - 44) * (8192u * 64u); pitch = 64; bstride = 12L * 8192 * 64; mode = 0; }
            else if (hidx < 72) { base = GA + (hidx - 56) * 64; pitch = 1024; bstride = 8192L * 1024; mode = 2; }
            else if (hidx < 88) { base = GB + (hidx - 72) * 64; pitch = 1024; bstride = 8192L * 1024; mode = 2; }
            else if (hidx == 88) mode = 3; else mode = 4;
            if (mode == 4) continue;
#pragma unroll
            for (int ai = 0; ai < 2; ++ai)
#pragma unroll
                for (int m = 0; m < 4; ++m) { const int R = u.pm * BM + ai * HALF + wr * 64 + m * 16 + fr, b = R >> 13, t = R & 8191;
                    f32x4 v0 = acc[ai][bj][m][0], v1 = acc[ai][bj][m][1];
                    if (mode == 3) { if (sub < 24) { float* p = GN + (size_t)R * 32 + sub;
#pragma unroll
                            for (int i = 0; i < 4; ++i) { v0[i] = sigmoid_f(v0[i]); v1[i] = sigmoid_f(v1[i]); }
                            *(f32x4*)p = v0; *(f32x4*)(p + 4) = v1; } }
                    else { if (mode == 1) { v0 = v0 * qscale; v1 = v1 * qscale; }
                        if (mode == 2) {
#pragma unroll
                            for (int i = 0; i < 4; ++i) { v0[i] = sigmoid_f(v0[i]); v1[i] = sigmoid_f(v1[i]); } }
                        u32x4 w; w.x = cvt_pk_bf16(v0[0], v0[1]); w.y = cvt_pk_bf16(v0[2], v0[3]); w.z = cvt_pk_bf16(v1[0], v1[1]); w.w = cvt_pk_bf16(v1[2], v1[3]);
                        *(u32x4*)(base + (size_t)b * bstride + (size_t)t * pitch + sub) = w; } }
        }
    }
};
template <class Epi, class Sched, bool ALIGN_EPI = false, bool SP2 = false>
__device__ __forceinline__ void gemm_phase(PG8_LAS unsigned char* lds, const Gemm g, const Sched& S, const Epi& E) {
    const int tid = threadIdx.x, wid = __builtin_amdgcn_readfirstlane(tid >> 6), lane = tid & 63, wr = wid >> 2, wc = wid & 3, fr = lane & 15, fq = lane >> 4;
    const int K = g.K, nt = K / BK;
    unsigned voffA[2], voffB[2];
#pragma unroll
    for (int i = 0; i < 2; ++i) { int R, C; stage_rc(tid * 16 + i * 8192, R, C); const int Rb = Epi::PERM ? ((R & ~31) + perm32(R & 31)) : R;
        voffA[i] = (unsigned)(R * K + C) * 2u; voffB[i] = (unsigned)(Rb * K + C) * 2u; }
    const size_t kstep = (size_t)(BK * 2);
    const size_t hstep = (size_t)HALF * K * 2;
    const size_t tstep = 2 * hstep;
    const unsigned ldsw = (unsigned)wid * 1024u;
    const int aoff = lds_byte(wr * 64 + fr, fq * 8), boff = lds_byte(wc * 32 + fr, fq * 8);
#define PG8_SA(b, h) (((b) * 2 + (h)) * HTB)
#define PG8_SB(b, h) ((4 + (b) * 2 + (h)) * HTB)
#define PG8_STAGE(bufoff, gbase, voff) do { _Pragma("unroll") for (int _i = 0; _i < 2; ++_i) \
        __builtin_amdgcn_global_load_lds((const unsigned*)((const char*)(gbase) + (voff)[_i]), (PG8_LAS unsigned*)(lds + (bufoff) + ldsw + _i * 8192), 16, 0, 0); } while (0)
#define PG8_LDA(dst, b, h) do { _Pragma("unroll") for (int m = 0; m < 4; ++m) _Pragma("unroll") for (int k = 0; k < 2; ++k) dst[m][k] = *(const PG8_LAS bf16x8*)(lds + PG8_SA(b, h) + aoff + m * 2048 + k * 1024); } while (0)
#define PG8_LDB(dst, b, h) do { _Pragma("unroll") for (int n = 0; n < 2; ++n) _Pragma("unroll") for (int k = 0; k < 2; ++k) dst[n][k] = *(const PG8_LAS bf16x8*)(lds + PG8_SB(b, h) + boff + n * 2048 + k * 1024); } while (0)
#define PG8_MMA(ai, bj, At, Bt) do { __builtin_amdgcn_s_setprio(1); _Pragma("unroll") for (int m = 0; m < 4; ++m) _Pragma("unroll") for (int n = 0; n < 2; ++n) _Pragma("unroll") for (int k = 0; k < 2; ++k) \
        acc[ai][bj][m][n] = __builtin_amdgcn_mfma_f32_16x16x32_bf16(Bt[n][k], At[m][k], acc[ai][bj][m][n], 0, 0, 0); __builtin_amdgcn_s_setprio(0); } while (0)
#define PG8_WAIT_V(n) asm volatile("s_waitcnt vmcnt(" #n ")" ::: "memory")
#define PG8_WAIT_L(n) asm volatile("s_waitcnt lgkmcnt(" #n ")" ::: "memory")
#define PG8_BAR __builtin_amdgcn_s_barrier()
#define PG8_SCHED __builtin_amdgcn_sched_barrier(0)
    Unit cur, nxt; int ui = 0;
    if (!S.next(0, cur)) return;
    f32x4 acc[2][2][4][2];
#pragma unroll
    for (int a = 0; a < 2; ++a)
#pragma unroll
        for (int b = 0; b < 2; ++b)
#pragma unroll
            for (int m = 0; m < 4; ++m)
#pragma unroll
                for (int n = 0; n < 2; ++n) acc[a][b][m][n] = (f32x4){0.f, 0.f, 0.f, 0.f};
    bf16x8 At[4][2], B0[2][2], B1[2][2];
    const char* cA = (const char*)g.A + (size_t)cur.pm * tstep; const char* cB = (const char*)g.Bt + (size_t)cur.pn * tstep;
    S.a_ready(cur);
    if constexpr (SP2) {
        PG8_STAGE(PG8_SB(0, 0), cB, voffB); PG8_STAGE(PG8_SB(0, 1), cB + hstep, voffB); PG8_STAGE(PG8_SA(0, 0), cA, voffA); PG8_STAGE(PG8_SA(0, 1), cA + hstep, voffA);
        if (wr == 1) PG8_BAR;
        PG8_WAIT_V(2); PG8_BAR;
        PG8_STAGE(PG8_SB(1, 0), cB + kstep, voffB); PG8_STAGE(PG8_SA(1, 0), cA + kstep, voffA); PG8_STAGE(PG8_SB(1, 1), cB + hstep + kstep, voffB);
        PG8_WAIT_V(6); PG8_BAR;
    } else {
        PG8_STAGE(PG8_SB(0, 0), cB, voffB); PG8_STAGE(PG8_SA(0, 0), cA, voffA); PG8_STAGE(PG8_SB(0, 1), cB + hstep, voffB); PG8_STAGE(PG8_SA(0, 1), cA + hstep, voffA);
        if (wr == 1) PG8_BAR;
        PG8_WAIT_V(4); PG8_BAR;
        PG8_STAGE(PG8_SB(1, 0), cB + kstep, voffB); PG8_STAGE(PG8_SA(1, 0), cA + kstep, voffA); PG8_STAGE(PG8_SB(1, 1), cB + hstep + kstep, voffB);
        PG8_WAIT_V(6); PG8_BAR;
    }
    for (;;) {
        const bool has_next = S.next(ui + 1, nxt);
        const char* nA = has_next ? (const char*)g.A + (size_t)nxt.pm * tstep : cA; const char* nB = has_next ? (const char*)g.Bt + (size_t)nxt.pn * tstep : cB;
        for (int t = 0; t < nt; t += 2) {
            const bool last = (t == nt - 2);
            const char* a1 = cA + (size_t)(t + 1) * kstep;
            const char* a2 = last ? nA : cA + (size_t)(t + 2) * kstep; const char* b2 = last ? nB : cB + (size_t)(t + 2) * kstep;
            const char* a3 = a2 + kstep; const char* b3 = b2 + kstep;
            if (last && has_next) S.a_ready(nxt);
            if constexpr (SP2) {
            PG8_LDB(B0, 0, 0); PG8_LDB(B1, 0, 1); PG8_SCHED; PG8_LDA(At, 0, 0); PG8_STAGE(PG8_SA(1, 1), a1 + hstep, voffA);
            PG8_WAIT_V(8); PG8_WAIT_L(0); PG8_BAR; PG8_MMA(0, 0, At, B0); PG8_MMA(0, 1, At, B1); PG8_BAR; PG8_SCHED;
            PG8_LDA(At, 0, 1); PG8_STAGE(PG8_SB(0, 0), b2, voffB); PG8_STAGE(PG8_SB(0, 1), b2 + hstep, voffB); PG8_STAGE(PG8_SA(0, 0), a2, voffA);
            PG8_WAIT_V(8); PG8_WAIT_L(0); PG8_BAR; PG8_MMA(1, 0, At, B0); PG8_MMA(1, 1, At, B1); PG8_BAR; PG8_SCHED;
            PG8_LDB(B0, 1, 0); PG8_LDB(B1, 1, 1); PG8_SCHED; PG8_LDA(At, 1, 0); PG8_STAGE(PG8_SA(0, 1), a2 + hstep, voffA);
            PG8_WAIT_V(8); PG8_WAIT_L(0); PG8_BAR; PG8_MMA(0, 0, At, B0); PG8_MMA(0, 1, At, B1); PG8_BAR; PG8_SCHED;
            PG8_LDA(At, 1, 1); PG8_STAGE(PG8_SB(1, 0), b3, voffB); PG8_STAGE(PG8_SB(1, 1), b3 + hstep, voffB); PG8_STAGE(PG8_SA(1, 0), a3, voffA);
            PG8_WAIT_V(8); PG8_WAIT_L(0); PG8_BAR; PG8_MMA(1, 0, At, B0); PG8_MMA(1, 1, At, B1); PG8_BAR; PG8_SCHED;
            } else {
            PG8_LDB(B0, 0, 0); PG8_SCHED; PG8_LDA(At, 0, 0); PG8_STAGE(PG8_SA(1, 1), a1 + hstep, voffA);
            PG8_WAIT_L(8); PG8_BAR; PG8_WAIT_L(0); PG8_MMA(0, 0, At, B0); PG8_BAR; PG8_SCHED;
            PG8_LDB(B1, 0, 1); PG8_STAGE(PG8_SB(0, 0), b2, voffB);
            PG8_BAR; PG8_WAIT_L(0); PG8_MMA(0, 1, At, B1); PG8_BAR;
            PG8_LDA(At, 0, 1); PG8_STAGE(PG8_SA(0, 0), a2, voffA);
            PG8_BAR; PG8_WAIT_L(0); PG8_MMA(1, 0, At, B0); PG8_BAR; PG8_SCHED;
            PG8_STAGE(PG8_SB(0, 1), b2 + hstep, voffB);
            PG8_WAIT_V(6); PG8_BAR; PG8_MMA(1, 1, At, B1); PG8_BAR;
            PG8_LDB(B0, 1, 0); PG8_SCHED; PG8_LDA(At, 1, 0); PG8_STAGE(PG8_SA(0, 1), a2 + hstep, voffA);
            PG8_WAIT_L(8); PG8_BAR; PG8_WAIT_L(0); PG8_MMA(0, 0, At, B0); PG8_BAR; PG8_SCHED;
            PG8_LDB(B1, 1, 1); PG8_STAGE(PG8_SB(1, 0), b3, voffB);
            PG8_BAR; PG8_WAIT_L(0); PG8_MMA(0, 1, At, B1); PG8_BAR;
            PG8_LDA(At, 1, 1); PG8_STAGE(PG8_SA(1, 0), a3, voffA);
            PG8_BAR; PG8_WAIT_L(0); PG8_MMA(1, 0, At, B0); PG8_BAR; PG8_SCHED;
            PG8_STAGE(PG8_SB(1, 1), b3 + hstep, voffB);
            PG8_WAIT_V(6); PG8_BAR; PG8_MMA(1, 1, At, B1); PG8_BAR;
            }
        }
        if constexpr (ALIGN_EPI) { if (wr == 0) PG8_BAR; }
        if constexpr (!Epi::AFTER_DRAIN) { E(acc, cur, wr, wc, fr, fq); S.done(cur); }
        if (!has_next) break;
#pragma unroll
        for (int a = 0; a < 2; ++a)
#pragma unroll
            for (int b = 0; b < 2; ++b)
#pragma unroll
                for (int m = 0; m < 4; ++m)
#pragma unroll
                    for (int n = 0; n < 2; ++n) acc[a][b][m][n] = (f32x4){0.f, 0.f, 0.f, 0.f};
        cur = nxt; cA = nA; cB = nB; ++ui;
        if constexpr (ALIGN_EPI) { if (wr == 1) PG8_BAR; }
    }
    PG8_WAIT_V(0);
    if constexpr (!ALIGN_EPI) { if (wr == 0) PG8_BAR; }
    PG8_BAR;
    if constexpr (Epi::AFTER_DRAIN) { E.fused(acc, cur, wr, wc, fr, fq, lds, wid, lane); S.done(cur); }
#undef PG8_SA
#undef PG8_SB
#undef PG8_STAGE
#undef PG8_LDA
#undef PG8_LDB
#undef PG8_MMA
#undef PG8_WAIT_V
#undef PG8_WAIT_L
#undef PG8_BAR
#undef PG8_SCHED
}
}
#define GAS __attribute__((address_space(1)))
#define LAS __attribute__((address_space(3)))
typedef unsigned short bf16;
typedef unsigned v4u __attribute__((ext_vector_type(4)));
typedef float f32x4 __attribute__((ext_vector_type(4)));
typedef short bf16x8 __attribute__((ext_vector_type(8)));
typedef GAS unsigned gu32;
typedef GAS unsigned long long gu64;
#define RLX_AGENT __ATOMIC_RELAXED, __HIP_MEMORY_SCOPE_AGENT
#define LDS_WAIT() asm volatile("s_waitcnt lgkmcnt(0)" ::: "memory")
#define VM_WAIT() asm volatile("s_waitcnt vmcnt(0)" ::: "memory")
__device__ __forceinline__ unsigned long long rt() { return __builtin_amdgcn_s_memrealtime(); }
__device__ __forceinline__ unsigned f2bf(float f) { unsigned u = __builtin_bit_cast(unsigned, f); return (u + 0x7fffu + ((u >> 16) & 1u)) >> 16; }
__device__ __forceinline__ unsigned pk2(float lo, float hi) { return f2bf(lo) | (f2bf(hi) << 16); }

#define XB_TMO      128
#define XB_XCNT(j)  (256  + 64 * (j))
#define XB_XSUB(j)  (1280 + 64 * (j))
#define XB_XGEN(j)  (2304 + 64 * (j))
#define XB_TOP      3328
#define XB_TOPGEN   3392
#define XCD_BAR_WORDS 3456
#define XB_SPIN_CAP (1u << 18)

__device__ __forceinline__ unsigned xb_ld(unsigned* p)              { return __hip_atomic_load(p, __ATOMIC_RELAXED, __HIP_MEMORY_SCOPE_AGENT); }
__device__ __forceinline__ unsigned xb_add(unsigned* p, unsigned v) { return __hip_atomic_fetch_add(p, v, __ATOMIC_RELAXED, __HIP_MEMORY_SCOPE_AGENT); }
__device__ __forceinline__ unsigned xb_xcc_id() { return (unsigned)__builtin_amdgcn_s_getreg((3 << 11) | 20) & 0xFu; }
#define XB_SPIN(cond, bar) do { unsigned _sp = 0; while (cond) { __builtin_amdgcn_s_sleep(1); \
    if ((++_sp & 255u) == 0u) { if (xb_ld(&(bar)[XB_TMO])) break; if (_sp > XB_SPIN_CAP) { atomicAdd(&(bar)[XB_TMO], 1u); break; } } } } while (0)

struct XcdBarrier {
    unsigned* bar; unsigned x;
    volatile LAS unsigned* st;
};

__device__ __forceinline__ XcdBarrier xcd_barrier_post(unsigned* bar, volatile LAS unsigned* st) {
    XcdBarrier b; b.bar = bar; b.x = xb_xcc_id(); b.st = st;
    if (threadIdx.x == 0) (void)xb_add(&bar[XB_XCNT(b.x)], 1u);
    return b;
}
__device__ __forceinline__ void xcd_barrier_complete(unsigned* bar, unsigned x, unsigned& nloc, unsigned& nx) {
    const unsigned G = gridDim.x * gridDim.y * gridDim.z;
    unsigned sum, cnt, mine, sp = 0u;
    for (;;) {
        sum = 0u; cnt = 0u; mine = 0u;
#pragma unroll
        for (unsigned j = 0; j < 16; ++j) { const unsigned c = xb_ld(&bar[XB_XCNT(j)]); sum += c; cnt += (c > 0u) ? 1u : 0u; mine = (j == x) ? c : mine; }
        if (sum == G) break;
        __builtin_amdgcn_s_sleep(1);
        if ((++sp & 255u) == 0u) { if (xb_ld(&bar[XB_TMO])) break; if (sp > XB_SPIN_CAP) { atomicAdd(&bar[XB_TMO], 1u); break; } }
    }
    nloc = mine > 0u ? mine : 1u; nx = cnt > 0u ? cnt : 1u;
}

__device__ __forceinline__ void xcd_barrier(const XcdBarrier& b) {
    asm volatile("s_waitcnt vmcnt(0)" ::: "memory");
    __syncthreads();
    if (threadIdx.x == 0) {
        unsigned* bar = b.bar;
        __builtin_amdgcn_s_waitcnt(0);
        unsigned nloc = b.st[0], nx = b.st[1];
        if (nloc == 0u) { xcd_barrier_complete(bar, b.x, nloc, nx); b.st[0] = nloc; b.st[1] = nx; }
        const unsigned old = xb_add(&bar[XB_XSUB(b.x)], 1u);
        const unsigned gen = old / nloc;
        if (old + 1u == (gen + 1u) * nloc) {
            __builtin_amdgcn_fence(__ATOMIC_RELEASE, "agent");
            asm volatile("s_waitcnt vmcnt(0)" ::: "memory");
            const unsigned og = xb_add(&bar[XB_TOP], 1u);
            const unsigned tg = og / nx;
            if (og + 1u == (tg + 1u) * nx) xb_add(&bar[XB_TOPGEN], 1u);
            else XB_SPIN(xb_ld(&bar[XB_TOPGEN]) == tg, bar);
            __builtin_amdgcn_fence(__ATOMIC_ACQUIRE, "agent");
            xb_add(&bar[XB_XGEN(b.x)], 1u);
            asm volatile("s_waitcnt vmcnt(0)" ::: "memory");
        } else {
            XB_SPIN(xb_ld(&bar[XB_XGEN(b.x)]) == gen, bar);
            __builtin_amdgcn_fence(__ATOMIC_ACQUIRE, "agent");
            asm volatile("s_waitcnt vmcnt(0)" ::: "memory");
        }
    }
    __syncthreads();
}

constexpr int NWAVES = 8;
constexpr int BATCH = 2, SEQ = 8192, D = 1024, FF = 2816, M = BATCH * SEQ;
constexpr int NPROJ_SRC = 5656, NPROJ = 5888;
constexpr float RMS_EPS = 1e-6f;
constexpr float LOG2E = 1.4426950408889634f;
constexpr float QSCALE = 0.125f * LOG2E;

constexpr size_t MiB = 1u << 20;
constexpr size_t WS_CTL = 0, CTL_ZERO_BYTES = 64 * 1024;
constexpr size_t WS_LUTN = 1 * MiB;
constexpr size_t WS_LUTD = WS_LUTN + 64 * 1024;
constexpr size_t WS_CB = WS_LUTD + 16 * 1024;
constexpr size_t WS_KCMP = 1 * MiB + 256 * 1024, WS_VCMP = WS_KCMP + 256 * 1024;
constexpr size_t WS_WIN = 2 * MiB;
constexpr size_t WS_WC1K = WS_WIN + (size_t)NPROJ * D * 2;
constexpr size_t WS_WC1V = WS_WC1K + 1 * MiB;
constexpr size_t WS_WC2K = WS_WC1V + 1 * MiB;
constexpr size_t WS_WC2V = WS_WC2K + 32 * 1024;
constexpr size_t WS_WBN = WS_WC2V + 32 * 1024;
constexpr size_t WS_WBD = WS_WBN + 1 * MiB;
constexpr size_t WS_WOUT = WS_WBD + MiB / 2;
constexpr size_t WS_WGU2 = WS_WOUT + 2 * MiB;
constexpr size_t WS_WD2 = WS_WGU2 + (size_t)2 * FF * D * 2;
constexpr size_t WS_WGU1 = 36 * MiB;
constexpr size_t WS_WD1 = WS_WGU1 + (size_t)2 * FF * D * 2;
static_assert(WS_WD2 + (size_t)D * FF * 2 <= WS_WGU1, "weights A");
static_assert(WS_WD1 + (size_t)D * FF * 2 <= 53 * MiB, "weights B");
constexpr size_t WS_QN = 36 * MiB;
constexpr size_t WS_XN = 53 * MiB;
constexpr size_t WS_MG = 141 * MiB;
constexpr size_t WS_YN = 69 * MiB;
constexpr size_t WS_H = 85 * MiB;
constexpr size_t WS_Y = 173 * MiB;
constexpr size_t WS_PL = 85 * MiB;
constexpr size_t WS_QD = 109 * MiB;
constexpr size_t WS_KD = 133 * MiB, WS_VD = 157 * MiB;
constexpr size_t WS_GA = 181 * MiB, WS_GB = 213 * MiB;
constexpr size_t WS_GN = 245 * MiB;
constexpr size_t WS_YD = 247 * MiB;
constexpr size_t WS_Y2P = 109 * MiB;
constexpr size_t WS_X2 = 205 * MiB;
constexpr size_t WS_END = 256 * MiB;
static_assert(WS_H + (size_t)M * FF * 2 <= WS_Y && WS_Y + (size_t)M * D * 4 <= WS_END, "ffn map");
static_assert(WS_YD + (size_t)M * 256 * 2 <= WS_END && WS_GN + (size_t)M * 32 * 4 <= WS_YD && WS_Y2P + (size_t)M * D * 2 <= WS_MG && WS_MG + (size_t)M * D * 2 <= WS_GA, "mixer map");
constexpr size_t PLSZ = (size_t)4 * 8192 * 64;
constexpr int CW_TMO = 0, CW_BAR = 1024;

constexpr int RING_OFF = 0, RING_BYTES = 131072;
constexpr int LDSCTL_OFF = 143360, MISC_OFF = LDSCTL_OFF + 320;
constexpr int LDS_BYTES = 147456;
constexpr int LUT_PAD = 64, LUTW = 1672;
constexpr int A_KV = 0;
constexpr int A_LUT = 65536;
constexpr int A_IMP = A_LUT + 4 * LUTW * 4;
constexpr int IMP_S = 132;
constexpr int A_SEL = A_IMP + 64 * IMP_S * 4;
constexpr int A_UM = A_SEL + 64 * 16;
constexpr int A_WSF = A_UM + 64;
constexpr int A_BL = A_WSF + 8 * 512;
constexpr int A_END = A_BL + 256;
static_assert(A_END <= LDSCTL_OFF, "attention LDS");
constexpr size_t WS_OD = 53 * MiB;
constexpr size_t WS_LSE = 255 * MiB;

__device__ __forceinline__ int fresh_tid() { int t = threadIdx.x; asm volatile("" : "+v"(t)); return t; }
struct Frame {
    LAS unsigned char* lds;
    volatile LAS unsigned* MISC;
    gu32* ctl;
    int vcu, G, nrep;
};

__device__ __forceinline__ float wave_sum(float v) {
#pragma unroll
    for (int o = 1; o < 64; o <<= 1) v += __shfl_xor(v, o);
    return v;
}
struct TrItem { const float* W; bf16* WT; int K, Nsrc, sc0, nvalid, dr0, kb, frag; };
__device__ __forceinline__ void tr_load(const TrItem& t, f32x4 (&v)[8], int lane) {
    const int c4 = (lane & 7) * 4, rr = lane >> 3;
#pragma unroll
    for (int i = 0; i < 8; ++i) v[i] = (c4 < t.nvalid) ? *(const GAS f32x4*)(t.W + (size_t)(64 * t.kb + rr + 8 * i) * t.Nsrc + t.sc0 + c4) : (f32x4){0.f, 0.f, 0.f, 0.f};
}
__device__ __forceinline__ void tr_finish(const TrItem& t, const f32x4 (&v)[8], LAS float* scr, int lane) {
    const int k0 = 64 * t.kb, c4 = (lane & 7) * 4, rr = lane >> 3;
#pragma unroll
    for (int i = 0; i < 8; ++i) { LAS float* d = scr + (rr + 8 * i) * 33 + c4; d[0] = v[i].x; d[1] = v[i].y; d[2] = v[i].z; d[3] = v[i].w; }
    LDS_WAIT(); asm volatile("" ::: "memory");
    const int c = lane & 7;
#pragma unroll
    for (int j = 0; j < 4; ++j) { const int n = (lane >> 3) + 8 * j; const LAS float* s = scr + (8 * c) * 33 + n;
        v4u o; o.x = pk2(s[0 * 33], s[1 * 33]); o.y = pk2(s[2 * 33], s[3 * 33]); o.z = pk2(s[4 * 33], s[5 * 33]); o.w = pk2(s[6 * 33], s[7 * 33]);
        const int ng = t.dr0 + n, kk = k0 + 8 * c;
        const size_t off = t.frag ? ((size_t)(((ng >> 5) * (t.K >> 4) + (kk >> 4)) * 64 + ((kk >> 3) & 1) * 32 + (ng & 31)) * 8) : ((size_t)ng * t.K + kk);
        *(GAS v4u*)(t.WT + off) = o; }
    LDS_WAIT(); asm volatile("" ::: "memory");
}
__device__ __forceinline__ void win_map(int dblk, int& sc0, int& nvalid) {
    const int hidx = dblk >> 1, half = dblk & 1; nvalid = 32;
    if (hidx < 8) sc0 = hidx * 64 + half * 32;
    else if (hidx < 20) sc0 = 512 + (hidx - 8) * 64 + half * 32;
    else if (hidx < 32) sc0 = 1304 + (hidx - 20) * 64 + half * 32;
    else if (hidx < 44) sc0 = 2072 + (hidx - 32) * 64 + half * 32;
    else if (hidx < 56) sc0 = 2840 + (hidx - 44) * 64 + half * 32;
    else if (hidx < 72) sc0 = 3608 + (hidx - 56) * 64 + half * 32;
    else if (hidx < 88) sc0 = 4632 + (hidx - 72) * 64 + half * 32;
    else if (hidx == 88 && half == 0) { sc0 = 1280; nvalid = 24; }
    else { sc0 = 0; nvalid = 0; }
}
__device__ __forceinline__ void gu_map(int dblk, int& sc0) { const int pn = dblk >> 3, q = dblk & 7; sc0 = (q < 4) ? (128 * pn + 32 * q) : (FF + 128 * pn + 32 * (q - 4)); }
__device__ __forceinline__ int t5_bucket(int d) {
    if (d < 16) return d;
    int b = 16;
    b += (d >= 22); b += (d >= 30); b += (d >= 40); b += (d >= 54); b += (d >= 73); b += (d >= 99); b += (d >= 134); b += (d >= 182);
    b += (d >= 246); b += (d >= 332); b += (d >= 450); b += (d >= 609); b += (d >= 825); b += (d >= 1117); b += (d >= 1513);
    return b;
}
struct In {
    const float *x, *f1_pre, *f1_wgu, *f1_wd, *f1_post, *mix_pre, *w_in, *cpos_k, *cw1_k, *cw2_k, *cpos_v, *cw1_v, *cw2_v, *w_bn, *w_bd, *w_out, *mix_post, *f2_pre, *f2_wgu, *f2_wd, *f2_post, *rel_bias;
};
__device__ __forceinline__ void rms_row_to_bf16(const float* xrow, const float* gain, bf16* orow, int lane) {
    const GAS f32x4* xr = (const GAS f32x4*)xrow + lane; const GAS f32x4* gr = (const GAS f32x4*)gain + lane;
    f32x4 v[4]; float s = 0.f;
#pragma unroll
    for (int j = 0; j < 4; ++j) { v[j] = xr[64 * j]; s += (v[j].x * v[j].x + v[j].y * v[j].y) + (v[j].z * v[j].z + v[j].w * v[j].w); }
    const float r = 1.f / sqrtf(wave_sum(s) * (1.f / D) + RMS_EPS);
    GAS unsigned long long* o8 = (GAS unsigned long long*)orow + lane;
#pragma unroll
    for (int j = 0; j < 4; ++j) { const f32x4 g = gr[64 * j]; o8[64 * j] = (unsigned long long)pk2(v[j].x * r * g.x, v[j].y * r * g.y) | ((unsigned long long)pk2(v[j].z * r * g.z, v[j].w * r * g.w) << 32); }
}
__device__ __forceinline__ void p0_prologue(Frame& F, const In& in, unsigned char* ws) {
    const int tid = fresh_tid(), lane = tid & 63, wave = __builtin_amdgcn_readfirstlane(tid >> 6);
    LAS float* scr = (LAS float*)(F.lds + RING_OFF + wave * 16384);
    const int gw = F.vcu * NWAVES + wave, NGW = F.G * NWAVES;
    constexpr int I_GU = 176 * 16, I_D = 32 * 44, I_IN = 184 * 16, I_C1 = 8 * 32, I_C2 = 2 * 4, I_BN = 32 * 8, I_BD = 32 * 4, I_O = 32 * 16;
    constexpr int NITEMS = 2 * I_GU + 2 * I_D + I_IN + 2 * I_C1 + 2 * I_C2 + I_BN + I_BD + I_O;
    auto decode = [&](int it) -> TrItem {
        TrItem t; int r = it, sc0 = 0, nv = 32; t.frag = 0;
        if (r < I_GU) { const int dblk = r / 16; gu_map(dblk, sc0); t = TrItem{in.f1_wgu, (bf16*)(ws + WS_WGU1), D, 2 * FF, sc0, 32, dblk * 32, r % 16, 0}; return t; } r -= I_GU;
        if (r < I_GU) { const int dblk = r / 16; gu_map(dblk, sc0); t = TrItem{in.f2_wgu, (bf16*)(ws + WS_WGU2), D, 2 * FF, sc0, 32, dblk * 32, r % 16, 0}; return t; } r -= I_GU;
        if (r < I_D) { const int dblk = r / 44; t = TrItem{in.f1_wd, (bf16*)(ws + WS_WD1), FF, D, dblk * 32, 32, dblk * 32, r % 44, 0}; return t; } r -= I_D;
        if (r < I_D) { const int dblk = r / 44; t = TrItem{in.f2_wd, (bf16*)(ws + WS_WD2), FF, D, dblk * 32, 32, dblk * 32, r % 44, 0}; return t; } r -= I_D;
        if (r < I_IN) { const int dblk = r / 16; win_map(dblk, sc0, nv); t = TrItem{in.w_in, (bf16*)(ws + WS_WIN), D, NPROJ_SRC, sc0, nv, dblk * 32, r % 16, 0}; return t; } r -= I_IN;
        if (r < I_C1) { const int dblk = r / 32; t = TrItem{in.cw1_k, (bf16*)(ws + WS_WC1K), 2048, 256, dblk * 32, 32, dblk * 32, r % 32, 1}; return t; } r -= I_C1;
        if (r < I_C1) { const int dblk = r / 32; t = TrItem{in.cw1_v, (bf16*)(ws + WS_WC1V), 2048, 256, dblk * 32, 32, dblk * 32, r % 32, 1}; return t; } r -= I_C1;
        if (r < I_C2) { const int dblk = r / 4; t = TrItem{in.cw2_k, (bf16*)(ws + WS_WC2K), 256, 64, dblk * 32, 32, dblk * 32, r % 4, 0}; return t; } r -= I_C2;
        if (r < I_C2) { const int dblk = r / 4; t = TrItem{in.cw2_v, (bf16*)(ws + WS_WC2V), 256, 64, dblk * 32, 32, dblk * 32, r % 4, 0}; return t; } r -= I_C2;
        if (r < I_BN) { const int dblk = r / 8; t = TrItem{in.w_bn, (bf16*)(ws + WS_WBN), 512, D, dblk * 32, 32, dblk * 32, r % 8, 0}; return t; } r -= I_BN;
        if (r < I_BD) { const int dblk = r / 4; t = TrItem{in.w_bd, (bf16*)(ws + WS_WBD), 256, D, dblk * 32, 32, dblk * 32, r % 4, 0}; return t; } r -= I_BD;
        { const int dblk = r / 16; t = TrItem{in.w_out, (bf16*)(ws + WS_WOUT), D, D, dblk * 32, 32, dblk * 32, r % 16, 0}; return t; }
    };
    {
        f32x4 va[8], vb[8]; TrItem ta, tb;
        int it = gw; if (it < NITEMS) { ta = decode(it); tr_load(ta, va, lane); }
        while (it < NITEMS) {
            const int itn = it + NGW; if (itn < NITEMS) { tb = decode(itn); tr_load(tb, vb, lane); }
            tr_finish(ta, va, scr, lane);
            it = itn; if (it >= NITEMS) break;
            const int itm = it + NGW; if (itm < NITEMS) { ta = decode(itm); tr_load(ta, va, lane); }
            tr_finish(tb, vb, scr, lane);
            it = itm;
        }
    }
    { float* ln = (float*)(ws + WS_LUTN); float* ld = (float*)(ws + WS_LUTD); const int gt = F.vcu * (NWAVES * 64) + tid, NGT = F.G * NWAVES * 64;
      for (int e = gt; e < 8 * LUTW; e += NGT) { const int hd = e / LUTW, d = e % LUTW - LUT_PAD; ln[e] = (d >= 0) ? in.rel_bias[t5_bucket(d) * 20 + hd] * LOG2E : 0.f; }
      for (int e = gt; e < 12 * 320; e += NGT) { const int hd = e / 320, st = e % 320 - LUT_PAD; const int dil = 1 << (2 * (hd >> 2)); ld[e] = (st >= 0 && st <= 128) ? in.rel_bias[t5_bucket(st * dil) * 20 + 8 + hd] * LOG2E : 0.f; } }
    { float* cb = (float*)(ws + WS_CB);
      for (int o = gw; o < 512; o += NGW) { const int ts = o >> 8, n = o & 255; const float* pos = ts ? in.cpos_v : in.cpos_k; const float* w1 = ts ? in.cw1_v : in.cw1_k;
          float s = 0.f; for (int k = lane; k < 2048; k += 64) s += pos[k] * w1[(size_t)k * 256 + n];
          s = wave_sum(s); if (lane == 0) cb[o] = s; } }
    for (int m = gw; m < M; m += 2 * NGW) {
        const int m2 = m + NGW;
        const GAS f32x4* xa = (const GAS f32x4*)(in.x + (size_t)m * D) + lane; const GAS f32x4* xb = (const GAS f32x4*)(in.x + (size_t)(m2 < M ? m2 : m) * D) + lane;
        const GAS f32x4* gr = (const GAS f32x4*)in.f1_pre + lane;
        f32x4 va[4], vb[4]; float sa = 0.f, sb = 0.f;
#pragma unroll
        for (int j = 0; j < 4; ++j) { va[j] = xa[64 * j]; vb[j] = xb[64 * j]; }
#pragma unroll
        for (int j = 0; j < 4; ++j) { sa += (va[j].x * va[j].x + va[j].y * va[j].y) + (va[j].z * va[j].z + va[j].w * va[j].w); sb += (vb[j].x * vb[j].x + vb[j].y * vb[j].y) + (vb[j].z * vb[j].z + vb[j].w * vb[j].w); }
        const float ra = 1.f / sqrtf(wave_sum(sa) * (1.f / D) + RMS_EPS), rb = 1.f / sqrtf(wave_sum(sb) * (1.f / D) + RMS_EPS);
        GAS unsigned long long* oa = (GAS unsigned long long*)((bf16*)(ws + WS_XN) + (size_t)m * D) + lane; GAS unsigned long long* ob = (GAS unsigned long long*)((bf16*)(ws + WS_XN) + (size_t)(m2 < M ? m2 : m) * D) + lane;
#pragma unroll
        for (int j = 0; j < 4; ++j) { const f32x4 g = gr[64 * j];
            oa[64 * j] = (unsigned long long)pk2(va[j].x * ra * g.x, va[j].y * ra * g.y) | ((unsigned long long)pk2(va[j].z * ra * g.z, va[j].w * ra * g.w) << 32);
            if (m2 < M) ob[64 * j] = (unsigned long long)pk2(vb[j].x * rb * g.x, vb[j].y * rb * g.y) | ((unsigned long long)pk2(vb[j].z * rb * g.z, vb[j].w * rb * g.w) << 32); }
    }
}
__device__ __forceinline__ f32x4 ld_bf4(const GAS unsigned long long* p) { const unsigned long long w = *p; const unsigned lo = (unsigned)w, hi = (unsigned)(w >> 32);
    f32x4 v; v.x = __uint_as_float(lo << 16); v.y = __uint_as_float(lo & 0xffff0000u); v.z = __uint_as_float(hi << 16); v.w = __uint_as_float(hi & 0xffff0000u); return v; }
template <bool BB, bool OB, int NR = 4> __device__ __forceinline__ void row_pass(Frame& F, const bf16* Y, const void* base, void* out, float alpha, const float* gpost, const float* gnext, bf16* XN) {
    const int tid = fresh_tid(), lane = tid & 63, wave = __builtin_amdgcn_readfirstlane(tid >> 6);
    const int gw = F.vcu * NWAVES + wave, NGW = F.G * NWAVES;
    const GAS f32x4* gp = (const GAS f32x4*)gpost + lane;
    for (int m0 = gw; m0 < M; m0 += NR * NGW) {
        int mr[NR];
#pragma unroll
        for (int q = 0; q < NR; ++q) mr[q] = (m0 + q * NGW < M) ? m0 + q * NGW : m0;
        f32x4 v[NR][4], bv[NR][4]; float s[NR];
#pragma unroll
        for (int q = 0; q < NR; ++q) s[q] = 0.f;
#pragma unroll
        for (int q = 0; q < NR; ++q) { const int m = mr[q];
            const GAS unsigned long long* yr = (const GAS unsigned long long*)(Y + (size_t)m * D) + lane;
#pragma unroll
            for (int j = 0; j < 4; ++j) { v[q][j] = ld_bf4(yr + 64 * j);
                if (BB) bv[q][j] = ld_bf4((const GAS unsigned long long*)((const bf16*)base + (size_t)m * D) + lane + 64 * j); else bv[q][j] = ((const GAS f32x4*)((const float*)base + (size_t)m * D) + lane)[64 * j]; } }
#pragma unroll
        for (int q = 0; q < NR; ++q)
#pragma unroll
            for (int j = 0; j < 4; ++j) s[q] += (v[q][j].x * v[q][j].x + v[q][j].y * v[q][j].y) + (v[q][j].z * v[q][j].z + v[q][j].w * v[q][j].w);
        float r[NR], s2[NR];
#pragma unroll
        for (int q = 0; q < NR; ++q) s2[q] = 0.f;
#pragma unroll
        for (int q = 0; q < NR; ++q) r[q] = alpha / sqrtf(wave_sum(s[q]) * (1.f / D) + RMS_EPS);
#pragma unroll
        for (int q = 0; q < NR; ++q) { const int m = mr[q]; if (q >= 1 && mr[q] == mr[0]) continue;
#pragma unroll
            for (int j = 0; j < 4; ++j) { const f32x4 g = gp[64 * j]; v[q][j] = bv[q][j] + v[q][j] * r[q] * g;
                if (OB) ((GAS unsigned long long*)((bf16*)out + (size_t)m * D) + lane)[64 * j] = (unsigned long long)pk2(v[q][j].x, v[q][j].y) | ((unsigned long long)pk2(v[q][j].z, v[q][j].w) << 32);
                else ((GAS f32x4*)((float*)out + (size_t)m * D) + lane)[64 * j] = v[q][j];
                s2[q] += (v[q][j].x * v[q][j].x + v[q][j].y * v[q][j].y) + (v[q][j].z * v[q][j].z + v[q][j].w * v[q][j].w); } }
        if (gnext) {
            const GAS f32x4* gn = (const GAS f32x4*)gnext + lane;
#pragma unroll
            for (int q = 0; q < NR; ++q) { const int m = mr[q]; if (q >= 1 && mr[q] == mr[0]) continue;
                const float r2 = 1.f / sqrtf(wave_sum(s2[q]) * (1.f / D) + RMS_EPS);
                GAS unsigned long long* o8 = (GAS unsigned long long*)(XN + (size_t)m * D) + lane;
#pragma unroll
                for (int j = 0; j < 4; ++j) { const f32x4 g = gn[64 * j]; o8[64 * j] = (unsigned long long)pk2(v[q][j].x * r2 * g.x, v[q][j].y * r2 * g.y) | ((unsigned long long)pk2(v[q][j].z * r2 * g.z, v[q][j].w * r2 * g.w) << 32); } }
        }
    }
}

namespace att {
typedef float f32x16 __attribute__((ext_vector_type(16)));
typedef short s16x4 __attribute__((ext_vector_type(4)));
typedef short v4i16_t __attribute__((ext_vector_type(4)));
constexpr float NEGV = -1.0e30f;
constexpr int TILE_B = 16384, SBUF = 2 * TILE_B;
enum { CLS_SKIP = 0, CLS_FULL = 1, CLS_PART = 2, CLS_CONST = 3 };
__device__ __forceinline__ constexpr int crow(int r, int hi) { return (r & 3) + 8 * (r >> 2) + 4 * hi; }
__device__ __forceinline__ unsigned cvtpk(float lo, float hi) { unsigned r; asm volatile("v_cvt_pk_bf16_f32 %0, %1, %2" : "=v"(r) : "v"(lo), "v"(hi)); return r; }
__device__ __forceinline__ float swapmax(float v) { auto rr = __builtin_amdgcn_permlane32_swap(__float_as_uint(v), __float_as_uint(v), false, false); return fmaxf(__uint_as_float(rr[0]), __uint_as_float(rr[1])); }
__device__ __forceinline__ float swapsum(float v) { auto rr = __builtin_amdgcn_permlane32_swap(__float_as_uint(v), __float_as_uint(v), false, false); return __uint_as_float(rr[0]) + __uint_as_float(rr[1]); }
__device__ __forceinline__ float quadsum(float v) {
    v += __int_as_float(__builtin_amdgcn_mov_dpp(__float_as_int(v), 0xB1, 0xF, 0xF, true));
    v += __int_as_float(__builtin_amdgcn_mov_dpp(__float_as_int(v), 0x4E, 0xF, 0xF, true));
    return v;
}
struct Stage { v4u k, v; };
struct Stage2 { Stage t[2]; };
__device__ __forceinline__ void tile_load(Stage& s, const bf16* Kp, const bf16* Vp, long row, int tid) {
    const int ch = tid & 7; s.k = *(const GAS v4u*)(Kp + row * 64 + ch * 8); s.v = *(const GAS v4u*)(Vp + row * 64 + ch * 8);
}
__device__ __forceinline__ void tile_store(LAS unsigned char* buf, const Stage& s, int tid) {
    const int key = tid >> 3, ch = tid & 7;
    *(LAS v4u*)(buf + ch * 1024 + key * 16) = s.k;
    *(LAS v4u*)(buf + 8192 + (ch >> 2) * 4096 + key * 64 + (ch & 3) * 16) = s.v;
}
#define SBAR() __builtin_amdgcn_sched_barrier(0)
#ifndef ATT_SHIFT
#define ATT_SHIFT 8
#endif
#define ATT_BAR() asm volatile("s_waitcnt lgkmcnt(0)\n\ts_barrier" ::: "memory")
__device__ __forceinline__ void qk(f32x16& p0, f32x16& p1, const LAS unsigned char* kb, const bf16x8 (&qr)[4]) {
#pragma unroll
    for (int d0 = 0; d0 < 4; ++d0) {
        const bf16x8 b0 = *(const LAS bf16x8*)(kb + d0 * 2048), b1 = *(const LAS bf16x8*)(kb + d0 * 2048 + 512);
        p0 = __builtin_amdgcn_mfma_f32_32x32x16_bf16(b0, qr[d0], p0, 0, 0, 0);
        p1 = __builtin_amdgcn_mfma_f32_32x32x16_bf16(b1, qr[d0], p1, 0, 0, 0);
    }
}
__device__ __forceinline__ float max3f(float a, float b, float c) { float r; asm("v_max3_f32 %0, %1, %2, %3" : "=v"(r) : "v"(a), "v"(b), "v"(c)); return r; }
__device__ __forceinline__ float rowmax32(const f32x16& p0, const f32x16& p1) {
    float a = max3f(p0[0], p1[0], p0[1]), b = max3f(p1[1], p0[2], p1[2]);
#pragma unroll
    for (int r = 3; r < 15; r += 2) { a = max3f(a, p0[r], p1[r]); b = max3f(b, p0[r + 1], p1[r + 1]); }
    a = max3f(a, p0[15], p1[15]);
    return swapmax(fmaxf(a, b));
}
__device__ __forceinline__ s16x4 vtr(const LAS unsigned char* p) { return __builtin_bit_cast(s16x4, __builtin_amdgcn_ds_read_tr16_b64_v4i16((LAS v4i16_t*)p)); }
__device__ __forceinline__ void pv(f32x16 (&o)[2], const LAS unsigned char* vb, const f32x16& p0, const f32x16& p1) {
    v4u pw[4];
#pragma unroll
    for (int s = 0; s < 2; ++s) {
        pw[s]     = (v4u){cvtpk(p0[8 * s], p0[8 * s + 1]), cvtpk(p0[8 * s + 2], p0[8 * s + 3]), cvtpk(p0[8 * s + 4], p0[8 * s + 5]), cvtpk(p0[8 * s + 6], p0[8 * s + 7])};
        pw[2 + s] = (v4u){cvtpk(p1[8 * s], p1[8 * s + 1]), cvtpk(p1[8 * s + 2], p1[8 * s + 3]), cvtpk(p1[8 * s + 4], p1[8 * s + 5]), cvtpk(p1[8 * s + 6], p1[8 * s + 7])};
    }
#pragma unroll
    for (int dh = 0; dh < 2; ++dh)
#pragma unroll
        for (int kg = 0; kg < 4; ++kg) {
            const s16x4 lo = vtr(vb + dh * 4096 + kg * 1024), hi = vtr(vb + dh * 4096 + kg * 1024 + 512);
            const bf16x8 vf = (bf16x8){lo[0], lo[1], lo[2], lo[3], hi[0], hi[1], hi[2], hi[3]};
            o[dh] = __builtin_amdgcn_mfma_f32_32x32x16_bf16(__builtin_bit_cast(bf16x8, pw[kg]), vf, o[dh], 0, 0, 0);
        }
}
struct Soft { float mref, lsum; };
__device__ __forceinline__ void proc_tile(int cls, const LAS unsigned char* tile, const bf16x8 (&qr)[4], Soft& st, f32x16 (&o)[2], const LAS float* lut, int d0, int dlo, int dhi, float cbias, bool rowsel,
                                          LAS float* wsf, int r32, int hi, int trb) {
    const bool unset = st.mref < -1.0e29f;
    const float base = unset ? 0.f : st.mref;
    const float negb = rowsel ? -base : NEGV;
    f32x16 p0, p1; bf16x8 kf0[4], kf1[4];
    { const LAS unsigned char* kb = tile + hi * 1024 + r32 * 16;
#pragma unroll
      for (int q = 0; q < 4; ++q) { kf0[q] = *(const LAS bf16x8*)(kb + q * 2048); kf1[q] = *(const LAS bf16x8*)(kb + q * 2048 + 512); } }
    if (cls == CLS_CONST) { const float iv = negb + cbias;
#pragma unroll
        for (int r = 0; r < 16; ++r) { p0[r] = iv; p1[r] = iv; }
    } else { const LAS float* pb = lut + (d0 - 4 * hi - 59);
#pragma unroll
        for (int r = 0; r < 16; ++r) { p0[r] = pb[59 - crow(r, 0)]; p1[r] = pb[27 - crow(r, 0)]; }
        SBAR();
#pragma unroll
        for (int r = 0; r < 16; ++r) { p0[r] += negb; p1[r] += negb; }
    }
    SBAR();
#pragma unroll
    for (int q = 0; q < 4; ++q) { p0 = __builtin_amdgcn_mfma_f32_32x32x16_bf16(kf0[q], qr[q], p0, 0, 0, 0); p1 = __builtin_amdgcn_mfma_f32_32x32x16_bf16(kf1[q], qr[q], p1, 0, 0, 0); }
    SBAR();
    s16x4 vlo[8], vhi[8];
    { const LAS unsigned char* vb = tile + 8192 + trb;
#pragma unroll
      for (int i = 0; i < 8; ++i) { vlo[i] = vtr(vb + (i >> 2) * 4096 + (i & 3) * 1024); vhi[i] = vtr(vb + (i >> 2) * 4096 + (i & 3) * 1024 + 512); } }
    SBAR();
    if (cls == CLS_PART) { const int dq = d0 - 4 * hi; const unsigned span = (unsigned)(dhi - dlo);
#pragma unroll
        for (int r = 0; r < 16; ++r) { const int da = dq - crow(r, 0), db = da - 32;
            p0[r] = ((unsigned)(da - dlo) <= span) ? p0[r] : NEGV; p1[r] = ((unsigned)(db - dlo) <= span) ? p1[r] : NEGV; }
    }
    const float rm = rowmax32(p0, p1);
    const bool upd = rowsel && (rm > -1.0e29f) && (unset || rm > 8.0f);
    if (__any(upd)) {
        const float delta = upd ? rm : 0.f;
#pragma unroll
        for (int r = 0; r < 16; ++r) { p0[r] -= delta; p1[r] -= delta; }
        const float f = (upd && !unset) ? __builtin_amdgcn_exp2f(-delta) : 1.0f;
        st.lsum *= f;
        if (upd) st.mref = base + delta;
        if (hi == 0) wsf[r32] = f;
        asm volatile("s_waitcnt lgkmcnt(0)" ::: "memory");
#pragma unroll
        for (int r = 0; r < 16; ++r) { const float fr = wsf[crow(r, hi)]; o[0][r] *= fr; o[1][r] *= fr; }
        asm volatile("s_waitcnt lgkmcnt(0)" ::: "memory");
    }
    float s = 0.f;
#pragma unroll
    for (int r = 0; r < 16; ++r) { p0[r] = __builtin_amdgcn_exp2f(p0[r]); p1[r] = __builtin_amdgcn_exp2f(p1[r]); s += p0[r] + p1[r]; }
    st.lsum += s;
    v4u pw[4];
#pragma unroll
    for (int q = 0; q < 2; ++q) {
        pw[q]     = (v4u){cvtpk(p0[8 * q], p0[8 * q + 1]), cvtpk(p0[8 * q + 2], p0[8 * q + 3]), cvtpk(p0[8 * q + 4], p0[8 * q + 5]), cvtpk(p0[8 * q + 6], p0[8 * q + 7])};
        pw[2 + q] = (v4u){cvtpk(p1[8 * q], p1[8 * q + 1]), cvtpk(p1[8 * q + 2], p1[8 * q + 3]), cvtpk(p1[8 * q + 4], p1[8 * q + 5]), cvtpk(p1[8 * q + 6], p1[8 * q + 7])};
    }
    SBAR();
#pragma unroll
    for (int kg = 0; kg < 4; ++kg)
#pragma unroll
        for (int dh = 0; dh < 2; ++dh) { const int i = dh * 4 + kg;
            const bf16x8 vf = (bf16x8){vlo[i][0], vlo[i][1], vlo[i][2], vlo[i][3], vhi[i][0], vhi[i][1], vhi[i][2], vhi[i][3]};
            o[dh] = __builtin_amdgcn_mfma_f32_32x32x16_bf16(__builtin_bit_cast(bf16x8, pw[kg]), vf, o[dh], 0, 0, 0); }
}
__device__ __forceinline__ float soft_final_inv(const Soft& st, float& ltot) { ltot = swapsum(st.lsum); return (st.mref > -1.0e29f) ? 1.0f / ltot : 0.f; }
}

struct Mix {
    bf16 *QN, *YN, *SCR, *PL, *QD, *KD, *VD, *YD, *KCMP, *VCMP, *OD; float* LSE; const float* GN; const float* LUTN; const float* LUTD; const float* CB;
    const bf16 *WC1K, *WC1V, *WC2K, *WC2V;
};
__device__ __forceinline__ void lut_to_lds(Frame& F, int tid, const float* img, int nf) {
    LAS f32x4* L = (LAS f32x4*)(F.lds + A_LUT); const GAS f32x4* G = (const GAS f32x4*)img;
    for (int e = tid; e < nf / 4; e += NWAVES * 64) L[e] = G[e];
}
__device__ __forceinline__ bf16x8 ldq(const bf16* p) { return *(const GAS bf16x8*)p; }

__device__ __forceinline__ int next_sel(int j, int c, unsigned u0, unsigned u1, unsigned u2, unsigned u3) {
    while (j <= c) { const unsigned w = (j < 32) ? u0 : (j < 64) ? u1 : (j < 96) ? u2 : u3; if ((w >> (j & 31)) & 1u) break; ++j; }
    return j;
}
template <bool ADD> __device__ __forceinline__ void yn_rows(bf16* YN, const att::f32x16 (&o)[2], float fac, LAS float* wsf, int r32, int hi, size_t R0, int g, int lane) {
    if (hi == 0) wsf[r32] = fac;
    asm volatile("s_waitcnt lgkmcnt(0)" ::: "memory");
#pragma unroll
    for (int r = 0; r < 16; ++r) { const int q = att::crow(r, hi); const float fr = wsf[q];
        bf16* op = YN + (R0 + (q >> 2)) * 512 + (4 * g + (q & 3)) * 64 + (lane & 31);
        float a0 = o[0][r] * fr, a1 = o[1][r] * fr;
        if (ADD) { a0 += __uint_as_float((unsigned)op[0] << 16); a1 += __uint_as_float((unsigned)op[32] << 16); }
        op[0] = (bf16)f2bf(a0); op[32] = (bf16)f2bf(a1); }
    asm volatile("s_waitcnt lgkmcnt(0)" ::: "memory");
}
__device__ __forceinline__ void nsa_unit(Frame& F, const Mix& X, int b, int g, int c, int& buf) {
    using namespace att;
    const int tid = fresh_tid(), lane = tid & 63, wave = __builtin_amdgcn_readfirstlane(tid >> 6), r32 = lane & 31, hi = lane >> 5;
    LAS unsigned char* kv = F.lds + A_KV; LAS float* lutl = (LAS float*)(F.lds + A_LUT); LAS float* imp = (LAS float*)(F.lds + A_IMP);
    LAS unsigned* selm = (LAS unsigned*)(F.lds + A_SEL); LAS unsigned* um = (LAS unsigned*)(F.lds + A_UM); LAS float* wsf = (LAS float*)(F.lds + A_WSF) + wave * 128;
    const int trb = ((lane >> 4) & 1) * 32 + (lane & 3) * 8 + (4 * hi + ((lane & 15) >> 2)) * 64;
    const int t0 = 64 * c, tok = 8 * wave + (r32 >> 2), h = r32 & 3, t = t0 + tok;
    const size_t R = (size_t)b * SEQ + t, R0 = (size_t)b * SEQ + t0 + 8 * wave;
    const int plane = b * 2 + g;
    const bf16* KS = X.PL + 2 * PLSZ + (size_t)plane * SEQ * 64; const bf16* VS = X.PL + 3 * PLSZ + (size_t)plane * SEQ * 64;
    const bf16* KW = X.PL + 4 * PLSZ + (size_t)plane * SEQ * 64; const bf16* VW = X.PL + 5 * PLSZ + (size_t)plane * SEQ * 64;
    const bf16* KC = X.KCMP + (size_t)plane * 512 * 64; const bf16* VC = X.VCMP + (size_t)plane * 512 * 64;
    __syncthreads();
    lut_to_lds(F, tid, X.LUTN + (size_t)g * 4 * LUTW, 4 * LUTW);
    for (int e = tid; e < 64 * IMP_S / 4; e += NWAVES * 64) ((LAS f32x4*)imp)[e] = (f32x4){0.f, 0.f, 0.f, 0.f};
    if (tid < 4) um[tid] = 0u;
    bf16x8 qr[4];
#pragma unroll
    for (int d0 = 0; d0 < 4; ++d0) qr[d0] = ldq(X.QN + R * 512 + (4 * g + h) * 64 + 16 * d0 + 8 * hi);
    const float g0 = X.GN[R * 32 + (4 * g + h) * 3 + 0], g1 = X.GN[R * 32 + (4 * g + h) * 3 + 1], g2 = X.GN[R * 32 + (4 * g + h) * 3 + 2];
    const LAS float* lrow = lutl + h * LUTW + LUT_PAD;
    __syncthreads();
    const int key = tid >> 3;
    Stage2 sg;
    {
        Soft st{NEGV, 0.f}; f32x16 o[2]; o[0] = f32x16{}; o[1] = f32x16{};
        const int it0 = (c >= 8) ? 0 : (8 - c), nt = 9 - it0, nss = (nt + 1) >> 1;
#pragma unroll
        for (int tt = 0; tt < 2; ++tt) { int it = it0 + tt; it = it > 8 ? 8 : it; tile_load(sg.t[tt], KW, VW, t0 - 512 + 64 * it + key, tid); }
        for (int ss = 0; ss < nss; ++ss) {
            LAS unsigned char* bp = kv + buf * SBUF;
            tile_store(bp, sg.t[0], tid); tile_store(bp + TILE_B, sg.t[1], tid); ATT_BAR();
            if (ss + 1 < nss) {
#pragma unroll
                for (int tt = 0; tt < 2; ++tt) { int it = it0 + 2 * (ss + 1) + tt; it = it > 8 ? 8 : it; tile_load(sg.t[tt], KW, VW, t0 - 512 + 64 * it + key, tid); } }
#pragma unroll
            for (int tt = 0; tt < 2; ++tt) { const int it = it0 + 2 * ss + tt;
                if (it <= 8) { const int kb = t0 - 512 + 64 * it; const int cls = (it == 0 || it == 8) ? CLS_PART : CLS_FULL;
                    proc_tile(cls, bp + tt * TILE_B, qr, st, o, lrow, t - kb, 0, 511, 0.f, true, wsf, r32, hi, trb); } }
            buf ^= 1;
        }
        float lt; const float inv = soft_final_inv(st, lt);
        yn_rows<false>(X.YN, o, g2 * inv, wsf, r32, hi, R0, g, lane);
    }
    {
        const int imax = (4 * c + 2 > 510) ? 510 : (4 * c + 2), ntc = imax / 64 + 1, nss = (ntc + 1) >> 1;
        const int dq = t - 31 - 16 * 4 * hi;
        const float cfar = lrow[1599];
        float m = NEGV, l = 0.f;
#pragma unroll
        for (int tt = 0; tt < 2; ++tt) { int it = tt; it = it > ntc - 1 ? ntc - 1 : it; tile_load(sg.t[tt], KC, VC, 64 * it + key, tid); }
        for (int ss = 0; ss < nss; ++ss) {
            LAS unsigned char* bp = kv + buf * SBUF;
            tile_store(bp, sg.t[0], tid); tile_store(bp + TILE_B, sg.t[1], tid); ATT_BAR();
            if (ss + 1 < nss) {
#pragma unroll
                for (int tt = 0; tt < 2; ++tt) { int it = 2 * (ss + 1) + tt; it = it > ntc - 1 ? ntc - 1 : it; tile_load(sg.t[tt], KC, VC, 64 * it + key, tid); } }
#pragma unroll
            for (int tt = 0; tt < 2; ++tt) { const int it = 2 * ss + tt;
                if (it < ntc) {
                    f32x16 p0, p1; const int dt = dq - 1024 * it;
                    const bool far = (t0 - 31 - 1024 * it - 1008) >= 1513;
                    if (far) {
#pragma unroll
                        for (int r = 0; r < 16; ++r) { p0[r] = cfar; p1[r] = cfar; }
                    } else {
#pragma unroll
                        for (int r = 0; r < 16; ++r) { const int da = dt - 16 * crow(r, 0), db = da - 512;
                            const int ia = da < -64 ? -64 : (da > 1599 ? 1599 : da), ib = db < -64 ? -64 : (db > 1599 ? 1599 : db);
                            p0[r] = lrow[ia]; p1[r] = lrow[ib]; }
                    }
                    qk(p0, p1, bp + tt * TILE_B + hi * 1024 + r32 * 16, qr);
                    if (!far) {
#pragma unroll
                        for (int r = 0; r < 16; ++r) { const int da = dt - 16 * crow(r, 0), db = da - 512; p0[r] = (da >= 0) ? p0[r] : NEGV; p1[r] = (db >= 0) ? p1[r] : NEGV; }
                    }
                    const float rm = rowmax32(p0, p1);
                    const float mn = fmaxf(m, rm); float s = 0.f;
#pragma unroll
                    for (int r = 0; r < 16; ++r) s += __builtin_amdgcn_exp2f(p0[r] - mn) + __builtin_amdgcn_exp2f(p1[r] - mn);
                    l = l * __builtin_amdgcn_exp2f(m - mn) + s; m = mn;
                } }
            buf ^= 1;
        }
        const float ltot = swapsum(l);
        const float invl = (m > -1.0e29f) ? 1.0f / ltot : 0.f;
        const float mz = (m > -1.0e29f) ? m : 0.f;
        f32x16 o[2]; o[0] = f32x16{}; o[1] = f32x16{};
        LAS float* improw = imp + tok * IMP_S; float icarry = 0.f;
#pragma unroll
        for (int tt = 0; tt < 2; ++tt) { int it = tt; it = it > ntc - 1 ? ntc - 1 : it; tile_load(sg.t[tt], KC, VC, 64 * it + key, tid); }
        for (int ss = 0; ss < nss; ++ss) {
            LAS unsigned char* bp = kv + buf * SBUF;
            tile_store(bp, sg.t[0], tid); tile_store(bp + TILE_B, sg.t[1], tid); ATT_BAR();
            if (ss + 1 < nss) {
#pragma unroll
                for (int tt = 0; tt < 2; ++tt) { int it = 2 * (ss + 1) + tt; it = it > ntc - 1 ? ntc - 1 : it; tile_load(sg.t[tt], KC, VC, 64 * it + key, tid); } }
#pragma unroll
            for (int tt = 0; tt < 2; ++tt) { const int it = 2 * ss + tt;
                if (it < ntc) {
                    f32x16 p0, p1; const int dt = dq - 1024 * it;
                    const bool far = (t0 - 31 - 1024 * it - 1008) >= 1513;
                    if (far) { const float iv = cfar - mz;
#pragma unroll
                        for (int r = 0; r < 16; ++r) { p0[r] = iv; p1[r] = iv; }
                    } else {
#pragma unroll
                        for (int r = 0; r < 16; ++r) { const int da = dt - 16 * crow(r, 0), db = da - 512;
                            const int ia = da < -64 ? -64 : (da > 1599 ? 1599 : da), ib = db < -64 ? -64 : (db > 1599 ? 1599 : db);
                            p0[r] = lrow[ia] - mz; p1[r] = lrow[ib] - mz; }
                    }
                    qk(p0, p1, bp + tt * TILE_B + hi * 1024 + r32 * 16, qr);
#pragma unroll
                    for (int r = 0; r < 16; ++r) { p0[r] = __builtin_amdgcn_exp2f(p0[r]) * invl; p1[r] = __builtin_amdgcn_exp2f(p1[r]) * invl; }
                    if (!far) {
#pragma unroll
                        for (int r = 0; r < 16; ++r) { const int da = dt - 16 * crow(r, 0), db = da - 512; p0[r] = (da >= 0) ? p0[r] : 0.f; p1[r] = (db >= 0) ? p1[r] : 0.f; }
                    }
                    { float a0[4], l0[4], a1[4], l1[4], x0[4], x1[4];
#pragma unroll
                      for (int q = 0; q < 4; ++q) { a0[q] = quadsum((p0[4 * q] + p0[4 * q + 1]) + (p0[4 * q + 2] + p0[4 * q + 3])); l0[q] = quadsum(p0[4 * q + 3]);
                                                    a1[q] = quadsum((p1[4 * q] + p1[4 * q + 1]) + (p1[4 * q + 2] + p1[4 * q + 3])); l1[q] = quadsum(p1[4 * q + 3]); }
#pragma unroll
                      for (int q = 0; q < 4; ++q) { auto ra = __builtin_amdgcn_permlane32_swap(__float_as_uint(l0[q]), __float_as_uint(l0[q]), false, false); x0[q] = __uint_as_float(hi ? ra[0] : ra[1]);
                                                    auto rb = __builtin_amdgcn_permlane32_swap(__float_as_uint(l1[q]), __float_as_uint(l1[q]), false, false); x1[q] = __uint_as_float(hi ? rb[0] : rb[1]); }
                      if (h == 0) {
#pragma unroll
                          for (int q = 0; q < 4; ++q) { const float pv0 = hi ? x0[q] : (q ? x0[q ? q - 1 : 0] : icarry), pv1 = hi ? x1[q] : (q ? x1[q ? q - 1 : 0] : x0[3]);
                              improw[16 * it + 2 * q + hi] = a0[q] + pv0; improw[16 * it + 2 * q + hi + 8] = a1[q] + pv1; } }
                      icarry = x1[3]; }
                    pv(o, bp + tt * TILE_B + 8192 + trb, p0, p1);
                } }
            buf ^= 1;
        }
        yn_rows<true>(X.YN, o, g0, wsf, r32, hi, R0, g, lane);
    }
    asm volatile("s_waitcnt lgkmcnt(0)" ::: "memory");
    unsigned msk[4] = {0u, 0u, 0u, 0u};
    if (c >= 16) {
        const int tl = lane >> 3, part = lane & 7;
        const LAS float* ir = imp + (8 * wave + tl) * IMP_S + part * 16;
        unsigned v[16];
#pragma unroll
        for (int r = 0; r < 16; ++r) { const int j = part * 16 + r; const unsigned bits = __float_as_uint(ir[r]); v[r] = (j >= 1 && j <= c - 2) ? ((bits & ~127u) | (unsigned)(127 - j)) : 0u; }
        unsigned sm[4] = {0u, 0u, 0u, 0u};
        for (int itn = 0; itn < 13; ++itn) {
            unsigned mx = v[0];
#pragma unroll
            for (int r = 1; r < 16; ++r) mx = mx > v[r] ? mx : v[r];
            { unsigned o1 = (unsigned)__shfl_xor((int)mx, 1); mx = mx > o1 ? mx : o1; o1 = (unsigned)__shfl_xor((int)mx, 2); mx = mx > o1 ? mx : o1; o1 = (unsigned)__shfl_xor((int)mx, 4); mx = mx > o1 ? mx : o1; }
            const int j = 127 - (int)(mx & 127u); const unsigned bit = 1u << (j & 31); const int w = j >> 5;
            if (mx != 0u) { sm[0] |= (w == 0) ? bit : 0u; sm[1] |= (w == 1) ? bit : 0u; sm[2] |= (w == 2) ? bit : 0u; sm[3] |= (w == 3) ? bit : 0u; }
#pragma unroll
            for (int r = 0; r < 16; ++r) v[r] = (v[r] == mx) ? 0u : v[r];
        }
        sm[0] |= 1u;
        { const int j = c - 1; const unsigned bit = 1u << (j & 31); const int w = j >> 5; sm[0] |= (w == 0) ? bit : 0u; sm[1] |= (w == 1) ? bit : 0u; sm[2] |= (w == 2) ? bit : 0u; sm[3] |= (w == 3) ? bit : 0u; }
        { const int j = c; const unsigned bit = 1u << (j & 31); const int w = j >> 5; sm[0] |= (w == 0) ? bit : 0u; sm[1] |= (w == 1) ? bit : 0u; sm[2] |= (w == 2) ? bit : 0u; sm[3] |= (w == 3) ? bit : 0u; }
        if (part == 0) {
#pragma unroll
            for (int w = 0; w < 4; ++w) { selm[(8 * wave + tl) * 4 + w] = sm[w]; __hip_atomic_fetch_or(um + w, sm[w], __ATOMIC_RELAXED, __HIP_MEMORY_SCOPE_WORKGROUP); }
        }
        __syncthreads();
#pragma unroll
        for (int w = 0; w < 4; ++w) msk[w] = selm[tok * 4 + w];
    } else {
        msk[0] = (2u << c) - 1u;
        __syncthreads();
    }
    unsigned umr[4];
#pragma unroll
    for (int w = 0; w < 4; ++w) umr[w] = (c >= 16) ? (unsigned)__builtin_amdgcn_readfirstlane((int)um[w]) : ((w == 0) ? ((2u << c) - 1u) : 0u);
    {
        Soft st{NEGV, 0.f}; f32x16 o[2]; o[0] = f32x16{}; o[1] = f32x16{};
        const float cfar = lrow[1599];
        LAS unsigned char* blist = (LAS unsigned char*)(F.lds + A_BL);
        if (tid == 0) { int n = 0; for (int j = 0; j <= c; ++j) { const unsigned w = (j < 32) ? umr[0] : (j < 64) ? umr[1] : (j < 96) ? umr[2] : umr[3]; if ((w >> (j & 31)) & 1u) blist[n++] = (unsigned char)j; }
                        blist[160] = (unsigned char)n; blist[n] = blist[n - 1]; blist[n + 1] = blist[n - 1]; blist[n + 2] = blist[n - 1]; blist[n + 3] = blist[n - 1]; }
        __syncthreads();
        const int nb = blist[160], nss = (nb + 1) >> 1;
        Stage2 sh;
#define SEL_LOAD(SG, ss_) do { const int ja_ = blist[2 * (ss_)], jb_ = blist[2 * (ss_) + 1]; tile_load((SG).t[0], KS, VS, 64 * ja_ + key, tid); tile_load((SG).t[1], KS, VS, 64 * jb_ + key, tid); } while (0)
#define SEL_STEP(SG, ss_) do { LAS unsigned char* bp = kv + buf * SBUF; \
            tile_store(bp, (SG).t[0], tid); tile_store(bp + TILE_B, (SG).t[1], tid); ATT_BAR(); \
            if ((ss_) + 2 < nss) SEL_LOAD(SG, (ss_) + 2); \
            _Pragma("unroll") for (int tt = 0; tt < 2; ++tt) { const int bi = 2 * (ss_) + tt; \
                if (bi < nb) { const int j = blist[bi]; \
                    const unsigned mw = (j < 32) ? msk[0] : (j < 64) ? msk[1] : (j < 96) ? msk[2] : msk[3]; \
                    const bool sel = (mw >> (j & 31)) & 1u; \
                    if (__any(sel)) { const int cls = (j == c) ? CLS_PART : ((c - j >= 25) ? CLS_CONST : CLS_FULL); \
                        proc_tile(cls, bp + tt * TILE_B, qr, st, o, lrow, t - 64 * j, 0, 0x3fffffff, cfar, sel, wsf, r32, hi, trb); } } } \
            buf ^= 1; } while (0)
        SEL_LOAD(sg, 0); if (nss > 1) SEL_LOAD(sh, 1);
        for (int ss = 0; ss < nss; ss += 2) { SEL_STEP(sg, ss); if (ss + 1 < nss) SEL_STEP(sh, ss + 1); }
#undef SEL_LOAD
#undef SEL_STEP
        float lt; const float inv = soft_final_inv(st, lt);
#ifdef PROBE_SEL_TWICE
        if (rep_) yn_rows<false>(X.SCR, o, g1 * inv, wsf, r32, hi, R0 & 8191, g, lane); else
#endif
        yn_rows<true>(X.YN, o, g1 * inv, wsf, r32, hi, R0, g, lane);
    }
}

__device__ __forceinline__ void dil_unit(Frame& F, const Mix& X, int gi, int b, int s, int rest, int& buf) {
    using namespace att;
    const int tid = fresh_tid(), lane = tid & 63, wave = __builtin_amdgcn_readfirstlane(tid >> 6), r32 = lane & 31, hi = lane >> 5;
    LAS unsigned char* kv = F.lds + A_KV; LAS float* lutl = (LAS float*)(F.lds + A_LUT); LAS float* wsf = (LAS float*)(F.lds + A_WSF) + wave * 128;
    const int trb = ((lane >> 4) & 1) * 32 + (lane & 3) * 8 + (4 * hi + ((lane & 15) >> 2)) * 64;
    const int dil = 1 << (2 * gi), lg = 2 * gi, nch = (SEQ >> lg) >> 8, res = rest / nch, ch = rest % nch;
    const int hd = 4 * gi + s, N0 = 256 * ch, Nw = N0 + 32 * wave, nq = Nw + r32, key = tid >> 3;
    const int t = (nq << lg) + res;
    const size_t R = (size_t)b * SEQ + t;
    __syncthreads();
    lut_to_lds(F, tid, X.LUTD + hd * 320, 320);
    bf16x8 qr[4];
#pragma unroll
    for (int d0 = 0; d0 < 4; ++d0) qr[d0] = ldq(X.QD + R * 768 + hd * 64 + 16 * d0 + 8 * hi);
    const bf16* Kp = X.KD + (size_t)(b * 12 + hd) * SEQ * 64; const bf16* Vp = X.VD + (size_t)(b * 12 + hd) * SEQ * 64;
    const LAS float* lrow = lutl + LUT_PAD;
    __syncthreads();
    Soft st{NEGV, 0.f}; f32x16 o[2]; o[0] = f32x16{}; o[1] = f32x16{};
    Stage2 sg;
    const int it0 = (ch == 0) ? 2 : 0, nss = (6 - it0) >> 1;
#pragma unroll
    for (int tt = 0; tt < 2; ++tt) { const int kb = N0 - 128 + 64 * (it0 + tt); tile_load(sg.t[tt], Kp, Vp, (long)((kb + key) << lg) + res, tid); }
    for (int ss = 0; ss < nss; ++ss) {
        LAS unsigned char* bp = kv + buf * SBUF;
        tile_store(bp, sg.t[0], tid); tile_store(bp + TILE_B, sg.t[1], tid); ATT_BAR();
        if (ss + 1 < nss) {
#pragma unroll
            for (int tt = 0; tt < 2; ++tt) { const int kb = N0 - 128 + 64 * (it0 + 2 * (ss + 1) + tt); tile_load(sg.t[tt], Kp, Vp, (long)((kb + key) << lg) + res, tid); } }
#pragma unroll
        for (int tt = 0; tt < 2; ++tt) { const int kb = N0 - 128 + 64 * (it0 + 2 * ss + tt);
            const int dmin = Nw - kb - 63, dmax = Nw + 31 - kb;
            if (dmax >= 0 && dmin <= 128) { const int cls = (dmin >= 0 && dmax <= 128) ? CLS_FULL : CLS_PART;
                proc_tile(cls, bp + tt * TILE_B, qr, st, o, lrow, nq - kb, 0, 128, 0.f, true, wsf, r32, hi, trb); } }
        buf ^= 1;
    }
    float ltot; const float inv = soft_final_inv(st, ltot);
    const float lse = st.mref + __builtin_amdgcn_logf(ltot);
    if (gi != 0) {
        bf16* OD = X.OD + (size_t)(gi - 1) * M * 256; float* LS = X.LSE + (size_t)(gi - 1) * M * 4;
        if (hi == 0) { wsf[r32] = inv; LS[R * 4 + s] = lse; }
        asm volatile("s_waitcnt lgkmcnt(0)" ::: "memory");
#pragma unroll
        for (int r = 0; r < 16; ++r) { const int q = crow(r, hi); const float fr = wsf[q]; const size_t Rq = (size_t)b * SEQ + ((size_t)(Nw + q) << lg) + res;
            bf16* op = OD + Rq * 256 + s * 64 + (lane & 31);
            op[0] = (bf16)f2bf(o[0][r] * fr); op[32] = (bf16)f2bf(o[1][r] * fr); }
        asm volatile("s_waitcnt lgkmcnt(0)" ::: "memory");
    } else {
        const float l4 = X.LSE[R * 4 + s], l16 = X.LSE[(size_t)M * 4 + R * 4 + s];
        const float mx = fmaxf(lse, fmaxf(l4, l16));
        const float w1 = __builtin_amdgcn_exp2f(lse - mx), w4 = __builtin_amdgcn_exp2f(l4 - mx), w16 = __builtin_amdgcn_exp2f(l16 - mx), iw = 1.0f / (w1 + w4 + w16);
        if (hi == 0) { wsf[r32] = w1 * iw * inv; wsf[32 + r32] = w4 * iw; wsf[64 + r32] = w16 * iw; }
        asm volatile("s_waitcnt lgkmcnt(0)" ::: "memory");
#pragma unroll
        for (int r = 0; r < 16; ++r) { const int q = crow(r, hi); const float a1 = wsf[q], a4 = wsf[32 + q], a16 = wsf[64 + q]; const size_t Rq = (size_t)b * SEQ + Nw + q;
            const bf16* p4 = X.OD + Rq * 256 + s * 64 + (lane & 31); const bf16* p16 = p4 + (size_t)M * 256;
            bf16* op = X.YD + Rq * 256 + s * 64 + (lane & 31);
            const float v0 = o[0][r] * a1 + __uint_as_float((unsigned)p4[0] << 16) * a4 + __uint_as_float((unsigned)p16[0] << 16) * a16;
            const float v1 = o[1][r] * a1 + __uint_as_float((unsigned)p4[32] << 16) * a4 + __uint_as_float((unsigned)p16[32] << 16) * a16;
            op[0] = (bf16)f2bf(v0); op[32] = (bf16)f2bf(v1); }
        asm volatile("s_waitcnt lgkmcnt(0)" ::: "memory");
    }
}

__device__ __forceinline__ void cmp_unit(Frame& F, const Mix& X, int cu) {
    using namespace att;
    const int tid = fresh_tid(), lane = tid & 63, wave = __builtin_amdgcn_readfirstlane(tid >> 6), r32 = lane & 31, hi = lane >> 5;
    const int ts = cu >> 6, rb = cu & 63, plane = rb >> 4, i0 = (rb & 15) * 32;
    const bf16* src = X.PL + (size_t)ts * PLSZ + (size_t)plane * SEQ * 64;
    const bf16* W1 = ts ? X.WC1V : X.WC1K; const bf16* W2 = ts ? X.WC2V : X.WC2K; const float* cb = X.CB + ts * 256;
    bf16* dst = (ts ? X.VCMP : X.KCMP) + (size_t)plane * 512 * 64;
    LAS unsigned char* aimg = F.lds;
    LAS unsigned char* hid = F.lds + 69632;
    __syncthreads();
    for (int chn = tid; chn < 528 * 8; chn += NWAVES * 64) { const int tau = chn >> 3, c8 = chn & 7; int tk = 16 * i0 + tau; tk = tk > SEQ - 1 ? SEQ - 1 : tk;
        *(LAS v4u*)(aimg + tau * 128 + 16 * (tau >> 4) + c8 * 16) = *(const GAS v4u*)(src + (size_t)tk * 64 + c8 * 8); }
    __syncthreads();
    f32x16 acc = f32x16{};
    const LAS unsigned char* ap = aimg + r32 * 2064 + 16 * hi;
    const bf16* bp = W1 + ((size_t)wave * 128 * 64 + lane) * 8;
#pragma unroll 16
    for (int ks = 0; ks < 128; ++ks) {
        const int l = ks >> 2;
        const bf16x8 a = *(const LAS bf16x8*)(ap + 128 * l + 16 * (l >> 4) + 32 * (ks & 3));
        const bf16x8 bb = ldq(bp + (size_t)ks * 512);
        acc = __builtin_amdgcn_mfma_f32_32x32x16_bf16(a, bb, acc, 0, 0, 0);
    }
    { const int col = 32 * wave + r32; const float bias = cb[col];
#pragma unroll
      for (int r = 0; r < 16; ++r) { const float v = acc[r] + bias; const float hv = v * __builtin_amdgcn_rcpf(1.0f + __builtin_amdgcn_exp2f(-LOG2E * v));
          *(LAS unsigned short*)(hid + crow(r, hi) * 528 + col * 2) = (unsigned short)f2bf(hv); } }
    __syncthreads();
    if (wave < 2) {
        const int nt = wave;
        f32x16 o2 = f32x16{};
        const LAS unsigned char* hp = hid + r32 * 528 + 16 * hi; const bf16* b2 = W2 + (size_t)(32 * nt + r32) * 256 + 8 * hi;
#pragma unroll
        for (int k0 = 0; k0 < 256; k0 += 16) { const bf16x8 a = *(const LAS bf16x8*)(hp + k0 * 2); const bf16x8 bb = ldq(b2 + k0); o2 = __builtin_amdgcn_mfma_f32_32x32x16_bf16(a, bb, o2, 0, 0, 0); }
#pragma unroll
        for (int r = 0; r < 16; ++r) { const int i = i0 + crow(r, hi); dst[(size_t)i * 64 + 32 * nt + r32] = (bf16)f2bf(o2[r]); }
    }
}

#ifndef MK_N_LAUNCHES
#define MK_N_LAUNCHES 1
#endif
constexpr int N_PHASES = 13;
constexpr int N_LAUNCHES = MK_N_LAUNCHES;
struct Args { const float* in[22]; float* out; unsigned char* ws; int ph_lo, ph_hi, li, pad; };
__global__ void __launch_bounds__(NWAVES * 64, 2) mk_fwd(Args args) {
    extern __shared__ __attribute__((aligned(16))) unsigned char lds[];
    Frame F;
    F.lds = (LAS unsigned char*)lds;
    F.MISC = (volatile LAS unsigned*)(F.lds + MISC_OFF);
    F.G = gridDim.x; { const int bx = blockIdx.x; F.vcu = (F.G % 8 == 0) ? (bx % 8) * (F.G / 8) + bx / 8 : bx; }
    unsigned char* ws = args.ws;
    F.ctl = (gu32*)(ws + WS_CTL);
    In in;
    in.x = args.in[0]; in.f1_pre = args.in[1]; in.f1_wgu = args.in[2]; in.f1_wd = args.in[3]; in.f1_post = args.in[4]; in.mix_pre = args.in[5]; in.w_in = args.in[6];
    in.cpos_k = args.in[7]; in.cw1_k = args.in[8]; in.cw2_k = args.in[9]; in.cpos_v = args.in[10]; in.cw1_v = args.in[11]; in.cw2_v = args.in[12];
    in.w_bn = args.in[13]; in.w_bd = args.in[14]; in.w_out = args.in[15]; in.mix_post = args.in[16]; in.f2_pre = args.in[17]; in.f2_wgu = args.in[18]; in.f2_wd = args.in[19]; in.f2_post = args.in[20]; in.rel_bias = args.in[21];
    float* out = args.out;
    for (int u = threadIdx.x; u < (LDS_BYTES - LDSCTL_OFF) / 4; u += NWAVES * 64) ((LAS unsigned*)(F.lds + LDSCTL_OFF))[u] = 0u;
    __syncthreads();
    const bool use_bar = (args.ph_hi - args.ph_lo) > 1;
    XcdBarrier bar; bar.bar = (unsigned*)(F.ctl + CW_BAR) + args.li * XCD_BAR_WORDS; bar.x = 0; bar.st = nullptr;
    if (use_bar) bar = xcd_barrier_post((unsigned*)(F.ctl + CW_BAR) + args.li * XCD_BAR_WORDS, F.MISC + 8);
    const int lo = args.ph_lo, hi = args.ph_hi;
#define IN(k) (lo <= (k) && (k) < hi)
#define SEAM(k) do { if (IN(k) && IN((k) + 1)) xcd_barrier(bar); } while (0)
    bf16* XN = (bf16*)(ws + WS_XN); bf16* H = (bf16*)(ws + WS_H); bf16* Y = (bf16*)(ws + WS_Y); bf16* Y2P = (bf16*)(ws + WS_Y2P); bf16* MG = (bf16*)(ws + WS_MG);
    Mix X; X.QN = (bf16*)(ws + WS_QN); X.YN = (bf16*)(ws + WS_YN); X.SCR = (bf16*)(ws + WS_Y); F.nrep = args.pad; X.PL = (bf16*)(ws + WS_PL); X.QD = (bf16*)(ws + WS_QD); X.KD = (bf16*)(ws + WS_KD); X.VD = (bf16*)(ws + WS_VD); X.YD = (bf16*)(ws + WS_YD); X.OD = (bf16*)(ws + WS_OD); X.LSE = (float*)(ws + WS_LSE);
    X.KCMP = (bf16*)(ws + WS_KCMP); X.VCMP = (bf16*)(ws + WS_VCMP); X.GN = (const float*)(ws + WS_GN); X.LUTN = (const float*)(ws + WS_LUTN); X.LUTD = (const float*)(ws + WS_LUTD); X.CB = (const float*)(ws + WS_CB);
    X.WC1K = (const bf16*)(ws + WS_WC1K); X.WC1V = (const bf16*)(ws + WS_WC1V); X.WC2K = (const bf16*)(ws + WS_WC2K); X.WC2V = (const bf16*)(ws + WS_WC2V);
    bf16* GA = (bf16*)(ws + WS_GA); bf16* GB = (bf16*)(ws + WS_GB);

    if (IN(0)) { p0_prologue(F, in, ws); }
    SEAM(0);
    if (IN(1)) { pg8::Gemm g{XN, (const bf16*)(ws + WS_WGU1), M, 2 * FF, D}; pg8::StaticOrder S; S.init(M, 2 * FF, F.G, (int)blockIdx.x);
        pg8::EpiSwiGLU E{H, FF}; pg8::gemm_phase<pg8::EpiSwiGLU, pg8::StaticOrder, true, true>(F.lds + RING_OFF, g, S, E); }
    SEAM(1);
    if (IN(2)) { pg8::Gemm g{H, (const bf16*)(ws + WS_WD1), M, D, FF}; pg8::StaticOrder S; S.init(M, D, F.G, (int)blockIdx.x);
        pg8::EpiBf16 E{Y, D}; pg8::gemm_phase<pg8::EpiBf16, pg8::StaticOrder, true, true>(F.lds + RING_OFF, g, S, E); }
    SEAM(2);
    if (IN(3)) { row_pass<false, true>(F, Y, in.x, out, 0.5f, in.f1_post, in.mix_pre, XN); }
    SEAM(3);
    if (IN(4)) { pg8::Gemm g{XN, (const bf16*)(ws + WS_WIN), M, NPROJ, D}; pg8::StaticOrder S; S.init(M, NPROJ, F.G, (int)blockIdx.x);
        pg8::EpiProj E{X.QN, X.PL, X.QD, X.KD, X.VD, GA, GB, (float*)(ws + WS_GN), QSCALE};
        pg8::gemm_phase<pg8::EpiProj, pg8::StaticOrder, true, true>(F.lds + RING_OFF, g, S, E); }
    SEAM(4);
    if (IN(5)) { int buf = 0;
        for (int cu = F.vcu; cu < 128; cu += F.G) cmp_unit(F, X, cu);
#pragma unroll 1
        for (int w = F.vcu; w < 512; w += F.G) { const int gi = 2 - (w >> 8), du = w & 255; dil_unit(F, X, gi, du >> 7, (du >> 5) & 3, du & 31, buf); }
        __syncthreads(); }
    SEAM(5);
    if (IN(6)) { int buf = 0;
        for (int p = F.vcu; p < 256; p += F.G) { const int b = p >> 7, g = (p >> 6) & 1, cc = p & 63;
#pragma unroll 1
            for (int k = 0; k < 2; ++k) nsa_unit(F, X, b, g, k ? cc : 127 - cc, buf); }
#pragma unroll 1
        for (int du = F.vcu; du < 256; du += F.G) dil_unit(F, X, 0, du >> 7, (du >> 5) & 3, du & 31, buf);
        __syncthreads(); }
    SEAM(6);
    if (IN(7)) {
        { pg8::Gemm g{X.YN, (const bf16*)(ws + WS_WBN), M, D, 512}; pg8::StaticOrder S; S.init(M, D, F.G, (int)blockIdx.x);
          pg8::EpiBranchA E{GA, Y2P}; pg8::gemm_phase<pg8::EpiBranchA, pg8::StaticOrder, true, true>(F.lds + RING_OFF, g, S, E); }
        { pg8::Gemm g{X.YD, (const bf16*)(ws + WS_WBD), M, D, 256}; pg8::StaticOrder S; S.init(M, D, F.G, (int)blockIdx.x);
          pg8::EpiBranchB E{GB, Y2P, MG}; pg8::gemm_phase<pg8::EpiBranchB, pg8::StaticOrder, true, true>(F.lds + RING_OFF, g, S, E); }
    }
    SEAM(7);
    if (IN(8)) { pg8::Gemm g{MG, (const bf16*)(ws + WS_WOUT), M, D, D}; pg8::StaticOrder S; S.init(M, D, F.G, (int)blockIdx.x);
        pg8::EpiBf16 E{Y, D}; pg8::gemm_phase<pg8::EpiBf16, pg8::StaticOrder, true, true>(F.lds + RING_OFF, g, S, E); }
    SEAM(8);
    if (IN(9)) { row_pass<true, true>(F, Y, out, ws + WS_X2, 1.0f, in.mix_post, in.f2_pre, XN); }
    SEAM(9);
    if (IN(10)) { pg8::Gemm g{XN, (const bf16*)(ws + WS_WGU2), M, 2 * FF, D}; pg8::StaticOrder S; S.init(M, 2 * FF, F.G, (int)blockIdx.x);
        pg8::EpiSwiGLU E{H, FF}; pg8::gemm_phase<pg8::EpiSwiGLU, pg8::StaticOrder, true, true>(F.lds + RING_OFF, g, S, E); }
    SEAM(10);
    if (IN(11)) { pg8::Gemm g{H, (const bf16*)(ws + WS_WD2), M, D, FF}; pg8::StaticOrder S; S.init(M, D, F.G, (int)blockIdx.x);
        pg8::EpiBf16 E{Y, D}; pg8::gemm_phase<pg8::EpiBf16, pg8::StaticOrder, true, true>(F.lds + RING_OFF, g, S, E); }
    SEAM(11);
    if (IN(12)) { row_pass<true, false>(F, Y, ws + WS_X2, out, 0.5f, in.f2_post, nullptr, nullptr); }
#undef IN
#undef SEAM
}

extern "C" void kernel_launch(void* const* d_in, const int* in_sizes, int n_in, void* d_out, int out_size, void* d_ws, size_t ws_size, hipStream_t stream) {
    static int grid = 0;
    if (grid == 0) {
        if (n_in != 22 || in_sizes[0] != M * D || out_size != M * D || ws_size < WS_END) { fprintf(stderr, "kernel_launch: unexpected shapes (n_in %d, in0 %d, out %d, ws %zu); nothing launched\n", n_in, n_in > 0 ? in_sizes[0] : -1, out_size, ws_size); grid = -1; return; }
        int dev = 0, cus = 0, per_cu = 0;
        if (hipGetDevice(&dev) != hipSuccess || hipDeviceGetAttribute(&cus, hipDeviceAttributeMultiprocessorCount, dev) != hipSuccess) { grid = -1; return; }
        if (hipFuncSetAttribute((const void*)mk_fwd, hipFuncAttributeMaxDynamicSharedMemorySize, LDS_BYTES) != hipSuccess) { fprintf(stderr, "kernel_launch: hipFuncSetAttribute failed\n"); grid = -1; return; }
        if (hipOccupancyMaxActiveBlocksPerMultiprocessor(&per_cu, (const void*)mk_fwd, NWAVES * 64, LDS_BYTES) != hipSuccess || per_cu < 1)
            fprintf(stderr, "kernel_launch: note: occupancy query reports %d workgroups per CU\n", per_cu);
        (void)hipGetLastError();
        grid = cus;
    }
    if (grid < 0) return;
    if (hipMemsetAsync((char*)d_ws + WS_CTL, 0, CTL_ZERO_BYTES, stream) != hipSuccess) return;
    Args a{};
    for (int i = 0; i < 22; ++i) a.in[i] = (const float*)d_in[i];
    a.out = (float*)d_out; a.ws = (unsigned char*)d_ws; a.pad = 2;
#ifdef PROBE_RANGES
    { static const int rg[][2] = PROBE_RANGES;
      for (int li = 0; li < (int)(sizeof(rg) / sizeof(rg[0])); ++li) { a.ph_lo = rg[li][0]; a.ph_hi = rg[li][1]; a.li = li; hipLaunchKernelGGL(mk_fwd, dim3(grid), dim3(NWAVES * 64), LDS_BYTES, stream, a); } }
#else
    if (N_LAUNCHES == 1) { a.ph_lo = 0; a.ph_hi = N_PHASES; a.li = 0; hipLaunchKernelGGL(mk_fwd, dim3(grid), dim3(NWAVES * 64), LDS_BYTES, stream, a); }
    else { for (int li = 0; li < N_PHASES; ++li) { a.ph_lo = li; a.ph_hi = li + 1; a.li = 0; hipLaunchKernelGGL(mk_fwd, dim3(grid), dim3(NWAVES * 64), LDS_BYTES, stream, a); } }
#endif
}
```

```cpp
#include <hip/hip_runtime.h>
#include <cstdio>
#include <cstdint>
namespace pg8 {
#define PG8_LAS __attribute__((address_space(3)))
typedef unsigned short bf16_t;
typedef short bf16x8 __attribute__((ext_vector_type(8)));
typedef float f32x4 __attribute__((ext_vector_type(4)));
typedef unsigned u32x4 __attribute__((ext_vector_type(4)));
constexpr int BM = 256, BK = 64, HALF = 128, HTB = HALF * BK * 2  , STAGE_BYTES = 8 * HTB, NXCD = 8, WGM = 8;

__host__ __device__ __forceinline__ int lds_byte(int r, int c) { const int st = (r >> 4) * 2 + (c >> 5), rr = r & 15, cc = c & 31, ob = rr * 64 + cc * 2; return st * 1024 + (ob ^ (((ob >> 9) & 1) << 5)); }
__host__ __device__ __forceinline__ void stage_rc(int b, int& R, int& C) { const int st = b / 1024, sb = b % 1024, swz = sb ^ (((sb >> 9) & 1) << 5); R = (st >> 1) * 16 + swz / 64; C = (st & 1) * 32 + (swz % 64) / 2; }
__host__ __device__ __forceinline__ int perm32(int rho) { const int n = rho >> 4, i = rho & 15; return 8 * (i >> 2) + 4 * n + (i & 3); }

struct Unit { int pm, pn; };
struct Gemm { const bf16_t* A; const bf16_t* Bt; int M, N, K; };

struct StaticOrder {
    int nM, nN, nwg, G, c;
    __host__ __device__ void init(int M, int N, int G_, int c_) { nM = M / BM; nN = N / BM; nwg = nM * nN; G = G_; c = c_; }
    __host__ __device__ bool next(int i, Unit& u) const {
        const long L = (long)i * G + c; if (L >= nwg) return false;
        int wgid = (int)L; { const int q = nwg / NXCD, r = nwg % NXCD, xcd = wgid % NXCD, off = wgid / NXCD; wgid = (xcd < r ? xcd * (q + 1) : r * (q + 1) + (xcd - r) * q) + off; }
        const int nig = WGM * nN, gid = wgid / nig, fm = gid * WGM, gsz = (nM - fm) < WGM ? (nM - fm) : WGM;
        u.pm = fm + ((wgid % nig) % gsz); u.pn = (wgid % nig) / gsz; return true;
    }
    __device__ __forceinline__ void a_ready(const Unit&) const {}
    __device__ __forceinline__ void done(const Unit&) const {}
};

__device__ __forceinline__ unsigned cvt_pk_bf16(float lo, float hi) { unsigned r; asm volatile("v_cvt_pk_bf16_f32 %0, %1, %2" : "=v"(r) : "v"(lo), "v"(hi)); return r; }
typedef float f32x2 __attribute__((ext_vector_type(2)));
__device__ __forceinline__ float sigmoid_f(float v) { return __builtin_amdgcn_rcpf(1.0f + __builtin_amdgcn_exp2f(-1.4426950408889634f * v)); }
__device__ __forceinline__ float bf_lo(unsigned w) { return __uint_as_float(w << 16); }
__device__ __forceinline__ float bf_hi(unsigned w) { return __uint_as_float(w & 0xffff0000u); }

struct EpiSwiGLU {
    static constexpr bool PERM = true, AFTER_DRAIN = false;
    bf16_t* H; int ldh;
    __device__ __forceinline__ void operator()(const f32x4 (&acc)[2][2][4][2], const Unit& u, int wr, int wc, int fr, int fq) const {
        const int row0 = u.pm * BM + wr * 64 + fr, col0 = u.pn * HALF + wc * 32 + 8 * fq;
#pragma unroll
        for (int ai = 0; ai < 2; ++ai)
#pragma unroll
            for (int m = 0; m < 4; ++m) { bf16_t* rowp = H + (size_t)(row0 + ai * HALF + m * 16) * ldh + col0;
                const f32x4 g0 = acc[ai][0][m][0], g1 = acc[ai][0][m][1], u0 = acc[ai][1][m][0], u1 = acc[ai][1][m][1];
                float h[8];
#pragma unroll
                for (int i = 0; i < 4; ++i) { h[i] = g0[i] * sigmoid_f(g0[i]) * u0[i]; h[4 + i] = g1[i] * sigmoid_f(g1[i]) * u1[i]; }
                u32x4 w; w.x = cvt_pk_bf16(h[0], h[1]); w.y = cvt_pk_bf16(h[2], h[3]); w.z = cvt_pk_bf16(h[4], h[5]); w.w = cvt_pk_bf16(h[6], h[7]);
                *(u32x4*)rowp = w; }
    }
};
struct EpiF32 {
    static constexpr bool PERM = true, AFTER_DRAIN = false;
    float* Y; int ldc;
    __device__ __forceinline__ void operator()(const f32x4 (&acc)[2][2][4][2], const Unit& u, int wr, int wc, int fr, int fq) const {
        const int row0 = u.pm * BM + wr * 64 + fr, col0 = u.pn * BM + wc * 32 + 8 * fq;
#pragma unroll
        for (int ai = 0; ai < 2; ++ai)
#pragma unroll
            for (int m = 0; m < 4; ++m) { float* rowp = Y + (size_t)(row0 + ai * HALF + m * 16) * ldc + col0;
#pragma unroll
                for (int bj = 0; bj < 2; ++bj) { *(f32x4*)(rowp + bj * HALF) = acc[ai][bj][m][0]; *(f32x4*)(rowp + bj * HALF + 4) = acc[ai][bj][m][1]; } }
    }
};
struct EpiBf16 {
    static constexpr bool PERM = true, AFTER_DRAIN = false;
    bf16_t* Y; int ldc;
    __device__ __forceinline__ void operator()(const f32x4 (&acc)[2][2][4][2], const Unit& u, int wr, int wc, int fr, int fq) const {
        const int row0 = u.pm * BM + wr * 64 + fr, col0 = u.pn * BM + wc * 32 + 8 * fq;
#pragma unroll
        for (int ai = 0; ai < 2; ++ai)
#pragma unroll
            for (int m = 0; m < 4; ++m) { bf16_t* rowp = Y + (size_t)(row0 + ai * HALF + m * 16) * ldc + col0;
#pragma unroll
                for (int bj = 0; bj < 2; ++bj) { const f32x4 a0 = acc[ai][bj][m][0], a1 = acc[ai][bj][m][1];
                    u32x4 w; w.x = cvt_pk_bf16(a0[0], a0[1]); w.y = cvt_pk_bf16(a0[2], a0[3]); w.z = cvt_pk_bf16(a1[0], a1[1]); w.w = cvt_pk_bf16(a1[2], a1[3]);
                    *(u32x4*)(rowp + bj * HALF) = w; } }
    }
};
struct EpiBranchA {
    static constexpr bool PERM = true, AFTER_DRAIN = false;
    const bf16_t* G; bf16_t* Y;
    __device__ __forceinline__ void operator()(const f32x4 (&acc)[2][2][4][2], const Unit& u, int wr, int wc, int fr, int fq) const {
        const int row0 = u.pm * BM + wr * 64 + fr, col0 = u.pn * BM + wc * 32 + 8 * fq;
#pragma unroll
        for (int ai = 0; ai < 2; ++ai)
#pragma unroll
            for (int m = 0; m < 4; ++m) { const size_t off = (size_t)(row0 + ai * HALF + m * 16) * 1024 + col0;
#pragma unroll
                for (int bj = 0; bj < 2; ++bj) { const u32x4 g = *(const u32x4*)(G + off + bj * HALF); const f32x4 a0 = acc[ai][bj][m][0], a1 = acc[ai][bj][m][1];
                    u32x4 w; w.x = cvt_pk_bf16(a0[0] * bf_lo(g.x), a0[1] * bf_hi(g.x)); w.y = cvt_pk_bf16(a0[2] * bf_lo(g.y), a0[3] * bf_hi(g.y));
                    w.z = cvt_pk_bf16(a1[0] * bf_lo(g.z), a1[1] * bf_hi(g.z)); w.w = cvt_pk_bf16(a1[2] * bf_lo(g.w), a1[3] * bf_hi(g.w));
                    *(u32x4*)(Y + off + bj * HALF) = w; } }
    }
};
struct EpiBranchB {
    static constexpr bool PERM = true, AFTER_DRAIN = false;
    const bf16_t* G; const bf16_t* Y; bf16_t* O;
    __device__ __forceinline__ void operator()(const f32x4 (&acc)[2][2][4][2], const Unit& u, int wr, int wc, int fr, int fq) const {
        const int row0 = u.pm * BM + wr * 64 + fr, col0 = u.pn * BM + wc * 32 + 8 * fq;
#pragma unroll
        for (int ai = 0; ai < 2; ++ai)
#pragma unroll
            for (int m = 0; m < 4; ++m) { const size_t off = (size_t)(row0 + ai * HALF + m * 16) * 1024 + col0;
#pragma unroll
                for (int bj = 0; bj < 2; ++bj) { const u32x4 g = *(const u32x4*)(G + off + bj * HALF), y = *(const u32x4*)(Y + off + bj * HALF); const f32x4 a0 = acc[ai][bj][m][0], a1 = acc[ai][bj][m][1];
                    u32x4 w; w.x = cvt_pk_bf16(bf_lo(y.x) + a0[0] * bf_lo(g.x), bf_hi(y.x) + a0[1] * bf_hi(g.x)); w.y = cvt_pk_bf16(bf_lo(y.y) + a0[2] * bf_lo(g.y), bf_hi(y.y) + a0[3] * bf_hi(g.y));
                    w.z = cvt_pk_bf16(bf_lo(y.z) + a1[0] * bf_lo(g.z), bf_hi(y.z) + a1[1] * bf_hi(g.z)); w.w = cvt_pk_bf16(bf_lo(y.w) + a1[2] * bf_lo(g.w), bf_hi(y.w) + a1[3] * bf_hi(g.w));
                    *(u32x4*)(O + off + bj * HALF) = w; } }
    }
};
struct EpiProj {
    static constexpr bool PERM = true, AFTER_DRAIN = false;
    bf16_t *QN, *PL, *QD, *KD, *VD, *GA, *GB; float* GN; float qscale;
    __device__ __forceinline__ void operator()(const f32x4 (&acc)[2][2][4][2], const Unit& u, int wr, int wc, int fr, int fq) const {
        const int sub = (wc & 1) * 32 + 8 * fq;
#pragma unroll
        for (int bj = 0; bj < 2; ++bj) {
            const int hidx = __builtin_amdgcn_readfirstlane(u.pn * 4 + bj * 2 + (wc >> 1));
            bf16_t* base = nullptr; long pitch = 0, bstride = 0; int mode = 0;
            if (hidx < 8) { base = QN + hidx * 64; pitch = 512; bstride = 8192L * 512; mode = 1; }
            else if (hidx < 20) { const int ti = (hidx - 8) >> 1, g = (hidx - 8) & 1; base = PL + (size_t)ti * (4u * 8192u * 64u) + (size_t)g * (8192u * 64u); pitch = 64; bstride = 2L * 8192 * 64; mode = 0; }
            else if (hidx < 32) { base = QD + (hidx - 20) * 64; pitch = 768; bstride = 8192L * 768; mode = 1; }
            else if (hidx < 44) { base = KD + (size_t)(hidx - 32) * (8192u * 64u); pitch = 64; bstride = 12L * 8192 * 64; mode = 0; }
            else if (hidx < 56) { base = VD + (size_t)(hidx - 44) * (8192u * 64u); pitch = 64; bstride = 12L * 8192 * 64; mode = 0; }
            else if (hidx < 72) { base = GA + (hidx - 56) * 64; pitch = 1024; bstride = 8192L * 1024; mode = 2; }
            else if (hidx < 88) { base = GB + (hidx - 72) * 64; pitch = 1024; bstride = 8192L * 1024; mode = 2; }
            else if (hidx == 88) mode = 3; else mode = 4;
            if (mode == 4) continue;
#pragma unroll
            for (int ai = 0; ai < 2; ++ai)
#pragma unroll
                for (int m = 0; m < 4; ++m) { const int R = u.pm * BM + ai * HALF + wr * 64 + m * 16 + fr, b = R >> 13, t = R & 8191;
                    f32x4 v0 = acc[ai][bj][m][0], v1 = acc[ai][bj][m][1];
                    if (mode == 3) { if (sub < 24) { float* p = GN + (size_t)R * 32 + sub;
#pragma unroll
                            for (int i = 0; i < 4; ++i) { v0[i] = sigmoid_f(v0[i]); v1[i] = sigmoid_f(v1[i]); }
                            *(f32x4*)p = v0; *(f32x4*)(p + 4) = v1; } }
                    else { if (mode == 1) { v0 = v0 * qscale; v1 = v1 * qscale; }
                        if (mode == 2) {
#pragma unroll
                            for (int i = 0; i < 4; ++i) { v0[i] = sigmoid_f(v0[i]); v1[i] = sigmoid_f(v1[i]); } }
                        u32x4 w; w.x = cvt_pk_bf16(v0[0], v0[1]); w.y = cvt_pk_bf16(v0[2], v0[3]); w.z = cvt_pk_bf16(v1[0], v1[1]); w.w = cvt_pk_bf16(v1[2], v1[3]);
                        *(u32x4*)(base + (size_t)b * bstride + (size_t)t * pitch + sub) = w; } }
        }
    }
};
template <class Epi, class Sched, bool ALIGN_EPI = false, bool SP2 = false>
__device__ __forceinline__ void gemm_phase(PG8_LAS unsigned char* lds, const Gemm g, const Sched& S, const Epi& E) {
    const int tid = threadIdx.x, wid = __builtin_amdgcn_readfirstlane(tid >> 6), lane = tid & 63, wr = wid >> 2, wc = wid & 3, fr = lane & 15, fq = lane >> 4;
    const int K = g.K, nt = K / BK;
    unsigned voffA[2], voffB[2];
#pragma unroll
    for (int i = 0; i < 2; ++i) { int R, C; stage_rc(tid * 16 + i * 8192, R, C); const int Rb = Epi::PERM ? ((R & ~31) + perm32(R & 31)) : R;
        voffA[i] = (unsigned)(R * K + C) * 2u; voffB[i] = (unsigned)(Rb * K + C) * 2u; }
    const size_t kstep = (size_t)(BK * 2);
    const size_t hstep = (size_t)HALF * K * 2;
    const size_t tstep = 2 * hstep;
    const unsigned ldsw = (unsigned)wid * 1024u;
    const int aoff = lds_byte(wr * 64 + fr, fq * 8), boff = lds_byte(wc * 32 + fr, fq * 8);
#define PG8_SA(b, h) (((b) * 2 + (h)) * HTB)
#define PG8_SB(b, h) ((4 + (b) * 2 + (h)) * HTB)
#define PG8_STAGE(bufoff, gbase, voff) do { _Pragma("unroll") for (int _i = 0; _i < 2; ++_i) \
        __builtin_amdgcn_global_load_lds((const unsigned*)((const char*)(gbase) + (voff)[_i]), (PG8_LAS unsigned*)(lds + (bufoff) + ldsw + _i * 8192), 16, 0, 0); } while (0)
#define PG8_LDA(dst, b, h) do { _Pragma("unroll") for (int m = 0; m < 4; ++m) _Pragma("unroll") for (int k = 0; k < 2; ++k) dst[m][k] = *(const PG8_LAS bf16x8*)(lds + PG8_SA(b, h) + aoff + m * 2048 + k * 1024); } while (0)
#define PG8_LDB(dst, b, h) do { _Pragma("unroll") for (int n = 0; n < 2; ++n) _Pragma("unroll") for (int k = 0; k < 2; ++k) dst[n][k] = *(const PG8_LAS bf16x8*)(lds + PG8_SB(b, h) + boff + n * 2048 + k * 1024); } while (0)
#define PG8_MMA(ai, bj, At, Bt) do { __builtin_amdgcn_s_setprio(1); _Pragma("unroll") for (int m = 0; m < 4; ++m) _Pragma("unroll") for (int n = 0; n < 2; ++n) _Pragma("unroll") for (int k = 0; k < 2; ++k) \
        acc[ai][bj][m][n] = __builtin_amdgcn_mfma_f32_16x16x32_bf16(Bt[n][k], At[m][k], acc[ai][bj][m][n], 0, 0, 0); __builtin_amdgcn_s_setprio(0); } while (0)
#define PG8_WAIT_V(n) asm volatile("s_waitcnt vmcnt(" #n ")" ::: "memory")
#define PG8_WAIT_L(n) asm volatile("s_waitcnt lgkmcnt(" #n ")" ::: "memory")
#define PG8_BAR __builtin_amdgcn_s_barrier()
#define PG8_SCHED __builtin_amdgcn_sched_barrier(0)
    Unit cur, nxt; int ui = 0;
    if (!S.next(0, cur)) return;
    f32x4 acc[2][2][4][2];
#pragma unroll
    for (int a = 0; a < 2; ++a)
#pragma unroll
        for (int b = 0; b < 2; ++b)
#pragma unroll
            for (int m = 0; m < 4; ++m)
#pragma unroll
                for (int n = 0; n < 2; ++n) acc[a][b][m][n] = (f32x4){0.f, 0.f, 0.f, 0.f};
    bf16x8 At[4][2], B0[2][2], B1[2][2];
    const char* cA = (const char*)g.A + (size_t)cur.pm * tstep; const char* cB = (const char*)g.Bt + (size_t)cur.pn * tstep;
    S.a_ready(cur);
    if constexpr (SP2) {
        PG8_STAGE(PG8_SB(0, 0), cB, voffB); PG8_STAGE(PG8_SB(0, 1), cB + hstep, voffB); PG8_STAGE(PG8_SA(0, 0), cA, voffA); PG8_STAGE(PG8_SA(0, 1), cA + hstep, voffA);
        if (wr == 1) PG8_BAR;
        PG8_WAIT_V(2); PG8_BAR;
        PG8_STAGE(PG8_SB(1, 0), cB + kstep, voffB); PG8_STAGE(PG8_SA(1, 0), cA + kstep, voffA); PG8_STAGE(PG8_SB(1, 1), cB + hstep + kstep, voffB);
        PG8_WAIT_V(6); PG8_BAR;
    } else {
        PG8_STAGE(PG8_SB(0, 0), cB, voffB); PG8_STAGE(PG8_SA(0, 0), cA, voffA); PG8_STAGE(PG8_SB(0, 1), cB + hstep, voffB); PG8_STAGE(PG8_SA(0, 1), cA + hstep, voffA);
        if (wr == 1) PG8_BAR;
        PG8_WAIT_V(4); PG8_BAR;
        PG8_STAGE(PG8_SB(1, 0), cB + kstep, voffB); PG8_STAGE(PG8_SA(1, 0), cA + kstep, voffA); PG8_STAGE(PG8_SB(1, 1), cB + hstep + kstep, voffB);
        PG8_WAIT_V(6); PG8_BAR;
    }
    for (;;) {
        const bool has_next = S.next(ui + 1, nxt);
        const char* nA = has_next ? (const char*)g.A + (size_t)nxt.pm * tstep : cA; const char* nB = has_next ? (const char*)g.Bt + (size_t)nxt.pn * tstep : cB;
        for (int t = 0; t < nt; t += 2) {
            const bool last = (t == nt - 2);
            const char* a1 = cA + (size_t)(t + 1) * kstep;
            const char* a2 = last ? nA : cA + (size_t)(t + 2) * kstep; const char* b2 = last ? nB : cB + (size_t)(t + 2) * kstep;
            const char* a3 = a2 + kstep; const char* b3 = b2 + kstep;
            if (last && has_next) S.a_ready(nxt);
            if constexpr (SP2) {
            PG8_LDB(B0, 0, 0); PG8_LDB(B1, 0, 1); PG8_SCHED; PG8_LDA(At, 0, 0); PG8_STAGE(PG8_SA(1, 1), a1 + hstep, voffA);
            PG8_WAIT_V(8); PG8_WAIT_L(0); PG8_BAR; PG8_MMA(0, 0, At, B0); PG8_MMA(0, 1, At, B1); PG8_BAR; PG8_SCHED;
            PG8_LDA(At, 0, 1); PG8_STAGE(PG8_SB(0, 0), b2, voffB); PG8_STAGE(PG8_SB(0, 1), b2 + hstep, voffB); PG8_STAGE(PG8_SA(0, 0), a2, voffA);
            PG8_WAIT_V(8); PG8_WAIT_L(0); PG8_BAR; PG8_MMA(1, 0, At, B0); PG8_MMA(1, 1, At, B1); PG8_BAR; PG8_SCHED;
            PG8_LDB(B0, 1, 0); PG8_LDB(B1, 1, 1); PG8_SCHED; PG8_LDA(At, 1, 0); PG8_STAGE(PG8_SA(0, 1), a2 + hstep, voffA);
            PG8_WAIT_V(8); PG8_WAIT_L(0); PG8_BAR; PG8_MMA(0, 0, At, B0); PG8_MMA(0, 1, At, B1); PG8_BAR; PG8_SCHED;
            PG8_LDA(At, 1, 1); PG8_STAGE(PG8_SB(1, 0), b3, voffB); PG8_STAGE(PG8_SB(1, 1), b3 + hstep, voffB); PG8_STAGE(PG8_SA(1, 0), a3, voffA);
            PG8_WAIT_V(8); PG8_WAIT_L(0); PG8_BAR; PG8_MMA(1, 0, At, B0); PG8_MMA(1, 1, At, B1); PG8_BAR; PG8_SCHED;
            } else {
            PG8_LDB(B0, 0, 0); PG8_SCHED; PG8_LDA(At, 0, 0); PG8_STAGE(PG8_SA(1, 1), a1 + hstep, voffA);
            PG8_WAIT_L(8); PG8_BAR; PG8_WAIT_L(0); PG8_MMA(0, 0, At, B0); PG8_BAR; PG8_SCHED;
            PG8_LDB(B1, 0, 1); PG8_STAGE(PG8_SB(0, 0), b2, voffB);
            PG8_BAR; PG8_WAIT_L(0); PG8_MMA(0, 1, At, B1); PG8_BAR;
            PG8_LDA(At, 0, 1); PG8_STAGE(PG8_SA(0, 0), a2, voffA);
            PG8_BAR; PG8_WAIT_L(0); PG8_MMA(1, 0, At, B0); PG8_BAR; PG8_SCHED;
            PG8_STAGE(PG8_SB(0, 1), b2 + hstep, voffB);
            PG8_WAIT_V(6); PG8_BAR; PG8_MMA(1, 1, At, B1); PG8_BAR;
            PG8_LDB(B0, 1, 0); PG8_SCHED; PG8_LDA(At, 1, 0); PG8_STAGE(PG8_SA(0, 1), a2 + hstep, voffA);
            PG8_WAIT_L(8); PG8_BAR; PG8_WAIT_L(0); PG8_MMA(0, 0, At, B0); PG8_BAR; PG8_SCHED;
            PG8_LDB(B1, 1, 1); PG8_STAGE(PG8_SB(1, 0), b3, voffB);
            PG8_BAR; PG8_WAIT_L(0); PG8_MMA(0, 1, At, B1); PG8_BAR;
            PG8_LDA(At, 1, 1); PG8_STAGE(PG8_SA(1, 0), a3, voffA);
            PG8_BAR; PG8_WAIT_L(0); PG8_MMA(1, 0, At, B0); PG8_BAR; PG8_SCHED;
            PG8_STAGE(PG8_SB(1, 1), b3 + hstep, voffB);
            PG8_WAIT_V(6); PG8_BAR; PG8_MMA(1, 1, At, B1); PG8_BAR;
            }
        }
        if constexpr (ALIGN_EPI) { if (wr == 0) PG8_BAR; }
        if constexpr (!Epi::AFTER_DRAIN) { E(acc, cur, wr, wc, fr, fq); S.done(cur); }
        if (!has_next) break;
#pragma unroll
        for (int a = 0; a < 2; ++a)
#pragma unroll
            for (int b = 0; b < 2; ++b)
#pragma unroll
                for (int m = 0; m < 4; ++m)
#pragma unroll
                    for (int n = 0; n < 2; ++n) acc[a][b][m][n] = (f32x4){0.f, 0.f, 0.f, 0.f};
        cur = nxt; cA = nA; cB = nB; ++ui;
        if constexpr (ALIGN_EPI) { if (wr == 1) PG8_BAR; }
    }
    PG8_WAIT_V(0);
    if constexpr (!ALIGN_EPI) { if (wr == 0) PG8_BAR; }
    PG8_BAR;
    if constexpr (Epi::AFTER_DRAIN) { E.fused(acc, cur, wr, wc, fr, fq, lds, wid, lane); S.done(cur); }
#undef PG8_SA
#undef PG8_SB
#undef PG8_STAGE
#undef PG8_LDA
#undef PG8_LDB
#undef PG8_MMA
#undef PG8_WAIT_V
#undef PG8_WAIT_L
#undef PG8_BAR
#undef PG8_SCHED
}
}
#define GAS __attribute__((address_space(1)))
#define LAS __attribute__((address_space(3)))
typedef unsigned short bf16;
typedef unsigned v4u __attribute__((ext_vector_type(4)));
typedef float f32x4 __attribute__((ext_vector_type(4)));
typedef short bf16x8 __attribute__((ext_vector_type(8)));
typedef GAS unsigned gu32;
typedef GAS unsigned long long gu64;
#define RLX_AGENT __ATOMIC_RELAXED, __HIP_MEMORY_SCOPE_AGENT
#define LDS_WAIT() asm volatile("s_waitcnt lgkmcnt(0)" ::: "memory")
#define VM_WAIT() asm volatile("s_waitcnt vmcnt(0)" ::: "memory")
__device__ __forceinline__ unsigned long long rt() { return __builtin_amdgcn_s_memrealtime(); }
__device__ __forceinline__ unsigned f2bf(float f) { unsigned u = __builtin_bit_cast(unsigned, f); return (u + 0x7fffu + ((u >> 16) & 1u)) >> 16; }
__device__ __forceinline__ unsigned pk2(float lo, float hi) { return f2bf(lo) | (f2bf(hi) << 16); }

#define XB_TMO      128
#define XB_XCNT(j)  (256  + 64 * (j))
#define XB_XSUB(j)  (1280 + 64 * (j))
#define XB_XGEN(j)  (2304 + 64 * (j))
#define XB_TOP      3328
#define XB_TOPGEN   3392
#define XCD_BAR_WORDS 3456
#define XB_SPIN_CAP (1u << 18)

__device__ __forceinline__ unsigned xb_ld(unsigned* p)              { return __hip_atomic_load(p, __ATOMIC_RELAXED, __HIP_MEMORY_SCOPE_AGENT); }
__device__ __forceinline__ unsigned xb_add(unsigned* p, unsigned v) { return __hip_atomic_fetch_add(p, v, __ATOMIC_RELAXED, __HIP_MEMORY_SCOPE_AGENT); }
__device__ __forceinline__ unsigned xb_xcc_id() { return (unsigned)__builtin_amdgcn_s_getreg((3 << 11) | 20) & 0xFu; }
#define XB_SPIN(cond, bar) do { unsigned _sp = 0; while (cond) { __builtin_amdgcn_s_sleep(1); \
    if ((++_sp & 255u) == 0u) { if (xb_ld(&(bar)[XB_TMO])) break; if (_sp > XB_SPIN_CAP) { atomicAdd(&(bar)[XB_TMO], 1u); break; } } } } while (0)

struct XcdBarrier {
    unsigned* bar; unsigned x;
    volatile LAS unsigned* st;
};

__device__ __forceinline__ XcdBarrier xcd_barrier_post(unsigned* bar, volatile LAS unsigned* st) {
    XcdBarrier b; b.bar = bar; b.x = xb_xcc_id(); b.st = st;
    if (threadIdx.x == 0) (void)xb_add(&bar[XB_XCNT(b.x)], 1u);
    return b;
}
__device__ __forceinline__ void xcd_barrier_complete(unsigned* bar, unsigned x, unsigned& nloc, unsigned& nx) {
    const unsigned G = gridDim.x * gridDim.y * gridDim.z;
    unsigned sum, cnt, mine, sp = 0u;
    for (;;) {
        sum = 0u; cnt = 0u; mine = 0u;
#pragma unroll
        for (unsigned j = 0; j < 16; ++j) { const unsigned c = xb_ld(&bar[XB_XCNT(j)]); sum += c; cnt += (c > 0u) ? 1u : 0u; mine = (j == x) ? c : mine; }
        if (sum == G) break;
        __builtin_amdgcn_s_sleep(1);
        if ((++sp & 255u) == 0u) { if (xb_ld(&bar[XB_TMO])) break; if (sp > XB_SPIN_CAP) { atomicAdd(&bar[XB_TMO], 1u); break; } }
    }
    nloc = mine > 0u ? mine : 1u; nx = cnt > 0u ? cnt : 1u;
}

__device__ __forceinline__ void xcd_barrier(const XcdBarrier& b) {
    asm volatile("s_waitcnt vmcnt(0)" ::: "memory");
    __syncthreads();
    if (threadIdx.x == 0) {
        unsigned* bar = b.bar;
        __builtin_amdgcn_s_waitcnt(0);
        unsigned nloc = b.st[0], nx = b.st[1];
        if (nloc == 0u) { xcd_barrier_complete(bar, b.x, nloc, nx); b.st[0] = nloc; b.st[1] = nx; }
        const unsigned old = xb_add(&bar[XB_XSUB(b.x)], 1u);
        const unsigned gen = old / nloc;
        if (old + 1u == (gen + 1u) * nloc) {
            __builtin_amdgcn_fence(__ATOMIC_RELEASE, "agent");
            asm volatile("s_waitcnt vmcnt(0)" ::: "memory");
            const unsigned og = xb_add(&bar[XB_TOP], 1u);
            const unsigned tg = og / nx;
            if (og + 1u == (tg + 1u) * nx) xb_add(&bar[XB_TOPGEN], 1u);
            else XB_SPIN(xb_ld(&bar[XB_TOPGEN]) == tg, bar);
            __builtin_amdgcn_fence(__ATOMIC_ACQUIRE, "agent");
            xb_add(&bar[XB_XGEN(b.x)], 1u);
            asm volatile("s_waitcnt vmcnt(0)" ::: "memory");
        } else {
            XB_SPIN(xb_ld(&bar[XB_XGEN(b.x)]) == gen, bar);
            __builtin_amdgcn_fence(__ATOMIC_ACQUIRE, "agent");
            asm volatile("s_waitcnt vmcnt(0)" ::: "memory");
        }
    }
    __syncthreads();
}

constexpr int NWAVES = 8;
constexpr int BATCH = 2, SEQ = 8192, D = 1024, FF = 2816, M = BATCH * SEQ;
constexpr int NPROJ_SRC = 5656, NPROJ = 5888;
constexpr float RMS_EPS = 1e-6f;
constexpr float LOG2E = 1.4426950408889634f;
constexpr float QSCALE = 0.125f * LOG2E;

constexpr size_t MiB = 1u << 20;
constexpr size_t WS_CTL = 0, CTL_ZERO_BYTES = 64 * 1024;
constexpr size_t WS_LUTN = 1 * MiB;
constexpr size_t WS_LUTD = WS_LUTN + 64 * 1024;
constexpr size_t WS_CB = WS_LUTD + 16 * 1024;
constexpr size_t WS_KCMP = 1 * MiB + 256 * 1024, WS_VCMP = WS_KCMP + 256 * 1024;
constexpr size_t WS_WIN = 2 * MiB;
constexpr size_t WS_WC1K = WS_WIN + (size_t)NPROJ * D * 2;
constexpr size_t WS_WC1V = WS_WC1K + 1 * MiB;
constexpr size_t WS_WC2K = WS_WC1V + 1 * MiB;
constexpr size_t WS_WC2V = WS_WC2K + 32 * 1024;
constexpr size_t WS_WBN = WS_WC2V + 32 * 1024;
constexpr size_t WS_WBD = WS_WBN + 1 * MiB;
constexpr size_t WS_WOUT = WS_WBD + MiB / 2;
constexpr size_t WS_WGU2 = WS_WOUT + 2 * MiB;
constexpr size_t WS_WD2 = WS_WGU2 + (size_t)2 * FF * D * 2;
constexpr size_t WS_WGU1 = 36 * MiB;
constexpr size_t WS_WD1 = WS_WGU1 + (size_t)2 * FF * D * 2;
static_assert(WS_WD2 + (size_t)D * FF * 2 <= WS_WGU1, "weights A");
static_assert(WS_WD1 + (size_t)D * FF * 2 <= 53 * MiB, "weights B");
constexpr size_t WS_QN = 36 * MiB;
constexpr size_t WS_XN = 53 * MiB;
constexpr size_t WS_MG = 141 * MiB;
constexpr size_t WS_YN = 69 * MiB;
constexpr size_t WS_H = 85 * MiB;
constexpr size_t WS_Y = 173 * MiB;
constexpr size_t WS_PL = 85 * MiB;
constexpr size_t WS_QD = 109 * MiB;
constexpr size_t WS_KD = 133 * MiB, WS_VD = 157 * MiB;
constexpr size_t WS_GA = 181 * MiB, WS_GB = 213 * MiB;
constexpr size_t WS_GN = 245 * MiB;
constexpr size_t WS_YD = 247 * MiB;
constexpr size_t WS_Y2P = 109 * MiB;
constexpr size_t WS_X2 = 205 * MiB;
constexpr size_t WS_END = 256 * MiB;
static_assert(WS_H + (size_t)M * FF * 2 <= WS_Y && WS_Y + (size_t)M * D * 4 <= WS_END, "ffn map");
static_assert(WS_YD + (size_t)M * 256 * 2 <= WS_END && WS_GN + (size_t)M * 32 * 4 <= WS_YD && WS_Y2P + (size_t)M * D * 2 <= WS_MG && WS_MG + (size_t)M * D * 2 <= WS_GA, "mixer map");
constexpr size_t PLSZ = (size_t)4 * 8192 * 64;
constexpr int CW_TMO = 0, CW_BAR = 1024;

constexpr int RING_OFF = 0, RING_BYTES = 131072;
constexpr int LDSCTL_OFF = 143360, MISC_OFF = LDSCTL_OFF + 320;
constexpr int LDS_BYTES = 147456;
constexpr int LUT_PAD = 64, LUTW = 1672;
constexpr int A_KV = 0;
constexpr int A_LUT = 65536;
constexpr int A_IMP = A_LUT + 4 * LUTW * 4;
constexpr int IMP_S = 132;
constexpr int A_SEL = A_IMP + 64 * IMP_S * 4;
constexpr int A_UM = A_SEL + 64 * 16;
constexpr int A_WSF = A_UM + 64;
constexpr int A_BL = A_WSF + 8 * 512;
constexpr int A_END = A_BL + 256;
static_assert(A_END <= LDSCTL_OFF, "attention LDS");
constexpr size_t WS_OD = 53 * MiB;
constexpr size_t WS_LSE = 255 * MiB;

__device__ __forceinline__ int fresh_tid() { int t = threadIdx.x; asm volatile("" : "+v"(t)); return t; }
struct Frame {
    LAS unsigned char* lds;
    volatile LAS unsigned* MISC;
    gu32* ctl;
    int vcu, G, nrep;
};

__device__ __forceinline__ float wave_sum(float v) {
#pragma unroll
    for (int o = 1; o < 64; o <<= 1) v += __shfl_xor(v, o);
    return v;
}
struct TrItem { const float* W; bf16* WT; int K, Nsrc, sc0, nvalid, dr0, kb, frag; };
__device__ __forceinline__ void tr_load(const TrItem& t, f32x4 (&v)[8], int lane) {
    const int c4 = (lane & 7) * 4, rr = lane >> 3;
#pragma unroll
    for (int i = 0; i < 8; ++i) v[i] = (c4 < t.nvalid) ? *(const GAS f32x4*)(t.W + (size_t)(64 * t.kb + rr + 8 * i) * t.Nsrc + t.sc0 + c4) : (f32x4){0.f, 0.f, 0.f, 0.f};
}
__device__ __forceinline__ void tr_finish(const TrItem& t, const f32x4 (&v)[8], LAS float* scr, int lane) {
    const int k0 = 64 * t.kb, c4 = (lane & 7) * 4, rr = lane >> 3;
#pragma unroll
    for (int i = 0; i < 8; ++i) { LAS float* d = scr + (rr + 8 * i) * 33 + c4; d[0] = v[i].x; d[1] = v[i].y; d[2] = v[i].z; d[3] = v[i].w; }
    LDS_WAIT(); asm volatile("" ::: "memory");
    const int c = lane & 7;
#pragma unroll
    for (int j = 0; j < 4; ++j) { const int n = (lane >> 3) + 8 * j; const LAS float* s = scr + (8 * c) * 33 + n;
        v4u o; o.x = pk2(s[0 * 33], s[1 * 33]); o.y = pk2(s[2 * 33], s[3 * 33]); o.z = pk2(s[4 * 33], s[5 * 33]); o.w = pk2(s[6 * 33], s[7 * 33]);
        const int ng = t.dr0 + n, kk = k0 + 8 * c;
        const size_t off = t.frag ? ((size_t)(((ng >> 5) * (t.K >> 4) + (kk >> 4)) * 64 + ((kk >> 3) & 1) * 32 + (ng & 31)) * 8) : ((size_t)ng * t.K + kk);
        *(GAS v4u*)(t.WT + off) = o; }
    LDS_WAIT(); asm volatile("" ::: "memory");
}
__device__ __forceinline__ void win_map(int dblk, int& sc0, int& nvalid) {
    const int hidx = dblk >> 1, half = dblk & 1; nvalid = 32;
    if (hidx < 8) sc0 = hidx * 64 + half * 32;
    else if (hidx < 20) sc0 = 512 + (hidx - 8) * 64 + half * 32;
    else if (hidx < 32) sc0 = 1304 + (hidx - 20) * 64 + half * 32;
    else if (hidx < 44) sc0 = 2072 + (hidx - 32) * 64 + half * 32;
    else if (hidx < 56) sc0 = 2840 + (hidx - 44) * 64 + half * 32;
    else if (hidx < 72) sc0 = 3608 + (hidx - 56) * 64 + half * 32;
    else if (hidx < 88) sc0 = 4632 + (hidx - 72) * 64 + half * 32;
    else if (hidx == 88 && half == 0) { sc0 = 1280; nvalid = 24; }
    else { sc0 = 0; nvalid = 0; }
}
__device__ __forceinline__ void gu_map(int dblk, int& sc0) { const int pn = dblk >> 3, q = dblk & 7; sc0 = (q < 4) ? (128 * pn + 32 * q) : (FF + 128 * pn + 32 * (q - 4)); }
__device__ __forceinline__ int t5_bucket(int d) {
    if (d < 16) return d;
    int b = 16;
    b += (d >= 22); b += (d >= 30); b += (d >= 40); b += (d >= 54); b += (d >= 73); b += (d >= 99); b += (d >= 134); b += (d >= 182);
    b += (d >= 246); b += (d >= 332); b += (d >= 450); b += (d >= 609); b += (d >= 825); b += (d >= 1117); b += (d >= 1513);
    return b;
}
struct In {
    const float *x, *f1_pre, *f1_wgu, *f1_wd, *f1_post, *mix_pre, *w_in, *cpos_k, *cw1_k, *cw2_k, *cpos_v, *cw1_v, *cw2_v, *w_bn, *w_bd, *w_out, *mix_post, *f2_pre, *f2_wgu, *f2_wd, *f2_post, *rel_bias;
};
__device__ __forceinline__ void rms_row_to_bf16(const float* xrow, const float* gain, bf16* orow, int lane) {
    const GAS f32x4* xr = (const GAS f32x4*)xrow + lane; const GAS f32x4* gr = (const GAS f32x4*)gain + lane;
    f32x4 v[4]; float s = 0.f;
#pragma unroll
    for (int j = 0; j < 4; ++j) { v[j] = xr[64 * j]; s += (v[j].x * v[j].x + v[j].y * v[j].y) + (v[j].z * v[j].z + v[j].w * v[j].w); }
    const float r = 1.f / sqrtf(wave_sum(s) * (1.f / D) + RMS_EPS);
    GAS unsigned long long* o8 = (GAS unsigned long long*)orow + lane;
#pragma unroll
    for (int j = 0; j < 4; ++j) { const f32x4 g = gr[64 * j]; o8[64 * j] = (unsigned long long)pk2(v[j].x * r * g.x, v[j].y * r * g.y) | ((unsigned long long)pk2(v[j].z * r * g.z, v[j].w * r * g.w) << 32); }
}
__device__ __forceinline__ void p0_prologue(Frame& F, const In& in, unsigned char* ws) {
    const int tid = fresh_tid(), lane = tid & 63, wave = __builtin_amdgcn_readfirstlane(tid >> 6);
    LAS float* scr = (LAS float*)(F.lds + RING_OFF + wave * 16384);
    const int gw = F.vcu * NWAVES + wave, NGW = F.G * NWAVES;
    constexpr int I_GU = 176 * 16, I_D = 32 * 44, I_IN = 184 * 16, I_C1 = 8 * 32, I_C2 = 2 * 4, I_BN = 32 * 8, I_BD = 32 * 4, I_O = 32 * 16;
    constexpr int NITEMS = 2 * I_GU + 2 * I_D + I_IN + 2 * I_C1 + 2 * I_C2 + I_BN + I_BD + I_O;
    auto decode = [&](int it) -> TrItem {
        TrItem t; int r = it, sc0 = 0, nv = 32; t.frag = 0;
        if (r < I_GU) { const int dblk = r / 16; gu_map(dblk, sc0); t = TrItem{in.f1_wgu, (bf16*)(ws + WS_WGU1), D, 2 * FF, sc0, 32, dblk * 32, r % 16, 0}; return t; } r -= I_GU;
        if (r < I_GU) { const int dblk = r / 16; gu_map(dblk, sc0); t = TrItem{in.f2_wgu, (bf16*)(ws + WS_WGU2), D, 2 * FF, sc0, 32, dblk * 32, r % 16, 0}; return t; } r -= I_GU;
        if (r < I_D) { const int dblk = r / 44; t = TrItem{in.f1_wd, (bf16*)(ws + WS_WD1), FF, D, dblk * 32, 32, dblk * 32, r % 44, 0}; return t; } r -= I_D;
        if (r < I_D) { const int dblk = r / 44; t = TrItem{in.f2_wd, (bf16*)(ws + WS_WD2), FF, D, dblk * 32, 32, dblk * 32, r % 44, 0}; return t; } r -= I_D;
        if (r < I_IN) { const int dblk = r / 16; win_map(dblk, sc0, nv); t = TrItem{in.w_in, (bf16*)(ws + WS_WIN), D, NPROJ_SRC, sc0, nv, dblk * 32, r % 16, 0}; return t; } r -= I_IN;
        if (r < I_C1) { const int dblk = r / 32; t = TrItem{in.cw1_k, (bf16*)(ws + WS_WC1K), 2048, 256, dblk * 32, 32, dblk * 32, r % 32, 1}; return t; } r -= I_C1;
        if (r < I_C1) { const int dblk = r / 32; t = TrItem{in.cw1_v, (bf16*)(ws + WS_WC1V), 2048, 256, dblk * 32, 32, dblk * 32, r % 32, 1}; return t; } r -= I_C1;
        if (r < I_C2) { const int dblk = r / 4; t = TrItem{in.cw2_k, (bf16*)(ws + WS_WC2K), 256, 64, dblk * 32, 32, dblk * 32, r % 4, 0}; return t; } r -= I_C2;
        if (r < I_C2) { const int dblk = r / 4; t = TrItem{in.cw2_v, (bf16*)(ws + WS_WC2V), 256, 64, dblk * 32, 32, dblk * 32, r % 4, 0}; return t; } r -= I_C2;
        if (r < I_BN) { const int dblk = r / 8; t = TrItem{in.w_bn, (bf16*)(ws + WS_WBN), 512, D, dblk * 32, 32, dblk * 32, r % 8, 0}; return t; } r -= I_BN;
        if (r < I_BD) { const int dblk = r / 4; t = TrItem{in.w_bd, (bf16*)(ws + WS_WBD), 256, D, dblk * 32, 32, dblk * 32, r % 4, 0}; return t; } r -= I_BD;
        { const int dblk = r / 16; t = TrItem{in.w_out, (bf16*)(ws + WS_WOUT), D, D, dblk * 32, 32, dblk * 32, r % 16, 0}; return t; }
    };
    {
        f32x4 va[8], vb[8]; TrItem ta, tb;
        int it = gw; if (it < NITEMS) { ta = decode(it); tr_load(ta, va, lane); }
        while (it < NITEMS) {
            const int itn = it + NGW; if (itn < NITEMS) { tb = decode(itn); tr_load(tb, vb, lane); }
            tr_finish(ta, va, scr, lane);
            it = itn; if (it >= NITEMS) break;
            const int itm = it + NGW; if (itm < NITEMS) { ta = decode(itm); tr_load(ta, va, lane); }
            tr_finish(tb, vb, scr, lane);
            it = itm;
        }
    }
    { float* ln = (float*)(ws + WS_LUTN); float* ld = (float*)(ws + WS_LUTD); const int gt = F.vcu * (NWAVES * 64) + tid, NGT = F.G * NWAVES * 64;
      for (int e = gt; e < 8 * LUTW; e += NGT) { const int hd = e / LUTW, d = e % LUTW - LUT_PAD; ln[e] = (d >= 0) ? in.rel_bias[t5_bucket(d) * 20 + hd] * LOG2E : 0.f; }
      for (int e = gt; e < 12 * 320; e += NGT) { const int hd = e / 320, st = e % 320 - LUT_PAD; const int dil = 1 << (2 * (hd >> 2)); ld[e] = (st >= 0 && st <= 128) ? in.rel_bias[t5_bucket(st * dil) * 20 + 8 + hd] * LOG2E : 0.f; } }
    { float* cb = (float*)(ws + WS_CB);
      for (int o = gw; o < 512; o += NGW) { const int ts = o >> 8, n = o & 255; const float* pos = ts ? in.cpos_v : in.cpos_k; const float* w1 = ts ? in.cw1_v : in.cw1_k;
          float s = 0.f; for (int k = lane; k < 2048; k += 64) s += pos[k] * w1[(size_t)k * 256 + n];
          s = wave_sum(s); if (lane == 0) cb[o] = s; } }
    for (int m = gw; m < M; m += 2 * NGW) {
        const int m2 = m + NGW;
        const GAS f32x4* xa = (const GAS f32x4*)(in.x + (size_t)m * D) + lane; const GAS f32x4* xb = (const GAS f32x4*)(in.x + (size_t)(m2 < M ? m2 : m) * D) + lane;
        const GAS f32x4* gr = (const GAS f32x4*)in.f1_pre + lane;
        f32x4 va[4], vb[4]; float sa = 0.f, sb = 0.f;
#pragma unroll
        for (int j = 0; j < 4; ++j) { va[j] = xa[64 * j]; vb[j] = xb[64 * j]; }
#pragma unroll
        for (int j = 0; j < 4; ++j) { sa += (va[j].x * va[j].x + va[j].y * va[j].y) + (va[j].z * va[j].z + va[j].w * va[j].w); sb += (vb[j].x * vb[j].x + vb[j].y * vb[j].y) + (vb[j].z * vb[j].z + vb[j].w * vb[j].w); }
        const float ra = 1.f / sqrtf(wave_sum(sa) * (1.f / D) + RMS_EPS), rb = 1.f / sqrtf(wave_sum(sb) * (1.f / D) + RMS_EPS);
        GAS unsigned long long* oa = (GAS unsigned long long*)((bf16*)(ws + WS_XN) + (size_t)m * D) + lane; GAS unsigned long long* ob = (GAS unsigned long long*)((bf16*)(ws + WS_XN) + (size_t)(m2 < M ? m2 : m) * D) + lane;
#pragma unroll
        for (int j = 0; j < 4; ++j) { const f32x4 g = gr[64 * j];
            oa[64 * j] = (unsigned long long)pk2(va[j].x * ra * g.x, va[j].y * ra * g.y) | ((unsigned long long)pk2(va[j].z * ra * g.z, va[j].w * ra * g.w) << 32);
            if (m2 < M) ob[64 * j] = (unsigned long long)pk2(vb[j].x * rb * g.x, vb[j].y * rb * g.y) | ((unsigned long long)pk2(vb[j].z * rb * g.z, vb[j].w * rb * g.w) << 32); }
    }
}
__device__ __forceinline__ f32x4 ld_bf4(const GAS unsigned long long* p) { const unsigned long long w = *p; const unsigned lo = (unsigned)w, hi = (unsigned)(w >> 32);
    f32x4 v; v.x = __uint_as_float(lo << 16); v.y = __uint_as_float(lo & 0xffff0000u); v.z = __uint_as_float(hi << 16); v.w = __uint_as_float(hi & 0xffff0000u); return v; }
template <bool BB, bool OB, int NR = 4> __device__ __forceinline__ void row_pass(Frame& F, const bf16* Y, const void* base, void* out, float alpha, const float* gpost, const float* gnext, bf16* XN) {
    const int tid = fresh_tid(), lane = tid & 63, wave = __builtin_amdgcn_readfirstlane(tid >> 6);
    const int gw = F.vcu * NWAVES + wave, NGW = F.G * NWAVES;
    const GAS f32x4* gp = (const GAS f32x4*)gpost + lane;
    for (int m0 = gw; m0 < M; m0 += NR * NGW) {
        int mr[NR];
#pragma unroll
        for (int q = 0; q < NR; ++q) mr[q] = (m0 + q * NGW < M) ? m0 + q * NGW : m0;
        f32x4 v[NR][4], bv[NR][4]; float s[NR];
#pragma unroll
        for (int q = 0; q < NR; ++q) s[q] = 0.f;
#pragma unroll
        for (int q = 0; q < NR; ++q) { const int m = mr[q];
            const GAS unsigned long long* yr = (const GAS unsigned long long*)(Y + (size_t)m * D) + lane;
#pragma unroll
            for (int j = 0; j < 4; ++j) { v[q][j] = ld_bf4(yr + 64 * j);
                if (BB) bv[q][j] = ld_bf4((const GAS unsigned long long*)((const bf16*)base + (size_t)m * D) + lane + 64 * j); else bv[q][j] = ((const GAS f32x4*)((const float*)base + (size_t)m * D) + lane)[64 * j]; } }
#pragma unroll
        for (int q = 0; q < NR; ++q)
#pragma unroll
            for (int j = 0; j < 4; ++j) s[q] += (v[q][j].x * v[q][j].x + v[q][j].y * v[q][j].y) + (v[q][j].z * v[q][j].z + v[q][j].w * v[q][j].w);
        float r[NR], s2[NR];
#pragma unroll
        for (int q = 0; q < NR; ++q) s2[q] = 0.f;
#pragma unroll
        for (int q = 0; q < NR; ++q) r[q] = alpha / sqrtf(wave_sum(s[q]) * (1.f / D) + RMS_EPS);
#pragma unroll
        for (int q = 0; q < NR; ++q) { const int m = mr[q]; if (q >= 1 && mr[q] == mr[0]) continue;
#pragma unroll
            for (int j = 0; j < 4; ++j) { const f32x4 g = gp[64 * j]; v[q][j] = bv[q][j] + v[q][j] * r[q] * g;
                if (OB) ((GAS unsigned long long*)((bf16*)out + (size_t)m * D) + lane)[64 * j] = (unsigned long long)pk2(v[q][j].x, v[q][j].y) | ((unsigned long long)pk2(v[q][j].z, v[q][j].w) << 32);
                else ((GAS f32x4*)((float*)out + (size_t)m * D) + lane)[64 * j] = v[q][j];
                s2[q] += (v[q][j].x * v[q][j].x + v[q][j].y * v[q][j].y) + (v[q][j].z * v[q][j].z + v[q][j].w * v[q][j].w); } }
        if (gnext) {
            const GAS f32x4* gn = (const GAS f32x4*)gnext + lane;
#pragma unroll
            for (int q = 0; q < NR; ++q) { const int m = mr[q]; if (q >= 1 && mr[q] == mr[0]) continue;
                const float r2 = 1.f / sqrtf(wave_sum(s2[q]) * (1.f / D) + RMS_EPS);
                GAS unsigned long long* o8 = (GAS unsigned long long*)(XN + (size_t)m * D) + lane;
#pragma unroll
                for (int j = 0; j < 4; ++j) { const f32x4 g = gn[64 * j]; o8[64 * j] = (unsigned long long)pk2(v[q][j].x * r2 * g.x, v[q][j].y * r2 * g.y) | ((unsigned long long)pk2(v[q][j].z * r2 * g.z, v[q][j].w * r2 * g.w) << 32); } }
        }
    }
}

namespace att {
typedef float f32x16 __attribute__((ext_vector_type(16)));
typedef short s16x4 __attribute__((ext_vector_type(4)));
typedef short v4i16_t __attribute__((ext_vector_type(4)));
constexpr float NEGV = -1.0e30f;
constexpr int TILE_B = 16384, SBUF = 2 * TILE_B;
enum { CLS_SKIP = 0, CLS_FULL = 1, CLS_PART = 2, CLS_CONST = 3 };
__device__ __forceinline__ constexpr int crow(int r, int hi) { return (r & 3) + 8 * (r >> 2) + 4 * hi; }
__device__ __forceinline__ unsigned cvtpk(float lo, float hi) { unsigned r; asm volatile("v_cvt_pk_bf16_f32 %0, %1, %2" : "=v"(r) : "v"(lo), "v"(hi)); return r; }
__device__ __forceinline__ float swapmax(float v) { auto rr = __builtin_amdgcn_permlane32_swap(__float_as_uint(v), __float_as_uint(v), false, false); return fmaxf(__uint_as_float(rr[0]), __uint_as_float(rr[1])); }
__device__ __forceinline__ float swapsum(float v) { auto rr = __builtin_amdgcn_permlane32_swap(__float_as_uint(v), __float_as_uint(v), false, false); return __uint_as_float(rr[0]) + __uint_as_float(rr[1]); }
__device__ __forceinline__ float quadsum(float v) {
    v += __int_as_float(__builtin_amdgcn_mov_dpp(__float_as_int(v), 0xB1, 0xF, 0xF, true));
    v += __int_as_float(__builtin_amdgcn_mov_dpp(__float_as_int(v), 0x4E, 0xF, 0xF, true));
    return v;
}
struct Stage { v4u k, v; };
struct Stage2 { Stage t[2]; };
__device__ __forceinline__ void tile_load(Stage& s, const bf16* Kp, const bf16* Vp, long row, int tid) {
    const int ch = tid & 7; s.k = *(const GAS v4u*)(Kp + row * 64 + ch * 8); s.v = *(const GAS v4u*)(Vp + row * 64 + ch * 8);
}
__device__ __forceinline__ void tile_store(LAS unsigned char* buf, const Stage& s, int tid) {
    const int key = tid >> 3, ch = tid & 7;
    *(LAS v4u*)(buf + ch * 1024 + key * 16) = s.k;
    *(LAS v4u*)(buf + 8192 + (ch >> 2) * 4096 + key * 64 + (ch & 3) * 16) = s.v;
}
#define SBAR() __builtin_amdgcn_sched_barrier(0)
#ifndef ATT_SHIFT
#define ATT_SHIFT 8
#endif
#define ATT_BAR() asm volatile("s_waitcnt lgkmcnt(0)\n\ts_barrier" ::: "memory")
__device__ __forceinline__ void qk(f32x16& p0, f32x16& p1, const LAS unsigned char* kb, const bf16x8 (&qr)[4]) {
#pragma unroll
    for (int d0 = 0; d0 < 4; ++d0) {
        const bf16x8 b0 = *(const LAS bf16x8*)(kb + d0 * 2048), b1 = *(const LAS bf16x8*)(kb + d0 * 2048 + 512);
        p0 = __builtin_amdgcn_mfma_f32_32x32x16_bf16(b0, qr[d0], p0, 0, 0, 0);
        p1 = __builtin_amdgcn_mfma_f32_32x32x16_bf16(b1, qr[d0], p1, 0, 0, 0);
    }
}
__device__ __forceinline__ float max3f(float a, float b, float c) { float r; asm("v_max3_f32 %0, %1, %2, %3" : "=v"(r) : "v"(a), "v"(b), "v"(c)); return r; }
__device__ __forceinline__ float rowmax32(const f32x16& p0, const f32x16& p1) {
    float a = max3f(p0[0], p1[0], p0[1]), b = max3f(p1[1], p0[2], p1[2]);
#pragma unroll
    for (int r = 3; r < 15; r += 2) { a = max3f(a, p0[r], p1[r]); b = max3f(b, p0[r + 1], p1[r + 1]); }
    a = max3f(a, p0[15], p1[15]);
    return swapmax(fmaxf(a, b));
}
__device__ __forceinline__ s16x4 vtr(const LAS unsigned char* p) { return __builtin_bit_cast(s16x4, __builtin_amdgcn_ds_read_tr16_b64_v4i16((LAS v4i16_t*)p)); }
__device__ __forceinline__ void pv(f32x16 (&o)[2], const LAS unsigned char* vb, const f32x16& p0, const f32x16& p1) {
    v4u pw[4];
#pragma unroll
    for (int s = 0; s < 2; ++s) {
        pw[s]     = (v4u){cvtpk(p0[8 * s], p0[8 * s + 1]), cvtpk(p0[8 * s + 2], p0[8 * s + 3]), cvtpk(p0[8 * s + 4], p0[8 * s + 5]), cvtpk(p0[8 * s + 6], p0[8 * s + 7])};
        pw[2 + s] = (v4u){cvtpk(p1[8 * s], p1[8 * s + 1]), cvtpk(p1[8 * s + 2], p1[8 * s + 3]), cvtpk(p1[8 * s + 4], p1[8 * s + 5]), cvtpk(p1[8 * s + 6], p1[8 * s + 7])};
    }
#pragma unroll
    for (int dh = 0; dh < 2; ++dh)
#pragma unroll
        for (int kg = 0; kg < 4; ++kg) {
            const s16x4 lo = vtr(vb + dh * 4096 + kg * 1024), hi = vtr(vb + dh * 4096 + kg * 1024 + 512);
            const bf16x8 vf = (bf16x8){lo[0], lo[1], lo[2], lo[3], hi[0], hi[1], hi[2], hi[3]};
            o[dh] = __builtin_amdgcn_mfma_f32_32x32x16_bf16(__builtin_bit_cast(bf16x8, pw[kg]), vf, o[dh], 0, 0, 0);
        }
}
struct Soft { float mref, lsum; };
__device__ __forceinline__ void proc_tile(int cls, const LAS unsigned char* tile, const bf16x8 (&qr)[4], Soft& st, f32x16 (&o)[2], const LAS float* lut, int d0, int dlo, int dhi, float cbias, bool rowsel,
                                          LAS float* wsf, int r32, int hi, int trb) {
    const bool unset = st.mref < -1.0e29f;
    const float base = unset ? 0.f : st.mref;
    const float negb = rowsel ? -base : NEGV;
    f32x16 p0, p1; bf16x8 kf0[4], kf1[4];
    { const LAS unsigned char* kb = tile + hi * 1024 + r32 * 16;
#pragma unroll
      for (int q = 0; q < 4; ++q) { kf0[q] = *(const LAS bf16x8*)(kb + q * 2048); kf1[q] = *(const LAS bf16x8*)(kb + q * 2048 + 512); } }
    if (cls == CLS_CONST) { const float iv = negb + cbias;
#pragma unroll
        for (int r = 0; r < 16; ++r) { p0[r] = iv; p1[r] = iv; }
    } else { const LAS float* pb = lut + (d0 - 4 * hi - 59);
#pragma unroll
        for (int r = 0; r < 16; ++r) { p0[r] = pb[59 - crow(r, 0)]; p1[r] = pb[27 - crow(r, 0)]; }
        SBAR();
#pragma unroll
        for (int r = 0; r < 16; ++r) { p0[r] += negb; p1[r] += negb; }
    }
    SBAR();
#pragma unroll
    for (int q = 0; q < 4; ++q) { p0 = __builtin_amdgcn_mfma_f32_32x32x16_bf16(kf0[q], qr[q], p0, 0, 0, 0); p1 = __builtin_amdgcn_mfma_f32_32x32x16_bf16(kf1[q], qr[q], p1, 0, 0, 0); }
    SBAR();
    s16x4 vlo[8], vhi[8];
    { const LAS unsigned char* vb = tile + 8192 + trb;
#pragma unroll
      for (int i = 0; i < 8; ++i) { vlo[i] = vtr(vb + (i >> 2) * 4096 + (i & 3) * 1024); vhi[i] = vtr(vb + (i >> 2) * 4096 + (i & 3) * 1024 + 512); } }
    SBAR();
    if (cls == CLS_PART) { const int dq = d0 - 4 * hi; const unsigned span = (unsigned)(dhi - dlo);
#pragma unroll
        for (int r = 0; r < 16; ++r) { const int da = dq - crow(r, 0), db = da - 32;
            p0[r] = ((unsigned)(da - dlo) <= span) ? p0[r] : NEGV; p1[r] = ((unsigned)(db - dlo) <= span) ? p1[r] : NEGV; }
    }
    const float rm = rowmax32(p0, p1);
    const bool upd = rowsel && (rm > -1.0e29f) && (unset || rm > 8.0f);
    if (__any(upd)) {
        const float delta = upd ? rm : 0.f;
#pragma unroll
        for (int r = 0; r < 16; ++r) { p0[r] -= delta; p1[r] -= delta; }
        const float f = (upd && !unset) ? __builtin_amdgcn_exp2f(-delta) : 1.0f;
        st.lsum *= f;
        if (upd) st.mref = base + delta;
        if (hi == 0) wsf[r32] = f;
        asm volatile("s_waitcnt lgkmcnt(0)" ::: "memory");
#pragma unroll
        for (int r = 0; r < 16; ++r) { const float fr = wsf[crow(r, hi)]; o[0][r] *= fr; o[1][r] *= fr; }
        asm volatile("s_waitcnt lgkmcnt(0)" ::: "memory");
    }
    float s = 0.f;
#pragma unroll
    for (int r = 0; r < 16; ++r) { p0[r] = __builtin_amdgcn_exp2f(p0[r]); p1[r] = __builtin_amdgcn_exp2f(p1[r]); s += p0[r] + p1[r]; }
    st.lsum += s;
    v4u pw[4];
#pragma unroll
    for (int q = 0; q < 2; ++q) {
        pw[q]     = (v4u){cvtpk(p0[8 * q], p0[8 * q + 1]), cvtpk(p0[8 * q + 2], p0[8 * q + 3]), cvtpk(p0[8 * q + 4], p0[8 * q + 5]), cvtpk(p0[8 * q + 6], p0[8 * q + 7])};
        pw[2 + q] = (v4u){cvtpk(p1[8 * q], p1[8 * q + 1]), cvtpk(p1[8 * q + 2], p1[8 * q + 3]), cvtpk(p1[8 * q + 4], p1[8 * q + 5]), cvtpk(p1[8 * q + 6], p1[8 * q + 7])};
    }
    SBAR();
#pragma unroll
    for (int kg = 0; kg < 4; ++kg)
#pragma unroll
        for (int dh = 0; dh < 2; ++dh) { const int i = dh * 4 + kg;
            const bf16x8 vf = (bf16x8){vlo[i][0], vlo[i][1], vlo[i][2], vlo[i][3], vhi[i][0], vhi[i][1], vhi[i][2], vhi[i][3]};
            o[dh] = __builtin_amdgcn_mfma_f32_32x32x16_bf16(__builtin_bit_cast(bf16x8, pw[kg]), vf, o[dh], 0, 0, 0); }
}
__device__ __forceinline__ float soft_final_inv(const Soft& st, float& ltot) { ltot = swapsum(st.lsum); return (st.mref > -1.0e29f) ? 1.0f / ltot : 0.f; }
}

struct Mix {
    bf16 *QN, *YN, *SCR, *PL, *QD, *KD, *VD, *YD, *KCMP, *VCMP, *OD; float* LSE; const float* GN; const float* LUTN; const float* LUTD; const float* CB;
    const bf16 *WC1K, *WC1V, *WC2K, *WC2V;
};
__device__ __forceinline__ void lut_to_lds(Frame& F, int tid, const float* img, int nf) {
    LAS f32x4* L = (LAS f32x4*)(F.lds + A_LUT); const GAS f32x4* G = (const GAS f32x4*)img;
    for (int e = tid; e < nf / 4; e += NWAVES * 64) L[e] = G[e];
}
__device__ __forceinline__ bf16x8 ldq(const bf16* p) { return *(const GAS bf16x8*)p; }

__device__ __forceinline__ int next_sel(int j, int c, unsigned u0, unsigned u1, unsigned u2, unsigned u3) {
    while (j <= c) { const unsigned w = (j < 32) ? u0 : (j < 64) ? u1 : (j < 96) ? u2 : u3; if ((w >> (j & 31)) & 1u) break; ++j; }
    return j;
}
template <bool ADD> __device__ __forceinline__ void yn_rows(bf16* YN, const att::f32x16 (&o)[2], float fac, LAS float* wsf, int r32, int hi, size_t R0, int g, int lane) {
    if (hi == 0) wsf[r32] = fac;
    asm volatile("s_waitcnt lgkmcnt(0)" ::: "memory");
#pragma unroll
    for (int r = 0; r < 16; ++r) { const int q = att::crow(r, hi); const float fr = wsf[q];
        bf16* op = YN + (R0 + (q >> 2)) * 512 + (4 * g + (q & 3)) * 64 + (lane & 31);
        float a0 = o[0][r] * fr, a1 = o[1][r] * fr;
        if (ADD) { a0 += __uint_as_float((unsigned)op[0] << 16); a1 += __uint_as_float((unsigned)op[32] << 16); }
        op[0] = (bf16)f2bf(a0); op[32] = (bf16)f2bf(a1); }
    asm volatile("s_waitcnt lgkmcnt(0)" ::: "memory");
}
__device__ __forceinline__ void nsa_unit(Frame& F, const Mix& X, int b, int g, int c, int& buf) {
    using namespace att;
    const int tid = fresh_tid(), lane = tid & 63, wave = __builtin_amdgcn_readfirstlane(tid >> 6), r32 = lane & 31, hi = lane >> 5;
    LAS unsigned char* kv = F.lds + A_KV; LAS float* lutl = (LAS float*)(F.lds + A_LUT); LAS float* imp = (LAS float*)(F.lds + A_IMP);
    LAS unsigned* selm = (LAS unsigned*)(F.lds + A_SEL); LAS unsigned* um = (LAS unsigned*)(F.lds + A_UM); LAS float* wsf = (LAS float*)(F.lds + A_WSF) + wave * 128;
    const int trb = ((lane >> 4) & 1) * 32 + (lane & 3) * 8 + (4 * hi + ((lane & 15) >> 2)) * 64;
    const int t0 = 64 * c, tok = 8 * wave + (r32 >> 2), h = r32 & 3, t = t0 + tok;
    const size_t R = (size_t)b * SEQ + t, R0 = (size_t)b * SEQ + t0 + 8 * wave;
    const int plane = b * 2 + g;
    const bf16* KS = X.PL + 2 * PLSZ + (size_t)plane * SEQ * 64; const bf16* VS = X.PL + 3 * PLSZ + (size_t)plane * SEQ * 64;
    const bf16* KW = X.PL + 4 * PLSZ + (size_t)plane * SEQ * 64; const bf16* VW = X.PL + 5 * PLSZ + (size_t)plane * SEQ * 64;
    const bf16* KC = X.KCMP + (size_t)plane * 512 * 64; const bf16* VC = X.VCMP + (size_t)plane * 512 * 64;
    __syncthreads();
    lut_to_lds(F, tid, X.LUTN + (size_t)g * 4 * LUTW, 4 * LUTW);
    for (int e = tid; e < 64 * IMP_S / 4; e += NWAVES * 64) ((LAS f32x4*)imp)[e] = (f32x4){0.f, 0.f, 0.f, 0.f};
    if (tid < 4) um[tid] = 0u;
    bf16x8 qr[4];
#pragma unroll
    for (int d0 = 0; d0 < 4; ++d0) qr[d0] = ldq(X.QN + R * 512 + (4 * g + h) * 64 + 16 * d0 + 8 * hi);
    const float g0 = X.GN[R * 32 + (4 * g + h) * 3 + 0], g1 = X.GN[R * 32 + (4 * g + h) * 3 + 1], g2 = X.GN[R * 32 + (4 * g + h) * 3 + 2];
    const LAS float* lrow = lutl + h * LUTW + LUT_PAD;
    __syncthreads();
    const int key = tid >> 3;
    Stage2 sg;
    {
        Soft st{NEGV, 0.f}; f32x16 o[2]; o[0] = f32x16{}; o[1] = f32x16{};
        const int it0 = (c >= 8) ? 0 : (8 - c), nt = 9 - it0, nss = (nt + 1) >> 1;
#pragma unroll
        for (int tt = 0; tt < 2; ++tt) { int it = it0 + tt; it = it > 8 ? 8 : it; tile_load(sg.t[tt], KW, VW, t0 - 512 + 64 * it + key, tid); }
        for (int ss = 0; ss < nss; ++ss) {
            LAS unsigned char* bp = kv + buf * SBUF;
            tile_store(bp, sg.t[0], tid); tile_store(bp + TILE_B, sg.t[1], tid); ATT_BAR();
            if (ss + 1 < nss) {
#pragma unroll
                for (int tt = 0; tt < 2; ++tt) { int it = it0 + 2 * (ss + 1) + tt; it = it > 8 ? 8 : it; tile_load(sg.t[tt], KW, VW, t0 - 512 + 64 * it + key, tid); } }
#pragma unroll
            for (int tt = 0; tt < 2; ++tt) { const int it = it0 + 2 * ss + tt;
                if (it <= 8) { const int kb = t0 - 512 + 64 * it; const int cls = (it == 0 || it == 8) ? CLS_PART : CLS_FULL;
                    proc_tile(cls, bp + tt * TILE_B, qr, st, o, lrow, t - kb, 0, 511, 0.f, true, wsf, r32, hi, trb); } }
            buf ^= 1;
        }
        float lt; const float inv = soft_final_inv(st, lt);
        yn_rows<false>(X.YN, o, g2 * inv, wsf, r32, hi, R0, g, lane);
    }
    {
        const int imax = (4 * c + 2 > 510) ? 510 : (4 * c + 2), ntc = imax / 64 + 1, nss = (ntc + 1) >> 1;
        const int dq = t - 31 - 16 * 4 * hi;
        const float cfar = lrow[1599];
        float m = NEGV, l = 0.f;
#pragma unroll
        for (int tt = 0; tt < 2; ++tt) { int it = tt; it = it > ntc - 1 ? ntc - 1 : it; tile_load(sg.t[tt], KC, VC, 64 * it + key, tid); }
        for (int ss = 0; ss < nss; ++ss) {
            LAS unsigned char* bp = kv + buf * SBUF;
            tile_store(bp, sg.t[0], tid); tile_store(bp + TILE_B, sg.t[1], tid); ATT_BAR();
            if (ss + 1 < nss) {
#pragma unroll
                for (int tt = 0; tt < 2; ++tt) { int it = 2 * (ss + 1) + tt; it = it > ntc - 1 ? ntc - 1 : it; tile_load(sg.t[tt], KC, VC, 64 * it + key, tid); } }
#pragma unroll
            for (int tt = 0; tt < 2; ++tt) { const int it = 2 * ss + tt;
                if (it < ntc) {
                    f32x16 p0, p1; const int dt = dq - 1024 * it;
                    const bool far = (t0 - 31 - 1024 * it - 1008) >= 1513;
                    if (far) {
#pragma unroll
                        for (int r = 0; r < 16; ++r) { p0[r] = cfar; p1[r] = cfar; }
                    } else {
#pragma unroll
                        for (int r = 0; r < 16; ++r) { const int da = dt - 16 * crow(r, 0), db = da - 512;
                            const int ia = da < -64 ? -64 : (da > 1599 ? 1599 : da), ib = db < -64 ? -64 : (db > 1599 ? 1599 : db);
                            p0[r] = lrow[ia]; p1[r] = lrow[ib]; }
                    }
                    qk(p0, p1, bp + tt * TILE_B + hi * 1024 + r32 * 16, qr);
                    if (!far) {
#pragma unroll
                        for (int r = 0; r < 16; ++r) { const int da = dt - 16 * crow(r, 0), db = da - 512; p0[r] = (da >= 0) ? p0[r] : NEGV; p1[r] = (db >= 0) ? p1[r] : NEGV; }
                    }
                    const float rm = rowmax32(p0, p1);
                    const float mn = fmaxf(m, rm); float s = 0.f;
#pragma unroll
                    for (int r = 0; r < 16; ++r) s += __builtin_amdgcn_exp2f(p0[r] - mn) + __builtin_amdgcn_exp2f(p1[r] - mn);
                    l = l * __builtin_amdgcn_exp2f(m - mn) + s; m = mn;
                } }
            buf ^= 1;
        }
        const float ltot = swapsum(l);
        const float invl = (m > -1.0e29f) ? 1.0f / ltot : 0.f;
        const float mz = (m > -1.0e29f) ? m : 0.f;
        f32x16 o[2]; o[0] = f32x16{}; o[1] = f32x16{};
        LAS float* improw = imp + tok * IMP_S; float icarry = 0.f;
#pragma unroll
        for (int tt = 0; tt < 2; ++tt) { int it = tt; it = it > ntc - 1 ? ntc - 1 : it; tile_load(sg.t[tt], KC, VC, 64 * it + key, tid); }
        for (int ss = 0; ss < nss; ++ss) {
            LAS unsigned char* bp = kv + buf * SBUF;
            tile_store(bp, sg.t[0], tid); tile_store(bp + TILE_B, sg.t[1], tid); ATT_BAR();
            if (ss + 1 < nss) {
#pragma unroll
                for (int tt = 0; tt < 2; ++tt) { int it = 2 * (ss + 1) + tt; it = it > ntc - 1 ? ntc - 1 : it; tile_load(sg.t[tt], KC, VC, 64 * it + key, tid); } }
#pragma unroll
            for (int tt = 0; tt < 2; ++tt) { const int it = 2 * ss + tt;
                if (it < ntc) {
                    f32x16 p0, p1; const int dt = dq - 1024 * it;
                    const bool far = (t0 - 31 - 1024 * it - 1008) >= 1513;
                    if (far) { const float iv = cfar - mz;
#pragma unroll
                        for (int r = 0; r < 16; ++r) { p0[r] = iv; p1[r] = iv; }
                    } else {
#pragma unroll
                        for (int r = 0; r < 16; ++r) { const int da = dt - 16 * crow(r, 0), db = da - 512;
                            const int ia = da < -64 ? -64 : (da > 1599 ? 1599 : da), ib = db < -64 ? -64 : (db > 1599 ? 1599 : db);
                            p0[r] = lrow[ia] - mz; p1[r] = lrow[ib] - mz; }
                    }
                    qk(p0, p1, bp + tt * TILE_B + hi * 1024 + r32 * 16, qr);
#pragma unroll
                    for (int r = 0; r < 16; ++r) { p0[r] = __builtin_amdgcn_exp2f(p0[r]) * invl; p1[r] = __builtin_amdgcn_exp2f(p1[r]) * invl; }
                    if (!far) {
#pragma unroll
                        for (int r = 0; r < 16; ++r) { const int da = dt - 16 * crow(r, 0), db = da - 512; p0[r] = (da >= 0) ? p0[r] : 0.f; p1[r] = (db >= 0) ? p1[r] : 0.f; }
                    }
                    { float a0[4], l0[4], a1[4], l1[4], x0[4], x1[4];
#pragma unroll
                      for (int q = 0; q < 4; ++q) { a0[q] = quadsum((p0[4 * q] + p0[4 * q + 1]) + (p0[4 * q + 2] + p0[4 * q + 3])); l0[q] = quadsum(p0[4 * q + 3]);
                                                    a1[q] = quadsum((p1[4 * q] + p1[4 * q + 1]) + (p1[4 * q + 2] + p1[4 * q + 3])); l1[q] = quadsum(p1[4 * q + 3]); }
#pragma unroll
                      for (int q = 0; q < 4; ++q) { auto ra = __builtin_amdgcn_permlane32_swap(__float_as_uint(l0[q]), __float_as_uint(l0[q]), false, false); x0[q] = __uint_as_float(hi ? ra[0] : ra[1]);
                                                    auto rb = __builtin_amdgcn_permlane32_swap(__float_as_uint(l1[q]), __float_as_uint(l1[q]), false, false); x1[q] = __uint_as_float(hi ? rb[0] : rb[1]); }
                      if (h == 0) {
#pragma unroll
                          for (int q = 0; q < 4; ++q) { const float pv0 = hi ? x0[q] : (q ? x0[q ? q - 1 : 0] : icarry), pv1 = hi ? x1[q] : (q ? x1[q ? q - 1 : 0] : x0[3]);
                              improw[16 * it + 2 * q + hi] = a0[q] + pv0; improw[16 * it + 2 * q + hi + 8] = a1[q] + pv1; } }
                      icarry = x1[3]; }
                    pv(o, bp + tt * TILE_B + 8192 + trb, p0, p1);
                } }
            buf ^= 1;
        }
        yn_rows<true>(X.YN, o, g0, wsf, r32, hi, R0, g, lane);
    }
    asm volatile("s_waitcnt lgkmcnt(0)" ::: "memory");
    unsigned msk[4] = {0u, 0u, 0u, 0u};
    if (c >= 16) {
        const int tl = lane >> 3, part = lane & 7;
        const LAS float* ir = imp + (8 * wave + tl) * IMP_S + part * 16;
        unsigned v[16];
#pragma unroll
        for (int r = 0; r < 16; ++r) { const int j = part * 16 + r; const unsigned bits = __float_as_uint(ir[r]); v[r] = (j >= 1 && j <= c - 2) ? ((bits & ~127u) | (unsigned)(127 - j)) : 0u; }
        unsigned sm[4] = {0u, 0u, 0u, 0u};
        for (int itn = 0; itn < 13; ++itn) {
            unsigned mx = v[0];
#pragma unroll
            for (int r = 1; r < 16; ++r) mx = mx > v[r] ? mx : v[r];
            { unsigned o1 = (unsigned)__builtin_amdgcn_mov_dpp((int)mx, 0xB1, 0xF, 0xF, true); mx = mx > o1 ? mx : o1;
              o1 = (unsigned)__builtin_amdgcn_mov_dpp((int)mx, 0x4E, 0xF, 0xF, true); mx = mx > o1 ? mx : o1; o1 = (unsigned)__builtin_amdgcn_mov_dpp((int)mx, 0x141, 0xF, 0xF, true); mx = mx > o1 ? mx : o1; }
            const int j = 127 - (int)(mx & 127u); const unsigned bit = 1u << (j & 31); const int w = j >> 5;
            if (mx != 0u) { sm[0] |= (w == 0) ? bit : 0u; sm[1] |= (w == 1) ? bit : 0u; sm[2] |= (w == 2) ? bit : 0u; sm[3] |= (w == 3) ? bit : 0u; }
#pragma unroll
            for (int r = 0; r < 16; ++r) v[r] = (v[r] == mx) ? 0u : v[r];
        }
        sm[0] |= 1u;
        { const int j = c - 1; const unsigned bit = 1u << (j & 31); const int w = j >> 5; sm[0] |= (w == 0) ? bit : 0u; sm[1] |= (w == 1) ? bit : 0u; sm[2] |= (w == 2) ? bit : 0u; sm[3] |= (w == 3) ? bit : 0u; }
        { const int j = c; const unsigned bit = 1u << (j & 31); const int w = j >> 5; sm[0] |= (w == 0) ? bit : 0u; sm[1] |= (w == 1) ? bit : 0u; sm[2] |= (w == 2) ? bit : 0u; sm[3] |= (w == 3) ? bit : 0u; }
        if (part == 0) {
#pragma unroll
            for (int w = 0; w < 4; ++w) { selm[(8 * wave + tl) * 4 + w] = sm[w]; __hip_atomic_fetch_or(um + w, sm[w], __ATOMIC_RELAXED, __HIP_MEMORY_SCOPE_WORKGROUP); }
        }
        __syncthreads();
#pragma unroll
        for (int w = 0; w < 4; ++w) msk[w] = selm[tok * 4 + w];
    } else {
        msk[0] = (2u << c) - 1u;
        __syncthreads();
    }
    unsigned umr[4];
#pragma unroll
    for (int w = 0; w < 4; ++w) umr[w] = (c >= 16) ? (unsigned)__builtin_amdgcn_readfirstlane((int)um[w]) : ((w == 0) ? ((2u << c) - 1u) : 0u);
    {
        Soft st{NEGV, 0.f}; f32x16 o[2]; o[0] = f32x16{}; o[1] = f32x16{};
        const float cfar = lrow[1599];
        LAS unsigned char* blist = (LAS unsigned char*)(F.lds + A_BL);
        if (tid == 0) { int n = 0; for (int j = 0; j <= c; ++j) { const unsigned w = (j < 32) ? umr[0] : (j < 64) ? umr[1] : (j < 96) ? umr[2] : umr[3]; if ((w >> (j & 31)) & 1u) blist[n++] = (unsigned char)j; }
                        blist[160] = (unsigned char)n; blist[n] = blist[n - 1]; blist[n + 1] = blist[n - 1]; blist[n + 2] = blist[n - 1]; blist[n + 3] = blist[n - 1]; }
        __syncthreads();
        const int nb = blist[160], nss = (nb + 1) >> 1;
        Stage2 sh;
#define SEL_LOAD(SG, ss_) do { const int ja_ = blist[2 * (ss_)], jb_ = blist[2 * (ss_) + 1]; tile_load((SG).t[0], KS, VS, 64 * ja_ + key, tid); tile_load((SG).t[1], KS, VS, 64 * jb_ + key, tid); } while (0)
#define SEL_STEP(SG, ss_) do { LAS unsigned char* bp = kv + buf * SBUF; \
            tile_store(bp, (SG).t[0], tid); tile_store(bp + TILE_B, (SG).t[1], tid); ATT_BAR(); \
            if ((ss_) + 2 < nss) SEL_LOAD(SG, (ss_) + 2); \
            _Pragma("unroll") for (int tt = 0; tt < 2; ++tt) { const int bi = 2 * (ss_) + tt; \
                if (bi < nb) { const int j = blist[bi]; \
                    const unsigned mw = (j < 32) ? msk[0] : (j < 64) ? msk[1] : (j < 96) ? msk[2] : msk[3]; \
                    const bool sel = (mw >> (j & 31)) & 1u; \
                    if (__any(sel)) { const int cls = (j == c) ? CLS_PART : ((c - j >= 25) ? CLS_CONST : CLS_FULL); \
                        proc_tile(cls, bp + tt * TILE_B, qr, st, o, lrow, t - 64 * j, 0, 0x3fffffff, cfar, sel, wsf, r32, hi, trb); } } } \
            buf ^= 1; } while (0)
        SEL_LOAD(sg, 0); if (nss > 1) SEL_LOAD(sh, 1);
        for (int ss = 0; ss < nss; ss += 2) { SEL_STEP(sg, ss); if (ss + 1 < nss) SEL_STEP(sh, ss + 1); }
#undef SEL_LOAD
#undef SEL_STEP
        float lt; const float inv = soft_final_inv(st, lt);
#ifdef PROBE_SEL_TWICE
        if (rep_) yn_rows<false>(X.SCR, o, g1 * inv, wsf, r32, hi, R0 & 8191, g, lane); else
#endif
        yn_rows<true>(X.YN, o, g1 * inv, wsf, r32, hi, R0, g, lane);
    }
}

__device__ __forceinline__ void dil_unit(Frame& F, const Mix& X, int gi, int b, int s, int rest, int& buf) {
    using namespace att;
    const int tid = fresh_tid(), lane = tid & 63, wave = __builtin_amdgcn_readfirstlane(tid >> 6), r32 = lane & 31, hi = lane >> 5;
    LAS unsigned char* kv = F.lds + A_KV; LAS float* lutl = (LAS float*)(F.lds + A_LUT); LAS float* wsf = (LAS float*)(F.lds + A_WSF) + wave * 128;
    const int trb = ((lane >> 4) & 1) * 32 + (lane & 3) * 8 + (4 * hi + ((lane & 15) >> 2)) * 64;
    const int dil = 1 << (2 * gi), lg = 2 * gi, nch = (SEQ >> lg) >> 8, res = rest / nch, ch = rest % nch;
    const int hd = 4 * gi + s, N0 = 256 * ch, Nw = N0 + 32 * wave, nq = Nw + r32, key = tid >> 3;
    const int t = (nq << lg) + res;
    const size_t R = (size_t)b * SEQ + t;
    __syncthreads();
    lut_to_lds(F, tid, X.LUTD + hd * 320, 320);
    bf16x8 qr[4];
#pragma unroll
    for (int d0 = 0; d0 < 4; ++d0) qr[d0] = ldq(X.QD + R * 768 + hd * 64 + 16 * d0 + 8 * hi);
    const bf16* Kp = X.KD + (size_t)(b * 12 + hd) * SEQ * 64; const bf16* Vp = X.VD + (size_t)(b * 12 + hd) * SEQ * 64;
    const LAS float* lrow = lutl + LUT_PAD;
    __syncthreads();
    Soft st{NEGV, 0.f}; f32x16 o[2]; o[0] = f32x16{}; o[1] = f32x16{};
    Stage2 sg[3];
    const int it0 = (ch == 0) ? 2 : 0, nss = (6 - it0) >> 1;
#pragma unroll
    for (int ss = 0; ss < 3; ++ss) if (ss < nss) {
#pragma unroll
        for (int tt = 0; tt < 2; ++tt) { const int kb = N0 - 128 + 64 * (it0 + 2 * ss + tt); tile_load(sg[ss].t[tt], Kp, Vp, (long)((kb + key) << lg) + res, tid); } }
#pragma unroll
    for (int ss = 0; ss < 3; ++ss) if (ss < nss) {
        LAS unsigned char* bp = kv + buf * SBUF;
        tile_store(bp, sg[ss].t[0], tid); tile_store(bp + TILE_B, sg[ss].t[1], tid); ATT_BAR();
#pragma unroll
        for (int tt = 0; tt < 2; ++tt) { const int kb = N0 - 128 + 64 * (it0 + 2 * ss + tt);
            const int dmin = Nw - kb - 63, dmax = Nw + 31 - kb;
            if (dmax >= 0 && dmin <= 128) { const int cls = (dmin >= 0 && dmax <= 128) ? CLS_FULL : CLS_PART;
                proc_tile(cls, bp + tt * TILE_B, qr, st, o, lrow, nq - kb, 0, 128, 0.f, true, wsf, r32, hi, trb); } }
        buf ^= 1;
    }
    float ltot; const float inv = soft_final_inv(st, ltot);
    const float lse = st.mref + __builtin_amdgcn_logf(ltot);
    if (gi != 0) {
        bf16* OD = X.OD + (size_t)(gi - 1) * M * 256; float* LS = X.LSE + (size_t)(gi - 1) * M * 4;
        if (hi == 0) { wsf[r32] = inv; LS[R * 4 + s] = lse; }
        asm volatile("s_waitcnt lgkmcnt(0)" ::: "memory");
#pragma unroll
        for (int r = 0; r < 16; ++r) { const int q = crow(r, hi); const float fr = wsf[q]; const size_t Rq = (size_t)b * SEQ + ((size_t)(Nw + q) << lg) + res;
            bf16* op = OD + Rq * 256 + s * 64 + (lane & 31);
            op[0] = (bf16)f2bf(o[0][r] * fr); op[32] = (bf16)f2bf(o[1][r] * fr); }
        asm volatile("s_waitcnt lgkmcnt(0)" ::: "memory");
    } else {
        const float l4 = X.LSE[R * 4 + s], l16 = X.LSE[(size_t)M * 4 + R * 4 + s];
        const float mx = fmaxf(lse, fmaxf(l4, l16));
        const float w1 = __builtin_amdgcn_exp2f(lse - mx), w4 = __builtin_amdgcn_exp2f(l4 - mx), w16 = __builtin_amdgcn_exp2f(l16 - mx), iw = 1.0f / (w1 + w4 + w16);
        if (hi == 0) { wsf[r32] = w1 * iw * inv; wsf[32 + r32] = w4 * iw; wsf[64 + r32] = w16 * iw; }
        asm volatile("s_waitcnt lgkmcnt(0)" ::: "memory");
#pragma unroll
        for (int r = 0; r < 16; ++r) { const int q = crow(r, hi); const float a1 = wsf[q], a4 = wsf[32 + q], a16 = wsf[64 + q]; const size_t Rq = (size_t)b * SEQ + Nw + q;
            const bf16* p4 = X.OD + Rq * 256 + s * 64 + (lane & 31); const bf16* p16 = p4 + (size_t)M * 256;
            bf16* op = X.YD + Rq * 256 + s * 64 + (lane & 31);
            const float v0 = o[0][r] * a1 + __uint_as_float((unsigned)p4[0] << 16) * a4 + __uint_as_float((unsigned)p16[0] << 16) * a16;
            const float v1 = o[1][r] * a1 + __uint_as_float((unsigned)p4[32] << 16) * a4 + __uint_as_float((unsigned)p16[32] << 16) * a16;
            op[0] = (bf16)f2bf(v0); op[32] = (bf16)f2bf(v1); }
        asm volatile("s_waitcnt lgkmcnt(0)" ::: "memory");
    }
}

__device__ __forceinline__ void cmp_unit(Frame& F, const Mix& X, int cu) {
    using namespace att;
    const int tid = fresh_tid(), lane = tid & 63, wave = __builtin_amdgcn_readfirstlane(tid >> 6), r32 = lane & 31, hi = lane >> 5;
    const int ts = cu >> 6, rb = cu & 63, plane = rb >> 4, i0 = (rb & 15) * 32;
    const bf16* src = X.PL + (size_t)ts * PLSZ + (size_t)plane * SEQ * 64;
    const bf16* W1 = ts ? X.WC1V : X.WC1K; const bf16* W2 = ts ? X.WC2V : X.WC2K; const float* cb = X.CB + ts * 256;
    bf16* dst = (ts ? X.VCMP : X.KCMP) + (size_t)plane * 512 * 64;
    LAS unsigned char* aimg = F.lds;
    LAS unsigned char* hid = F.lds + 69632;
    __syncthreads();
    for (int chn = tid; chn < 528 * 8; chn += NWAVES * 64) { const int tau = chn >> 3, c8 = chn & 7; int tk = 16 * i0 + tau; tk = tk > SEQ - 1 ? SEQ - 1 : tk;
        *(LAS v4u*)(aimg + tau * 128 + 16 * (tau >> 4) + c8 * 16) = *(const GAS v4u*)(src + (size_t)tk * 64 + c8 * 8); }
    __syncthreads();
    f32x16 acc = f32x16{};
    const LAS unsigned char* ap = aimg + r32 * 2064 + 16 * hi;
    const bf16* bp = W1 + ((size_t)wave * 128 * 64 + lane) * 8;
#pragma unroll 16
    for (int ks = 0; ks < 128; ++ks) {
        const int l = ks >> 2;
        const bf16x8 a = *(const LAS bf16x8*)(ap + 128 * l + 16 * (l >> 4) + 32 * (ks & 3));
        const bf16x8 bb = ldq(bp + (size_t)ks * 512);
        acc = __builtin_amdgcn_mfma_f32_32x32x16_bf16(a, bb, acc, 0, 0, 0);
    }
    { const int col = 32 * wave + r32; const float bias = cb[col];
#pragma unroll
      for (int r = 0; r < 16; ++r) { const float v = acc[r] + bias; const float hv = v * __builtin_amdgcn_rcpf(1.0f + __builtin_amdgcn_exp2f(-LOG2E * v));
          *(LAS unsigned short*)(hid + crow(r, hi) * 528 + col * 2) = (unsigned short)f2bf(hv); } }
    __syncthreads();
    if (wave < 2) {
        const int nt = wave;
        f32x16 o2 = f32x16{};
        const LAS unsigned char* hp = hid + r32 * 528 + 16 * hi; const bf16* b2 = W2 + (size_t)(32 * nt + r32) * 256 + 8 * hi;
#pragma unroll
        for (int k0 = 0; k0 < 256; k0 += 16) { const bf16x8 a = *(const LAS bf16x8*)(hp + k0 * 2); const bf16x8 bb = ldq(b2 + k0); o2 = __builtin_amdgcn_mfma_f32_32x32x16_bf16(a, bb, o2, 0, 0, 0); }
#pragma unroll
        for (int r = 0; r < 16; ++r) { const int i = i0 + crow(r, hi); dst[(size_t)i * 64 + 32 * nt + r32] = (bf16)f2bf(o2[r]); }
    }
}

#ifndef MK_N_LAUNCHES
#define MK_N_LAUNCHES 1
#endif
constexpr int N_PHASES = 13;
constexpr int N_LAUNCHES = MK_N_LAUNCHES;
struct Args { const float* in[22]; float* out; unsigned char* ws; int ph_lo, ph_hi, li, pad; };
__global__ void __launch_bounds__(NWAVES * 64, 2) mk_fwd(Args args) {
    extern __shared__ __attribute__((aligned(16))) unsigned char lds[];
    Frame F;
    F.lds = (LAS unsigned char*)lds;
    F.MISC = (volatile LAS unsigned*)(F.lds + MISC_OFF);
    F.G = gridDim.x; { const int bx = blockIdx.x; F.vcu = (F.G % 8 == 0) ? (bx % 8) * (F.G / 8) + bx / 8 : bx; }
    unsigned char* ws = args.ws;
    F.ctl = (gu32*)(ws + WS_CTL);
    In in;
    in.x = args.in[0]; in.f1_pre = args.in[1]; in.f1_wgu = args.in[2]; in.f1_wd = args.in[3]; in.f1_post = args.in[4]; in.mix_pre = args.in[5]; in.w_in = args.in[6];
    in.cpos_k = args.in[7]; in.cw1_k = args.in[8]; in.cw2_k = args.in[9]; in.cpos_v = args.in[10]; in.cw1_v = args.in[11]; in.cw2_v = args.in[12];
    in.w_bn = args.in[13]; in.w_bd = args.in[14]; in.w_out = args.in[15]; in.mix_post = args.in[16]; in.f2_pre = args.in[17]; in.f2_wgu = args.in[18]; in.f2_wd = args.in[19]; in.f2_post = args.in[20]; in.rel_bias = args.in[21];
    float* out = args.out;
    for (int u = threadIdx.x; u < (LDS_BYTES - LDSCTL_OFF) / 4; u += NWAVES * 64) ((LAS unsigned*)(F.lds + LDSCTL_OFF))[u] = 0u;
    __syncthreads();
    const bool use_bar = (args.ph_hi - args.ph_lo) > 1;
    XcdBarrier bar; bar.bar = (unsigned*)(F.ctl + CW_BAR) + args.li * XCD_BAR_WORDS; bar.x = 0; bar.st = nullptr;
    if (use_bar) bar = xcd_barrier_post((unsigned*)(F.ctl + CW_BAR) + args.li * XCD_BAR_WORDS, F.MISC + 8);
    const int lo = args.ph_lo, hi = args.ph_hi;
#define IN(k) (lo <= (k) && (k) < hi)
#define SEAM(k) do { if (IN(k) && IN((k) + 1)) xcd_barrier(bar); } while (0)
    bf16* XN = (bf16*)(ws + WS_XN); bf16* H = (bf16*)(ws + WS_H); bf16* Y = (bf16*)(ws + WS_Y); bf16* Y2P = (bf16*)(ws + WS_Y2P); bf16* MG = (bf16*)(ws + WS_MG);
    Mix X; X.QN = (bf16*)(ws + WS_QN); X.YN = (bf16*)(ws + WS_YN); X.SCR = (bf16*)(ws + WS_Y); F.nrep = args.pad; X.PL = (bf16*)(ws + WS_PL); X.QD = (bf16*)(ws + WS_QD); X.KD = (bf16*)(ws + WS_KD); X.VD = (bf16*)(ws + WS_VD); X.YD = (bf16*)(ws + WS_YD); X.OD = (bf16*)(ws + WS_OD); X.LSE = (float*)(ws + WS_LSE);
    X.KCMP = (bf16*)(ws + WS_KCMP); X.VCMP = (bf16*)(ws + WS_VCMP); X.GN = (const float*)(ws + WS_GN); X.LUTN = (const float*)(ws + WS_LUTN); X.LUTD = (const float*)(ws + WS_LUTD); X.CB = (const float*)(ws + WS_CB);
    X.WC1K = (const bf16*)(ws + WS_WC1K); X.WC1V = (const bf16*)(ws + WS_WC1V); X.WC2K = (const bf16*)(ws + WS_WC2K); X.WC2V = (const bf16*)(ws + WS_WC2V);
    bf16* GA = (bf16*)(ws + WS_GA); bf16* GB = (bf16*)(ws + WS_GB);

    if (IN(0)) { p0_prologue(F, in, ws); }
    SEAM(0);
    if (IN(1)) { pg8::Gemm g{XN, (const bf16*)(ws + WS_WGU1), M, 2 * FF, D}; pg8::StaticOrder S; S.init(M, 2 * FF, F.G, (int)blockIdx.x);
        pg8::EpiSwiGLU E{H, FF}; pg8::gemm_phase<pg8::EpiSwiGLU, pg8::StaticOrder, true, true>(F.lds + RING_OFF, g, S, E); }
    SEAM(1);
    if (IN(2)) { pg8::Gemm g{H, (const bf16*)(ws + WS_WD1), M, D, FF}; pg8::StaticOrder S; S.init(M, D, F.G, (int)blockIdx.x);
        pg8::EpiBf16 E{Y, D}; pg8::gemm_phase<pg8::EpiBf16, pg8::StaticOrder, true, true>(F.lds + RING_OFF, g, S, E); }
    SEAM(2);
    if (IN(3)) { row_pass<false, true>(F, Y, in.x, out, 0.5f, in.f1_post, in.mix_pre, XN); }
    SEAM(3);
    if (IN(4)) { pg8::Gemm g{XN, (const bf16*)(ws + WS_WIN), M, NPROJ, D}; pg8::StaticOrder S; S.init(M, NPROJ, F.G, (int)blockIdx.x);
        pg8::EpiProj E{X.QN, X.PL, X.QD, X.KD, X.VD, GA, GB, (float*)(ws + WS_GN), QSCALE};
        pg8::gemm_phase<pg8::EpiProj, pg8::StaticOrder, true, true>(F.lds + RING_OFF, g, S, E); }
    SEAM(4);
    if (IN(5)) { int buf = 0;
        for (int cu = F.vcu; cu < 128; cu += F.G) cmp_unit(F, X, cu);
#pragma unroll 1
        for (int w = F.vcu; w < 512; w += F.G) { const int gi = 2 - (w >> 8), du = w & 255; dil_unit(F, X, gi, du >> 7, (du >> 5) & 3, du & 31, buf); }
        __syncthreads(); }
    SEAM(5);
    if (IN(6)) { int buf = 0;
        for (int p = F.vcu; p < 256; p += F.G) { const int b = p >> 7, g = (p >> 6) & 1, cc = p & 63;
#pragma unroll 1
            for (int k = 0; k < 2; ++k) nsa_unit(F, X, b, g, k ? cc : 127 - cc, buf); }
#pragma unroll 1
        for (int du = F.vcu; du < 256; du += F.G) dil_unit(F, X, 0, du >> 7, (du >> 5) & 3, du & 31, buf);
        __syncthreads(); }
    SEAM(6);
    if (IN(7)) {
        { pg8::Gemm g{X.YN, (const bf16*)(ws + WS_WBN), M, D, 512}; pg8::StaticOrder S; S.init(M, D, F.G, (int)blockIdx.x);
          pg8::EpiBranchA E{GA, Y2P}; pg8::gemm_phase<pg8::EpiBranchA, pg8::StaticOrder, true, true>(F.lds + RING_OFF, g, S, E); }
        { pg8::Gemm g{X.YD, (const bf16*)(ws + WS_WBD), M, D, 256}; pg8::StaticOrder S; S.init(M, D, F.G, (int)blockIdx.x);
          pg8::EpiBranchB E{GB, Y2P, MG}; pg8::gemm_phase<pg8::EpiBranchB, pg8::StaticOrder, true, true>(F.lds + RING_OFF, g, S, E); }
    }
    SEAM(7);
    if (IN(8)) { pg8::Gemm g{MG, (const bf16*)(ws + WS_WOUT), M, D, D}; pg8::StaticOrder S; S.init(M, D, F.G, (int)blockIdx.x);
        pg8::EpiBf16 E{Y, D}; pg8::gemm_phase<pg8::EpiBf16, pg8::StaticOrder, true, true>(F.lds + RING_OFF, g, S, E); }
    SEAM(8);
    if (IN(9)) { row_pass<true, true>(F, Y, out, ws + WS_X2, 1.0f, in.mix_post, in.f2_pre, XN); }
    SEAM(9);
    if (IN(10)) { pg8::Gemm g{XN, (const bf16*)(ws + WS_WGU2), M, 2 * FF, D}; pg8::StaticOrder S; S.init(M, 2 * FF, F.G, (int)blockIdx.x);
        pg8::EpiSwiGLU E{H, FF}; pg8::gemm_phase<pg8::EpiSwiGLU, pg8::StaticOrder, true, true>(F.lds + RING_OFF, g, S, E); }
    SEAM(10);
    if (IN(11)) { pg8::Gemm g{H, (const bf16*)(ws + WS_WD2), M, D, FF}; pg8::StaticOrder S; S.init(M, D, F.G, (int)blockIdx.x);
        pg8::EpiBf16 E{Y, D}; pg8::gemm_phase<pg8::EpiBf16, pg8::StaticOrder, true, true>(F.lds + RING_OFF, g, S, E); }
    SEAM(11);
    if (IN(12)) { row_pass<true, false>(F, Y, ws + WS_X2, out, 0.5f, in.f2_post, nullptr, nullptr); }
#undef IN
#undef SEAM
}

extern "C" void kernel_launch(void* const* d_in, const int* in_sizes, int n_in, void* d_out, int out_size, void* d_ws, size_t ws_size, hipStream_t stream) {
    static int grid = 0;
    if (grid == 0) {
        if (n_in != 22 || in_sizes[0] != M * D || out_size != M * D || ws_size < WS_END) { fprintf(stderr, "kernel_launch: unexpected shapes (n_in %d, in0 %d, out %d, ws %zu); nothing launched\n", n_in, n_in > 0 ? in_sizes[0] : -1, out_size, ws_size); grid = -1; return; }
        int dev = 0, cus = 0, per_cu = 0;
        if (hipGetDevice(&dev) != hipSuccess || hipDeviceGetAttribute(&cus, hipDeviceAttributeMultiprocessorCount, dev) != hipSuccess) { grid = -1; return; }
        if (hipFuncSetAttribute((const void*)mk_fwd, hipFuncAttributeMaxDynamicSharedMemorySize, LDS_BYTES) != hipSuccess) { fprintf(stderr, "kernel_launch: hipFuncSetAttribute failed\n"); grid = -1; return; }
        if (hipOccupancyMaxActiveBlocksPerMultiprocessor(&per_cu, (const void*)mk_fwd, NWAVES * 64, LDS_BYTES) != hipSuccess || per_cu < 1)
            fprintf(stderr, "kernel_launch: note: occupancy query reports %d workgroups per CU\n", per_cu);
        (void)hipGetLastError();
        grid = cus;
    }
    if (grid < 0) return;
    if (hipMemsetAsync((char*)d_ws + WS_CTL, 0, CTL_ZERO_BYTES, stream) != hipSuccess) return;
    Args a{};
    for (int i = 0; i < 22; ++i) a.in[i] = (const float*)d_in[i];
    a.out = (float*)d_out; a.ws = (unsigned char*)d_ws; a.pad = 2;
#ifdef PROBE_RANGES
    { static const int rg[][2] = PROBE_RANGES;
      for (int li = 0; li < (int)(sizeof(rg) / sizeof(rg[0])); ++li) { a.ph_lo = rg[li][0]; a.ph_hi = rg[li][1]; a.li = li; hipLaunchKernelGGL(mk_fwd, dim3(grid), dim3(NWAVES * 64), LDS_BYTES, stream, a); } }
#else
    if (N_LAUNCHES == 1) { a.ph_lo = 0; a.ph_hi = N_PHASES; a.li = 0; hipLaunchKernelGGL(mk_fwd, dim3(grid), dim3(NWAVES * 64), LDS_BYTES, stream, a); }
    else { for (int li = 0; li < N_PHASES; ++li) { a.ph_lo = li; a.ph_hi = li + 1; a.li = 0; hipLaunchKernelGGL(mk_fwd, dim3(grid), dim3(NWAVES * 64), LDS_BYTES, stream, a); } }
#endif
}
```

```cpp
#include <hip/hip_runtime.h>
#include <cstdio>
#include <cstdint>
namespace pg8 {
#define PG8_LAS __attribute__((address_space(3)))
typedef unsigned short bf16_t;
typedef short bf16x8 __attribute__((ext_vector_type(8)));
typedef float f32x4 __attribute__((ext_vector_type(4)));
typedef unsigned u32x4 __attribute__((ext_vector_type(4)));
constexpr int BM = 256, BK = 64, HALF = 128, HTB = HALF * BK * 2  , STAGE_BYTES = 8 * HTB, NXCD = 8, WGM = 8;

__host__ __device__ __forceinline__ int lds_byte(int r, int c) { const int st = (r >> 4) * 2 + (c >> 5), rr = r & 15, cc = c & 31, ob = rr * 64 + cc * 2; return st * 1024 + (ob ^ (((ob >> 9) & 1) << 5)); }
__host__ __device__ __forceinline__ void stage_rc(int b, int& R, int& C) { const int st = b / 1024, sb = b % 1024, swz = sb ^ (((sb >> 9) & 1) << 5); R = (st >> 1) * 16 + swz / 64; C = (st & 1) * 32 + (swz % 64) / 2; }
__host__ __device__ __forceinline__ int perm32(int rho) { const int n = rho >> 4, i = rho & 15; return 8 * (i >> 2) + 4 * n + (i & 3); }

struct Unit { int pm, pn; };
struct Gemm { const bf16_t* A; const bf16_t* Bt; int M, N, K; };

struct StaticOrder {
    int nM, nN, nwg, G, c;
    __host__ __device__ void init(int M, int N, int G_, int c_) { nM = M / BM; nN = N / BM; nwg = nM * nN; G = G_; c = c_; }
    __host__ __device__ bool next(int i, Unit& u) const {
        const long L = (long)i * G + c; if (L >= nwg) return false;
        int wgid = (int)L; { const int q = nwg / NXCD, r = nwg % NXCD, xcd = wgid % NXCD, off = wgid / NXCD; wgid = (xcd < r ? xcd * (q + 1) : r * (q + 1) + (xcd - r) * q) + off; }
        const int nig = WGM * nN, gid = wgid / nig, fm = gid * WGM, gsz = (nM - fm) < WGM ? (nM - fm) : WGM;
        u.pm = fm + ((wgid % nig) % gsz); u.pn = (wgid % nig) / gsz; return true;
    }
    __device__ __forceinline__ void a_ready(const Unit&) const {}
    __device__ __forceinline__ void done(const Unit&) const {}
};

__device__ __forceinline__ unsigned cvt_pk_bf16(float lo, float hi) { unsigned r; asm volatile("v_cvt_pk_bf16_f32 %0, %1, %2" : "=v"(r) : "v"(lo), "v"(hi)); return r; }
typedef float f32x2 __attribute__((ext_vector_type(2)));
__device__ __forceinline__ float sigmoid_f(float v) { return __builtin_amdgcn_rcpf(1.0f + __builtin_amdgcn_exp2f(-1.4426950408889634f * v)); }
__device__ __forceinline__ float bf_lo(unsigned w) { return __uint_as_float(w << 16); }
__device__ __forceinline__ float bf_hi(unsigned w) { return __uint_as_float(w & 0xffff0000u); }

struct EpiSwiGLU {
    static constexpr bool PERM = true, AFTER_DRAIN = false;
    bf16_t* H; int ldh;
    __device__ __forceinline__ void operator()(const f32x4 (&acc)[2][2][4][2], const Unit& u, int wr, int wc, int fr, int fq) const {
        const int row0 = u.pm * BM + wr * 64 + fr, col0 = u.pn * HALF + wc * 32 + 8 * fq;
#pragma unroll
        for (int ai = 0; ai < 2; ++ai)
#pragma unroll
            for (int m = 0; m < 4; ++m) { bf16_t* rowp = H + (size_t)(row0 + ai * HALF + m * 16) * ldh + col0;
                const f32x4 g0 = acc[ai][0][m][0], g1 = acc[ai][0][m][1], u0 = acc[ai][1][m][0], u1 = acc[ai][1][m][1];
                float h[8];
#pragma unroll
                for (int i = 0; i < 4; ++i) { h[i] = g0[i] * sigmoid_f(g0[i]) * u0[i]; h[4 + i] = g1[i] * sigmoid_f(g1[i]) * u1[i]; }
                u32x4 w; w.x = cvt_pk_bf16(h[0], h[1]); w.y = cvt_pk_bf16(h[2], h[3]); w.z = cvt_pk_bf16(h[4], h[5]); w.w = cvt_pk_bf16(h[6], h[7]);
                *(u32x4*)rowp = w; }
    }
};
struct EpiF32 {
    static constexpr bool PERM = true, AFTER_DRAIN = false;
    float* Y; int ldc;
    __device__ __forceinline__ void operator()(const f32x4 (&acc)[2][2][4][2], const Unit& u, int wr, int wc, int fr, int fq) const {
        const int row0 = u.pm * BM + wr * 64 + fr, col0 = u.pn * BM + wc * 32 + 8 * fq;
#pragma unroll
        for (int ai = 0; ai < 2; ++ai)
#pragma unroll
            for (int m = 0; m < 4; ++m) { float* rowp = Y + (size_t)(row0 + ai * HALF + m * 16) * ldc + col0;
#pragma unroll
                for (int bj = 0; bj < 2; ++bj) { *(f32x4*)(rowp + bj * HALF) = acc[ai][bj][m][0]; *(f32x4*)(rowp + bj * HALF + 4) = acc[ai][bj][m][1]; } }
    }
};
struct EpiBf16 {
    static constexpr bool PERM = true, AFTER_DRAIN = false;
    bf16_t* Y; int ldc;
    __device__ __forceinline__ void operator()(const f32x4 (&acc)[2][2][4][2], const Unit& u, int wr, int wc, int fr, int fq) const {
        const int row0 = u.pm * BM + wr * 64 + fr, col0 = u.pn * BM + wc * 32 + 8 * fq;
#pragma unroll
        for (int ai = 0; ai < 2; ++ai)
#pragma unroll
            for (int m = 0; m < 4; ++m) { bf16_t* rowp = Y + (size_t)(row0 + ai * HALF + m * 16) * ldc + col0;
#pragma unroll
                for (int bj = 0; bj < 2; ++bj) { const f32x4 a0 = acc[ai][bj][m][0], a1 = acc[ai][bj][m][1];
                    u32x4 w; w.x = cvt_pk_bf16(a0[0], a0[1]); w.y = cvt_pk_bf16(a0[2], a0[3]); w.z = cvt_pk_bf16(a1[0], a1[1]); w.w = cvt_pk_bf16(a1[2], a1[3]);
                    *(u32x4*)(rowp + bj * HALF) = w; } }
    }
};
struct EpiBranchA {
    static constexpr bool PERM = true, AFTER_DRAIN = false;
    const bf16_t* G; bf16_t* Y;
    __device__ __forceinline__ void operator()(const f32x4 (&acc)[2][2][4][2], const Unit& u, int wr, int wc, int fr, int fq) const {
        const int row0 = u.pm * BM + wr * 64 + fr, col0 = u.pn * BM + wc * 32 + 8 * fq;
#pragma unroll
        for (int ai = 0; ai < 2; ++ai)
#pragma unroll
            for (int m = 0; m < 4; ++m) { const size_t off = (size_t)(row0 + ai * HALF + m * 16) * 1024 + col0;
#pragma unroll
                for (int bj = 0; bj < 2; ++bj) { const u32x4 g = *(const u32x4*)(G + off + bj * HALF); const f32x4 a0 = acc[ai][bj][m][0], a1 = acc[ai][bj][m][1];
                    u32x4 w; w.x = cvt_pk_bf16(a0[0] * bf_lo(g.x), a0[1] * bf_hi(g.x)); w.y = cvt_pk_bf16(a0[2] * bf_lo(g.y), a0[3] * bf_hi(g.y));
                    w.z = cvt_pk_bf16(a1[0] * bf_lo(g.z), a1[1] * bf_hi(g.z)); w.w = cvt_pk_bf16(a1[2] * bf_lo(g.w), a1[3] * bf_hi(g.w));
                    *(u32x4*)(Y + off + bj * HALF) = w; } }
    }
};
struct EpiBranchB {
    static constexpr bool PERM = true, AFTER_DRAIN = false;
    const bf16_t* G; const bf16_t* Y; bf16_t* O;
    __device__ __forceinline__ void operator()(const f32x4 (&acc)[2][2][4][2], const Unit& u, int wr, int wc, int fr, int fq) const {
        const int row0 = u.pm * BM + wr * 64 + fr, col0 = u.pn * BM + wc * 32 + 8 * fq;
#pragma unroll
        for (int ai = 0; ai < 2; ++ai)
#pragma unroll
            for (int m = 0; m < 4; ++m) { const size_t off = (size_t)(row0 + ai * HALF + m * 16) * 1024 + col0;
#pragma unroll
                for (int bj = 0; bj < 2; ++bj) { const u32x4 g = *(const u32x4*)(G + off + bj * HALF), y = *(const u32x4*)(Y + off + bj * HALF); const f32x4 a0 = acc[ai][bj][m][0], a1 = acc[ai][bj][m][1];
                    u32x4 w; w.x = cvt_pk_bf16(bf_lo(y.x) + a0[0] * bf_lo(g.x), bf_hi(y.x) + a0[1] * bf_hi(g.x)); w.y = cvt_pk_bf16(bf_lo(y.y) + a0[2] * bf_lo(g.y), bf_hi(y.y) + a0[3] * bf_hi(g.y));
                    w.z = cvt_pk_bf16(bf_lo(y.z) + a1[0] * bf_lo(g.z), bf_hi(y.z) + a1[1] * bf_hi(g.z)); w.w = cvt_pk_bf16(bf_lo(y.w) + a1[2] * bf_lo(g.w), bf_hi(y.w) + a1[3] * bf_hi(g.w));
                    *(u32x4*)(O + off + bj * HALF) = w; } }
    }
};
struct EpiProj {
    static constexpr bool PERM = true, AFTER_DRAIN = false;
    bf16_t *QN, *PL, *QD, *KD, *VD, *GA, *GB; float* GN; float qscale;
    __device__ __forceinline__ void operator()(const f32x4 (&acc)[2][2][4][2], const Unit& u, int wr, int wc, int fr, int fq) const {
        const int sub = (wc & 1) * 32 + 8 * fq;
#pragma unroll
        for (int bj = 0; bj < 2; ++bj) {
            const int hidx = __builtin_amdgcn_readfirstlane(u.pn * 4 + bj * 2 + (wc >> 1));
            bf16_t* base = nullptr; long pitch = 0, bstride = 0; int mode = 0;
            if (hidx < 8) { base = QN + hidx * 64; pitch = 512; bstride = 8192L * 512; mode = 1; }
            else if (hidx < 20) { const int ti = (hidx - 8) >> 1, g = (hidx - 8) & 1; base = PL + (size_t)ti * (4u * 8192u * 64u) + (size_t)g * (8192u * 64u); pitch = 64; bstride = 2L * 8192 * 64; mode = 0; }
            else if (hidx < 32) { base = QD + (hidx - 20) * 64; pitch = 768; bstride = 8192L * 768; mode = 1; }
            else if (hidx < 44) { base = KD + (size_t)(hidx - 32) * (8192u * 64u); pitch = 64; bstride = 12L * 8192 * 64; mode = 0; }
            else if (hidx < 56) { base = VD + (size_t)(hidx - 44) * (8192u * 64u); pitch = 64; bstride = 12L * 8192 * 64; mode = 0; }
            else if (hidx < 72) { base = GA + (hidx - 56) * 64; pitch = 1024; bstride = 8192L * 1024; mode = 2; }
            else if (hidx < 88) { base = GB + (hidx - 72) * 64; pitch = 1024; bstride = 8192L * 1024; mode = 2; }
            else if (hidx == 88) mode = 3; else mode = 4;
            if (mode == 4) continue;
#pragma unroll
            for (int ai = 0; ai < 2; ++ai)
#pragma unroll
                for (int m = 0; m < 4; ++m) { const int R = u.pm * BM + ai * HALF + wr * 64 + m * 16 + fr, b = R >> 13, t = R & 8191;
                    f32x4 v0 = acc[ai][bj][m][0], v1 = acc[ai][bj][m][1];
                    if (mode == 3) { if (sub < 24) { float* p = GN + (size_t)R * 32 + sub;
#pragma unroll
                            for (int i = 0; i < 4; ++i) { v0[i] = sigmoid_f(v0[i]); v1[i] = sigmoid_f(v1[i]); }
                            *(f32x4*)p = v0; *(f32x4*)(p + 4) = v1; } }
                    else { if (mode == 1) { v0 = v0 * qscale; v1 = v1 * qscale; }
                        if (mode == 2) {
#pragma unroll
                            for (int i = 0; i < 4; ++i) { v0[i] = sigmoid_f(v0[i]); v1[i] = sigmoid_f(v1[i]); } }
                        u32x4 w; w.x = cvt_pk_bf16(v0[0], v0[1]); w.y = cvt_pk_bf16(v0[2], v0[3]); w.z = cvt_pk_bf16(v1[0], v1[1]); w.w = cvt_pk_bf16(v1[2], v1[3]);
                        *(u32x4*)(base + (size_t)b * bstride + (size_t)t * pitch + sub) = w; } }
        }
    }
};
template <class Epi, class Sched, bool ALIGN_EPI = false, bool SP2 = false>
__device__ __forceinline__ void gemm_phase(PG8_LAS unsigned char* lds, const Gemm g, const Sched& S, const Epi& E) {
    const int tid = threadIdx.x, wid = __builtin_amdgcn_readfirstlane(tid >> 6), lane = tid & 63, wr = wid >> 2, wc = wid & 3, fr = lane & 15, fq = lane >> 4;
    const int K = g.K, nt = K / BK;
    unsigned voffA[2], voffB[2];
#pragma unroll
    for (int i = 0; i < 2; ++i) { int R, C; stage_rc(tid * 16 + i * 8192, R, C); const int Rb = Epi::PERM ? ((R & ~31) + perm32(R & 31)) : R;
        voffA[i] = (unsigned)(R * K + C) * 2u; voffB[i] = (unsigned)(Rb * K + C) * 2u; }
    const size_t kstep = (size_t)(BK * 2);
    const size_t hstep = (size_t)HALF * K * 2;
    const size_t tstep = 2 * hstep;
    const unsigned ldsw = (unsigned)wid * 1024u;
    const int aoff = lds_byte(wr * 64 + fr, fq * 8), boff = lds_byte(wc * 32 + fr, fq * 8);
#define PG8_SA(b, h) (((b) * 2 + (h)) * HTB)
#define PG8_SB(b, h) ((4 + (b) * 2 + (h)) * HTB)
#define PG8_STAGE(bufoff, gbase, voff) do { _Pragma("unroll") for (int _i = 0; _i < 2; ++_i) \
        __builtin_amdgcn_global_load_lds((const unsigned*)((const char*)(gbase) + (voff)[_i]), (PG8_LAS unsigned*)(lds + (bufoff) + ldsw + _i * 8192), 16, 0, 0); } while (0)
#define PG8_LDA(dst, b, h) do { _Pragma("unroll") for (int m = 0; m < 4; ++m) _Pragma("unroll") for (int k = 0; k < 2; ++k) dst[m][k] = *(const PG8_LAS bf16x8*)(lds + PG8_SA(b, h) + aoff + m * 2048 + k * 1024); } while (0)
#define PG8_LDB(dst, b, h) do { _Pragma("unroll") for (int n = 0; n < 2; ++n) _Pragma("unroll") for (int k = 0; k < 2; ++k) dst[n][k] = *(const PG8_LAS bf16x8*)(lds + PG8_SB(b, h) + boff + n * 2048 + k * 1024); } while (0)
#define PG8_MMA(ai, bj, At, Bt) do { __builtin_amdgcn_s_setprio(1); _Pragma("unroll") for (int m = 0; m < 4; ++m) _Pragma("unroll") for (int n = 0; n < 2; ++n) _Pragma("unroll") for (int k = 0; k < 2; ++k) \
        acc[ai][bj][m][n] = __builtin_amdgcn_mfma_f32_16x16x32_bf16(Bt[n][k], At[m][k], acc[ai][bj][m][n], 0, 0, 0); __builtin_amdgcn_s_setprio(0); } while (0)
#define PG8_WAIT_V(n) asm volatile("s_waitcnt vmcnt(" #n ")" ::: "memory")
#define PG8_WAIT_L(n) asm volatile("s_waitcnt lgkmcnt(" #n ")" ::: "memory")
#define PG8_BAR __builtin_amdgcn_s_barrier()
#define PG8_SCHED __builtin_amdgcn_sched_barrier(0)
    Unit cur, nxt; int ui = 0;
    if (!S.next(0, cur)) return;
    f32x4 acc[2][2][4][2];
#pragma unroll
    for (int a = 0; a < 2; ++a)
#pragma unroll
        for (int b = 0; b < 2; ++b)
#pragma unroll
            for (int m = 0; m < 4; ++m)
#pragma unroll
                for (int n = 0; n < 2; ++n) acc[a][b][m][n] = (f32x4){0.f, 0.f, 0.f, 0.f};
    bf16x8 At[4][2], B0[2][2], B1[2][2];
    const char* cA = (const char*)g.A + (size_t)cur.pm * tstep; const char* cB = (const char*)g.Bt + (size_t)cur.pn * tstep;
    S.a_ready(cur);
    if constexpr (SP2) {
        PG8_STAGE(PG8_SB(0, 0), cB, voffB); PG8_STAGE(PG8_SB(0, 1), cB + hstep, voffB); PG8_STAGE(PG8_SA(0, 0), cA, voffA); PG8_STAGE(PG8_SA(0, 1), cA + hstep, voffA);
        if (wr == 1) PG8_BAR;
        PG8_WAIT_V(2); PG8_BAR;
        PG8_STAGE(PG8_SB(1, 0), cB + kstep, voffB); PG8_STAGE(PG8_SA(1, 0), cA + kstep, voffA); PG8_STAGE(PG8_SB(1, 1), cB + hstep + kstep, voffB);
        PG8_WAIT_V(6); PG8_BAR;
    } else {
        PG8_STAGE(PG8_SB(0, 0), cB, voffB); PG8_STAGE(PG8_SA(0, 0), cA, voffA); PG8_STAGE(PG8_SB(0, 1), cB + hstep, voffB); PG8_STAGE(PG8_SA(0, 1), cA + hstep, voffA);
        if (wr == 1) PG8_BAR;
        PG8_WAIT_V(4); PG8_BAR;
        PG8_STAGE(PG8_SB(1, 0), cB + kstep, voffB); PG8_STAGE(PG8_SA(1, 0), cA + kstep, voffA); PG8_STAGE(PG8_SB(1, 1), cB + hstep + kstep, voffB);
        PG8_WAIT_V(6); PG8_BAR;
    }
    for (;;) {
        const bool has_next = S.next(ui + 1, nxt);
        const char* nA = has_next ? (const char*)g.A + (size_t)nxt.pm * tstep : cA; const char* nB = has_next ? (const char*)g.Bt + (size_t)nxt.pn * tstep : cB;
        for (int t = 0; t < nt; t += 2) {
            const bool last = (t == nt - 2);
            const char* a1 = cA + (size_t)(t + 1) * kstep;
            const char* a2 = last ? nA : cA + (size_t)(t + 2) * kstep; const char* b2 = last ? nB : cB + (size_t)(t + 2) * kstep;
            const char* a3 = a2 + kstep; const char* b3 = b2 + kstep;
            if (last && has_next) S.a_ready(nxt);
            if constexpr (SP2) {
            PG8_LDB(B0, 0, 0); PG8_LDB(B1, 0, 1); PG8_SCHED; PG8_LDA(At, 0, 0); PG8_STAGE(PG8_SA(1, 1), a1 + hstep, voffA);
            PG8_WAIT_V(8); PG8_WAIT_L(0); PG8_BAR; PG8_MMA(0, 0, At, B0); PG8_MMA(0, 1, At, B1); PG8_BAR; PG8_SCHED;
            PG8_LDA(At, 0, 1); PG8_STAGE(PG8_SB(0, 0), b2, voffB); PG8_STAGE(PG8_SB(0, 1), b2 + hstep, voffB); PG8_STAGE(PG8_SA(0, 0), a2, voffA);
            PG8_WAIT_V(8); PG8_WAIT_L(0); PG8_BAR; PG8_MMA(1, 0, At, B0); PG8_MMA(1, 1, At, B1); PG8_BAR; PG8_SCHED;
            PG8_LDB(B0, 1, 0); PG8_LDB(B1, 1, 1); PG8_SCHED; PG8_LDA(At, 1, 0); PG8_STAGE(PG8_SA(0, 1), a2 + hstep, voffA);
            PG8_WAIT_V(8); PG8_WAIT_L(0); PG8_BAR; PG8_MMA(0, 0, At, B0); PG8_MMA(0, 1, At, B1); PG8_BAR; PG8_SCHED;
            PG8_LDA(At, 1, 1); PG8_STAGE(PG8_SB(1, 0), b3, voffB); PG8_STAGE(PG8_SB(1, 1), b3 + hstep, voffB); PG8_STAGE(PG8_SA(1, 0), a3, voffA);
            PG8_WAIT_V(8); PG8_WAIT_L(0); PG8_BAR; PG8_MMA(1, 0, At, B0); PG8_MMA(1, 1, At, B1); PG8_BAR; PG8_SCHED;
            } else {
            PG8_LDB(B0, 0, 0); PG8_SCHED; PG8_LDA(At, 0, 0); PG8_STAGE(PG8_SA(1, 1), a1 + hstep, voffA);
            PG8_WAIT_L(8); PG8_BAR; PG8_WAIT_L(0); PG8_MMA(0, 0, At, B0); PG8_BAR; PG8_SCHED;
            PG8_LDB(B1, 0, 1); PG8_STAGE(PG8_SB(0, 0), b2, voffB);
            PG8_BAR; PG8_WAIT_L(0); PG8_MMA(0, 1, At, B1); PG8_BAR;
            PG8_LDA(At, 0, 1); PG8_STAGE(PG8_SA(0, 0), a2, voffA);
            PG8_BAR; PG8_WAIT_L(0); PG8_MMA(1, 0, At, B0); PG8_BAR; PG8_SCHED;
            PG8_STAGE(PG8_SB(0, 1), b2 + hstep, voffB);
            PG8_WAIT_V(6); PG8_BAR; PG8_MMA(1, 1, At, B1); PG8_BAR;
            PG8_LDB(B0, 1, 0); PG8_SCHED; PG8_LDA(At, 1, 0); PG8_STAGE(PG8_SA(0, 1), a2 + hstep, voffA);
            PG8_WAIT_L(8); PG8_BAR; PG8_WAIT_L(0); PG8_MMA(0, 0, At, B0); PG8_BAR; PG8_SCHED;
            PG8_LDB(B1, 1, 1); PG8_STAGE(PG8_SB(1, 0), b3, voffB);
            PG8_BAR; PG8_WAIT_L(0); PG8_MMA(0, 1, At, B1); PG8_BAR;
            PG8_LDA(At, 1, 1); PG8_STAGE(PG8_SA(1, 0), a3, voffA);
            PG8_BAR; PG8_WAIT_L(0); PG8_MMA(1, 0, At, B0); PG8_BAR; PG8_SCHED;
            PG8_STAGE(PG8_SB(1, 1), b3 + hstep, voffB);
            PG8_WAIT_V(6); PG8_BAR; PG8_MMA(1, 1, At, B1); PG8_BAR;
            }
        }
        if constexpr (ALIGN_EPI) { if (wr == 0) PG8_BAR; }
        if constexpr (!Epi::AFTER_DRAIN) { E(acc, cur, wr, wc, fr, fq); S.done(cur); }
        if (!has_next) break;
#pragma unroll
        for (int a = 0; a < 2; ++a)
#pragma unroll
            for (int b = 0; b < 2; ++b)
#pragma unroll
                for (int m = 0; m < 4; ++m)
#pragma unroll
                    for (int n = 0; n < 2; ++n) acc[a][b][m][n] = (f32x4){0.f, 0.f, 0.f, 0.f};
        cur = nxt; cA = nA; cB = nB; ++ui;
        if constexpr (ALIGN_EPI) { if (wr == 1) PG8_BAR; }
    }
    PG8_WAIT_V(0);
    if constexpr (!ALIGN_EPI) { if (wr == 0) PG8_BAR; }
    PG8_BAR;
    if constexpr (Epi::AFTER_DRAIN) { E.fused(acc, cur, wr, wc, fr, fq, lds, wid, lane); S.done(cur); }
#undef PG8_SA
#undef PG8_SB
#undef PG8_STAGE
#undef PG8_LDA
#undef PG8_LDB
#undef PG8_MMA
#undef PG8_WAIT_V
#undef PG8_WAIT_L
#undef PG8_BAR
#undef PG8_SCHED
}
}
#define GAS __attribute__((address_space(1)))
#define LAS __attribute__((address_space(3)))
typedef unsigned short bf16;
typedef unsigned v4u __attribute__((ext_vector_type(4)));
typedef float f32x4 __attribute__((ext_vector_type(4)));
typedef short bf16x8 __attribute__((ext_vector_type(8)));
typedef GAS unsigned gu32;
typedef GAS unsigned long long gu64;
#define RLX_AGENT __ATOMIC_RELAXED, __HIP_MEMORY_SCOPE_AGENT
#define LDS_WAIT() asm volatile("s_waitcnt lgkmcnt(0)" ::: "memory")
#define VM_WAIT() asm volatile("s_waitcnt vmcnt(0)" ::: "memory")
__device__ __forceinline__ unsigned long long rt() { return __builtin_amdgcn_s_memrealtime(); }
__device__ __forceinline__ unsigned f2bf(float f) { unsigned u = __builtin_bit_cast(unsigned, f); return (u + 0x7fffu + ((u >> 16) & 1u)) >> 16; }
__device__ __forceinline__ unsigned pk2(float lo, float hi) { return f2bf(lo) | (f2bf(hi) << 16); }

#define XB_TMO      128
#define XB_XCNT(j)  (256  + 64 * (j))
#define XB_XSUB(j)  (1280 + 64 * (j))
#define XB_XGEN(j)  (2304 + 64 * (j))
#define XB_TOP      3328
#define XB_TOPGEN   3392
#define XCD_BAR_WORDS 3456
#define XB_SPIN_CAP (1u << 18)

__device__ __forceinline__ unsigned xb_ld(unsigned* p)              { return __hip_atomic_load(p, __ATOMIC_RELAXED, __HIP_MEMORY_SCOPE_AGENT); }
__device__ __forceinline__ unsigned xb_add(unsigned* p, unsigned v) { return __hip_atomic_fetch_add(p, v, __ATOMIC_RELAXED, __HIP_MEMORY_SCOPE_AGENT); }
__device__ __forceinline__ unsigned xb_xcc_id() { return (unsigned)__builtin_amdgcn_s_getreg((3 << 11) | 20) & 0xFu; }
#define XB_SPIN(cond, bar) do { unsigned _sp = 0; while (cond) { __builtin_amdgcn_s_sleep(1); \
    if ((++_sp & 255u) == 0u) { if (xb_ld(&(bar)[XB_TMO])) break; if (_sp > XB_SPIN_CAP) { atomicAdd(&(bar)[XB_TMO], 1u); break; } } } } while (0)

struct XcdBarrier {
    unsigned* bar; unsigned x;
    volatile LAS unsigned* st;
};

__device__ __forceinline__ XcdBarrier xcd_barrier_post(unsigned* bar, volatile LAS unsigned* st) {
    XcdBarrier b; b.bar = bar; b.x = xb_xcc_id(); b.st = st;
    if (threadIdx.x == 0) (void)xb_add(&bar[XB_XCNT(b.x)], 1u);
    return b;
}
__device__ __forceinline__ void xcd_barrier_complete(unsigned* bar, unsigned x, unsigned& nloc, unsigned& nx) {
    const unsigned G = gridDim.x * gridDim.y * gridDim.z;
    unsigned sum, cnt, mine, sp = 0u;
    for (;;) {
        sum = 0u; cnt = 0u; mine = 0u;
#pragma unroll
        for (unsigned j = 0; j < 16; ++j) { const unsigned c = xb_ld(&bar[XB_XCNT(j)]); sum += c; cnt += (c > 0u) ? 1u : 0u; mine = (j == x) ? c : mine; }
        if (sum == G) break;
        __builtin_amdgcn_s_sleep(1);
        if ((++sp & 255u) == 0u) { if (xb_ld(&bar[XB_TMO])) break; if (sp > XB_SPIN_CAP) { atomicAdd(&bar[XB_TMO], 1u); break; } }
    }
    nloc = mine > 0u ? mine : 1u; nx = cnt > 0u ? cnt : 1u;
}

__device__ __forceinline__ void xcd_barrier(const XcdBarrier& b) {
    asm volatile("s_waitcnt vmcnt(0)" ::: "memory");
    __syncthreads();
    if (threadIdx.x == 0) {
        unsigned* bar = b.bar;
        __builtin_amdgcn_s_waitcnt(0);
        unsigned nloc = b.st[0], nx = b.st[1];
        if (nloc == 0u) { xcd_barrier_complete(bar, b.x, nloc, nx); b.st[0] = nloc; b.st[1] = nx; }
        const unsigned old = xb_add(&bar[XB_XSUB(b.x)], 1u);
        const unsigned gen = old / nloc;
        if (old + 1u == (gen + 1u) * nloc) {
            __builtin_amdgcn_fence(__ATOMIC_RELEASE, "agent");
            asm volatile("s_waitcnt vmcnt(0)" ::: "memory");
            const unsigned og = xb_add(&bar[XB_TOP], 1u);
            const unsigned tg = og / nx;
            if (og + 1u == (tg + 1u) * nx) xb_add(&bar[XB_TOPGEN], 1u);
            else XB_SPIN(xb_ld(&bar[XB_TOPGEN]) == tg, bar);
            __builtin_amdgcn_fence(__ATOMIC_ACQUIRE, "agent");
            xb_add(&bar[XB_XGEN(b.x)], 1u);
            asm volatile("s_waitcnt vmcnt(0)" ::: "memory");
        } else {
            XB_SPIN(xb_ld(&bar[XB_XGEN(b.x)]) == gen, bar);
            __builtin_amdgcn_fence(__ATOMIC_ACQUIRE, "agent");
            asm volatile("s_waitcnt vmcnt(0)" ::: "memory");
        }
    }
    __syncthreads();
}

constexpr int NWAVES = 8;
constexpr int BATCH = 2, SEQ = 8192, D = 1024, FF = 2816, M = BATCH * SEQ;
constexpr int NPROJ_SRC = 5656, NPROJ = 5888;
constexpr float RMS_EPS = 1e-6f;
constexpr float LOG2E = 1.4426950408889634f;
constexpr float QSCALE = 0.125f * LOG2E;

constexpr size_t MiB = 1u << 20;
constexpr size_t WS_CTL = 0, CTL_ZERO_BYTES = 64 * 1024;
constexpr size_t WS_LUTN = 1 * MiB;
constexpr size_t WS_LUTD = WS_LUTN + 64 * 1024;
constexpr size_t WS_CB = WS_LUTD + 16 * 1024;
constexpr size_t WS_KCMP = 1 * MiB + 256 * 1024, WS_VCMP = WS_KCMP + 256 * 1024;
constexpr size_t WS_WIN = 2 * MiB;
constexpr size_t WS_WC1K = WS_WIN + (size_t)NPROJ * D * 2;
constexpr size_t WS_WC1V = WS_WC1K + 1 * MiB;
constexpr size_t WS_WC2K = WS_WC1V + 1 * MiB;
constexpr size_t WS_WC2V = WS_WC2K + 32 * 1024;
constexpr size_t WS_WBN = WS_WC2V + 32 * 1024;
constexpr size_t WS_WBD = WS_WBN + 1 * MiB;
constexpr size_t WS_WOUT = WS_WBD + MiB / 2;
constexpr size_t WS_WGU2 = WS_WOUT + 2 * MiB;
constexpr size_t WS_WD2 = WS_WGU2 + (size_t)2 * FF * D * 2;
constexpr size_t WS_WGU1 = 36 * MiB;
constexpr size_t WS_WD1 = WS_WGU1 + (size_t)2 * FF * D * 2;
static_assert(WS_WD2 + (size_t)D * FF * 2 <= WS_WGU1, "weights A");
static_assert(WS_WD1 + (size_t)D * FF * 2 <= 53 * MiB, "weights B");
constexpr size_t WS_QN = 36 * MiB;
constexpr size_t WS_XN = 53 * MiB;
constexpr size_t WS_MG = 141 * MiB;
constexpr size_t WS_YN = 69 * MiB;
constexpr size_t WS_H = 85 * MiB;
constexpr size_t WS_Y = 173 * MiB;
constexpr size_t WS_PL = 85 * MiB;
constexpr size_t WS_QD = 109 * MiB;
constexpr size_t WS_KD = 133 * MiB, WS_VD = 157 * MiB;
constexpr size_t WS_GA = 181 * MiB, WS_GB = 213 * MiB;
constexpr size_t WS_GN = 245 * MiB;
constexpr size_t WS_YD = 247 * MiB;
constexpr size_t WS_Y2P = 109 * MiB;
constexpr size_t WS_X2 = 205 * MiB;
constexpr size_t WS_END = 256 * MiB;
static_assert(WS_H + (size_t)M * FF * 2 <= WS_Y && WS_Y + (size_t)M * D * 4 <= WS_END, "ffn map");
static_assert(WS_YD + (size_t)M * 256 * 2 <= WS_END && WS_GN + (size_t)M * 32 * 4 <= WS_YD && WS_Y2P + (size_t)M * D * 2 <= WS_MG && WS_MG + (size_t)M * D * 2 <= WS_GA, "mixer map");
constexpr size_t PLSZ = (size_t)4 * 8192 * 64;
constexpr int CW_TMO = 0, CW_BAR = 1024;

constexpr int RING_OFF = 0, RING_BYTES = 131072;
constexpr int LDSCTL_OFF = 143360, MISC_OFF = LDSCTL_OFF + 320;
constexpr int LDS_BYTES = 147456;
constexpr int LUT_PAD = 64, LUTW = 1672;
constexpr int A_KV = 0;
constexpr int A_LUT = 65536;
constexpr int A_IMP = A_LUT + 4 * LUTW * 4;
constexpr int IMP_S = 132;
constexpr int A_SEL = A_IMP + 64 * IMP_S * 4;
constexpr int A_UM = A_SEL + 64 * 16;
constexpr int A_WSF = A_UM + 64;
constexpr int A_BL = A_WSF + 8 * 512;
constexpr int A_END = A_BL + 256;
static_assert(A_END <= LDSCTL_OFF, "attention LDS");
constexpr size_t WS_OD = 53 * MiB;
constexpr size_t WS_LSE = 255 * MiB;

__device__ __forceinline__ int fresh_tid() { int t = threadIdx.x; asm volatile("" : "+v"(t)); return t; }
struct Frame {
    LAS unsigned char* lds;
    volatile LAS unsigned* MISC;
    gu32* ctl;
    int vcu, G, nrep;
};

__device__ __forceinline__ float wave_sum(float v) {
#pragma unroll
    for (int o = 1; o < 64; o <<= 1) v += __shfl_xor(v, o);
    return v;
}
struct TrItem { const float* W; bf16* WT; int K, Nsrc, sc0, nvalid, dr0, kb, frag; };
__device__ __forceinline__ void tr_load(const TrItem& t, f32x4 (&v)[8], int lane) {
    const int c4 = (lane & 7) * 4, rr = lane >> 3;
#pragma unroll
    for (int i = 0; i < 8; ++i) v[i] = (c4 < t.nvalid) ? *(const GAS f32x4*)(t.W + (size_t)(64 * t.kb + rr + 8 * i) * t.Nsrc + t.sc0 + c4) : (f32x4){0.f, 0.f, 0.f, 0.f};
}
__device__ __forceinline__ void tr_finish(const TrItem& t, const f32x4 (&v)[8], LAS float* scr, int lane) {
    const int k0 = 64 * t.kb, c4 = (lane & 7) * 4, rr = lane >> 3;
#pragma unroll
    for (int i = 0; i < 8; ++i) { LAS float* d = scr + (rr + 8 * i) * 33 + c4; d[0] = v[i].x; d[1] = v[i].y; d[2] = v[i].z; d[3] = v[i].w; }
    LDS_WAIT(); asm volatile("" ::: "memory");
    const int c = lane & 7;
#pragma unroll
    for (int j = 0; j < 4; ++j) { const int n = (lane >> 3) + 8 * j; const LAS float* s = scr + (8 * c) * 33 + n;
        v4u o; o.x = pk2(s[0 * 33], s[1 * 33]); o.y = pk2(s[2 * 33], s[3 * 33]); o.z = pk2(s[4 * 33], s[5 * 33]); o.w = pk2(s[6 * 33], s[7 * 33]);
        const int ng = t.dr0 + n, kk = k0 + 8 * c;
        const size_t off = t.frag ? ((size_t)(((ng >> 5) * (t.K >> 4) + (kk >> 4)) * 64 + ((kk >> 3) & 1) * 32 + (ng & 31)) * 8) : ((size_t)ng * t.K + kk);
        *(GAS v4u*)(t.WT + off) = o; }
    LDS_WAIT(); asm volatile("" ::: "memory");
}
__device__ __forceinline__ void win_map(int dblk, int& sc0, int& nvalid) {
    const int hidx = dblk >> 1, half = dblk & 1; nvalid = 32;
    if (hidx < 8) sc0 = hidx * 64 + half * 32;
    else if (hidx < 20) sc0 = 512 + (hidx - 8) * 64 + half * 32;
    else if (hidx < 32) sc0 = 1304 + (hidx - 20) * 64 + half * 32;
    else if (hidx < 44) sc0 = 2072 + (hidx - 32) * 64 + half * 32;
    else if (hidx < 56) sc0 = 2840 + (hidx - 44) * 64 + half * 32;
    else if (hidx < 72) sc0 = 3608 + (hidx - 56) * 64 + half * 32;
    else if (hidx < 88) sc0 = 4632 + (hidx - 72) * 64 + half * 32;
    else if (hidx == 88 && half == 0) { sc0 = 1280; nvalid = 24; }
    else { sc0 = 0; nvalid = 0; }
}
__device__ __forceinline__ void gu_map(int dblk, int& sc0) { const int pn = dblk >> 3, q = dblk & 7; sc0 = (q < 4) ? (128 * pn + 32 * q) : (FF + 128 * pn + 32 * (q - 4)); }
__device__ __forceinline__ int t5_bucket(int d) {
    if (d < 16) return d;
    int b = 16;
    b += (d >= 22); b += (d >= 30); b += (d >= 40); b += (d >= 54); b += (d >= 73); b += (d >= 99); b += (d >= 134); b += (d >= 182);
    b += (d >= 246); b += (d >= 332); b += (d >= 450); b += (d >= 609); b += (d >= 825); b += (d >= 1117); b += (d >= 1513);
    return b;
}
struct In {
    const float *x, *f1_pre, *f1_wgu, *f1_wd, *f1_post, *mix_pre, *w_in, *cpos_k, *cw1_k, *cw2_k, *cpos_v, *cw1_v, *cw2_v, *w_bn, *w_bd, *w_out, *mix_post, *f2_pre, *f2_wgu, *f2_wd, *f2_post, *rel_bias;
};
__device__ __forceinline__ void rms_row_to_bf16(const float* xrow, const float* gain, bf16* orow, int lane) {
    const GAS f32x4* xr = (const GAS f32x4*)xrow + lane; const GAS f32x4* gr = (const GAS f32x4*)gain + lane;
    f32x4 v[4]; float s = 0.f;
#pragma unroll
    for (int j = 0; j < 4; ++j) { v[j] = xr[64 * j]; s += (v[j].x * v[j].x + v[j].y * v[j].y) + (v[j].z * v[j].z + v[j].w * v[j].w); }
    const float r = 1.f / sqrtf(wave_sum(s) * (1.f / D) + RMS_EPS);
    GAS unsigned long long* o8 = (GAS unsigned long long*)orow + lane;
#pragma unroll
    for (int j = 0; j < 4; ++j) { const f32x4 g = gr[64 * j]; o8[64 * j] = (unsigned long long)pk2(v[j].x * r * g.x, v[j].y * r * g.y) | ((unsigned long long)pk2(v[j].z * r * g.z, v[j].w * r * g.w) << 32); }
}
__device__ __forceinline__ void p0_prologue(Frame& F, const In& in, unsigned char* ws) {
    const int tid = fresh_tid(), lane = tid & 63, wave = __builtin_amdgcn_readfirstlane(tid >> 6);
    LAS float* scr = (LAS float*)(F.lds + RING_OFF + wave * 16384);
    const int gw = F.vcu * NWAVES + wave, NGW = F.G * NWAVES;
    constexpr int I_GU = 176 * 16, I_D = 32 * 44, I_IN = 184 * 16, I_C1 = 8 * 32, I_C2 = 2 * 4, I_BN = 32 * 8, I_BD = 32 * 4, I_O = 32 * 16;
    constexpr int NITEMS = 2 * I_GU + 2 * I_D + I_IN + 2 * I_C1 + 2 * I_C2 + I_BN + I_BD + I_O;
    auto decode = [&](int it) -> TrItem {
        TrItem t; int r = it, sc0 = 0, nv = 32; t.frag = 0;
        if (r < I_GU) { const int dblk = r / 16; gu_map(dblk, sc0); t = TrItem{in.f1_wgu, (bf16*)(ws + WS_WGU1), D, 2 * FF, sc0, 32, dblk * 32, r % 16, 0}; return t; } r -= I_GU;
        if (r < I_GU) { const int dblk = r / 16; gu_map(dblk, sc0); t = TrItem{in.f2_wgu, (bf16*)(ws + WS_WGU2), D, 2 * FF, sc0, 32, dblk * 32, r % 16, 0}; return t; } r -= I_GU;
        if (r < I_D) { const int dblk = r / 44; t = TrItem{in.f1_wd, (bf16*)(ws + WS_WD1), FF, D, dblk * 32, 32, dblk * 32, r % 44, 0}; return t; } r -= I_D;
        if (r < I_D) { const int dblk = r / 44; t = TrItem{in.f2_wd, (bf16*)(ws + WS_WD2), FF, D, dblk * 32, 32, dblk * 32, r % 44, 0}; return t; } r -= I_D;
        if (r < I_IN) { const int dblk = r / 16; win_map(dblk, sc0, nv); t = TrItem{in.w_in, (bf16*)(ws + WS_WIN), D, NPROJ_SRC, sc0, nv, dblk * 32, r % 16, 0}; return t; } r -= I_IN;
        if (r < I_C1) { const int dblk = r / 32; t = TrItem{in.cw1_k, (bf16*)(ws + WS_WC1K), 2048, 256, dblk * 32, 32, dblk * 32, r % 32, 1}; return t; } r -= I_C1;
        if (r < I_C1) { const int dblk = r / 32; t = TrItem{in.cw1_v, (bf16*)(ws + WS_WC1V), 2048, 256, dblk * 32, 32, dblk * 32, r % 32, 1}; return t; } r -= I_C1;
        if (r < I_C2) { const int dblk = r / 4; t = TrItem{in.cw2_k, (bf16*)(ws + WS_WC2K), 256, 64, dblk * 32, 32, dblk * 32, r % 4, 0}; return t; } r -= I_C2;
        if (r < I_C2) { const int dblk = r / 4; t = TrItem{in.cw2_v, (bf16*)(ws + WS_WC2V), 256, 64, dblk * 32, 32, dblk * 32, r % 4, 0}; return t; } r -= I_C2;
        if (r < I_BN) { const int dblk = r / 8; t = TrItem{in.w_bn, (bf16*)(ws + WS_WBN), 512, D, dblk * 32, 32, dblk * 32, r % 8, 0}; return t; } r -= I_BN;
        if (r < I_BD) { const int dblk = r / 4; t = TrItem{in.w_bd, (bf16*)(ws + WS_WBD), 256, D, dblk * 32, 32, dblk * 32, r % 4, 0}; return t; } r -= I_BD;
        { const int dblk = r / 16; t = TrItem{in.w_out, (bf16*)(ws + WS_WOUT), D, D, dblk * 32, 32, dblk * 32, r % 16, 0}; return t; }
    };
    {
        f32x4 va[8], vb[8]; TrItem ta, tb;
        int it = gw; if (it < NITEMS) { ta = decode(it); tr_load(ta, va, lane); }
        while (it < NITEMS) {
            const int itn = it + NGW; if (itn < NITEMS) { tb = decode(itn); tr_load(tb, vb, lane); }
            tr_finish(ta, va, scr, lane);
            it = itn; if (it >= NITEMS) break;
            const int itm = it + NGW; if (itm < NITEMS) { ta = decode(itm); tr_load(ta, va, lane); }
            tr_finish(tb, vb, scr, lane);
            it = itm;
        }
    }
    { float* ln = (float*)(ws + WS_LUTN); float* ld = (float*)(ws + WS_LUTD); const int gt = F.vcu * (NWAVES * 64) + tid, NGT = F.G * NWAVES * 64;
      for (int e = gt; e < 8 * LUTW; e += NGT) { const int hd = e / LUTW, d = e % LUTW - LUT_PAD; ln[e] = (d >= 0) ? in.rel_bias[t5_bucket(d) * 20 + hd] * LOG2E : 0.f; }
      for (int e = gt; e < 12 * 320; e += NGT) { const int hd = e / 320, st = e % 320 - LUT_PAD; const int dil = 1 << (2 * (hd >> 2)); ld[e] = (st >= 0 && st <= 128) ? in.rel_bias[t5_bucket(st * dil) * 20 + 8 + hd] * LOG2E : 0.f; } }
    { float* cb = (float*)(ws + WS_CB);
      for (int o = gw; o < 512; o += NGW) { const int ts = o >> 8, n = o & 255; const float* pos = ts ? in.cpos_v : in.cpos_k; const float* w1 = ts ? in.cw1_v : in.cw1_k;
          float s = 0.f; for (int k = lane; k < 2048; k += 64) s += pos[k] * w1[(size_t)k * 256 + n];
          s = wave_sum(s); if (lane == 0) cb[o] = s; } }
    for (int m = gw; m < M; m += 2 * NGW) {
        const int m2 = m + NGW;
        const GAS f32x4* xa = (const GAS f32x4*)(in.x + (size_t)m * D) + lane; const GAS f32x4* xb = (const GAS f32x4*)(in.x + (size_t)(m2 < M ? m2 : m) * D) + lane;
        const GAS f32x4* gr = (const GAS f32x4*)in.f1_pre + lane;
        f32x4 va[4], vb[4]; float sa = 0.f, sb = 0.f;
#pragma unroll
        for (int j = 0; j < 4; ++j) { va[j] = xa[64 * j]; vb[j] = xb[64 * j]; }
#pragma unroll
        for (int j = 0; j < 4; ++j) { sa += (va[j].x * va[j].x + va[j].y * va[j].y) + (va[j].z * va[j].z + va[j].w * va[j].w); sb += (vb[j].x * vb[j].x + vb[j].y * vb[j].y) + (vb[j].z * vb[j].z + vb[j].w * vb[j].w); }
        const float ra = 1.f / sqrtf(wave_sum(sa) * (1.f / D) + RMS_EPS), rb = 1.f / sqrtf(wave_sum(sb) * (1.f / D) + RMS_EPS);
        GAS unsigned long long* oa = (GAS unsigned long long*)((bf16*)(ws + WS_XN) + (size_t)m * D) + lane; GAS unsigned long long* ob = (GAS unsigned long long*)((bf16*)(ws + WS_XN) + (size_t)(m2 < M ? m2 : m) * D) + lane;
#pragma unroll
        for (int j = 0; j < 4; ++j) { const f32x4 g = gr[64 * j];
            oa[64 * j] = (unsigned long long)pk2(va[j].x * ra * g.x, va[j].y * ra * g.y) | ((unsigned long long)pk2(va[j].z * ra * g.z, va[j].w * ra * g.w) << 32);
            if (m2 < M) ob[64 * j] = (unsigned long long)pk2(vb[j].x * rb * g.x, vb[j].y * rb * g.y) | ((unsigned long long)pk2(vb[j].z * rb * g.z, vb[j].w * rb * g.w) << 32); }
    }
}
__device__ __forceinline__ f32x4 ld_bf4(const GAS unsigned long long* p) { const unsigned long long w = *p; const unsigned lo = (unsigned)w, hi = (unsigned)(w >> 32);
    f32x4 v; v.x = __uint_as_float(lo << 16); v.y = __uint_as_float(lo & 0xffff0000u); v.z = __uint_as_float(hi << 16); v.w = __uint_as_float(hi & 0xffff0000u); return v; }
template <bool BB, bool OB, int NR = 4> __device__ __forceinline__ void row_pass(Frame& F, const bf16* Y, const void* base, void* out, float alpha, const float* gpost, const float* gnext, bf16* XN) {
    const int tid = fresh_tid(), lane = tid & 63, wave = __builtin_amdgcn_readfirstlane(tid >> 6);
    const int gw = F.vcu * NWAVES + wave, NGW = F.G * NWAVES;
    const GAS f32x4* gp = (const GAS f32x4*)gpost + lane;
    for (int m0 = gw; m0 < M; m0 += NR * NGW) {
        int mr[NR];
#pragma unroll
        for (int q = 0; q < NR; ++q) mr[q] = (m0 + q * NGW < M) ? m0 + q * NGW : m0;
        f32x4 v[NR][4], bv[NR][4]; float s[NR];
#pragma unroll
        for (int q = 0; q < NR; ++q) s[q] = 0.f;
#pragma unroll
        for (int q = 0; q < NR; ++q) { const int m = mr[q];
            const GAS unsigned long long* yr = (const GAS unsigned long long*)(Y + (size_t)m * D) + lane;
#pragma unroll
            for (int j = 0; j < 4; ++j) { v[q][j] = ld_bf4(yr + 64 * j);
                if (BB) bv[q][j] = ld_bf4((const GAS unsigned long long*)((const bf16*)base + (size_t)m * D) + lane + 64 * j); else bv[q][j] = ((const GAS f32x4*)((const float*)base + (size_t)m * D) + lane)[64 * j]; } }
#pragma unroll
        for (int q = 0; q < NR; ++q)
#pragma unroll
            for (int j = 0; j < 4; ++j) s[q] += (v[q][j].x * v[q][j].x + v[q][j].y * v[q][j].y) + (v[q][j].z * v[q][j].z + v[q][j].w * v[q][j].w);
        float r[NR], s2[NR];
#pragma unroll
        for (int q = 0; q < NR; ++q) s2[q] = 0.f;
#pragma unroll
        for (int q = 0; q < NR; ++q) r[q] = alpha / sqrtf(wave_sum(s[q]) * (1.f / D) + RMS_EPS);
#pragma unroll
        for (int q = 0; q < NR; ++q) { const int m = mr[q]; if (q >= 1 && mr[q] == mr[0]) continue;
#pragma unroll
            for (int j = 0; j < 4; ++j) { const f32x4 g = gp[64 * j]; v[q][j] = bv[q][j] + v[q][j] * r[q] * g;
                if (OB) ((GAS unsigned long long*)((bf16*)out + (size_t)m * D) + lane)[64 * j] = (unsigned long long)pk2(v[q][j].x, v[q][j].y) | ((unsigned long long)pk2(v[q][j].z, v[q][j].w) << 32);
                else ((GAS f32x4*)((float*)out + (size_t)m * D) + lane)[64 * j] = v[q][j];
                s2[q] += (v[q][j].x * v[q][j].x + v[q][j].y * v[q][j].y) + (v[q][j].z * v[q][j].z + v[q][j].w * v[q][j].w); } }
        if (gnext) {
            const GAS f32x4* gn = (const GAS f32x4*)gnext + lane;
#pragma unroll
            for (int q = 0; q < NR; ++q) { const int m = mr[q]; if (q >= 1 && mr[q] == mr[0]) continue;
                const float r2 = 1.f / sqrtf(wave_sum(s2[q]) * (1.f / D) + RMS_EPS);
                GAS unsigned long long* o8 = (GAS unsigned long long*)(XN + (size_t)m * D) + lane;
#pragma unroll
                for (int j = 0; j < 4; ++j) { const f32x4 g = gn[64 * j]; o8[64 * j] = (unsigned long long)pk2(v[q][j].x * r2 * g.x, v[q][j].y * r2 * g.y) | ((unsigned long long)pk2(v[q][j].z * r2 * g.z, v[q][j].w * r2 * g.w) << 32); } }
        }
    }
}

namespace att {
typedef float f32x16 __attribute__((ext_vector_type(16)));
typedef short s16x4 __attribute__((ext_vector_type(4)));
typedef short v4i16_t __attribute__((ext_vector_type(4)));
constexpr float NEGV = -1.0e30f;
constexpr int TILE_B = 16384, SBUF = 2 * TILE_B;
enum { CLS_SKIP = 0, CLS_FULL = 1, CLS_PART = 2, CLS_CONST = 3 };
__device__ __forceinline__ constexpr int crow(int r, int hi) { return (r & 3) + 8 * (r >> 2) + 4 * hi; }
__device__ __forceinline__ unsigned cvtpk(float lo, float hi) { unsigned r; asm volatile("v_cvt_pk_bf16_f32 %0, %1, %2" : "=v"(r) : "v"(lo), "v"(hi)); return r; }
__device__ __forceinline__ float swapmax(float v) { auto rr = __builtin_amdgcn_permlane32_swap(__float_as_uint(v), __float_as_uint(v), false, false); return fmaxf(__uint_as_float(rr[0]), __uint_as_float(rr[1])); }
__device__ __forceinline__ float swapsum(float v) { auto rr = __builtin_amdgcn_permlane32_swap(__float_as_uint(v), __float_as_uint(v), false, false); return __uint_as_float(rr[0]) + __uint_as_float(rr[1]); }
__device__ __forceinline__ float quadsum(float v) {
    v += __int_as_float(__builtin_amdgcn_mov_dpp(__float_as_int(v), 0xB1, 0xF, 0xF, true));
    v += __int_as_float(__builtin_amdgcn_mov_dpp(__float_as_int(v), 0x4E, 0xF, 0xF, true));
    return v;
}
struct Stage { v4u k, v; };
struct Stage2 { Stage t[2]; };
__device__ __forceinline__ void tile_load(Stage& s, const bf16* Kp, const bf16* Vp, long row, int tid) {
    const int ch = tid & 7; s.k = *(const GAS v4u*)(Kp + row * 64 + ch * 8); s.v = *(const GAS v4u*)(Vp + row * 64 + ch * 8);
}
__device__ __forceinline__ void tile_store(LAS unsigned char* buf, const Stage& s, int tid) {
    const int key = tid >> 3, ch = tid & 7;
    *(LAS v4u*)(buf + ch * 1024 + key * 16) = s.k;
    *(LAS v4u*)(buf + 8192 + (ch >> 2) * 4096 + key * 64 + (ch & 3) * 16) = s.v;
}
#define SBAR() __builtin_amdgcn_sched_barrier(0)
#ifndef ATT_SHIFT
#define ATT_SHIFT 8
#endif
#define ATT_BAR() asm volatile("s_waitcnt lgkmcnt(0)\n\ts_barrier" ::: "memory")
__device__ __forceinline__ void qk(f32x16& p0, f32x16& p1, const LAS unsigned char* kb, const bf16x8 (&qr)[4]) {
#pragma unroll
    for (int d0 = 0; d0 < 4; ++d0) {
        const bf16x8 b0 = *(const LAS bf16x8*)(kb + d0 * 2048), b1 = *(const LAS bf16x8*)(kb + d0 * 2048 + 512);
        p0 = __builtin_amdgcn_mfma_f32_32x32x16_bf16(b0, qr[d0], p0, 0, 0, 0);
        p1 = __builtin_amdgcn_mfma_f32_32x32x16_bf16(b1, qr[d0], p1, 0, 0, 0);
    }
}
__device__ __forceinline__ float max3f(float a, float b, float c) { float r; asm("v_max3_f32 %0, %1, %2, %3" : "=v"(r) : "v"(a), "v"(b), "v"(c)); return r; }
__device__ __forceinline__ float rowmax32(const f32x16& p0, const f32x16& p1) {
    float a = __builtin_fmaxf(p0[0], p1[0]), b = __builtin_fmaxf(p0[1], p1[1]);
    asm volatile("" : "+v"(a), "+v"(b));
#pragma unroll
    for (int r = 2; r < 16; r += 2) { a = max3f(a, p0[r], p1[r]); b = max3f(b, p0[r + 1], p1[r + 1]); }
    return swapmax(fmaxf(a, b));
}
__device__ __forceinline__ s16x4 vtr(const LAS unsigned char* p) { return __builtin_bit_cast(s16x4, __builtin_amdgcn_ds_read_tr16_b64_v4i16((LAS v4i16_t*)p)); }
__device__ __forceinline__ void pv(f32x16 (&o)[2], const LAS unsigned char* vb, const f32x16& p0, const f32x16& p1) {
    v4u pw[4];
#pragma unroll
    for (int s = 0; s < 2; ++s) {
        pw[s]     = (v4u){cvtpk(p0[8 * s], p0[8 * s + 1]), cvtpk(p0[8 * s + 2], p0[8 * s + 3]), cvtpk(p0[8 * s + 4], p0[8 * s + 5]), cvtpk(p0[8 * s + 6], p0[8 * s + 7])};
        pw[2 + s] = (v4u){cvtpk(p1[8 * s], p1[8 * s + 1]), cvtpk(p1[8 * s + 2], p1[8 * s + 3]), cvtpk(p1[8 * s + 4], p1[8 * s + 5]), cvtpk(p1[8 * s + 6], p1[8 * s + 7])};
    }
#pragma unroll
    for (int dh = 0; dh < 2; ++dh)
#pragma unroll
        for (int kg = 0; kg < 4; ++kg) {
            const s16x4 lo = vtr(vb + dh * 4096 + kg * 1024), hi = vtr(vb + dh * 4096 + kg * 1024 + 512);
            const bf16x8 vf = (bf16x8){lo[0], lo[1], lo[2], lo[3], hi[0], hi[1], hi[2], hi[3]};
            o[dh] = __builtin_amdgcn_mfma_f32_32x32x16_bf16(__builtin_bit_cast(bf16x8, pw[kg]), vf, o[dh], 0, 0, 0);
        }
}
struct Soft { float mref, lsum; };
__device__ __forceinline__ void proc_tile(int cls, const LAS unsigned char* tile, const bf16x8 (&qr)[4], Soft& st, f32x16 (&o)[2], const LAS float* lut, int d0, int dlo, int dhi, float cbias, bool rowsel,
                                          LAS float* wsf, int r32, int hi, int trb) {
    const bool unset = st.mref < -1.0e29f;
    const float base = unset ? 0.f : st.mref;
    const float negb = rowsel ? -base : NEGV;
    f32x16 p0, p1; bf16x8 kf0[4], kf1[4];
    { const LAS unsigned char* kb = tile + hi * 1024 + r32 * 16;
#pragma unroll
      for (int q = 0; q < 4; ++q) { kf0[q] = *(const LAS bf16x8*)(kb + q * 2048); kf1[q] = *(const LAS bf16x8*)(kb + q * 2048 + 512); } }
    if (cls == CLS_CONST) { const float iv = negb + cbias;
#pragma unroll
        for (int r = 0; r < 16; ++r) { p0[r] = iv; p1[r] = iv; }
    } else { const LAS float* pb = lut + (d0 - 4 * hi - 59);
#pragma unroll
        for (int r = 0; r < 16; ++r) { p0[r] = pb[59 - crow(r, 0)]; p1[r] = pb[27 - crow(r, 0)]; }
        SBAR();
#pragma unroll
        for (int r = 0; r < 16; ++r) { p0[r] += negb; p1[r] += negb; }
    }
    SBAR();
#pragma unroll
    for (int q = 0; q < 4; ++q) { p0 = __builtin_amdgcn_mfma_f32_32x32x16_bf16(kf0[q], qr[q], p0, 0, 0, 0); p1 = __builtin_amdgcn_mfma_f32_32x32x16_bf16(kf1[q], qr[q], p1, 0, 0, 0); }
    SBAR();
    s16x4 vlo[8], vhi[8];
    { const LAS unsigned char* vb = tile + 8192 + trb;
#pragma unroll
      for (int i = 0; i < 8; ++i) { vlo[i] = vtr(vb + (i >> 2) * 4096 + (i & 3) * 1024); vhi[i] = vtr(vb + (i >> 2) * 4096 + (i & 3) * 1024 + 512); } }
    SBAR();
    if (cls == CLS_PART) { const int dq = d0 - 4 * hi; const unsigned span = (unsigned)(dhi - dlo);
#pragma unroll
        for (int r = 0; r < 16; ++r) { const int da = dq - crow(r, 0), db = da - 32;
            p0[r] = ((unsigned)(da - dlo) <= span) ? p0[r] : NEGV; p1[r] = ((unsigned)(db - dlo) <= span) ? p1[r] : NEGV; }
    }
    const float rm = rowmax32(p0, p1);
    const bool upd = rowsel && (rm > -1.0e29f) && (unset || rm > 8.0f);
    if (__any(upd)) {
        const float delta = upd ? rm : 0.f;
#pragma unroll
        for (int r = 0; r < 16; ++r) { p0[r] -= delta; p1[r] -= delta; }
        const float f = (upd && !unset) ? __builtin_amdgcn_exp2f(-delta) : 1.0f;
        st.lsum *= f;
        if (upd) st.mref = base + delta;
        if (hi == 0) wsf[r32] = f;
        asm volatile("s_waitcnt lgkmcnt(0)" ::: "memory");
#pragma unroll
        for (int r = 0; r < 16; ++r) { const float fr = wsf[crow(r, hi)]; o[0][r] *= fr; o[1][r] *= fr; }
        asm volatile("s_waitcnt lgkmcnt(0)" ::: "memory");
    }
    float s = 0.f;
#pragma unroll
    for (int r = 0; r < 16; ++r) { p0[r] = __builtin_amdgcn_exp2f(p0[r]); p1[r] = __builtin_amdgcn_exp2f(p1[r]); s += p0[r] + p1[r]; }
    st.lsum += s;
    v4u pw[4];
#pragma unroll
    for (int q = 0; q < 2; ++q) {
        pw[q]     = (v4u){cvtpk(p0[8 * q], p0[8 * q + 1]), cvtpk(p0[8 * q + 2], p0[8 * q + 3]), cvtpk(p0[8 * q + 4], p0[8 * q + 5]), cvtpk(p0[8 * q + 6], p0[8 * q + 7])};
        pw[2 + q] = (v4u){cvtpk(p1[8 * q], p1[8 * q + 1]), cvtpk(p1[8 * q + 2], p1[8 * q + 3]), cvtpk(p1[8 * q + 4], p1[8 * q + 5]), cvtpk(p1[8 * q + 6], p1[8 * q + 7])};
    }
    SBAR();
#pragma unroll
    for (int kg = 0; kg < 4; ++kg)
#pragma unroll
        for (int dh = 0; dh < 2; ++dh) { const int i = dh * 4 + kg;
            const bf16x8 vf = (bf16x8){vlo[i][0], vlo[i][1], vlo[i][2], vlo[i][3], vhi[i][0], vhi[i][1], vhi[i][2], vhi[i][3]};
            o[dh] = __builtin_amdgcn_mfma_f32_32x32x16_bf16(__builtin_bit_cast(bf16x8, pw[kg]), vf, o[dh], 0, 0, 0); }
}
__device__ __forceinline__ void proc_pair(int clsA, int clsB, const LAS unsigned char* tA, const LAS unsigned char* tB, const bf16x8 (&qr)[4], Soft& st, f32x16 (&o)[2], const LAS float* lut,
                                          int d0A, int d0B, int dlo, int dhi, float cbias, bool selA, bool selB, LAS float* wsf, int r32, int hi, int trb) {
    const bool unset = st.mref < -1.0e29f;
    const float base = unset ? 0.f : st.mref;
    const float negA = selA ? -base : NEGV, negB = selB ? -base : NEGV;
    f32x16 a0, a1, b0, b1; bf16x8 kA0[4], kA1[4], kB0[4], kB1[4];
    { const LAS unsigned char* kb = tA + hi * 1024 + r32 * 16;
#pragma unroll
      for (int q = 0; q < 4; ++q) { kA0[q] = *(const LAS bf16x8*)(kb + q * 2048); kA1[q] = *(const LAS bf16x8*)(kb + q * 2048 + 512); } }
    if (clsA == CLS_CONST) { const float iv = negA + cbias;
#pragma unroll
        for (int r = 0; r < 16; ++r) { a0[r] = iv; a1[r] = iv; }
    } else { const LAS float* pb = lut + (d0A - 4 * hi - 59);
#pragma unroll
        for (int r = 0; r < 16; ++r) { a0[r] = pb[59 - crow(r, 0)]; a1[r] = pb[27 - crow(r, 0)]; } }
    if (clsB == CLS_CONST) { const float iv = negB + cbias;
#pragma unroll
        for (int r = 0; r < 16; ++r) { b0[r] = iv; b1[r] = iv; }
    } else { const LAS float* pb = lut + (d0B - 4 * hi - 59);
#pragma unroll
        for (int r = 0; r < 16; ++r) { b0[r] = pb[59 - crow(r, 0)]; b1[r] = pb[27 - crow(r, 0)]; } }
    SBAR();
    if (clsA != CLS_CONST) {
#pragma unroll
        for (int r = 0; r < 16; ++r) { a0[r] += negA; a1[r] += negA; } }
    if (clsB != CLS_CONST) {
#pragma unroll
        for (int r = 0; r < 16; ++r) { b0[r] += negB; b1[r] += negB; } }
    SBAR();
#pragma unroll
    for (int q = 0; q < 4; ++q) { a0 = __builtin_amdgcn_mfma_f32_32x32x16_bf16(kA0[q], qr[q], a0, 0, 0, 0); a1 = __builtin_amdgcn_mfma_f32_32x32x16_bf16(kA1[q], qr[q], a1, 0, 0, 0); }
    { const LAS unsigned char* kb = tB + hi * 1024 + r32 * 16;
#pragma unroll
      for (int q = 0; q < 4; ++q) { kB0[q] = *(const LAS bf16x8*)(kb + q * 2048); kB1[q] = *(const LAS bf16x8*)(kb + q * 2048 + 512); } }
    SBAR();
#pragma unroll
    for (int q = 0; q < 4; ++q) { b0 = __builtin_amdgcn_mfma_f32_32x32x16_bf16(kB0[q], qr[q], b0, 0, 0, 0); b1 = __builtin_amdgcn_mfma_f32_32x32x16_bf16(kB1[q], qr[q], b1, 0, 0, 0); }
    SBAR();
    s16x4 vlo[8], vhi[8];
    { const LAS unsigned char* vb = tA + 8192 + trb;
#pragma unroll
      for (int i = 0; i < 8; ++i) { vlo[i] = vtr(vb + (i >> 2) * 4096 + (i & 3) * 1024); vhi[i] = vtr(vb + (i >> 2) * 4096 + (i & 3) * 1024 + 512); } }
    SBAR();
    if (clsA == CLS_PART) { const int dq = d0A - 4 * hi; const unsigned span = (unsigned)(dhi - dlo);
#pragma unroll
        for (int r = 0; r < 16; ++r) { const int da = dq - crow(r, 0), db = da - 32;
            a0[r] = ((unsigned)(da - dlo) <= span) ? a0[r] : NEGV; a1[r] = ((unsigned)(db - dlo) <= span) ? a1[r] : NEGV; } }
    if (clsB == CLS_PART) { const int dq = d0B - 4 * hi; const unsigned span = (unsigned)(dhi - dlo);
#pragma unroll
        for (int r = 0; r < 16; ++r) { const int da = dq - crow(r, 0), db = da - 32;
            b0[r] = ((unsigned)(da - dlo) <= span) ? b0[r] : NEGV; b1[r] = ((unsigned)(db - dlo) <= span) ? b1[r] : NEGV; } }
    const float rm = fmaxf(rowmax32(a0, a1), rowmax32(b0, b1));
    const bool upd = (selA || selB) && (rm > -1.0e29f) && (unset || rm > 8.0f);
    if (__any(upd)) {
        const float delta = upd ? rm : 0.f;
#pragma unroll
        for (int r = 0; r < 16; ++r) { a0[r] -= delta; a1[r] -= delta; b0[r] -= delta; b1[r] -= delta; }
        const float f = (upd && !unset) ? __builtin_amdgcn_exp2f(-delta) : 1.0f;
        st.lsum *= f;
        if (upd) st.mref = base + delta;
        if (hi == 0) wsf[r32] = f;
        asm volatile("s_waitcnt lgkmcnt(0)" ::: "memory");
#pragma unroll
        for (int r = 0; r < 16; ++r) { const float fr = wsf[crow(r, hi)]; o[0][r] *= fr; o[1][r] *= fr; }
        asm volatile("s_waitcnt lgkmcnt(0)" ::: "memory");
    }
    float s = 0.f;
#pragma unroll
    for (int r = 0; r < 16; ++r) { a0[r] = __builtin_amdgcn_exp2f(a0[r]); a1[r] = __builtin_amdgcn_exp2f(a1[r]); b0[r] = __builtin_amdgcn_exp2f(b0[r]); b1[r] = __builtin_amdgcn_exp2f(b1[r]); s += (a0[r] + a1[r]) + (b0[r] + b1[r]); }
    st.lsum += s;
    v4u pa[4], pq[4];
#pragma unroll
    for (int q = 0; q < 2; ++q) {
        pa[q]     = (v4u){cvtpk(a0[8 * q], a0[8 * q + 1]), cvtpk(a0[8 * q + 2], a0[8 * q + 3]), cvtpk(a0[8 * q + 4], a0[8 * q + 5]), cvtpk(a0[8 * q + 6], a0[8 * q + 7])};
        pa[2 + q] = (v4u){cvtpk(a1[8 * q], a1[8 * q + 1]), cvtpk(a1[8 * q + 2], a1[8 * q + 3]), cvtpk(a1[8 * q + 4], a1[8 * q + 5]), cvtpk(a1[8 * q + 6], a1[8 * q + 7])};
        pq[q]     = (v4u){cvtpk(b0[8 * q], b0[8 * q + 1]), cvtpk(b0[8 * q + 2], b0[8 * q + 3]), cvtpk(b0[8 * q + 4], b0[8 * q + 5]), cvtpk(b0[8 * q + 6], b0[8 * q + 7])};
        pq[2 + q] = (v4u){cvtpk(b1[8 * q], b1[8 * q + 1]), cvtpk(b1[8 * q + 2], b1[8 * q + 3]), cvtpk(b1[8 * q + 4], b1[8 * q + 5]), cvtpk(b1[8 * q + 6], b1[8 * q + 7])};
    }
    SBAR();
#pragma unroll
    for (int kg = 0; kg < 4; ++kg)
#pragma unroll
        for (int dh = 0; dh < 2; ++dh) { const int i = dh * 4 + kg;
            const bf16x8 vf = (bf16x8){vlo[i][0], vlo[i][1], vlo[i][2], vlo[i][3], vhi[i][0], vhi[i][1], vhi[i][2], vhi[i][3]};
            o[dh] = __builtin_amdgcn_mfma_f32_32x32x16_bf16(__builtin_bit_cast(bf16x8, pa[kg]), vf, o[dh], 0, 0, 0); }
    s16x4 wlo[8], whi[8];
    { const LAS unsigned char* vb = tB + 8192 + trb;
#pragma unroll
      for (int i = 0; i < 8; ++i) { wlo[i] = vtr(vb + (i >> 2) * 4096 + (i & 3) * 1024); whi[i] = vtr(vb + (i >> 2) * 4096 + (i & 3) * 1024 + 512); } }
    SBAR();
#pragma unroll
    for (int kg = 0; kg < 4; ++kg)
#pragma unroll
        for (int dh = 0; dh < 2; ++dh) { const int i = dh * 4 + kg;
            const bf16x8 vf = (bf16x8){wlo[i][0], wlo[i][1], wlo[i][2], wlo[i][3], whi[i][0], whi[i][1], whi[i][2], whi[i][3]};
            o[dh] = __builtin_amdgcn_mfma_f32_32x32x16_bf16(__builtin_bit_cast(bf16x8, pq[kg]), vf, o[dh], 0, 0, 0); }
}
__device__ __forceinline__ float soft_final_inv(const Soft& st, float& ltot) { ltot = swapsum(st.lsum); return (st.mref > -1.0e29f) ? 1.0f / ltot : 0.f; }
}

struct Mix {
    bf16 *QN, *YN, *SCR, *PL, *QD, *KD, *VD, *YD, *KCMP, *VCMP, *OD; float* LSE; const float* GN; const float* LUTN; const float* LUTD; const float* CB;
    const bf16 *WC1K, *WC1V, *WC2K, *WC2V;
};
__device__ __forceinline__ void lut_to_lds(Frame& F, int tid, const float* img, int nf) {
    LAS f32x4* L = (LAS f32x4*)(F.lds + A_LUT); const GAS f32x4* G = (const GAS f32x4*)img;
    for (int e = tid; e < nf / 4; e += NWAVES * 64) L[e] = G[e];
}
__device__ __forceinline__ bf16x8 ldq(const bf16* p) { return *(const GAS bf16x8*)p; }

__device__ __forceinline__ int next_sel(int j, int c, unsigned u0, unsigned u1, unsigned u2, unsigned u3) {
    while (j <= c) { const unsigned w = (j < 32) ? u0 : (j < 64) ? u1 : (j < 96) ? u2 : u3; if ((w >> (j & 31)) & 1u) break; ++j; }
    return j;
}
template <bool ADD> __device__ __forceinline__ void yn_rows(bf16* YN, const att::f32x16 (&o)[2], float fac, LAS float* wsf, int r32, int hi, size_t R0, int g, int lane) {
    if (hi == 0) wsf[r32] = fac;
    asm volatile("s_waitcnt lgkmcnt(0)" ::: "memory");
#pragma unroll
    for (int r = 0; r < 16; ++r) { const int q = att::crow(r, hi); const float fr = wsf[q];
        bf16* op = YN + (R0 + (q >> 2)) * 512 + (4 * g + (q & 3)) * 64 + (lane & 31);
        float a0 = o[0][r] * fr, a1 = o[1][r] * fr;
        if (ADD) { a0 += __uint_as_float((unsigned)op[0] << 16); a1 += __uint_as_float((unsigned)op[32] << 16); }
        op[0] = (bf16)f2bf(a0); op[32] = (bf16)f2bf(a1); }
    asm volatile("s_waitcnt lgkmcnt(0)" ::: "memory");
}
__device__ __forceinline__ void nsa_unit(Frame& F, const Mix& X, int b, int g, int c, int& buf) {
    using namespace att;
    const int tid = fresh_tid(), lane = tid & 63, wave = __builtin_amdgcn_readfirstlane(tid >> 6), r32 = lane & 31, hi = lane >> 5;
    LAS unsigned char* kv = F.lds + A_KV; LAS float* lutl = (LAS float*)(F.lds + A_LUT); LAS float* imp = (LAS float*)(F.lds + A_IMP);
    LAS unsigned* selm = (LAS unsigned*)(F.lds + A_SEL); LAS unsigned* um = (LAS unsigned*)(F.lds + A_UM); LAS float* wsf = (LAS float*)(F.lds + A_WSF) + wave * 128;
    const int trb = ((lane >> 4) & 1) * 32 + (lane & 3) * 8 + (4 * hi + ((lane & 15) >> 2)) * 64;
    const int t0 = 64 * c, tok = 8 * wave + (r32 >> 2), h = r32 & 3, t = t0 + tok;
    const size_t R = (size_t)b * SEQ + t, R0 = (size_t)b * SEQ + t0 + 8 * wave;
    const int plane = b * 2 + g;
    const bf16* KS = X.PL + 2 * PLSZ + (size_t)plane * SEQ * 64; const bf16* VS = X.PL + 3 * PLSZ + (size_t)plane * SEQ * 64;
    const bf16* KW = X.PL + 4 * PLSZ + (size_t)plane * SEQ * 64; const bf16* VW = X.PL + 5 * PLSZ + (size_t)plane * SEQ * 64;
    const bf16* KC = X.KCMP + (size_t)plane * 512 * 64; const bf16* VC = X.VCMP + (size_t)plane * 512 * 64;
    __syncthreads();
    lut_to_lds(F, tid, X.LUTN + (size_t)g * 4 * LUTW, 4 * LUTW);
    for (int e = tid; e < 64 * IMP_S / 4; e += NWAVES * 64) ((LAS f32x4*)imp)[e] = (f32x4){0.f, 0.f, 0.f, 0.f};
    if (tid < 4) um[tid] = 0u;
    bf16x8 qr[4];
#pragma unroll
    for (int d0 = 0; d0 < 4; ++d0) qr[d0] = ldq(X.QN + R * 512 + (4 * g + h) * 64 + 16 * d0 + 8 * hi);
    const float g0 = X.GN[R * 32 + (4 * g + h) * 3 + 0], g1 = X.GN[R * 32 + (4 * g + h) * 3 + 1], g2 = X.GN[R * 32 + (4 * g + h) * 3 + 2];
    const LAS float* lrow = lutl + h * LUTW + LUT_PAD;
    __syncthreads();
    const int key = tid >> 3;
    Stage2 sg;
    {
        Soft st{NEGV, 0.f}; f32x16 o[2]; o[0] = f32x16{}; o[1] = f32x16{};
        const int it0 = (c >= 8) ? 0 : (8 - c), nt = 9 - it0, nss = (nt + 1) >> 1;
#pragma unroll
        for (int tt = 0; tt < 2; ++tt) { int it = it0 + tt; it = it > 8 ? 8 : it; tile_load(sg.t[tt], KW, VW, t0 - 512 + 64 * it + key, tid); }
        for (int ss = 0; ss < nss; ++ss) {
            LAS unsigned char* bp = kv + buf * SBUF;
            tile_store(bp, sg.t[0], tid); tile_store(bp + TILE_B, sg.t[1], tid); ATT_BAR();
            if (ss + 1 < nss) {
#pragma unroll
                for (int tt = 0; tt < 2; ++tt) { int it = it0 + 2 * (ss + 1) + tt; it = it > 8 ? 8 : it; tile_load(sg.t[tt], KW, VW, t0 - 512 + 64 * it + key, tid); } }
            { const int itA = it0 + 2 * ss, itB = itA + 1; const int kbA = t0 - 512 + 64 * itA, kbB = kbA + 64;
              const int clsA = (itA == 0 || itA == 8) ? CLS_PART : CLS_FULL, clsB = (itB == 8) ? CLS_PART : CLS_FULL;
              if (itB <= 8) proc_pair(clsA, clsB, bp, bp + TILE_B, qr, st, o, lrow, t - kbA, t - kbB, 0, 511, 0.f, true, true, wsf, r32, hi, trb);
              else proc_tile(clsA, bp, qr, st, o, lrow, t - kbA, 0, 511, 0.f, true, wsf, r32, hi, trb); }
            buf ^= 1;
        }
        float lt; const float inv = soft_final_inv(st, lt);
        yn_rows<false>(X.YN, o, g2 * inv, wsf, r32, hi, R0, g, lane);
    }
    {
        const int imax = (4 * c + 2 > 510) ? 510 : (4 * c + 2), ntc = imax / 64 + 1, nss = (ntc + 1) >> 1;
        const int dq = t - 31 - 16 * 4 * hi;
        const float cfar = lrow[1599];
        float m = NEGV, l = 0.f;
#pragma unroll
        for (int tt = 0; tt < 2; ++tt) { int it = tt; it = it > ntc - 1 ? ntc - 1 : it; tile_load(sg.t[tt], KC, VC, 64 * it + key, tid); }
        for (int ss = 0; ss < nss; ++ss) {
            LAS unsigned char* bp = kv + buf * SBUF;
            tile_store(bp, sg.t[0], tid); tile_store(bp + TILE_B, sg.t[1], tid); ATT_BAR();
            if (ss + 1 < nss) {
#pragma unroll
                for (int tt = 0; tt < 2; ++tt) { int it = 2 * (ss + 1) + tt; it = it > ntc - 1 ? ntc - 1 : it; tile_load(sg.t[tt], KC, VC, 64 * it + key, tid); } }
#pragma unroll
            for (int tt = 0; tt < 2; ++tt) { const int it = 2 * ss + tt;
                if (it < ntc) {
                    f32x16 p0, p1; const int dt = dq - 1024 * it;
                    const bool far = (t0 - 31 - 1024 * it - 1008) >= 1513;
                    if (far) {
#pragma unroll
                        for (int r = 0; r < 16; ++r) { p0[r] = cfar; p1[r] = cfar; }
                    } else {
#pragma unroll
                        for (int r = 0; r < 16; ++r) { const int da = dt - 16 * crow(r, 0), db = da - 512;
                            const int ia = da < -64 ? -64 : (da > 1599 ? 1599 : da), ib = db < -64 ? -64 : (db > 1599 ? 1599 : db);
                            p0[r] = lrow[ia]; p1[r] = lrow[ib]; }
                    }
                    qk(p0, p1, bp + tt * TILE_B + hi * 1024 + r32 * 16, qr);
                    if (!far) {
#pragma unroll
                        for (int r = 0; r < 16; ++r) { const int da = dt - 16 * crow(r, 0), db = da - 512; p0[r] = (da >= 0) ? p0[r] : NEGV; p1[r] = (db >= 0) ? p1[r] : NEGV; }
                    }
                    const float rm = rowmax32(p0, p1);
                    const float mn = fmaxf(m, rm); float s = 0.f;
#pragma unroll
                    for (int r = 0; r < 16; ++r) s += __builtin_amdgcn_exp2f(p0[r] - mn) + __builtin_amdgcn_exp2f(p1[r] - mn);
                    l = l * __builtin_amdgcn_exp2f(m - mn) + s; m = mn;
                } }
            buf ^= 1;
        }
        const float ltot = swapsum(l);
        const float invl = (m > -1.0e29f) ? 1.0f / ltot : 0.f;
        const float mz = (m > -1.0e29f) ? m : 0.f;
        f32x16 o[2]; o[0] = f32x16{}; o[1] = f32x16{};
        LAS float* improw = imp + tok * IMP_S; float icarry = 0.f;
#pragma unroll
        for (int tt = 0; tt < 2; ++tt) { int it = tt; it = it > ntc - 1 ? ntc - 1 : it; tile_load(sg.t[tt], KC, VC, 64 * it + key, tid); }
        for (int ss = 0; ss < nss; ++ss) {
            LAS unsigned char* bp = kv + buf * SBUF;
            tile_store(bp, sg.t[0], tid); tile_store(bp + TILE_B, sg.t[1], tid); ATT_BAR();
            if (ss + 1 < nss) {
#pragma unroll
                for (int tt = 0; tt < 2; ++tt) { int it = 2 * (ss + 1) + tt; it = it > ntc - 1 ? ntc - 1 : it; tile_load(sg.t[tt], KC, VC, 64 * it + key, tid); } }
#pragma unroll
            for (int tt = 0; tt < 2; ++tt) { const int it = 2 * ss + tt;
                if (it < ntc) {
                    f32x16 p0, p1; const int dt = dq - 1024 * it;
                    const bool far = (t0 - 31 - 1024 * it - 1008) >= 1513;
                    if (far) { const float iv = cfar - mz;
#pragma unroll
                        for (int r = 0; r < 16; ++r) { p0[r] = iv; p1[r] = iv; }
                    } else {
#pragma unroll
                        for (int r = 0; r < 16; ++r) { const int da = dt - 16 * crow(r, 0), db = da - 512;
                            const int ia = da < -64 ? -64 : (da > 1599 ? 1599 : da), ib = db < -64 ? -64 : (db > 1599 ? 1599 : db);
                            p0[r] = lrow[ia] - mz; p1[r] = lrow[ib] - mz; }
                    }
                    qk(p0, p1, bp + tt * TILE_B + hi * 1024 + r32 * 16, qr);
#pragma unroll
                    for (int r = 0; r < 16; ++r) { p0[r] = __builtin_amdgcn_exp2f(p0[r]) * invl; p1[r] = __builtin_amdgcn_exp2f(p1[r]) * invl; }
                    if (!far) {
#pragma unroll
                        for (int r = 0; r < 16; ++r) { const int da = dt - 16 * crow(r, 0), db = da - 512; p0[r] = (da >= 0) ? p0[r] : 0.f; p1[r] = (db >= 0) ? p1[r] : 0.f; }
                    }
                    { float a0[4], l0[4], a1[4], l1[4], x0[4], x1[4];
#pragma unroll
                      for (int q = 0; q < 4; ++q) { a0[q] = quadsum((p0[4 * q] + p0[4 * q + 1]) + (p0[4 * q + 2] + p0[4 * q + 3])); l0[q] = quadsum(p0[4 * q + 3]);
                                                    a1[q] = quadsum((p1[4 * q] + p1[4 * q + 1]) + (p1[4 * q + 2] + p1[4 * q + 3])); l1[q] = quadsum(p1[4 * q + 3]); }
#pragma unroll
                      for (int q = 0; q < 4; ++q) { auto ra = __builtin_amdgcn_permlane32_swap(__float_as_uint(l0[q]), __float_as_uint(l0[q]), false, false); x0[q] = __uint_as_float(hi ? ra[0] : ra[1]);
                                                    auto rb = __builtin_amdgcn_permlane32_swap(__float_as_uint(l1[q]), __float_as_uint(l1[q]), false, false); x1[q] = __uint_as_float(hi ? rb[0] : rb[1]); }
                      if (h == 0) {
#pragma unroll
                          for (int q = 0; q < 4; ++q) { const float pv0 = hi ? x0[q] : (q ? x0[q ? q - 1 : 0] : icarry), pv1 = hi ? x1[q] : (q ? x1[q ? q - 1 : 0] : x0[3]);
                              improw[16 * it + 2 * q + hi] = a0[q] + pv0; improw[16 * it + 2 * q + hi + 8] = a1[q] + pv1; } }
                      icarry = x1[3]; }
                    pv(o, bp + tt * TILE_B + 8192 + trb, p0, p1);
                } }
            buf ^= 1;
        }
        yn_rows<true>(X.YN, o, g0, wsf, r32, hi, R0, g, lane);
    }
    asm volatile("s_waitcnt lgkmcnt(0)" ::: "memory");
    unsigned msk[4] = {0u, 0u, 0u, 0u};
    if (c >= 16) {
        const int tl = lane >> 3, part = lane & 7;
        const LAS float* ir = imp + (8 * wave + tl) * IMP_S + part * 16;
        unsigned v[16];
#pragma unroll
        for (int r = 0; r < 16; ++r) { const int j = part * 16 + r; const unsigned bits = __float_as_uint(ir[r]); v[r] = (j >= 1 && j <= c - 2) ? ((bits & ~127u) | (unsigned)(127 - j)) : 0u; }
        unsigned sm[4] = {0u, 0u, 0u, 0u};
        for (int itn = 0; itn < 13; ++itn) {
            unsigned mx = v[0];
#pragma unroll
            for (int r = 1; r < 16; ++r) mx = mx > v[r] ? mx : v[r];
            { unsigned o1 = (unsigned)__builtin_amdgcn_mov_dpp((int)mx, 0xB1, 0xF, 0xF, true); mx = mx > o1 ? mx : o1;
              o1 = (unsigned)__builtin_amdgcn_mov_dpp((int)mx, 0x4E, 0xF, 0xF, true); mx = mx > o1 ? mx : o1; o1 = (unsigned)__builtin_amdgcn_mov_dpp((int)mx, 0x141, 0xF, 0xF, true); mx = mx > o1 ? mx : o1; }
            const int j = 127 - (int)(mx & 127u); const unsigned bit = 1u << (j & 31); const int w = j >> 5;
            if (mx != 0u) { sm[0] |= (w == 0) ? bit : 0u; sm[1] |= (w == 1) ? bit : 0u; sm[2] |= (w == 2) ? bit : 0u; sm[3] |= (w == 3) ? bit : 0u; }
#pragma unroll
            for (int r = 0; r < 16; ++r) v[r] = (v[r] == mx) ? 0u : v[r];
        }
        sm[0] |= 1u;
        { const int j = c - 1; const unsigned bit = 1u << (j & 31); const int w = j >> 5; sm[0] |= (w == 0) ? bit : 0u; sm[1] |= (w == 1) ? bit : 0u; sm[2] |= (w == 2) ? bit : 0u; sm[3] |= (w == 3) ? bit : 0u; }
        { const int j = c; const unsigned bit = 1u << (j & 31); const int w = j >> 5; sm[0] |= (w == 0) ? bit : 0u; sm[1] |= (w == 1) ? bit : 0u; sm[2] |= (w == 2) ? bit : 0u; sm[3] |= (w == 3) ? bit : 0u; }
        if (part == 0) {
#pragma unroll
            for (int w = 0; w < 4; ++w) { selm[(8 * wave + tl) * 4 + w] = sm[w]; __hip_atomic_fetch_or(um + w, sm[w], __ATOMIC_RELAXED, __HIP_MEMORY_SCOPE_WORKGROUP); }
        }
        __syncthreads();
#pragma unroll
        for (int w = 0; w < 4; ++w) msk[w] = selm[tok * 4 + w];
    } else {
        msk[0] = (2u << c) - 1u;
        __syncthreads();
    }
    unsigned umr[4];
#pragma unroll
    for (int w = 0; w < 4; ++w) umr[w] = (c >= 16) ? (unsigned)__builtin_amdgcn_readfirstlane((int)um[w]) : ((w == 0) ? ((2u << c) - 1u) : 0u);
    {
        Soft st{NEGV, 0.f}; f32x16 o[2]; o[0] = f32x16{}; o[1] = f32x16{};
        const float cfar = lrow[1599];
        LAS unsigned char* blist = (LAS unsigned char*)(F.lds + A_BL);
        if (tid == 0) { int n = 0; for (int j = 0; j <= c; ++j) { const unsigned w = (j < 32) ? umr[0] : (j < 64) ? umr[1] : (j < 96) ? umr[2] : umr[3]; if ((w >> (j & 31)) & 1u) blist[n++] = (unsigned char)j; }
                        blist[160] = (unsigned char)n; blist[n] = blist[n - 1]; blist[n + 1] = blist[n - 1]; blist[n + 2] = blist[n - 1]; blist[n + 3] = blist[n - 1]; }
        __syncthreads();
        const int nb = blist[160], nss = (nb + 1) >> 1;
#define SEL_LOAD(ss_) do { const int ja_ = blist[2 * (ss_)], jb_ = blist[2 * (ss_) + 1]; tile_load(sg.t[0], KS, VS, 64 * ja_ + key, tid); tile_load(sg.t[1], KS, VS, 64 * jb_ + key, tid); } while (0)
        SEL_LOAD(0);
        for (int ss = 0; ss < nss; ++ss) {
            LAS unsigned char* bp = kv + buf * SBUF;
            tile_store(bp, sg.t[0], tid); tile_store(bp + TILE_B, sg.t[1], tid); ATT_BAR();
            if (ss + 1 < nss) SEL_LOAD(ss + 1);
            { const int jA = blist[2 * ss], jB = blist[2 * ss + 1]; const bool vB_ = 2 * ss + 1 < nb;
              const unsigned mA = (jA < 32) ? msk[0] : (jA < 64) ? msk[1] : (jA < 96) ? msk[2] : msk[3], mB = (jB < 32) ? msk[0] : (jB < 64) ? msk[1] : (jB < 96) ? msk[2] : msk[3];
              const bool sA = (mA >> (jA & 31)) & 1u, sB = vB_ && ((mB >> (jB & 31)) & 1u);
              const int cA = (jA == c) ? CLS_PART : ((c - jA >= 25) ? CLS_CONST : CLS_FULL), cB = (jB == c) ? CLS_PART : ((c - jB >= 25) ? CLS_CONST : CLS_FULL);
              const bool nA = __any(sA), nB = __any(sB);
              if (nA && nB) proc_pair(cA, cB, bp, bp + TILE_B, qr, st, o, lrow, t - 64 * jA, t - 64 * jB, 0, 0x3fffffff, cfar, sA, sB, wsf, r32, hi, trb);
              else if (nA) proc_tile(cA, bp, qr, st, o, lrow, t - 64 * jA, 0, 0x3fffffff, cfar, sA, wsf, r32, hi, trb);
              else if (nB) proc_tile(cB, bp + TILE_B, qr, st, o, lrow, t - 64 * jB, 0, 0x3fffffff, cfar, sB, wsf, r32, hi, trb); }
            buf ^= 1;
        }
#undef SEL_LOAD
        float lt; const float inv = soft_final_inv(st, lt);
#ifdef PROBE_SEL_TWICE
        if (rep_) yn_rows<false>(X.SCR, o, g1 * inv, wsf, r32, hi, R0 & 8191, g, lane); else
#endif
        yn_rows<true>(X.YN, o, g1 * inv, wsf, r32, hi, R0, g, lane);
    }
}

__device__ __forceinline__ void dil_unit(Frame& F, const Mix& X, int gi, int b, int s, int rest, int& buf) {
    using namespace att;
    const int tid = fresh_tid(), lane = tid & 63, wave = __builtin_amdgcn_readfirstlane(tid >> 6), r32 = lane & 31, hi = lane >> 5;
    LAS unsigned char* kv = F.lds + A_KV; LAS float* lutl = (LAS float*)(F.lds + A_LUT); LAS float* wsf = (LAS float*)(F.lds + A_WSF) + wave * 128;
    const int trb = ((lane >> 4) & 1) * 32 + (lane & 3) * 8 + (4 * hi + ((lane & 15) >> 2)) * 64;
    const int dil = 1 << (2 * gi), lg = 2 * gi, nch = (SEQ >> lg) >> 8, res = rest / nch, ch = rest % nch;
    const int hd = 4 * gi + s, N0 = 256 * ch, Nw = N0 + 32 * wave, nq = Nw + r32, key = tid >> 3;
    const int t = (nq << lg) + res;
    const size_t R = (size_t)b * SEQ + t;
    __syncthreads();
    lut_to_lds(F, tid, X.LUTD + hd * 320, 320);
    bf16x8 qr[4];
#pragma unroll
    for (int d0 = 0; d0 < 4; ++d0) qr[d0] = ldq(X.QD + R * 768 + hd * 64 + 16 * d0 + 8 * hi);
    const bf16* Kp = X.KD + (size_t)(b * 12 + hd) * SEQ * 64; const bf16* Vp = X.VD + (size_t)(b * 12 + hd) * SEQ * 64;
    const LAS float* lrow = lutl + LUT_PAD;
    __syncthreads();
    Soft st{NEGV, 0.f}; f32x16 o[2]; o[0] = f32x16{}; o[1] = f32x16{};
    Stage2 sg[3];
    const int it0 = (ch == 0) ? 2 : 0, nss = (6 - it0) >> 1;
#pragma unroll
    for (int ss = 0; ss < 3; ++ss) if (ss < nss) {
#pragma unroll
        for (int tt = 0; tt < 2; ++tt) { const int kb = N0 - 128 + 64 * (it0 + 2 * ss + tt); tile_load(sg[ss].t[tt], Kp, Vp, (long)((kb + key) << lg) + res, tid); } }
#pragma unroll
    for (int ss = 0; ss < 3; ++ss) if (ss < nss) {
        LAS unsigned char* bp = kv + buf * SBUF;
        tile_store(bp, sg[ss].t[0], tid); tile_store(bp + TILE_B, sg[ss].t[1], tid); ATT_BAR();
        { const int kbA = N0 - 128 + 64 * (it0 + 2 * ss), kbB = kbA + 64;
          const bool nA = (Nw + 31 - kbA >= 0) && (Nw - kbA - 63 <= 128), nB = (Nw + 31 - kbB >= 0) && (Nw - kbB - 63 <= 128);
          const int cA = (Nw - kbA - 63 >= 0 && Nw + 31 - kbA <= 128) ? CLS_FULL : CLS_PART, cB = (Nw - kbB - 63 >= 0 && Nw + 31 - kbB <= 128) ? CLS_FULL : CLS_PART;
          if (nA && nB) proc_pair(cA, cB, bp, bp + TILE_B, qr, st, o, lrow, nq - kbA, nq - kbB, 0, 128, 0.f, true, true, wsf, r32, hi, trb);
          else if (nA) proc_tile(cA, bp, qr, st, o, lrow, nq - kbA, 0, 128, 0.f, true, wsf, r32, hi, trb);
          else if (nB) proc_tile(cB, bp + TILE_B, qr, st, o, lrow, nq - kbB, 0, 128, 0.f, true, wsf, r32, hi, trb); }
        buf ^= 1;
    }
    float ltot; const float inv = soft_final_inv(st, ltot);
    const float lse = st.mref + __builtin_amdgcn_logf(ltot);
    if (gi != 0) {
        bf16* OD = X.OD + (size_t)(gi - 1) * M * 256; float* LS = X.LSE + (size_t)(gi - 1) * M * 4;
        if (hi == 0) { wsf[r32] = inv; LS[R * 4 + s] = lse; }
        asm volatile("s_waitcnt lgkmcnt(0)" ::: "memory");
#pragma unroll
        for (int r = 0; r < 16; ++r) { const int q = crow(r, hi); const float fr = wsf[q]; const size_t Rq = (size_t)b * SEQ + ((size_t)(Nw + q) << lg) + res;
            bf16* op = OD + Rq * 256 + s * 64 + (lane & 31);
            op[0] = (bf16)f2bf(o[0][r] * fr); op[32] = (bf16)f2bf(o[1][r] * fr); }
        asm volatile("s_waitcnt lgkmcnt(0)" ::: "memory");
    } else {
        const float l4 = X.LSE[R * 4 + s], l16 = X.LSE[(size_t)M * 4 + R * 4 + s];
        const float mx = fmaxf(lse, fmaxf(l4, l16));
        const float w1 = __builtin_amdgcn_exp2f(lse - mx), w4 = __builtin_amdgcn_exp2f(l4 - mx), w16 = __builtin_amdgcn_exp2f(l16 - mx), iw = 1.0f / (w1 + w4 + w16);
        if (hi == 0) { wsf[r32] = w1 * iw * inv; wsf[32 + r32] = w4 * iw; wsf[64 + r32] = w16 * iw; }
        asm volatile("s_waitcnt lgkmcnt(0)" ::: "memory");
#pragma unroll
        for (int r = 0; r < 16; ++r) { const int q = crow(r, hi); const float a1 = wsf[q], a4 = wsf[32 + q], a16 = wsf[64 + q]; const size_t Rq = (size_t)b * SEQ + Nw + q;
            const bf16* p4 = X.OD + Rq * 256 + s * 64 + (lane & 31); const bf16* p16 = p4 + (size_t)M * 256;
            bf16* op = X.YD + Rq * 256 + s * 64 + (lane & 31);
            const float v0 = o[0][r] * a1 + __uint_as_float((unsigned)p4[0] << 16) * a4 + __uint_as_float((unsigned)p16[0] << 16) * a16;
            const float v1 = o[1][r] * a1 + __uint_as_float((unsigned)p4[32] << 16) * a4 + __uint_as_float((unsigned)p16[32] << 16) * a16;
            op[0] = (bf16)f2bf(v0); op[32] = (bf16)f2bf(v1); }
        asm volatile("s_waitcnt lgkmcnt(0)" ::: "memory");
    }
}

__device__ __forceinline__ void cmp_unit(Frame& F, const Mix& X, int cu) {
    using namespace att;
    const int tid = fresh_tid(), lane = tid & 63, wave = __builtin_amdgcn_readfirstlane(tid >> 6), r32 = lane & 31, hi = lane >> 5;
    const int ts = cu >> 6, rb = cu & 63, plane = rb >> 4, i0 = (rb & 15) * 32;
    const bf16* src = X.PL + (size_t)ts * PLSZ + (size_t)plane * SEQ * 64;
    const bf16* W1 = ts ? X.WC1V : X.WC1K; const bf16* W2 = ts ? X.WC2V : X.WC2K; const float* cb = X.CB + ts * 256;
    bf16* dst = (ts ? X.VCMP : X.KCMP) + (size_t)plane * 512 * 64;
    LAS unsigned char* aimg = F.lds;
    LAS unsigned char* hid = F.lds + 69632;
    __syncthreads();
    for (int chn = tid; chn < 528 * 8; chn += NWAVES * 64) { const int tau = chn >> 3, c8 = chn & 7; int tk = 16 * i0 + tau; tk = tk > SEQ - 1 ? SEQ - 1 : tk;
        *(LAS v4u*)(aimg + tau * 128 + 16 * (tau >> 4) + c8 * 16) = *(const GAS v4u*)(src + (size_t)tk * 64 + c8 * 8); }
    __syncthreads();
    f32x16 acc = f32x16{};
    const LAS unsigned char* ap = aimg + r32 * 2064 + 16 * hi;
    const bf16* bp = W1 + ((size_t)wave * 128 * 64 + lane) * 8;
#pragma unroll 16
    for (int ks = 0; ks < 128; ++ks) {
        const int l = ks >> 2;
        const bf16x8 a = *(const LAS bf16x8*)(ap + 128 * l + 16 * (l >> 4) + 32 * (ks & 3));
        const bf16x8 bb = ldq(bp + (size_t)ks * 512);
        acc = __builtin_amdgcn_mfma_f32_32x32x16_bf16(a, bb, acc, 0, 0, 0);
    }
    { const int col = 32 * wave + r32; const float bias = cb[col];
#pragma unroll
      for (int r = 0; r < 16; ++r) { const float v = acc[r] + bias; const float hv = v * __builtin_amdgcn_rcpf(1.0f + __builtin_amdgcn_exp2f(-LOG2E * v));
          *(LAS unsigned short*)(hid + crow(r, hi) * 528 + col * 2) = (unsigned short)f2bf(hv); } }
    __syncthreads();
    if (wave < 2) {
        const int nt = wave;
        f32x16 o2 = f32x16{};
        const LAS unsigned char* hp = hid + r32 * 528 + 16 * hi; const bf16* b2 = W2 + (size_t)(32 * nt + r32) * 256 + 8 * hi;
#pragma unroll
        for (int k0 = 0; k0 < 256; k0 += 16) { const bf16x8 a = *(const LAS bf16x8*)(hp + k0 * 2); const bf16x8 bb = ldq(b2 + k0); o2 = __builtin_amdgcn_mfma_f32_32x32x16_bf16(a, bb, o2, 0, 0, 0); }
#pragma unroll
        for (int r = 0; r < 16; ++r) { const int i = i0 + crow(r, hi); dst[(size_t)i * 64 + 32 * nt + r32] = (bf16)f2bf(o2[r]); }
    }
}

#ifndef MK_N_LAUNCHES
#define MK_N_LAUNCHES 1
#endif
constexpr int N_PHASES = 13;
constexpr int N_LAUNCHES = MK_N_LAUNCHES;
struct Args { const float* in[22]; float* out; unsigned char* ws; int ph_lo, ph_hi, li, pad; };
__global__ void __launch_bounds__(NWAVES * 64, 2) mk_fwd(Args args) {
    extern __shared__ __attribute__((aligned(16))) unsigned char lds[];
    Frame F;
    F.lds = (LAS unsigned char*)lds;
    F.MISC = (volatile LAS unsigned*)(F.lds + MISC_OFF);
    F.G = gridDim.x; { const int bx = blockIdx.x; F.vcu = (F.G % 8 == 0) ? (bx % 8) * (F.G / 8) + bx / 8 : bx; }
    unsigned char* ws = args.ws;
    F.ctl = (gu32*)(ws + WS_CTL);
    In in;
    in.x = args.in[0]; in.f1_pre = args.in[1]; in.f1_wgu = args.in[2]; in.f1_wd = args.in[3]; in.f1_post = args.in[4]; in.mix_pre = args.in[5]; in.w_in = args.in[6];
    in.cpos_k = args.in[7]; in.cw1_k = args.in[8]; in.cw2_k = args.in[9]; in.cpos_v = args.in[10]; in.cw1_v = args.in[11]; in.cw2_v = args.in[12];
    in.w_bn = args.in[13]; in.w_bd = args.in[14]; in.w_out = args.in[15]; in.mix_post = args.in[16]; in.f2_pre = args.in[17]; in.f2_wgu = args.in[18]; in.f2_wd = args.in[19]; in.f2_post = args.in[20]; in.rel_bias = args.in[21];
    float* out = args.out;
    for (int u = threadIdx.x; u < (LDS_BYTES - LDSCTL_OFF) / 4; u += NWAVES * 64) ((LAS unsigned*)(F.lds + LDSCTL_OFF))[u] = 0u;
    __syncthreads();
    const bool use_bar = (args.ph_hi - args.ph_lo) > 1;
    XcdBarrier bar; bar.bar = (unsigned*)(F.ctl + CW_BAR) + args.li * XCD_BAR_WORDS; bar.x = 0; bar.st = nullptr;
    if (use_bar) bar = xcd_barrier_post((unsigned*)(F.ctl + CW_BAR) + args.li * XCD_BAR_WORDS, F.MISC + 8);
    const int lo = args.ph_lo, hi = args.ph_hi;
#define IN(k) (lo <= (k) && (k) < hi)
#define SEAM(k) do { if (IN(k) && IN((k) + 1)) xcd_barrier(bar); } while (0)
    bf16* XN = (bf16*)(ws + WS_XN); bf16* H = (bf16*)(ws + WS_H); bf16* Y = (bf16*)(ws + WS_Y); bf16* Y2P = (bf16*)(ws + WS_Y2P); bf16* MG = (bf16*)(ws + WS_MG);
    Mix X; X.QN = (bf16*)(ws + WS_QN); X.YN = (bf16*)(ws + WS_YN); X.SCR = (bf16*)(ws + WS_Y); F.nrep = args.pad; X.PL = (bf16*)(ws + WS_PL); X.QD = (bf16*)(ws + WS_QD); X.KD = (bf16*)(ws + WS_KD); X.VD = (bf16*)(ws + WS_VD); X.YD = (bf16*)(ws + WS_YD); X.OD = (bf16*)(ws + WS_OD); X.LSE = (float*)(ws + WS_LSE);
    X.KCMP = (bf16*)(ws + WS_KCMP); X.VCMP = (bf16*)(ws + WS_VCMP); X.GN = (const float*)(ws + WS_GN); X.LUTN = (const float*)(ws + WS_LUTN); X.LUTD = (const float*)(ws + WS_LUTD); X.CB = (const float*)(ws + WS_CB);
    X.WC1K = (const bf16*)(ws + WS_WC1K); X.WC1V = (const bf16*)(ws + WS_WC1V); X.WC2K = (const bf16*)(ws + WS_WC2K); X.WC2V = (const bf16*)(ws + WS_WC2V);
    bf16* GA = (bf16*)(ws + WS_GA); bf16* GB = (bf16*)(ws + WS_GB);

    if (IN(0)) { p0_prologue(F, in, ws); }
    SEAM(0);
    if (IN(1)) { pg8::Gemm g{XN, (const bf16*)(ws + WS_WGU1), M, 2 * FF, D}; pg8::StaticOrder S; S.init(M, 2 * FF, F.G, (int)blockIdx.x);
        pg8::EpiSwiGLU E{H, FF}; pg8::gemm_phase<pg8::EpiSwiGLU, pg8::StaticOrder, true, true>(F.lds + RING_OFF, g, S, E); }
    SEAM(1);
    if (IN(2)) { pg8::Gemm g{H, (const bf16*)(ws + WS_WD1), M, D, FF}; pg8::StaticOrder S; S.init(M, D, F.G, (int)blockIdx.x);
        pg8::EpiBf16 E{Y, D}; pg8::gemm_phase<pg8::EpiBf16, pg8::StaticOrder, true, true>(F.lds + RING_OFF, g, S, E); }
    SEAM(2);
    if (IN(3)) { row_pass<false, true>(F, Y, in.x, out, 0.5f, in.f1_post, in.mix_pre, XN); }
    SEAM(3);
    if (IN(4)) { pg8::Gemm g{XN, (const bf16*)(ws + WS_WIN), M, NPROJ, D}; pg8::StaticOrder S; S.init(M, NPROJ, F.G, (int)blockIdx.x);
        pg8::EpiProj E{X.QN, X.PL, X.QD, X.KD, X.VD, GA, GB, (float*)(ws + WS_GN), QSCALE};
        pg8::gemm_phase<pg8::EpiProj, pg8::StaticOrder, true, true>(F.lds + RING_OFF, g, S, E); }
    SEAM(4);
    if (IN(5)) { int buf = 0;
        for (int cu = F.vcu; cu < 128; cu += F.G) cmp_unit(F, X, cu);
#pragma unroll 1
        for (int w = F.vcu; w < 512; w += F.G) { const int gi = 2 - (w >> 8), du = w & 255; dil_unit(F, X, gi, du >> 7, (du >> 5) & 3, du & 31, buf); }
        __syncthreads(); }
    SEAM(5);
    if (IN(6)) { int buf = 0;
        for (int p = F.vcu; p < 256; p += F.G) { const int b = p >> 7, g = (p >> 6) & 1, cc = p & 63;
#pragma unroll 1
            for (int k = 0; k < 2; ++k) nsa_unit(F, X, b, g, k ? cc : 127 - cc, buf); }
#pragma unroll 1
        for (int du = F.vcu; du < 256; du += F.G) dil_unit(F, X, 0, du >> 7, (du >> 5) & 3, du & 31, buf);
        __syncthreads(); }
    SEAM(6);
    if (IN(7)) {
        { pg8::Gemm g{X.YN, (const bf16*)(ws + WS_WBN), M, D, 512}; pg8::StaticOrder S; S.init(M, D, F.G, (int)blockIdx.x);
          pg8::EpiBranchA E{GA, Y2P}; pg8::gemm_phase<pg8::EpiBranchA, pg8::StaticOrder, true, true>(F.lds + RING_OFF, g, S, E); }
        { pg8::Gemm g{X.YD, (const bf16*)(ws + WS_WBD), M, D, 256}; pg8::StaticOrder S; S.init(M, D, F.G, (int)blockIdx.x);
          pg8::EpiBranchB E{GB, Y2P, MG}; pg8::gemm_phase<pg8::EpiBranchB, pg8::StaticOrder, true, true>(F.lds + RING_OFF, g, S, E); }
    }
    SEAM(7);
    if (IN(8)) { pg8::Gemm g{MG, (const bf16*)(ws + WS_WOUT), M, D, D}; pg8::StaticOrder S; S.init(M, D, F.G, (int)blockIdx.x);
        pg8::EpiBf16 E{Y, D}; pg8::gemm_phase<pg8::EpiBf16, pg8::StaticOrder, true, true>(F.lds + RING_OFF, g, S, E); }
    SEAM(8);
    if (IN(9)) { row_pass<true, true>(F, Y, out, ws + WS_X2, 1.0f, in.mix_post, in.f2_pre, XN); }
    SEAM(9);
    if (IN(10)) { pg8::Gemm g{XN, (const bf16*)(ws + WS_WGU2), M, 2 * FF, D}; pg8::StaticOrder S; S.init(M, 2 * FF, F.G, (int)blockIdx.x);
        pg8::EpiSwiGLU E{H, FF}; pg8::gemm_phase<pg8::EpiSwiGLU, pg8::StaticOrder, true, true>(F.lds + RING_OFF, g, S, E); }
    SEAM(10);
    if (IN(11)) { pg8::Gemm g{H, (const bf16*)(ws + WS_WD2), M, D, FF}; pg8::StaticOrder S; S.init(M, D, F.G, (int)blockIdx.x);
        pg8::EpiBf16 E{Y, D}; pg8::gemm_phase<pg8::EpiBf16, pg8::StaticOrder, true, true>(F.lds + RING_OFF, g, S, E); }
    SEAM(11);
    if (IN(12)) { row_pass<true, false>(F, Y, ws + WS_X2, out, 0.5f, in.f2_post, nullptr, nullptr); }
#undef IN
#undef SEAM
}

extern "C" void kernel_launch(void* const* d_in, const int* in_sizes, int n_in, void* d_out, int out_size, void* d_ws, size_t ws_size, hipStream_t stream) {
    static int grid = 0;
    if (grid == 0) {
        if (n_in != 22 || in_sizes[0] != M * D || out_size != M * D || ws_size < WS_END) { fprintf(stderr, "kernel_launch: unexpected shapes (n_in %d, in0 %d, out %d, ws %zu); nothing launched\n", n_in, n_in > 0 ? in_sizes[0] : -1, out_size, ws_size); grid = -1; return; }
        int dev = 0, cus = 0, per_cu = 0;
        if (hipGetDevice(&dev) != hipSuccess || hipDeviceGetAttribute(&cus, hipDeviceAttributeMultiprocessorCount, dev) != hipSuccess) { grid = -1; return; }
        if (hipFuncSetAttribute((const void*)mk_fwd, hipFuncAttributeMaxDynamicSharedMemorySize, LDS_BYTES) != hipSuccess) { fprintf(stderr, "kernel_launch: hipFuncSetAttribute failed\n"); grid = -1; return; }
        if (hipOccupancyMaxActiveBlocksPerMultiprocessor(&per_cu, (const void*)mk_fwd, NWAVES * 64, LDS_BYTES) != hipSuccess || per_cu < 1)
            fprintf(stderr, "kernel_launch: note: occupancy query reports %d workgroups per CU\n", per_cu);
        (void)hipGetLastError();
        grid = cus;
    }
    if (grid < 0) return;
    if (hipMemsetAsync((char*)d_ws + WS_CTL, 0, CTL_ZERO_BYTES, stream) != hipSuccess) return;
    Args a{};
    for (int i = 0; i < 22; ++i) a.in[i] = (const float*)d_in[i];
    a.out = (float*)d_out; a.ws = (unsigned char*)d_ws; a.pad = 2;
#ifdef PROBE_RANGES
    { static const int rg[][2] = PROBE_RANGES;
      for (int li = 0; li < (int)(sizeof(rg) / sizeof(rg[0])); ++li) { a.ph_lo = rg[li][0]; a.ph_hi = rg[li][1]; a.li = li; hipLaunchKernelGGL(mk_fwd, dim3(grid), dim3(NWAVES * 64), LDS_BYTES, stream, a); } }
#else
    if (N_LAUNCHES == 1) { a.ph_lo = 0; a.ph_hi = N_PHASES; a.li = 0; hipLaunchKernelGGL(mk_fwd, dim3(grid), dim3(NWAVES * 64), LDS_BYTES, stream, a); }
    else { for (int li = 0; li < N_PHASES; ++li) { a.ph_lo = li; a.ph_hi = li + 1; a.li = 0; hipLaunchKernelGGL(mk_fwd, dim3(grid), dim3(NWAVES * 64), LDS_BYTES, stream, a); } }
#endif
}
```

```cpp
#include <hip/hip_runtime.h>
#include <cstdio>
#include <cstdint>
namespace pg8 {
#define PG8_LAS __attribute__((address_space(3)))
typedef unsigned short bf16_t;
typedef short bf16x8 __attribute__((ext_vector_type(8)));
typedef float f32x4 __attribute__((ext_vector_type(4)));
typedef unsigned u32x4 __attribute__((ext_vector_type(4)));
constexpr int BM = 256, BK = 64, HALF = 128, HTB = HALF * BK * 2  , STAGE_BYTES = 8 * HTB, NXCD = 8, WGM = 8;

__host__ __device__ __forceinline__ int lds_byte(int r, int c) { const int st = (r >> 4) * 2 + (c >> 5), rr = r & 15, cc = c & 31, ob = rr * 64 + cc * 2; return st * 1024 + (ob ^ (((ob >> 9) & 1) << 5)); }
__host__ __device__ __forceinline__ void stage_rc(int b, int& R, int& C) { const int st = b / 1024, sb = b % 1024, swz = sb ^ (((sb >> 9) & 1) << 5); R = (st >> 1) * 16 + swz / 64; C = (st & 1) * 32 + (swz % 64) / 2; }
__host__ __device__ __forceinline__ int perm32(int rho) { const int n = rho >> 4, i = rho & 15; return 8 * (i >> 2) + 4 * n + (i & 3); }

struct Unit { int pm, pn; };
struct Gemm { const bf16_t* A; const bf16_t* Bt; int M, N, K; };

struct StaticOrder {
    int nM, nN, nwg, G, c;
    __host__ __device__ void init(int M, int N, int G_, int c_) { nM = M / BM; nN = N / BM; nwg = nM * nN; G = G_; c = c_; }
    __host__ __device__ bool next(int i, Unit& u) const {
        const long L = (long)i * G + c; if (L >= nwg) return false;
        int wgid = (int)L; { const int q = nwg / NXCD, r = nwg % NXCD, xcd = wgid % NXCD, off = wgid / NXCD; wgid = (xcd < r ? xcd * (q + 1) : r * (q + 1) + (xcd - r) * q) + off; }
        const int nig = WGM * nN, gid = wgid / nig, fm = gid * WGM, gsz = (nM - fm) < WGM ? (nM - fm) : WGM;
        u.pm = fm + ((wgid % nig) % gsz); u.pn = (wgid % nig) / gsz; return true;
    }
    __device__ __forceinline__ void a_ready(const Unit&) const {}
    __device__ __forceinline__ void done(const Unit&) const {}
};

__device__ __forceinline__ unsigned cvt_pk_bf16(float lo, float hi) { unsigned r; asm volatile("v_cvt_pk_bf16_f32 %0, %1, %2" : "=v"(r) : "v"(lo), "v"(hi)); return r; }
typedef float f32x2 __attribute__((ext_vector_type(2)));
__device__ __forceinline__ float sigmoid_f(float v) { return __builtin_amdgcn_rcpf(1.0f + __builtin_amdgcn_exp2f(-1.4426950408889634f * v)); }
__device__ __forceinline__ float bf_lo(unsigned w) { return __uint_as_float(w << 16); }
__device__ __forceinline__ float bf_hi(unsigned w) { return __uint_as_float(w & 0xffff0000u); }

struct EpiSwiGLU {
    static constexpr bool PERM = true, AFTER_DRAIN = false;
    bf16_t* H; int ldh;
    __device__ __forceinline__ void operator()(const f32x4 (&acc)[2][2][4][2], const Unit& u, int wr, int wc, int fr, int fq) const {
        const int row0 = u.pm * BM + wr * 64 + fr, col0 = u.pn * HALF + wc * 32 + 8 * fq;
#pragma unroll
        for (int ai = 0; ai < 2; ++ai)
#pragma unroll
            for (int m = 0; m < 4; ++m) { bf16_t* rowp = H + (size_t)(row0 + ai * HALF + m * 16) * ldh + col0;
                const f32x4 g0 = acc[ai][0][m][0], g1 = acc[ai][0][m][1], u0 = acc[ai][1][m][0], u1 = acc[ai][1][m][1];
                float h[8];
#pragma unroll
                for (int i = 0; i < 4; ++i) { h[i] = g0[i] * sigmoid_f(g0[i]) * u0[i]; h[4 + i] = g1[i] * sigmoid_f(g1[i]) * u1[i]; }
                u32x4 w; w.x = cvt_pk_bf16(h[0], h[1]); w.y = cvt_pk_bf16(h[2], h[3]); w.z = cvt_pk_bf16(h[4], h[5]); w.w = cvt_pk_bf16(h[6], h[7]);
                *(u32x4*)rowp = w; }
    }
};
struct EpiF32 {
    static constexpr bool PERM = true, AFTER_DRAIN = false;
    float* Y; int ldc;
    __device__ __forceinline__ void operator()(const f32x4 (&acc)[2][2][4][2], const Unit& u, int wr, int wc, int fr, int fq) const {
        const int row0 = u.pm * BM + wr * 64 + fr, col0 = u.pn * BM + wc * 32 + 8 * fq;
#pragma unroll
        for (int ai = 0; ai < 2; ++ai)
#pragma unroll
            for (int m = 0; m < 4; ++m) { float* rowp = Y + (size_t)(row0 + ai * HALF + m * 16) * ldc + col0;
#pragma unroll
                for (int bj = 0; bj < 2; ++bj) { *(f32x4*)(rowp + bj * HALF) = acc[ai][bj][m][0]; *(f32x4*)(rowp + bj * HALF + 4) = acc[ai][bj][m][1]; } }
    }
};
struct EpiBf16 {
    static constexpr bool PERM = true, AFTER_DRAIN = false;
    bf16_t* Y; int ldc;
    __device__ __forceinline__ void operator()(const f32x4 (&acc)[2][2][4][2], const Unit& u, int wr, int wc, int fr, int fq) const {
        const int row0 = u.pm * BM + wr * 64 + fr, col0 = u.pn * BM + wc * 32 + 8 * fq;
#pragma unroll
        for (int ai = 0; ai < 2; ++ai)
#pragma unroll
            for (int m = 0; m < 4; ++m) { bf16_t* rowp = Y + (size_t)(row0 + ai * HALF + m * 16) * ldc + col0;
#pragma unroll
                for (int bj = 0; bj < 2; ++bj) { const f32x4 a0 = acc[ai][bj][m][0], a1 = acc[ai][bj][m][1];
                    u32x4 w; w.x = cvt_pk_bf16(a0[0], a0[1]); w.y = cvt_pk_bf16(a0[2], a0[3]); w.z = cvt_pk_bf16(a1[0], a1[1]); w.w = cvt_pk_bf16(a1[2], a1[3]);
                    *(u32x4*)(rowp + bj * HALF) = w; } }
    }
};
struct EpiBranchA {
    static constexpr bool PERM = true, AFTER_DRAIN = false;
    const bf16_t* G; bf16_t* Y;
    __device__ __forceinline__ void operator()(const f32x4 (&acc)[2][2][4][2], const Unit& u, int wr, int wc, int fr, int fq) const {
        const int row0 = u.pm * BM + wr * 64 + fr, col0 = u.pn * BM + wc * 32 + 8 * fq;
#pragma unroll
        for (int ai = 0; ai < 2; ++ai)
#pragma unroll
            for (int m = 0; m < 4; ++m) { const size_t off = (size_t)(row0 + ai * HALF + m * 16) * 1024 + col0;
#pragma unroll
                for (int bj = 0; bj < 2; ++bj) { const u32x4 g = *(const u32x4*)(G + off + bj * HALF); const f32x4 a0 = acc[ai][bj][m][0], a1 = acc[ai][bj][m][1];
                    u32x4 w; w.x = cvt_pk_bf16(a0[0] * bf_lo(g.x), a0[1] * bf_hi(g.x)); w.y = cvt_pk_bf16(a0[2] * bf_lo(g.y), a0[3] * bf_hi(g.y));
                    w.z = cvt_pk_bf16(a1[0] * bf_lo(g.z), a1[1] * bf_hi(g.z)); w.w = cvt_pk_bf16(a1[2] * bf_lo(g.w), a1[3] * bf_hi(g.w));
                    *(u32x4*)(Y + off + bj * HALF) = w; } }
    }
};
struct EpiBranchB {
    static constexpr bool PERM = true, AFTER_DRAIN = false;
    const bf16_t* G; const bf16_t* Y; bf16_t* O;
    __device__ __forceinline__ void operator()(const f32x4 (&acc)[2][2][4][2], const Unit& u, int wr, int wc, int fr, int fq) const {
        const int row0 = u.pm * BM + wr * 64 + fr, col0 = u.pn * BM + wc * 32 + 8 * fq;
#pragma unroll
        for (int ai = 0; ai < 2; ++ai)
#pragma unroll
            for (int m = 0; m < 4; ++m) { const size_t off = (size_t)(row0 + ai * HALF + m * 16) * 1024 + col0;
#pragma unroll
                for (int bj = 0; bj < 2; ++bj) { const u32x4 g = *(const u32x4*)(G + off + bj * HALF), y = *(const u32x4*)(Y + off + bj * HALF); const f32x4 a0 = acc[ai][bj][m][0], a1 = acc[ai][bj][m][1];
                    u32x4 w; w.x = cvt_pk_bf16(bf_lo(y.x) + a0[0] * bf_lo(g.x), bf_hi(y.x) + a0[1] * bf_hi(g.x)); w.y = cvt_pk_bf16(bf_lo(y.y) + a0[2] * bf_lo(g.y), bf_hi(y.y) + a0[3] * bf_hi(g.y));
                    w.z = cvt_pk_bf16(bf_lo(y.z) + a1[0] * bf_lo(g.z), bf_hi(y.z) + a1[1] * bf_hi(g.z)); w.w = cvt_pk_bf16(bf_lo(y.w) + a1[2] * bf_lo(g.w), bf_hi(y.w) + a1[3] * bf_hi(g.w));
                    *(u32x4*)(O + off + bj * HALF) = w; } }
    }
};
struct EpiProj {
    static constexpr bool PERM = true, AFTER_DRAIN = false;
    bf16_t *QN, *PL, *QD, *KD, *VD, *GA, *GB; float* GN; float qscale;
    __device__ __forceinline__ void operator()(const f32x4 (&acc)[2][2][4][2], const Unit& u, int wr, int wc, int fr, int fq) const {
        const int sub = (wc & 1) * 32 + 8 * fq;
#pragma unroll
        for (int bj = 0; bj < 2; ++bj) {
            const int hidx = __builtin_amdgcn_readfirstlane(u.pn * 4 + bj * 2 + (wc >> 1));
            bf16_t* base = nullptr; long pitch = 0, bstride = 0; int mode = 0;
            if (hidx < 8) { base = QN + hidx * 64; pitch = 512; bstride = 8192L * 512; mode = 1; }
            else if (hidx < 20) { const int ti = (hidx - 8) >> 1, g = (hidx - 8) & 1; base = PL + (size_t)ti * (4u * 8192u * 64u) + (size_t)g * (8192u * 64u); pitch = 64; bstride = 2L * 8192 * 64; mode = 0; }
            else if (hidx < 32) { base = QD + (hidx - 20) * 64; pitch = 768; bstride = 8192L * 768; mode = 1; }
            else if (hidx < 44) { base = KD + (size_t)(hidx - 32) * (8192u * 64u); pitch = 64; bstride = 12L * 8192 * 64; mode = 0; }
            else if (hidx < 56) { base = VD + (size_t)(hidx - 44) * (8192u * 64u); pitch = 64; bstride = 12L * 8192 * 64; mode = 0; }
            else if (hidx < 72) { base = GA + (hidx - 56) * 64; pitch = 1024; bstride = 8192L * 1024; mode = 2; }
            else if (hidx < 88) { base = GB + (hidx - 72) * 64; pitch = 1024; bstride = 8192L * 1024; mode = 2; }
            else if (hidx == 88) mode = 3; else mode = 4;
            if (mode == 4) continue;
#pragma unroll
            for (int ai = 0; ai < 2; ++ai)
#pragma unroll
                for (int m = 0; m < 4; ++m) { const int R = u.pm * BM + ai * HALF + wr * 64 + m * 16 + fr, b = R >> 13, t = R & 8191;
                    f32x4 v0 = acc[ai][bj][m][0], v1 = acc[ai][bj][m][1];
                    if (mode == 3) { if (sub < 24) { float* p = GN + (size_t)R * 32 + sub;
#pragma unroll
                            for (int i = 0; i < 4; ++i) { v0[i] = sigmoid_f(v0[i]); v1[i] = sigmoid_f(v1[i]); }
                            *(f32x4*)p = v0; *(f32x4*)(p + 4) = v1; } }
                    else { if (mode == 1) { v0 = v0 * qscale; v1 = v1 * qscale; }
                        if (mode == 2) {
#pragma unroll
                            for (int i = 0; i < 4; ++i) { v0[i] = sigmoid_f(v0[i]); v1[i] = sigmoid_f(v1[i]); } }
                        u32x4 w; w.x = cvt_pk_bf16(v0[0], v0[1]); w.y = cvt_pk_bf16(v0[2], v0[3]); w.z = cvt_pk_bf16(v1[0], v1[1]); w.w = cvt_pk_bf16(v1[2], v1[3]);
                        *(u32x4*)(base + (size_t)b * bstride + (size_t)t * pitch + sub) = w; } }
        }
    }
};
template <class Epi, class Sched, bool ALIGN_EPI = false, bool SP2 = false>
__device__ __forceinline__ void gemm_phase(PG8_LAS unsigned char* lds, const Gemm g, const Sched& S, const Epi& E) {
    const int tid = threadIdx.x, wid = __builtin_amdgcn_readfirstlane(tid >> 6), lane = tid & 63, wr = wid >> 2, wc = wid & 3, fr = lane & 15, fq = lane >> 4;
    const int K = g.K, nt = K / BK;
    unsigned voffA[2], voffB[2];
#pragma unroll
    for (int i = 0; i < 2; ++i) { int R, C; stage_rc(tid * 16 + i * 8192, R, C); const int Rb = Epi::PERM ? ((R & ~31) + perm32(R & 31)) : R;
        voffA[i] = (unsigned)(R * K + C) * 2u; voffB[i] = (unsigned)(Rb * K + C) * 2u; }
    const size_t kstep = (size_t)(BK * 2);
    const size_t hstep = (size_t)HALF * K * 2;
    const size_t tstep = 2 * hstep;
    const unsigned ldsw = (unsigned)wid * 1024u;
    const int aoff = lds_byte(wr * 64 + fr, fq * 8), boff = lds_byte(wc * 32 + fr, fq * 8);
#define PG8_SA(b, h) (((b) * 2 + (h)) * HTB)
#define PG8_SB(b, h) ((4 + (b) * 2 + (h)) * HTB)
#define PG8_STAGE(bufoff, gbase, voff) do { _Pragma("unroll") for (int _i = 0; _i < 2; ++_i) \
        __builtin_amdgcn_global_load_lds((const unsigned*)((const char*)(gbase) + (voff)[_i]), (PG8_LAS unsigned*)(lds + (bufoff) + ldsw + _i * 8192), 16, 0, 0); } while (0)
#define PG8_LDA(dst, b, h) do { _Pragma("unroll") for (int m = 0; m < 4; ++m) _Pragma("unroll") for (int k = 0; k < 2; ++k) dst[m][k] = *(const PG8_LAS bf16x8*)(lds + PG8_SA(b, h) + aoff + m * 2048 + k * 1024); } while (0)
#define PG8_LDB(dst, b, h) do { _Pragma("unroll") for (int n = 0; n < 2; ++n) _Pragma("unroll") for (int k = 0; k < 2; ++k) dst[n][k] = *(const PG8_LAS bf16x8*)(lds + PG8_SB(b, h) + boff + n * 2048 + k * 1024); } while (0)
#define PG8_MMA(ai, bj, At, Bt) do { __builtin_amdgcn_s_setprio(1); _Pragma("unroll") for (int m = 0; m < 4; ++m) _Pragma("unroll") for (int n = 0; n < 2; ++n) _Pragma("unroll") for (int k = 0; k < 2; ++k) \
        acc[ai][bj][m][n] = __builtin_amdgcn_mfma_f32_16x16x32_bf16(Bt[n][k], At[m][k], acc[ai][bj][m][n], 0, 0, 0); __builtin_amdgcn_s_setprio(0); } while (0)
#define PG8_WAIT_V(n) asm volatile("s_waitcnt vmcnt(" #n ")" ::: "memory")
#define PG8_WAIT_L(n) asm volatile("s_waitcnt lgkmcnt(" #n ")" ::: "memory")
#define PG8_BAR __builtin_amdgcn_s_barrier()
#define PG8_SCHED __builtin_amdgcn_sched_barrier(0)
    Unit cur, nxt; int ui = 0;
    if (!S.next(0, cur)) return;
    f32x4 acc[2][2][4][2];
#pragma unroll
    for (int a = 0; a < 2; ++a)
#pragma unroll
        for (int b = 0; b < 2; ++b)
#pragma unroll
            for (int m = 0; m < 4; ++m)
#pragma unroll
                for (int n = 0; n < 2; ++n) acc[a][b][m][n] = (f32x4){0.f, 0.f, 0.f, 0.f};
    bf16x8 At[4][2], B0[2][2], B1[2][2];
    const char* cA = (const char*)g.A + (size_t)cur.pm * tstep; const char* cB = (const char*)g.Bt + (size_t)cur.pn * tstep;
    S.a_ready(cur);
    if constexpr (SP2) {
        PG8_STAGE(PG8_SB(0, 0), cB, voffB); PG8_STAGE(PG8_SB(0, 1), cB + hstep, voffB); PG8_STAGE(PG8_SA(0, 0), cA, voffA); PG8_STAGE(PG8_SA(0, 1), cA + hstep, voffA);
        if (wr == 1) PG8_BAR;
        PG8_WAIT_V(2); PG8_BAR;
        PG8_STAGE(PG8_SB(1, 0), cB + kstep, voffB); PG8_STAGE(PG8_SA(1, 0), cA + kstep, voffA); PG8_STAGE(PG8_SB(1, 1), cB + hstep + kstep, voffB);
        PG8_WAIT_V(6); PG8_BAR;
    } else {
        PG8_STAGE(PG8_SB(0, 0), cB, voffB); PG8_STAGE(PG8_SA(0, 0), cA, voffA); PG8_STAGE(PG8_SB(0, 1), cB + hstep, voffB); PG8_STAGE(PG8_SA(0, 1), cA + hstep, voffA);
        if (wr == 1) PG8_BAR;
        PG8_WAIT_V(4); PG8_BAR;
        PG8_STAGE(PG8_SB(1, 0), cB + kstep, voffB); PG8_STAGE(PG8_SA(1, 0), cA + kstep, voffA); PG8_STAGE(PG8_SB(1, 1), cB + hstep + kstep, voffB);
        PG8_WAIT_V(6); PG8_BAR;
    }
    for (;;) {
        const bool has_next = S.next(ui + 1, nxt);
        const char* nA = has_next ? (const char*)g.A + (size_t)nxt.pm * tstep : cA; const char* nB = has_next ? (const char*)g.Bt + (size_t)nxt.pn * tstep : cB;
        for (int t = 0; t < nt; t += 2) {
            const bool last = (t == nt - 2);
            const char* a1 = cA + (size_t)(t + 1) * kstep;
            const char* a2 = last ? nA : cA + (size_t)(t + 2) * kstep; const char* b2 = last ? nB : cB + (size_t)(t + 2) * kstep;
            const char* a3 = a2 + kstep; const char* b3 = b2 + kstep;
            if (last && has_next) S.a_ready(nxt);
            if constexpr (SP2) {
            PG8_LDB(B0, 0, 0); PG8_LDB(B1, 0, 1); PG8_SCHED; PG8_LDA(At, 0, 0); PG8_STAGE(PG8_SA(1, 1), a1 + hstep, voffA);
            PG8_WAIT_V(8); PG8_WAIT_L(0); PG8_BAR; PG8_MMA(0, 0, At, B0); PG8_MMA(0, 1, At, B1); PG8_BAR; PG8_SCHED;
            PG8_LDA(At, 0, 1); PG8_STAGE(PG8_SB(0, 0), b2, voffB); PG8_STAGE(PG8_SB(0, 1), b2 + hstep, voffB); PG8_STAGE(PG8_SA(0, 0), a2, voffA);
            PG8_WAIT_V(8); PG8_WAIT_L(0); PG8_BAR; PG8_MMA(1, 0, At, B0); PG8_MMA(1, 1, At, B1); PG8_BAR; PG8_SCHED;
            PG8_LDB(B0, 1, 0); PG8_LDB(B1, 1, 1); PG8_SCHED; PG8_LDA(At, 1, 0); PG8_STAGE(PG8_SA(0, 1), a2 + hstep, voffA);
            PG8_WAIT_V(8); PG8_WAIT_L(0); PG8_BAR; PG8_MMA(0, 0, At, B0); PG8_MMA(0, 1, At, B1); PG8_BAR; PG8_SCHED;
            PG8_LDA(At, 1, 1); PG8_STAGE(PG8_SB(1, 0), b3, voffB); PG8_STAGE(PG8_SB(1, 1), b3 + hstep, voffB); PG8_STAGE(PG8_SA(1, 0), a3, voffA);
            PG8_WAIT_V(8); PG8_WAIT_L(0); PG8_BAR; PG8_MMA(1, 0, At, B0); PG8_MMA(1, 1, At, B1); PG8_BAR; PG8_SCHED;
            } else {
            PG8_LDB(B0, 0, 0); PG8_SCHED; PG8_LDA(At, 0, 0); PG8_STAGE(PG8_SA(1, 1), a1 + hstep, voffA);
            PG8_WAIT_L(8); PG8_BAR; PG8_WAIT_L(0); PG8_MMA(0, 0, At, B0); PG8_BAR; PG8_SCHED;
            PG8_LDB(B1, 0, 1); PG8_STAGE(PG8_SB(0, 0), b2, voffB);
            PG8_BAR; PG8_WAIT_L(0); PG8_MMA(0, 1, At, B1); PG8_BAR;
            PG8_LDA(At, 0, 1); PG8_STAGE(PG8_SA(0, 0), a2, voffA);
            PG8_BAR; PG8_WAIT_L(0); PG8_MMA(1, 0, At, B0); PG8_BAR; PG8_SCHED;
            PG8_STAGE(PG8_SB(0, 1), b2 + hstep, voffB);
            PG8_WAIT_V(6); PG8_BAR; PG8_MMA(1, 1, At, B1); PG8_BAR;
            PG8_LDB(B0, 1, 0); PG8_SCHED; PG8_LDA(At, 1, 0); PG8_STAGE(PG8_SA(0, 1), a2 + hstep, voffA);
            PG8_WAIT_L(8); PG8_BAR; PG8_WAIT_L(0); PG8_MMA(0, 0, At, B0); PG8_BAR; PG8_SCHED;
            PG8_LDB(B1, 1, 1); PG8_STAGE(PG8_SB(1, 0), b3, voffB);
            PG8_BAR; PG8_WAIT_L(0); PG8_MMA(0, 1, At, B1); PG8_BAR;
            PG8_LDA(At, 1, 1); PG8_STAGE(PG8_SA(1, 0), a3, voffA);
            PG8_BAR; PG8_WAIT_L(0); PG8_MMA(1, 0, At, B0); PG8_BAR; PG8_SCHED;
            PG8_STAGE(PG8_SB(1, 1), b3 + hstep, voffB);
            PG8_WAIT_V(6); PG8_BAR; PG8_MMA(1, 1, At, B1); PG8_BAR;
            }
        }
        if constexpr (ALIGN_EPI) { if (wr == 0) PG8_BAR; }
        if constexpr (!Epi::AFTER_DRAIN) { E(acc, cur, wr, wc, fr, fq); S.done(cur); }
        if (!has_next) break;
#pragma unroll
        for (int a = 0; a < 2; ++a)
#pragma unroll
            for (int b = 0; b < 2; ++b)
#pragma unroll
                for (int m = 0; m < 4; ++m)
#pragma unroll
                    for (int n = 0; n < 2; ++n) acc[a][b][m][n] = (f32x4){0.f, 0.f, 0.f, 0.f};
        cur = nxt; cA = nA; cB = nB; ++ui;
        if constexpr (ALIGN_EPI) { if (wr == 1) PG8_BAR; }
    }
    PG8_WAIT_V(0);
    if constexpr (!ALIGN_EPI) { if (wr == 0) PG8_BAR; }
    PG8_BAR;
    if constexpr (Epi::AFTER_DRAIN) { E.fused(acc, cur, wr, wc, fr, fq, lds, wid, lane); S.done(cur); }
#undef PG8_SA
#undef PG8_SB
#undef PG8_STAGE
#undef PG8_LDA
#undef PG8_LDB
#undef PG8_MMA
#undef PG8_WAIT_V
#undef PG8_WAIT_L
#undef PG8_BAR
#undef PG8_SCHED
}
}
#define GAS __attribute__((address_space(1)))
#define LAS __attribute__((address_space(3)))
typedef unsigned short bf16;
typedef unsigned v4u __attribute__((ext_vector_type(4)));
typedef float f32x4 __attribute__((ext_vector_type(4)));
typedef short bf16x8 __attribute__((ext_vector_type(8)));
typedef GAS unsigned gu32;
typedef GAS unsigned long long gu64;
#define RLX_AGENT __ATOMIC_RELAXED, __HIP_MEMORY_SCOPE_AGENT
#define LDS_WAIT() asm volatile("s_waitcnt lgkmcnt(0)" ::: "memory")
#define VM_WAIT() asm volatile("s_waitcnt vmcnt(0)" ::: "memory")
__device__ __forceinline__ unsigned long long rt() { return __builtin_amdgcn_s_memrealtime(); }
__device__ __forceinline__ unsigned f2bf(float f) { unsigned u = __builtin_bit_cast(unsigned, f); return (u + 0x7fffu + ((u >> 16) & 1u)) >> 16; }
__device__ __forceinline__ unsigned pk2(float lo, float hi) { return f2bf(lo) | (f2bf(hi) << 16); }

#define XB_TMO      128
#define XB_XCNT(j)  (256  + 64 * (j))
#define XB_XSUB(j)  (1280 + 64 * (j))
#define XB_XGEN(j)  (2304 + 64 * (j))
#define XB_TOP      3328
#define XB_TOPGEN   3392
#define XCD_BAR_WORDS 3456
#define XB_SPIN_CAP (1u << 18)

__device__ __forceinline__ unsigned xb_ld(unsigned* p)              { return __hip_atomic_load(p, __ATOMIC_RELAXED, __HIP_MEMORY_SCOPE_AGENT); }
__device__ __forceinline__ unsigned xb_add(unsigned* p, unsigned v) { return __hip_atomic_fetch_add(p, v, __ATOMIC_RELAXED, __HIP_MEMORY_SCOPE_AGENT); }
__device__ __forceinline__ unsigned xb_xcc_id() { return (unsigned)__builtin_amdgcn_s_getreg((3 << 11) | 20) & 0xFu; }
#define XB_SPIN(cond, bar) do { unsigned _sp = 0; while (cond) { __builtin_amdgcn_s_sleep(1); \
    if ((++_sp & 255u) == 0u) { if (xb_ld(&(bar)[XB_TMO])) break; if (_sp > XB_SPIN_CAP) { atomicAdd(&(bar)[XB_TMO], 1u); break; } } } } while (0)

struct XcdBarrier {
    unsigned* bar; unsigned x;
    volatile LAS unsigned* st;
};

__device__ __forceinline__ XcdBarrier xcd_barrier_post(unsigned* bar, volatile LAS unsigned* st) {
    XcdBarrier b; b.bar = bar; b.x = xb_xcc_id(); b.st = st;
    if (threadIdx.x == 0) (void)xb_add(&bar[XB_XCNT(b.x)], 1u);
    return b;
}
__device__ __forceinline__ void xcd_barrier_complete(unsigned* bar, unsigned x, unsigned& nloc, unsigned& nx) {
    const unsigned G = gridDim.x * gridDim.y * gridDim.z;
    unsigned sum, cnt, mine, sp = 0u;
    for (;;) {
        sum = 0u; cnt = 0u; mine = 0u;
#pragma unroll
        for (unsigned j = 0; j < 16; ++j) { const unsigned c = xb_ld(&bar[XB_XCNT(j)]); sum += c; cnt += (c > 0u) ? 1u : 0u; mine = (j == x) ? c : mine; }
        if (sum == G) break;
        __builtin_amdgcn_s_sleep(1);
        if ((++sp & 255u) == 0u) { if (xb_ld(&bar[XB_TMO])) break; if (sp > XB_SPIN_CAP) { atomicAdd(&bar[XB_TMO], 1u); break; } }
    }
    nloc = mine > 0u ? mine : 1u; nx = cnt > 0u ? cnt : 1u;
}

__device__ __forceinline__ void xcd_barrier(const XcdBarrier& b) {
    asm volatile("s_waitcnt vmcnt(0)" ::: "memory");
    __syncthreads();
    if (threadIdx.x == 0) {
        unsigned* bar = b.bar;
        __builtin_amdgcn_s_waitcnt(0);
        unsigned nloc = b.st[0], nx = b.st[1];
        if (nloc == 0u) { xcd_barrier_complete(bar, b.x, nloc, nx); b.st[0] = nloc; b.st[1] = nx; }
        const unsigned old = xb_add(&bar[XB_XSUB(b.x)], 1u);
        const unsigned gen = old / nloc;
        if (old + 1u == (gen + 1u) * nloc) {
            __builtin_amdgcn_fence(__ATOMIC_RELEASE, "agent");
            asm volatile("s_waitcnt vmcnt(0)" ::: "memory");
            const unsigned og = xb_add(&bar[XB_TOP], 1u);
            const unsigned tg = og / nx;
            if (og + 1u == (tg + 1u) * nx) xb_add(&bar[XB_TOPGEN], 1u);
            else XB_SPIN(xb_ld(&bar[XB_TOPGEN]) == tg, bar);
            __builtin_amdgcn_fence(__ATOMIC_ACQUIRE, "agent");
            xb_add(&bar[XB_XGEN(b.x)], 1u);
            asm volatile("s_waitcnt vmcnt(0)" ::: "memory");
        } else {
            XB_SPIN(xb_ld(&bar[XB_XGEN(b.x)]) == gen, bar);
            __builtin_amdgcn_fence(__ATOMIC_ACQUIRE, "agent");
            asm volatile("s_waitcnt vmcnt(0)" ::: "memory");
        }
    }
    __syncthreads();
}

constexpr int NWAVES = 8;
constexpr int BATCH = 2, SEQ = 8192, D = 1024, FF = 2816, M = BATCH * SEQ;
constexpr int NPROJ_SRC = 5656, NPROJ = 5888;
constexpr float RMS_EPS = 1e-6f;
constexpr float LOG2E = 1.4426950408889634f;
constexpr float QSCALE = 0.125f * LOG2E;

constexpr size_t MiB = 1u << 20;
constexpr size_t WS_CTL = 0, CTL_ZERO_BYTES = 64 * 1024;
constexpr size_t WS_LUTN = 1 * MiB;
constexpr size_t WS_LUTD = WS_LUTN + 64 * 1024;
constexpr size_t WS_CB = WS_LUTD + 16 * 1024;
constexpr size_t WS_KCMP = 1 * MiB + 256 * 1024, WS_VCMP = WS_KCMP + 256 * 1024;
constexpr size_t WS_WIN = 2 * MiB;
constexpr size_t WS_WC1K = WS_WIN + (size_t)NPROJ * D * 2;
constexpr size_t WS_WC1V = WS_WC1K + 1 * MiB;
constexpr size_t WS_WC2K = WS_WC1V + 1 * MiB;
constexpr size_t WS_WC2V = WS_WC2K + 32 * 1024;
constexpr size_t WS_WBN = WS_WC2V + 32 * 1024;
constexpr size_t WS_WBD = WS_WBN + 1 * MiB;
constexpr size_t WS_WOUT = WS_WBD + MiB / 2;
constexpr size_t WS_WGU2 = WS_WOUT + 2 * MiB;
constexpr size_t WS_WD2 = WS_WGU2 + (size_t)2 * FF * D * 2;
constexpr size_t WS_WGU1 = 36 * MiB;
constexpr size_t WS_WD1 = WS_WGU1 + (size_t)2 * FF * D * 2;
static_assert(WS_WD2 + (size_t)D * FF * 2 <= WS_WGU1, "weights A");
static_assert(WS_WD1 + (size_t)D * FF * 2 <= 53 * MiB, "weights B");
constexpr size_t WS_QN = 36 * MiB;
constexpr size_t WS_XN = 53 * MiB;
constexpr size_t WS_MG = 141 * MiB;
constexpr size_t WS_YN = 69 * MiB;
constexpr size_t WS_H = 85 * MiB;
constexpr size_t WS_Y = 173 * MiB;
constexpr size_t WS_PL = 85 * MiB;
constexpr size_t WS_QD = 109 * MiB;
constexpr size_t WS_KD = 133 * MiB, WS_VD = 157 * MiB;
constexpr size_t WS_GA = 181 * MiB, WS_GB = 213 * MiB;
constexpr size_t WS_GN = 245 * MiB;
constexpr size_t WS_YD = 247 * MiB;
constexpr size_t WS_Y2P = 109 * MiB;
constexpr size_t WS_X2 = 205 * MiB;
constexpr size_t WS_END = 256 * MiB;
static_assert(WS_H + (size_t)M * FF * 2 <= WS_Y && WS_Y + (size_t)M * D * 4 <= WS_END, "ffn map");
static_assert(WS_YD + (size_t)M * 256 * 2 <= WS_END && WS_GN + (size_t)M * 32 * 4 <= WS_YD && WS_Y2P + (size_t)M * D * 2 <= WS_MG && WS_MG + (size_t)M * D * 2 <= WS_GA, "mixer map");
constexpr size_t PLSZ = (size_t)4 * 8192 * 64;
constexpr int CW_TMO = 0, CW_BAR = 1024;

constexpr int RING_OFF = 0, RING_BYTES = 131072;
constexpr int LDSCTL_OFF = 143360, MISC_OFF = LDSCTL_OFF + 320;
constexpr int LDS_BYTES = 147456;
constexpr int LUT_PAD = 64, LUTW = 1672;
constexpr int A_KV = 0;
constexpr int A_LUT = 65536;
constexpr int A_IMP = A_LUT + 4 * LUTW * 4;
constexpr int IMP_S = 132;
constexpr int A_SEL = A_IMP + 64 * IMP_S * 4;
constexpr int A_UM = A_SEL + 64 * 16;
constexpr int A_WSF = A_UM + 64;
constexpr int A_BL = A_WSF + 8 * 512;
constexpr int A_END = A_BL + 256;
static_assert(A_END <= LDSCTL_OFF, "attention LDS");
constexpr size_t WS_OD = 53 * MiB;
constexpr size_t WS_LSE = 255 * MiB;

__device__ __forceinline__ int fresh_tid() { int t = threadIdx.x; asm volatile("" : "+v"(t)); return t; }
struct Frame {
    LAS unsigned char* lds;
    volatile LAS unsigned* MISC;
    gu32* ctl;
    int vcu, G, nrep;
};

__device__ __forceinline__ float wave_sum(float v) {
#pragma unroll
    for (int o = 1; o < 64; o <<= 1) v += __shfl_xor(v, o);
    return v;
}
struct TrItem { const float* W; bf16* WT; int K, Nsrc, sc0, nvalid, dr0, kb, frag; };
__device__ __forceinline__ void tr_load(const TrItem& t, f32x4 (&v)[8], int lane) {
    const int c4 = (lane & 7) * 4, rr = lane >> 3;
#pragma unroll
    for (int i = 0; i < 8; ++i) v[i] = (c4 < t.nvalid) ? *(const GAS f32x4*)(t.W + (size_t)(64 * t.kb + rr + 8 * i) * t.Nsrc + t.sc0 + c4) : (f32x4){0.f, 0.f, 0.f, 0.f};
}
__device__ __forceinline__ void tr_finish(const TrItem& t, const f32x4 (&v)[8], LAS float* scr, int lane) {
    const int k0 = 64 * t.kb, c4 = (lane & 7) * 4, rr = lane >> 3;
#pragma unroll
    for (int i = 0; i < 8; ++i) { LAS float* d = scr + (rr + 8 * i) * 33 + c4; d[0] = v[i].x; d[1] = v[i].y; d[2] = v[i].z; d[3] = v[i].w; }
    LDS_WAIT(); asm volatile("" ::: "memory");
    const int c = lane & 7;
#pragma unroll
    for (int j = 0; j < 4; ++j) { const int n = (lane >> 3) + 8 * j; const LAS float* s = scr + (8 * c) * 33 + n;
        v4u o; o.x = pk2(s[0 * 33], s[1 * 33]); o.y = pk2(s[2 * 33], s[3 * 33]); o.z = pk2(s[4 * 33], s[5 * 33]); o.w = pk2(s[6 * 33], s[7 * 33]);
        const int ng = t.dr0 + n, kk = k0 + 8 * c;
        const size_t off = t.frag ? ((size_t)(((ng >> 5) * (t.K >> 4) + (kk >> 4)) * 64 + ((kk >> 3) & 1) * 32 + (ng & 31)) * 8) : ((size_t)ng * t.K + kk);
        *(GAS v4u*)(t.WT + off) = o; }
    LDS_WAIT(); asm volatile("" ::: "memory");
}
__device__ __forceinline__ void win_map(int dblk, int& sc0, int& nvalid) {
    const int hidx = dblk >> 1, half = dblk & 1; nvalid = 32;
    if (hidx < 8) sc0 = hidx * 64 + half * 32;
    else if (hidx < 20) sc0 = 512 + (hidx - 8) * 64 + half * 32;
    else if (hidx < 32) sc0 = 1304 + (hidx - 20) * 64 + half * 32;
    else if (hidx < 44) sc0 = 2072 + (hidx - 32) * 64 + half * 32;
    else if (hidx < 56) sc0 = 2840 + (hidx - 44) * 64 + half * 32;
    else if (hidx < 72) sc0 = 3608 + (hidx - 56) * 64 + half * 32;
    else if (hidx < 88) sc0 = 4632 + (hidx - 72) * 64 + half * 32;
    else if (hidx == 88 && half == 0) { sc0 = 1280; nvalid = 24; }
    else { sc0 = 0; nvalid = 0; }
}
__device__ __forceinline__ void gu_map(int dblk, int& sc0) { const int pn = dblk >> 3, q = dblk & 7; sc0 = (q < 4) ? (128 * pn + 32 * q) : (FF + 128 * pn + 32 * (q - 4)); }
__device__ __forceinline__ int t5_bucket(int d) {
    if (d < 16) return d;
    int b = 16;
    b += (d >= 22); b += (d >= 30); b += (d >= 40); b += (d >= 54); b += (d >= 73); b += (d >= 99); b += (d >= 134); b += (d >= 182);
    b += (d >= 246); b += (d >= 332); b += (d >= 450); b += (d >= 609); b += (d >= 825); b += (d >= 1117); b += (d >= 1513);
    return b;
}
struct In {
    const float *x, *f1_pre, *f1_wgu, *f1_wd, *f1_post, *mix_pre, *w_in, *cpos_k, *cw1_k, *cw2_k, *cpos_v, *cw1_v, *cw2_v, *w_bn, *w_bd, *w_out, *mix_post, *f2_pre, *f2_wgu, *f2_wd, *f2_post, *rel_bias;
};
__device__ __forceinline__ void rms_row_to_bf16(const float* xrow, const float* gain, bf16* orow, int lane) {
    const GAS f32x4* xr = (const GAS f32x4*)xrow + lane; const GAS f32x4* gr = (const GAS f32x4*)gain + lane;
    f32x4 v[4]; float s = 0.f;
#pragma unroll
    for (int j = 0; j < 4; ++j) { v[j] = xr[64 * j]; s += (v[j].x * v[j].x + v[j].y * v[j].y) + (v[j].z * v[j].z + v[j].w * v[j].w); }
    const float r = 1.f / sqrtf(wave_sum(s) * (1.f / D) + RMS_EPS);
    GAS unsigned long long* o8 = (GAS unsigned long long*)orow + lane;
#pragma unroll
    for (int j = 0; j < 4; ++j) { const f32x4 g = gr[64 * j]; o8[64 * j] = (unsigned long long)pk2(v[j].x * r * g.x, v[j].y * r * g.y) | ((unsigned long long)pk2(v[j].z * r * g.z, v[j].w * r * g.w) << 32); }
}
__device__ __forceinline__ void p0_prologue(Frame& F, const In& in, unsigned char* ws) {
    const int tid = fresh_tid(), lane = tid & 63, wave = __builtin_amdgcn_readfirstlane(tid >> 6);
    LAS float* scr = (LAS float*)(F.lds + RING_OFF + wave * 16384);
    const int gw = F.vcu * NWAVES + wave, NGW = F.G * NWAVES;
    constexpr int I_GU = 176 * 16, I_D = 32 * 44, I_IN = 184 * 16, I_C1 = 8 * 32, I_C2 = 2 * 4, I_BN = 32 * 8, I_BD = 32 * 4, I_O = 32 * 16;
    constexpr int NITEMS = 2 * I_GU + 2 * I_D + I_IN + 2 * I_C1 + 2 * I_C2 + I_BN + I_BD + I_O;
    auto decode = [&](int it) -> TrItem {
        TrItem t; int r = it, sc0 = 0, nv = 32; t.frag = 0;
        if (r < I_GU) { const int dblk = r / 16; gu_map(dblk, sc0); t = TrItem{in.f1_wgu, (bf16*)(ws + WS_WGU1), D, 2 * FF, sc0, 32, dblk * 32, r % 16, 0}; return t; } r -= I_GU;
        if (r < I_GU) { const int dblk = r / 16; gu_map(dblk, sc0); t = TrItem{in.f2_wgu, (bf16*)(ws + WS_WGU2), D, 2 * FF, sc0, 32, dblk * 32, r % 16, 0}; return t; } r -= I_GU;
        if (r < I_D) { const int dblk = r / 44; t = TrItem{in.f1_wd, (bf16*)(ws + WS_WD1), FF, D, dblk * 32, 32, dblk * 32, r % 44, 0}; return t; } r -= I_D;
        if (r < I_D) { const int dblk = r / 44; t = TrItem{in.f2_wd, (bf16*)(ws + WS_WD2), FF, D, dblk * 32, 32, dblk * 32, r % 44, 0}; return t; } r -= I_D;
        if (r < I_IN) { const int dblk = r / 16; win_map(dblk, sc0, nv); t = TrItem{in.w_in, (bf16*)(ws + WS_WIN), D, NPROJ_SRC, sc0, nv, dblk * 32, r % 16, 0}; return t; } r -= I_IN;
        if (r < I_C1) { const int dblk = r / 32; t = TrItem{in.cw1_k, (bf16*)(ws + WS_WC1K), 2048, 256, dblk * 32, 32, dblk * 32, r % 32, 1}; return t; } r -= I_C1;
        if (r < I_C1) { const int dblk = r / 32; t = TrItem{in.cw1_v, (bf16*)(ws + WS_WC1V), 2048, 256, dblk * 32, 32, dblk * 32, r % 32, 1}; return t; } r -= I_C1;
        if (r < I_C2) { const int dblk = r / 4; t = TrItem{in.cw2_k, (bf16*)(ws + WS_WC2K), 256, 64, dblk * 32, 32, dblk * 32, r % 4, 0}; return t; } r -= I_C2;
        if (r < I_C2) { const int dblk = r / 4; t = TrItem{in.cw2_v, (bf16*)(ws + WS_WC2V), 256, 64, dblk * 32, 32, dblk * 32, r % 4, 0}; return t; } r -= I_C2;
        if (r < I_BN) { const int dblk = r / 8; t = TrItem{in.w_bn, (bf16*)(ws + WS_WBN), 512, D, dblk * 32, 32, dblk * 32, r % 8, 0}; return t; } r -= I_BN;
        if (r < I_BD) { const int dblk = r / 4; t = TrItem{in.w_bd, (bf16*)(ws + WS_WBD), 256, D, dblk * 32, 32, dblk * 32, r % 4, 0}; return t; } r -= I_BD;
        { const int dblk = r / 16; t = TrItem{in.w_out, (bf16*)(ws + WS_WOUT), D, D, dblk * 32, 32, dblk * 32, r % 16, 0}; return t; }
    };
    {
        f32x4 va[8], vb[8]; TrItem ta, tb;
        int it = gw; if (it < NITEMS) { ta = decode(it); tr_load(ta, va, lane); }
        while (it < NITEMS) {
            const int itn = it + NGW; if (itn < NITEMS) { tb = decode(itn); tr_load(tb, vb, lane); }
            tr_finish(ta, va, scr, lane);
            it = itn; if (it >= NITEMS) break;
            const int itm = it + NGW; if (itm < NITEMS) { ta = decode(itm); tr_load(ta, va, lane); }
            tr_finish(tb, vb, scr, lane);
            it = itm;
        }
    }
    { float* ln = (float*)(ws + WS_LUTN); float* ld = (float*)(ws + WS_LUTD); const int gt = F.vcu * (NWAVES * 64) + tid, NGT = F.G * NWAVES * 64;
      for (int e = gt; e < 8 * LUTW; e += NGT) { const int hd = e / LUTW, d = e % LUTW - LUT_PAD; ln[e] = (d >= 0) ? in.rel_bias[t5_bucket(d) * 20 + hd] * LOG2E : 0.f; }
      for (int e = gt; e < 12 * 320; e += NGT) { const int hd = e / 320, st = e % 320 - LUT_PAD; const int dil = 1 << (2 * (hd >> 2)); ld[e] = (st >= 0 && st <= 128) ? in.rel_bias[t5_bucket(st * dil) * 20 + 8 + hd] * LOG2E : 0.f; } }
    { float* cb = (float*)(ws + WS_CB);
      for (int o = gw; o < 512; o += NGW) { const int ts = o >> 8, n = o & 255; const float* pos = ts ? in.cpos_v : in.cpos_k; const float* w1 = ts ? in.cw1_v : in.cw1_k;
          float s = 0.f; for (int k = lane; k < 2048; k += 64) s += pos[k] * w1[(size_t)k * 256 + n];
          s = wave_sum(s); if (lane == 0) cb[o] = s; } }
    for (int m = gw; m < M; m += 2 * NGW) {
        const int m2 = m + NGW;
        const GAS f32x4* xa = (const GAS f32x4*)(in.x + (size_t)m * D) + lane; const GAS f32x4* xb = (const GAS f32x4*)(in.x + (size_t)(m2 < M ? m2 : m) * D) + lane;
        const GAS f32x4* gr = (const GAS f32x4*)in.f1_pre + lane;
        f32x4 va[4], vb[4]; float sa = 0.f, sb = 0.f;
#pragma unroll
        for (int j = 0; j < 4; ++j) { va[j] = xa[64 * j]; vb[j] = xb[64 * j]; }
#pragma unroll
        for (int j = 0; j < 4; ++j) { sa += (va[j].x * va[j].x + va[j].y * va[j].y) + (va[j].z * va[j].z + va[j].w * va[j].w); sb += (vb[j].x * vb[j].x + vb[j].y * vb[j].y) + (vb[j].z * vb[j].z + vb[j].w * vb[j].w); }
        const float ra = 1.f / sqrtf(wave_sum(sa) * (1.f / D) + RMS_EPS), rb = 1.f / sqrtf(wave_sum(sb) * (1.f / D) + RMS_EPS);
        GAS unsigned long long* oa = (GAS unsigned long long*)((bf16*)(ws + WS_XN) + (size_t)m * D) + lane; GAS unsigned long long* ob = (GAS unsigned long long*)((bf16*)(ws + WS_XN) + (size_t)(m2 < M ? m2 : m) * D) + lane;
#pragma unroll
        for (int j = 0; j < 4; ++j) { const f32x4 g = gr[64 * j];
            oa[64 * j] = (unsigned long long)pk2(va[j].x * ra * g.x, va[j].y * ra * g.y) | ((unsigned long long)pk2(va[j].z * ra * g.z, va[j].w * ra * g.w) << 32);
            if (m2 < M) ob[64 * j] = (unsigned long long)pk2(vb[j].x * rb * g.x, vb[j].y * rb * g.y) | ((unsigned long long)pk2(vb[j].z * rb * g.z, vb[j].w * rb * g.w) << 32); }
    }
}
__device__ __forceinline__ f32x4 ld_bf4(const GAS unsigned long long* p) { const unsigned long long w = *p; const unsigned lo = (unsigned)w, hi = (unsigned)(w >> 32);
    f32x4 v; v.x = __uint_as_float(lo << 16); v.y = __uint_as_float(lo & 0xffff0000u); v.z = __uint_as_float(hi << 16); v.w = __uint_as_float(hi & 0xffff0000u); return v; }
template <bool BB, bool OB, int NR = 4> __device__ __forceinline__ void row_pass(Frame& F, const bf16* Y, const void* base, void* out, float alpha, const float* gpost, const float* gnext, bf16* XN) {
    const int tid = fresh_tid(), lane = tid & 63, wave = __builtin_amdgcn_readfirstlane(tid >> 6);
    const int gw = F.vcu * NWAVES + wave, NGW = F.G * NWAVES;
    const GAS f32x4* gp = (const GAS f32x4*)gpost + lane;
    for (int m0 = gw; m0 < M; m0 += NR * NGW) {
        int mr[NR];
#pragma unroll
        for (int q = 0; q < NR; ++q) mr[q] = (m0 + q * NGW < M) ? m0 + q * NGW : m0;
        f32x4 v[NR][4], bv[NR][4]; float s[NR];
#pragma unroll
        for (int q = 0; q < NR; ++q) s[q] = 0.f;
#pragma unroll
        for (int q = 0; q < NR; ++q) { const int m = mr[q];
            const GAS unsigned long long* yr = (const GAS unsigned long long*)(Y + (size_t)m * D) + lane;
#pragma unroll
            for (int j = 0; j < 4; ++j) { v[q][j] = ld_bf4(yr + 64 * j);
                if (BB) bv[q][j] = ld_bf4((const GAS unsigned long long*)((const bf16*)base + (size_t)m * D) + lane + 64 * j); else bv[q][j] = ((const GAS f32x4*)((const float*)base + (size_t)m * D) + lane)[64 * j]; } }
#pragma unroll
        for (int q = 0; q < NR; ++q)
#pragma unroll
            for (int j = 0; j < 4; ++j) s[q] += (v[q][j].x * v[q][j].x + v[q][j].y * v[q][j].y) + (v[q][j].z * v[q][j].z + v[q][j].w * v[q][j].w);
        float r[NR], s2[NR];
#pragma unroll
        for (int q = 0; q < NR; ++q) s2[q] = 0.f;
#pragma unroll
        for (int q = 0; q < NR; ++q) r[q] = alpha / sqrtf(wave_sum(s[q]) * (1.f / D) + RMS_EPS);
#pragma unroll
        for (int q = 0; q < NR; ++q) { const int m = mr[q]; if (q >= 1 && mr[q] == mr[0]) continue;
#pragma unroll
            for (int j = 0; j < 4; ++j) { const f32x4 g = gp[64 * j]; v[q][j] = bv[q][j] + v[q][j] * r[q] * g;
                if (OB) ((GAS unsigned long long*)((bf16*)out + (size_t)m * D) + lane)[64 * j] = (unsigned long long)pk2(v[q][j].x, v[q][j].y) | ((unsigned long long)pk2(v[q][j].z, v[q][j].w) << 32);
                else ((GAS f32x4*)((float*)out + (size_t)m * D) + lane)[64 * j] = v[q][j];
                s2[q] += (v[q][j].x * v[q][j].x + v[q][j].y * v[q][j].y) + (v[q][j].z * v[q][j].z + v[q][j].w * v[q][j].w); } }
        if (gnext) {
            const GAS f32x4* gn = (const GAS f32x4*)gnext + lane;
#pragma unroll
            for (int q = 0; q < NR; ++q) { const int m = mr[q]; if (q >= 1 && mr[q] == mr[0]) continue;
                const float r2 = 1.f / sqrtf(wave_sum(s2[q]) * (1.f / D) + RMS_EPS);
                GAS unsigned long long* o8 = (GAS unsigned long long*)(XN + (size_t)m * D) + lane;
#pragma unroll
                for (int j = 0; j < 4; ++j) { const f32x4 g = gn[64 * j]; o8[64 * j] = (unsigned long long)pk2(v[q][j].x * r2 * g.x, v[q][j].y * r2 * g.y) | ((unsigned long long)pk2(v[q][j].z * r2 * g.z, v[q][j].w * r2 * g.w) << 32); } }
        }
    }
}

namespace att {
typedef float f32x16 __attribute__((ext_vector_type(16)));
typedef short s16x4 __attribute__((ext_vector_type(4)));
typedef short v4i16_t __attribute__((ext_vector_type(4)));
constexpr float NEGV = -1.0e30f;
constexpr int TILE_B = 16384, SBUF = 2 * TILE_B;
enum { CLS_SKIP = 0, CLS_FULL = 1, CLS_PART = 2, CLS_CONST = 3 };
__device__ __forceinline__ constexpr int crow(int r, int hi) { return (r & 3) + 8 * (r >> 2) + 4 * hi; }
__device__ __forceinline__ unsigned cvtpk(float lo, float hi) { unsigned r; asm volatile("v_cvt_pk_bf16_f32 %0, %1, %2" : "=v"(r) : "v"(lo), "v"(hi)); return r; }
__device__ __forceinline__ float swapmax(float v) { auto rr = __builtin_amdgcn_permlane32_swap(__float_as_uint(v), __float_as_uint(v), false, false); return fmaxf(__uint_as_float(rr[0]), __uint_as_float(rr[1])); }
__device__ __forceinline__ float swapsum(float v) { auto rr = __builtin_amdgcn_permlane32_swap(__float_as_uint(v), __float_as_uint(v), false, false); return __uint_as_float(rr[0]) + __uint_as_float(rr[1]); }
__device__ __forceinline__ float quadsum(float v) {
    v += __int_as_float(__builtin_amdgcn_mov_dpp(__float_as_int(v), 0xB1, 0xF, 0xF, true));
    v += __int_as_float(__builtin_amdgcn_mov_dpp(__float_as_int(v), 0x4E, 0xF, 0xF, true));
    return v;
}
struct Stage { v4u k, v; };
struct Stage2 { Stage t[2]; };
__device__ __forceinline__ void tile_load(Stage& s, const bf16* Kp, const bf16* Vp, long row, int tid) {
    const int ch = tid & 7; s.k = *(const GAS v4u*)(Kp + row * 64 + ch * 8); s.v = *(const GAS v4u*)(Vp + row * 64 + ch * 8);
}
__device__ __forceinline__ void tile_store(LAS unsigned char* buf, const Stage& s, int tid) {
    const int key = tid >> 3, ch = tid & 7;
    *(LAS v4u*)(buf + ch * 1024 + key * 16) = s.k;
    *(LAS v4u*)(buf + 8192 + (ch >> 2) * 4096 + key * 64 + (ch & 3) * 16) = s.v;
}
#define SBAR() __builtin_amdgcn_sched_barrier(0)
#ifndef ATT_SHIFT
#define ATT_SHIFT 8
#endif
#define ATT_BAR() asm volatile("s_waitcnt lgkmcnt(0)\n\ts_barrier" ::: "memory")
__device__ __forceinline__ void qk(f32x16& p0, f32x16& p1, const LAS unsigned char* kb, const bf16x8 (&qr)[4]) {
#pragma unroll
    for (int d0 = 0; d0 < 4; ++d0) {
        const bf16x8 b0 = *(const LAS bf16x8*)(kb + d0 * 2048), b1 = *(const LAS bf16x8*)(kb + d0 * 2048 + 512);
        p0 = __builtin_amdgcn_mfma_f32_32x32x16_bf16(b0, qr[d0], p0, 0, 0, 0);
        p1 = __builtin_amdgcn_mfma_f32_32x32x16_bf16(b1, qr[d0], p1, 0, 0, 0);
    }
}
__device__ __forceinline__ float max3f(float a, float b, float c) { float r; asm("v_max3_f32 %0, %1, %2, %3" : "=v"(r) : "v"(a), "v"(b), "v"(c)); return r; }
__device__ __forceinline__ float rowmax32(const f32x16& p0, const f32x16& p1) {
    float a = __builtin_fmaxf(p0[0], p1[0]), b = __builtin_fmaxf(p0[1], p1[1]);
    asm volatile("" : "+v"(a), "+v"(b));
#pragma unroll
    for (int r = 2; r < 16; r += 2) { a = max3f(a, p0[r], p1[r]); b = max3f(b, p0[r + 1], p1[r + 1]); }
    return swapmax(fmaxf(a, b));
}
__device__ __forceinline__ s16x4 vtr(const LAS unsigned char* p) { return __builtin_bit_cast(s16x4, __builtin_amdgcn_ds_read_tr16_b64_v4i16((LAS v4i16_t*)p)); }
__device__ __forceinline__ void pv(f32x16 (&o)[2], const LAS unsigned char* vb, const f32x16& p0, const f32x16& p1) {
    v4u pw[4];
#pragma unroll
    for (int s = 0; s < 2; ++s) {
        pw[s]     = (v4u){cvtpk(p0[8 * s], p0[8 * s + 1]), cvtpk(p0[8 * s + 2], p0[8 * s + 3]), cvtpk(p0[8 * s + 4], p0[8 * s + 5]), cvtpk(p0[8 * s + 6], p0[8 * s + 7])};
        pw[2 + s] = (v4u){cvtpk(p1[8 * s], p1[8 * s + 1]), cvtpk(p1[8 * s + 2], p1[8 * s + 3]), cvtpk(p1[8 * s + 4], p1[8 * s + 5]), cvtpk(p1[8 * s + 6], p1[8 * s + 7])};
    }
#pragma unroll
    for (int dh = 0; dh < 2; ++dh)
#pragma unroll
        for (int kg = 0; kg < 4; ++kg) {
            const s16x4 lo = vtr(vb + dh * 4096 + kg * 1024), hi = vtr(vb + dh * 4096 + kg * 1024 + 512);
            const bf16x8 vf = (bf16x8){lo[0], lo[1], lo[2], lo[3], hi[0], hi[1], hi[2], hi[3]};
            o[dh] = __builtin_amdgcn_mfma_f32_32x32x16_bf16(__builtin_bit_cast(bf16x8, pw[kg]), vf, o[dh], 0, 0, 0);
        }
}
struct Soft { float mref, lsum; };
__device__ __forceinline__ void proc_tile(int cls, const LAS unsigned char* tile, const bf16x8 (&qr)[4], Soft& st, f32x16 (&o)[2], const LAS float* lut, int d0, int dlo, int dhi, float cbias, bool rowsel,
                                          LAS float* wsf, int r32, int hi, int trb) {
    const bool unset = st.mref < -1.0e29f;
    const float base = unset ? 0.f : st.mref;
    const float negb = rowsel ? -base : NEGV;
    f32x16 p0, p1; bf16x8 kf0[4], kf1[4];
    { const LAS unsigned char* kb = tile + hi * 1024 + r32 * 16;
#pragma unroll
      for (int q = 0; q < 4; ++q) { kf0[q] = *(const LAS bf16x8*)(kb + q * 2048); kf1[q] = *(const LAS bf16x8*)(kb + q * 2048 + 512); } }
    if (cls == CLS_CONST) { const float iv = negb + cbias;
#pragma unroll
        for (int r = 0; r < 16; ++r) { p0[r] = iv; p1[r] = iv; }
    } else { const LAS float* pb = lut + (d0 - 4 * hi - 59);
#pragma unroll
        for (int r = 0; r < 16; ++r) { p0[r] = pb[59 - crow(r, 0)]; p1[r] = pb[27 - crow(r, 0)]; }
        SBAR();
#pragma unroll
        for (int r = 0; r < 16; ++r) { p0[r] += negb; p1[r] += negb; }
    }
    SBAR();
#pragma unroll
    for (int q = 0; q < 4; ++q) { p0 = __builtin_amdgcn_mfma_f32_32x32x16_bf16(kf0[q], qr[q], p0, 0, 0, 0); p1 = __builtin_amdgcn_mfma_f32_32x32x16_bf16(kf1[q], qr[q], p1, 0, 0, 0); }
    SBAR();
    s16x4 vlo[8], vhi[8];
    { const LAS unsigned char* vb = tile + 8192 + trb;
#pragma unroll
      for (int i = 0; i < 8; ++i) { vlo[i] = vtr(vb + (i >> 2) * 4096 + (i & 3) * 1024); vhi[i] = vtr(vb + (i >> 2) * 4096 + (i & 3) * 1024 + 512); } }
    SBAR();
    if (cls == CLS_PART) { const int dq = d0 - 4 * hi; const unsigned span = (unsigned)(dhi - dlo);
#pragma unroll
        for (int r = 0; r < 16; ++r) { const int da = dq - crow(r, 0), db = da - 32;
            p0[r] = ((unsigned)(da - dlo) <= span) ? p0[r] : NEGV; p1[r] = ((unsigned)(db - dlo) <= span) ? p1[r] : NEGV; }
    }
    const float rm = rowmax32(p0, p1);
    const bool upd = rowsel && (rm > -1.0e29f) && (unset || rm > 8.0f);
    if (__any(upd)) {
        const float delta = upd ? rm : 0.f;
#pragma unroll
        for (int r = 0; r < 16; ++r) { p0[r] -= delta; p1[r] -= delta; }
        const float f = (upd && !unset) ? __builtin_amdgcn_exp2f(-delta) : 1.0f;
        st.lsum *= f;
        if (upd) st.mref = base + delta;
        if (hi == 0) wsf[r32] = f;
        asm volatile("s_waitcnt lgkmcnt(0)" ::: "memory");
#pragma unroll
        for (int r = 0; r < 16; ++r) { const float fr = wsf[crow(r, hi)]; o[0][r] *= fr; o[1][r] *= fr; }
        asm volatile("s_waitcnt lgkmcnt(0)" ::: "memory");
    }
    float s = 0.f;
#pragma unroll
    for (int r = 0; r < 16; ++r) { p0[r] = __builtin_amdgcn_exp2f(p0[r]); p1[r] = __builtin_amdgcn_exp2f(p1[r]); s += p0[r] + p1[r]; }
    st.lsum += s;
    v4u pw[4];
#pragma unroll
    for (int q = 0; q < 2; ++q) {
        pw[q]     = (v4u){cvtpk(p0[8 * q], p0[8 * q + 1]), cvtpk(p0[8 * q + 2], p0[8 * q + 3]), cvtpk(p0[8 * q + 4], p0[8 * q + 5]), cvtpk(p0[8 * q + 6], p0[8 * q + 7])};
        pw[2 + q] = (v4u){cvtpk(p1[8 * q], p1[8 * q + 1]), cvtpk(p1[8 * q + 2], p1[8 * q + 3]), cvtpk(p1[8 * q + 4], p1[8 * q + 5]), cvtpk(p1[8 * q + 6], p1[8 * q + 7])};
    }
    SBAR();
#pragma unroll
    for (int kg = 0; kg < 4; ++kg)
#pragma unroll
        for (int dh = 0; dh < 2; ++dh) { const int i = dh * 4 + kg;
            const bf16x8 vf = (bf16x8){vlo[i][0], vlo[i][1], vlo[i][2], vlo[i][3], vhi[i][0], vhi[i][1], vhi[i][2], vhi[i][3]};
            o[dh] = __builtin_amdgcn_mfma_f32_32x32x16_bf16(__builtin_bit_cast(bf16x8, pw[kg]), vf, o[dh], 0, 0, 0); }
}
__device__ __forceinline__ void proc_pair(int clsA, int clsB, const LAS unsigned char* tA, const LAS unsigned char* tB, const bf16x8 (&qr)[4], Soft& st, f32x16 (&o)[2], const LAS float* lut,
                                          int d0A, int d0B, int dlo, int dhi, float cbias, bool selA, bool selB, LAS float* wsf, int r32, int hi, int trb) {
    const bool unset = st.mref < -1.0e29f;
    const float base = unset ? 0.f : st.mref;
    const float negA = selA ? -base : NEGV, negB = selB ? -base : NEGV;
    f32x16 a0, a1, b0, b1; bf16x8 kA0[4], kA1[4], kB0[4], kB1[4];
    { const LAS unsigned char* kb = tA + hi * 1024 + r32 * 16;
#pragma unroll
      for (int q = 0; q < 4; ++q) { kA0[q] = *(const LAS bf16x8*)(kb + q * 2048); kA1[q] = *(const LAS bf16x8*)(kb + q * 2048 + 512); } }
    if (clsA == CLS_CONST) { const float iv = negA + cbias;
#pragma unroll
        for (int r = 0; r < 16; ++r) { a0[r] = iv; a1[r] = iv; }
    } else { const LAS float* pb = lut + (d0A - 4 * hi - 59);
#pragma unroll
        for (int r = 0; r < 16; ++r) { a0[r] = pb[59 - crow(r, 0)]; a1[r] = pb[27 - crow(r, 0)]; } }
    if (clsB == CLS_CONST) { const float iv = negB + cbias;
#pragma unroll
        for (int r = 0; r < 16; ++r) { b0[r] = iv; b1[r] = iv; }
    } else { const LAS float* pb = lut + (d0B - 4 * hi - 59);
#pragma unroll
        for (int r = 0; r < 16; ++r) { b0[r] = pb[59 - crow(r, 0)]; b1[r] = pb[27 - crow(r, 0)]; } }
    SBAR();
    if (clsA != CLS_CONST) {
#pragma unroll
        for (int r = 0; r < 16; ++r) { a0[r] += negA; a1[r] += negA; } }
    if (clsB != CLS_CONST) {
#pragma unroll
        for (int r = 0; r < 16; ++r) { b0[r] += negB; b1[r] += negB; } }
    SBAR();
#pragma unroll
    for (int q = 0; q < 4; ++q) { a0 = __builtin_amdgcn_mfma_f32_32x32x16_bf16(kA0[q], qr[q], a0, 0, 0, 0); a1 = __builtin_amdgcn_mfma_f32_32x32x16_bf16(kA1[q], qr[q], a1, 0, 0, 0); }
    { const LAS unsigned char* kb = tB + hi * 1024 + r32 * 16;
#pragma unroll
      for (int q = 0; q < 4; ++q) { kB0[q] = *(const LAS bf16x8*)(kb + q * 2048); kB1[q] = *(const LAS bf16x8*)(kb + q * 2048 + 512); } }
    SBAR();
#pragma unroll
    for (int q = 0; q < 4; ++q) { b0 = __builtin_amdgcn_mfma_f32_32x32x16_bf16(kB0[q], qr[q], b0, 0, 0, 0); b1 = __builtin_amdgcn_mfma_f32_32x32x16_bf16(kB1[q], qr[q], b1, 0, 0, 0); }
    SBAR();
    s16x4 vlo[8], vhi[8];
    { const LAS unsigned char* vb = tA + 8192 + trb;
#pragma unroll
      for (int i = 0; i < 8; ++i) { vlo[i] = vtr(vb + (i >> 2) * 4096 + (i & 3) * 1024); vhi[i] = vtr(vb + (i >> 2) * 4096 + (i & 3) * 1024 + 512); } }
    SBAR();
    if (clsA == CLS_PART) { const int dq = d0A - 4 * hi; const unsigned span = (unsigned)(dhi - dlo);
#pragma unroll
        for (int r = 0; r < 16; ++r) { const int da = dq - crow(r, 0), db = da - 32;
            a0[r] = ((unsigned)(da - dlo) <= span) ? a0[r] : NEGV; a1[r] = ((unsigned)(db - dlo) <= span) ? a1[r] : NEGV; } }
    if (clsB == CLS_PART) { const int dq = d0B - 4 * hi; const unsigned span = (unsigned)(dhi - dlo);
#pragma unroll
        for (int r = 0; r < 16; ++r) { const int da = dq - crow(r, 0), db = da - 32;
            b0[r] = ((unsigned)(da - dlo) <= span) ? b0[r] : NEGV; b1[r] = ((unsigned)(db - dlo) <= span) ? b1[r] : NEGV; } }
    const float rm = fmaxf(rowmax32(a0, a1), rowmax32(b0, b1));
    const bool upd = (selA || selB) && (rm > -1.0e29f) && (unset || rm > 8.0f);
    if (__any(upd)) {
        const float delta = upd ? rm : 0.f;
#pragma unroll
        for (int r = 0; r < 16; ++r) { a0[r] -= delta; a1[r] -= delta; b0[r] -= delta; b1[r] -= delta; }
        const float f = (upd && !unset) ? __builtin_amdgcn_exp2f(-delta) : 1.0f;
        st.lsum *= f;
        if (upd) st.mref = base + delta;
        if (hi == 0) wsf[r32] = f;
        asm volatile("s_waitcnt lgkmcnt(0)" ::: "memory");
#pragma unroll
        for (int r = 0; r < 16; ++r) { const float fr = wsf[crow(r, hi)]; o[0][r] *= fr; o[1][r] *= fr; }
        asm volatile("s_waitcnt lgkmcnt(0)" ::: "memory");
    }
    float s = 0.f;
#pragma unroll
    for (int r = 0; r < 16; ++r) { a0[r] = __builtin_amdgcn_exp2f(a0[r]); a1[r] = __builtin_amdgcn_exp2f(a1[r]); b0[r] = __builtin_amdgcn_exp2f(b0[r]); b1[r] = __builtin_amdgcn_exp2f(b1[r]); s += (a0[r] + a1[r]) + (b0[r] + b1[r]); }
    st.lsum += s;
    v4u pa[4], pq[4];
#pragma unroll
    for (int q = 0; q < 2; ++q) {
        pa[q]     = (v4u){cvtpk(a0[8 * q], a0[8 * q + 1]), cvtpk(a0[8 * q + 2], a0[8 * q + 3]), cvtpk(a0[8 * q + 4], a0[8 * q + 5]), cvtpk(a0[8 * q + 6], a0[8 * q + 7])};
        pa[2 + q] = (v4u){cvtpk(a1[8 * q], a1[8 * q + 1]), cvtpk(a1[8 * q + 2], a1[8 * q + 3]), cvtpk(a1[8 * q + 4], a1[8 * q + 5]), cvtpk(a1[8 * q + 6], a1[8 * q + 7])};
        pq[q]     = (v4u){cvtpk(b0[8 * q], b0[8 * q + 1]), cvtpk(b0[8 * q + 2], b0[8 * q + 3]), cvtpk(b0[8 * q + 4], b0[8 * q + 5]), cvtpk(b0[8 * q + 6], b0[8 * q + 7])};
        pq[2 + q] = (v4u){cvtpk(b1[8 * q], b1[8 * q + 1]), cvtpk(b1[8 * q + 2], b1[8 * q + 3]), cvtpk(b1[8 * q + 4], b1[8 * q + 5]), cvtpk(b1[8 * q + 6], b1[8 * q + 7])};
    }
    SBAR();
#pragma unroll
    for (int kg = 0; kg < 4; ++kg)
#pragma unroll
        for (int dh = 0; dh < 2; ++dh) { const int i = dh * 4 + kg;
            const bf16x8 vf = (bf16x8){vlo[i][0], vlo[i][1], vlo[i][2], vlo[i][3], vhi[i][0], vhi[i][1], vhi[i][2], vhi[i][3]};
            o[dh] = __builtin_amdgcn_mfma_f32_32x32x16_bf16(__builtin_bit_cast(bf16x8, pa[kg]), vf, o[dh], 0, 0, 0); }
    s16x4 wlo[8], whi[8];
    { const LAS unsigned char* vb = tB + 8192 + trb;
#pragma unroll
      for (int i = 0; i < 8; ++i) { wlo[i] = vtr(vb + (i >> 2) * 4096 + (i & 3) * 1024); whi[i] = vtr(vb + (i >> 2) * 4096 + (i & 3) * 1024 + 512); } }
    SBAR();
#pragma unroll
    for (int kg = 0; kg < 4; ++kg)
#pragma unroll
        for (int dh = 0; dh < 2; ++dh) { const int i = dh * 4 + kg;
            const bf16x8 vf = (bf16x8){wlo[i][0], wlo[i][1], wlo[i][2], wlo[i][3], whi[i][0], whi[i][1], whi[i][2], whi[i][3]};
            o[dh] = __builtin_amdgcn_mfma_f32_32x32x16_bf16(__builtin_bit_cast(bf16x8, pq[kg]), vf, o[dh], 0, 0, 0); }
}
__device__ __forceinline__ float soft_final_inv(const Soft& st, float& ltot) { ltot = swapsum(st.lsum); return (st.mref > -1.0e29f) ? 1.0f / ltot : 0.f; }
}

struct Mix {
    bf16 *QN, *YN, *SCR, *PL, *QD, *KD, *VD, *YD, *KCMP, *VCMP, *OD; float* LSE; const float* GN; const float* LUTN; const float* LUTD; const float* CB;
    const bf16 *WC1K, *WC1V, *WC2K, *WC2V;
};
__device__ __forceinline__ void lut_to_lds(Frame& F, int tid, const float* img, int nf) {
    LAS f32x4* L = (LAS f32x4*)(F.lds + A_LUT); const GAS f32x4* G = (const GAS f32x4*)img;
    for (int e = tid; e < nf / 4; e += NWAVES * 64) L[e] = G[e];
}
__device__ __forceinline__ bf16x8 ldq(const bf16* p) { return *(const GAS bf16x8*)p; }

__device__ __forceinline__ int next_sel(int j, int c, unsigned u0, unsigned u1, unsigned u2, unsigned u3) {
    while (j <= c) { const unsigned w = (j < 32) ? u0 : (j < 64) ? u1 : (j < 96) ? u2 : u3; if ((w >> (j & 31)) & 1u) break; ++j; }
    return j;
}
template <bool ADD> __device__ __forceinline__ void yn_rows(bf16* YN, const att::f32x16 (&o)[2], float fac, LAS float* wsf, int r32, int hi, size_t R0, int g, int lane) {
    if (hi == 0) wsf[r32] = fac;
    asm volatile("s_waitcnt lgkmcnt(0)" ::: "memory");
#pragma unroll
    for (int r = 0; r < 16; ++r) { const int q = att::crow(r, hi); const float fr = wsf[q];
        bf16* op = YN + (R0 + (q >> 2)) * 512 + (4 * g + (q & 3)) * 64 + (lane & 31);
        float a0 = o[0][r] * fr, a1 = o[1][r] * fr;
        if (ADD) { a0 += __uint_as_float((unsigned)op[0] << 16); a1 += __uint_as_float((unsigned)op[32] << 16); }
        op[0] = (bf16)f2bf(a0); op[32] = (bf16)f2bf(a1); }
    asm volatile("s_waitcnt lgkmcnt(0)" ::: "memory");
}
__device__ __forceinline__ void nsa_unit(Frame& F, const Mix& X, int b, int g, int c, int& buf, bool load_lut) {
    using namespace att;
    const int tid = fresh_tid(), lane = tid & 63, wave = __builtin_amdgcn_readfirstlane(tid >> 6), r32 = lane & 31, hi = lane >> 5;
    LAS unsigned char* kv = F.lds + A_KV; LAS float* lutl = (LAS float*)(F.lds + A_LUT); LAS float* imp = (LAS float*)(F.lds + A_IMP);
    LAS unsigned* selm = (LAS unsigned*)(F.lds + A_SEL); LAS unsigned* um = (LAS unsigned*)(F.lds + A_UM); LAS float* wsf = (LAS float*)(F.lds + A_WSF) + wave * 128;
    const int trb = ((lane >> 4) & 1) * 32 + (lane & 3) * 8 + (4 * hi + ((lane & 15) >> 2)) * 64;
    const int t0 = 64 * c, tok = 8 * wave + (r32 >> 2), h = r32 & 3, t = t0 + tok;
    const size_t R = (size_t)b * SEQ + t, R0 = (size_t)b * SEQ + t0 + 8 * wave;
    const int plane = b * 2 + g;
    const bf16* KS = X.PL + 2 * PLSZ + (size_t)plane * SEQ * 64; const bf16* VS = X.PL + 3 * PLSZ + (size_t)plane * SEQ * 64;
    const bf16* KW = X.PL + 4 * PLSZ + (size_t)plane * SEQ * 64; const bf16* VW = X.PL + 5 * PLSZ + (size_t)plane * SEQ * 64;
    const bf16* KC = X.KCMP + (size_t)plane * 512 * 64; const bf16* VC = X.VCMP + (size_t)plane * 512 * 64;
    __syncthreads();
    if (load_lut) lut_to_lds(F, tid, X.LUTN + (size_t)g * 4 * LUTW, 4 * LUTW);
    bf16x8 qr[4];
#pragma unroll
    for (int d0 = 0; d0 < 4; ++d0) qr[d0] = ldq(X.QN + R * 512 + (4 * g + h) * 64 + 16 * d0 + 8 * hi);
    const float g0 = X.GN[R * 32 + (4 * g + h) * 3 + 0], g1 = X.GN[R * 32 + (4 * g + h) * 3 + 1], g2 = X.GN[R * 32 + (4 * g + h) * 3 + 2];
    const LAS float* lrow = lutl + h * LUTW + LUT_PAD;
    __syncthreads();
    const int key = tid >> 3;
    Stage2 sg;
    const int imax = (4 * c + 2 > 510) ? 510 : (4 * c + 2), ntc = imax / 64 + 1;
#define CMP_LOAD0() do { _Pragma("unroll") for (int tt = 0; tt < 2; ++tt) { int it = tt; it = it > ntc - 1 ? ntc - 1 : it; tile_load(sg.t[tt], KC, VC, 64 * it + key, tid); } } while (0)
    {
        Soft st{NEGV, 0.f}; f32x16 o[2]; o[0] = f32x16{}; o[1] = f32x16{};
        const int it0 = (c >= 8) ? 0 : (8 - c), nt = 9 - it0, nss = (nt + 1) >> 1;
#pragma unroll
        for (int tt = 0; tt < 2; ++tt) { int it = it0 + tt; it = it > 8 ? 8 : it; tile_load(sg.t[tt], KW, VW, t0 - 512 + 64 * it + key, tid); }
        for (int ss = 0; ss < nss; ++ss) {
            LAS unsigned char* bp = kv + buf * SBUF;
            tile_store(bp, sg.t[0], tid); tile_store(bp + TILE_B, sg.t[1], tid); ATT_BAR();
            if (ss + 1 < nss) {
#pragma unroll
                for (int tt = 0; tt < 2; ++tt) { int it = it0 + 2 * (ss + 1) + tt; it = it > 8 ? 8 : it; tile_load(sg.t[tt], KW, VW, t0 - 512 + 64 * it + key, tid); } }
            else CMP_LOAD0();
            { const int itA = it0 + 2 * ss, itB = itA + 1; const int kbA = t0 - 512 + 64 * itA, kbB = kbA + 64;
              const int clsA = (itA == 0 || itA == 8) ? CLS_PART : CLS_FULL, clsB = (itB == 8) ? CLS_PART : CLS_FULL;
              if (itB <= 8) proc_pair(clsA, clsB, bp, bp + TILE_B, qr, st, o, lrow, t - kbA, t - kbB, 0, 511, 0.f, true, true, wsf, r32, hi, trb);
              else proc_tile(clsA, bp, qr, st, o, lrow, t - kbA, 0, 511, 0.f, true, wsf, r32, hi, trb); }
            buf ^= 1;
        }
        float lt; const float inv = soft_final_inv(st, lt);
        yn_rows<false>(X.YN, o, g2 * inv, wsf, r32, hi, R0, g, lane);
    }
    {
        const int nss = (ntc + 1) >> 1;
        const int dq = t - 31 - 16 * 4 * hi;
        const float cfar = lrow[1599];
        float m = NEGV, l = 0.f;
        for (int ss = 0; ss < nss; ++ss) {
            LAS unsigned char* bp = kv + buf * SBUF;
            tile_store(bp, sg.t[0], tid); tile_store(bp + TILE_B, sg.t[1], tid); ATT_BAR();
            if (ss + 1 < nss) {
#pragma unroll
                for (int tt = 0; tt < 2; ++tt) { int it = 2 * (ss + 1) + tt; it = it > ntc - 1 ? ntc - 1 : it; tile_load(sg.t[tt], KC, VC, 64 * it + key, tid); } }
            else CMP_LOAD0();
#pragma unroll
            for (int tt = 0; tt < 2; ++tt) { const int it = 2 * ss + tt;
                if (it < ntc) {
                    f32x16 p0, p1; const int dt = dq - 1024 * it;
                    const bool far = (t0 - 31 - 1024 * it - 1008) >= 1513;
                    if (far) {
#pragma unroll
                        for (int r = 0; r < 16; ++r) { p0[r] = cfar; p1[r] = cfar; }
                    } else {
#pragma unroll
                        for (int r = 0; r < 16; ++r) { const int da = dt - 16 * crow(r, 0), db = da - 512;
                            const int ia = da < -64 ? -64 : (da > 1599 ? 1599 : da), ib = db < -64 ? -64 : (db > 1599 ? 1599 : db);
                            p0[r] = lrow[ia]; p1[r] = lrow[ib]; }
                    }
                    qk(p0, p1, bp + tt * TILE_B + hi * 1024 + r32 * 16, qr);
                    if (!far) {
#pragma unroll
                        for (int r = 0; r < 16; ++r) { const int da = dt - 16 * crow(r, 0), db = da - 512; p0[r] = (da >= 0) ? p0[r] : NEGV; p1[r] = (db >= 0) ? p1[r] : NEGV; }
                    }
                    const float rm = rowmax32(p0, p1);
                    const float mn = fmaxf(m, rm); float s = 0.f;
#pragma unroll
                    for (int r = 0; r < 16; ++r) s += __builtin_amdgcn_exp2f(p0[r] - mn) + __builtin_amdgcn_exp2f(p1[r] - mn);
                    l = l * __builtin_amdgcn_exp2f(m - mn) + s; m = mn;
                } }
            buf ^= 1;
        }
        const float ltot = swapsum(l);
        const float invl = (m > -1.0e29f) ? 1.0f / ltot : 0.f;
        const float mz = (m > -1.0e29f) ? m : 0.f;
        f32x16 o[2]; o[0] = f32x16{}; o[1] = f32x16{};
        LAS float* improw = imp + tok * IMP_S; float icarry = 0.f;
        for (int ss = 0; ss < nss; ++ss) {
            LAS unsigned char* bp = kv + buf * SBUF;
            tile_store(bp, sg.t[0], tid); tile_store(bp + TILE_B, sg.t[1], tid); ATT_BAR();
            if (ss + 1 < nss) {
#pragma unroll
                for (int tt = 0; tt < 2; ++tt) { int it = 2 * (ss + 1) + tt; it = it > ntc - 1 ? ntc - 1 : it; tile_load(sg.t[tt], KC, VC, 64 * it + key, tid); } }
            else { tile_load(sg.t[0], KS, VS, key, tid); tile_load(sg.t[1], KS, VS, 64 * (c >= 1 ? 1 : 0) + key, tid); }
#pragma unroll
            for (int tt = 0; tt < 2; ++tt) { const int it = 2 * ss + tt;
                if (it < ntc) {
                    f32x16 p0, p1; const int dt = dq - 1024 * it;
                    const bool far = (t0 - 31 - 1024 * it - 1008) >= 1513;
                    if (far) { const float iv = cfar - mz;
#pragma unroll
                        for (int r = 0; r < 16; ++r) { p0[r] = iv; p1[r] = iv; }
                    } else {
#pragma unroll
                        for (int r = 0; r < 16; ++r) { const int da = dt - 16 * crow(r, 0), db = da - 512;
                            const int ia = da < -64 ? -64 : (da > 1599 ? 1599 : da), ib = db < -64 ? -64 : (db > 1599 ? 1599 : db);
                            p0[r] = lrow[ia] - mz; p1[r] = lrow[ib] - mz; }
                    }
                    qk(p0, p1, bp + tt * TILE_B + hi * 1024 + r32 * 16, qr);
#pragma unroll
                    for (int r = 0; r < 16; ++r) { p0[r] = __builtin_amdgcn_exp2f(p0[r]) * invl; p1[r] = __builtin_amdgcn_exp2f(p1[r]) * invl; }
                    if (!far) {
#pragma unroll
                        for (int r = 0; r < 16; ++r) { const int da = dt - 16 * crow(r, 0), db = da - 512; p0[r] = (da >= 0) ? p0[r] : 0.f; p1[r] = (db >= 0) ? p1[r] : 0.f; }
                    }
                    { float a0[4], l0[4], a1[4], l1[4], x0[4], x1[4];
#pragma unroll
                      for (int q = 0; q < 4; ++q) { a0[q] = quadsum((p0[4 * q] + p0[4 * q + 1]) + (p0[4 * q + 2] + p0[4 * q + 3])); l0[q] = quadsum(p0[4 * q + 3]);
                                                    a1[q] = quadsum((p1[4 * q] + p1[4 * q + 1]) + (p1[4 * q + 2] + p1[4 * q + 3])); l1[q] = quadsum(p1[4 * q + 3]); }
#pragma unroll
                      for (int q = 0; q < 4; ++q) { auto ra = __builtin_amdgcn_permlane32_swap(__float_as_uint(l0[q]), __float_as_uint(l0[q]), false, false); x0[q] = __uint_as_float(hi ? ra[0] : ra[1]);
                                                    auto rb = __builtin_amdgcn_permlane32_swap(__float_as_uint(l1[q]), __float_as_uint(l1[q]), false, false); x1[q] = __uint_as_float(hi ? rb[0] : rb[1]); }
                      if (h == 0) {
#pragma unroll
                          for (int q = 0; q < 4; ++q) { const float pv0 = hi ? x0[q] : (q ? x0[q ? q - 1 : 0] : icarry), pv1 = hi ? x1[q] : (q ? x1[q ? q - 1 : 0] : x0[3]);
                              improw[16 * it + 2 * q + hi] = a0[q] + pv0; improw[16 * it + 2 * q + hi + 8] = a1[q] + pv1; } }
                      icarry = x1[3]; }
                    pv(o, bp + tt * TILE_B + 8192 + trb, p0, p1);
                } }
            buf ^= 1;
        }
        yn_rows<true>(X.YN, o, g0, wsf, r32, hi, R0, g, lane);
    }
    asm volatile("s_waitcnt lgkmcnt(0)" ::: "memory");
    unsigned msk[4] = {0u, 0u, 0u, 0u};
    if (c >= 16) {
        const int tl = lane >> 3, part = lane & 7;
        const LAS float* ir = imp + (8 * wave + tl) * IMP_S + part * 16;
        unsigned v[16];
#pragma unroll
        for (int r = 0; r < 16; ++r) { const int j = part * 16 + r; const unsigned bits = __float_as_uint(ir[r]); v[r] = (j >= 1 && j <= c - 2) ? ((bits & ~127u) | (unsigned)(127 - j)) : 0u; }
        unsigned sm[4] = {0u, 0u, 0u, 0u};
        for (int itn = 0; itn < 13; ++itn) {
            unsigned mx = v[0];
#pragma unroll
            for (int r = 1; r < 16; ++r) mx = mx > v[r] ? mx : v[r];
            { unsigned o1 = (unsigned)__builtin_amdgcn_mov_dpp((int)mx, 0xB1, 0xF, 0xF, true); mx = mx > o1 ? mx : o1;
              o1 = (unsigned)__builtin_amdgcn_mov_dpp((int)mx, 0x4E, 0xF, 0xF, true); mx = mx > o1 ? mx : o1; o1 = (unsigned)__builtin_amdgcn_mov_dpp((int)mx, 0x141, 0xF, 0xF, true); mx = mx > o1 ? mx : o1; }
            const int j = 127 - (int)(mx & 127u); const unsigned bit = 1u << (j & 31); const int w = j >> 5;
            if (mx != 0u) { sm[0] |= (w == 0) ? bit : 0u; sm[1] |= (w == 1) ? bit : 0u; sm[2] |= (w == 2) ? bit : 0u; sm[3] |= (w == 3) ? bit : 0u; }
#pragma unroll
            for (int r = 0; r < 16; ++r) v[r] = (v[r] == mx) ? 0u : v[r];
        }
        sm[0] |= 1u;
        { const int j = c - 1; const unsigned bit = 1u << (j & 31); const int w = j >> 5; sm[0] |= (w == 0) ? bit : 0u; sm[1] |= (w == 1) ? bit : 0u; sm[2] |= (w == 2) ? bit : 0u; sm[3] |= (w == 3) ? bit : 0u; }
        { const int j = c; const unsigned bit = 1u << (j & 31); const int w = j >> 5; sm[0] |= (w == 0) ? bit : 0u; sm[1] |= (w == 1) ? bit : 0u; sm[2] |= (w == 2) ? bit : 0u; sm[3] |= (w == 3) ? bit : 0u; }
        if (part == 0) {
#pragma unroll
            for (int w = 0; w < 4; ++w) selm[(8 * wave + tl) * 4 + w] = sm[w];
        }
        __syncthreads();
#pragma unroll
        for (int w = 0; w < 4; ++w) msk[w] = selm[tok * 4 + w];
    } else {
        msk[0] = (2u << c) - 1u;
        __syncthreads();
    }
    {
        Soft st{NEGV, 0.f}; f32x16 o[2]; o[0] = f32x16{}; o[1] = f32x16{};
        const float cfar = lrow[1599];
        const int nb = c + 1, nss = (nb + 1) >> 1;
#define SEL_LOAD(ss_) do { const int ja_ = 2 * (ss_), jb_ = (2 * (ss_) + 1 <= c) ? 2 * (ss_) + 1 : c; tile_load(sg.t[0], KS, VS, 64 * ja_ + key, tid); tile_load(sg.t[1], KS, VS, 64 * jb_ + key, tid); } while (0)
        for (int ss = 0; ss < nss; ++ss) {
            LAS unsigned char* bp = kv + buf * SBUF;
            tile_store(bp, sg.t[0], tid); tile_store(bp + TILE_B, sg.t[1], tid); ATT_BAR();
            if (ss + 1 < nss) SEL_LOAD(ss + 1);
            { const int jA = 2 * ss, jB = 2 * ss + 1; const bool vB_ = jB <= c;
              const unsigned mA = (jA < 32) ? msk[0] : (jA < 64) ? msk[1] : (jA < 96) ? msk[2] : msk[3], mB = (jB < 32) ? msk[0] : (jB < 64) ? msk[1] : (jB < 96) ? msk[2] : msk[3];
              const bool sA = (mA >> (jA & 31)) & 1u, sB = vB_ && ((mB >> (jB & 31)) & 1u);
              const int cA = (jA == c) ? CLS_PART : ((c - jA >= 25) ? CLS_CONST : CLS_FULL), cB = (jB == c) ? CLS_PART : ((c - jB >= 25) ? CLS_CONST : CLS_FULL);
              const bool nA = __any(sA), nB = __any(sB);
              if (nA && nB) proc_pair(cA, cB, bp, bp + TILE_B, qr, st, o, lrow, t - 64 * jA, t - 64 * jB, 0, 0x3fffffff, cfar, sA, sB, wsf, r32, hi, trb);
              else if (nA) proc_tile(cA, bp, qr, st, o, lrow, t - 64 * jA, 0, 0x3fffffff, cfar, sA, wsf, r32, hi, trb);
              else if (nB) proc_tile(cB, bp + TILE_B, qr, st, o, lrow, t - 64 * jB, 0, 0x3fffffff, cfar, sB, wsf, r32, hi, trb); }
            buf ^= 1;
        }
#undef SEL_LOAD
        float lt; const float inv = soft_final_inv(st, lt);
#ifdef PROBE_SEL_TWICE
        if (rep_) yn_rows<false>(X.SCR, o, g1 * inv, wsf, r32, hi, R0 & 8191, g, lane); else
#endif
        yn_rows<true>(X.YN, o, g1 * inv, wsf, r32, hi, R0, g, lane);
    }
}

__device__ __forceinline__ void dil_unit(Frame& F, const Mix& X, int gi, int b, int s, int rest, int& buf) {
    using namespace att;
    const int tid = fresh_tid(), lane = tid & 63, wave = __builtin_amdgcn_readfirstlane(tid >> 6), r32 = lane & 31, hi = lane >> 5;
    LAS unsigned char* kv = F.lds + A_KV; LAS float* lutl = (LAS float*)(F.lds + A_LUT); LAS float* wsf = (LAS float*)(F.lds + A_WSF) + wave * 128;
    const int trb = ((lane >> 4) & 1) * 32 + (lane & 3) * 8 + (4 * hi + ((lane & 15) >> 2)) * 64;
    const int dil = 1 << (2 * gi), lg = 2 * gi, nch = (SEQ >> lg) >> 8, res = rest / nch, ch = rest % nch;
    const int hd = 4 * gi + s, N0 = 256 * ch, Nw = N0 + 32 * wave, nq = Nw + r32, key = tid >> 3;
    const int t = (nq << lg) + res;
    const size_t R = (size_t)b * SEQ + t;
    __syncthreads();
    lut_to_lds(F, tid, X.LUTD + hd * 320, 320);
    bf16x8 qr[4];
#pragma unroll
    for (int d0 = 0; d0 < 4; ++d0) qr[d0] = ldq(X.QD + R * 768 + hd * 64 + 16 * d0 + 8 * hi);
    const bf16* Kp = X.KD + (size_t)(b * 12 + hd) * SEQ * 64; const bf16* Vp = X.VD + (size_t)(b * 12 + hd) * SEQ * 64;
    const LAS float* lrow = lutl + LUT_PAD;
    __syncthreads();
    Soft st{NEGV, 0.f}; f32x16 o[2]; o[0] = f32x16{}; o[1] = f32x16{};
    Stage2 sg[3];
    const int it0 = (ch == 0) ? 2 : 0, nss = (6 - it0) >> 1;
#pragma unroll
    for (int ss = 0; ss < 3; ++ss) if (ss < nss) {
#pragma unroll
        for (int tt = 0; tt < 2; ++tt) { const int kb = N0 - 128 + 64 * (it0 + 2 * ss + tt); tile_load(sg[ss].t[tt], Kp, Vp, (long)((kb + key) << lg) + res, tid); } }
#pragma unroll
    for (int ss = 0; ss < 3; ++ss) if (ss < nss) {
        LAS unsigned char* bp = kv + buf * SBUF;
        tile_store(bp, sg[ss].t[0], tid); tile_store(bp + TILE_B, sg[ss].t[1], tid); ATT_BAR();
        { const int kbA = N0 - 128 + 64 * (it0 + 2 * ss), kbB = kbA + 64;
          const bool nA = (Nw + 31 - kbA >= 0) && (Nw - kbA - 63 <= 128), nB = (Nw + 31 - kbB >= 0) && (Nw - kbB - 63 <= 128);
          const int cA = (Nw - kbA - 63 >= 0 && Nw + 31 - kbA <= 128) ? CLS_FULL : CLS_PART, cB = (Nw - kbB - 63 >= 0 && Nw + 31 - kbB <= 128) ? CLS_FULL : CLS_PART;
          if (nA && nB) proc_pair(cA, cB, bp, bp + TILE_B, qr, st, o, lrow, nq - kbA, nq - kbB, 0, 128, 0.f, true, true, wsf, r32, hi, trb);
          else if (nA) proc_tile(cA, bp, qr, st, o, lrow, nq - kbA, 0, 128, 0.f, true, wsf, r32, hi, trb);
          else if (nB) proc_tile(cB, bp + TILE_B, qr, st, o, lrow, nq - kbB, 0, 128, 0.f, true, wsf, r32, hi, trb); }
        buf ^= 1;
    }
    float ltot; const float inv = soft_final_inv(st, ltot);
    const float lse = st.mref + __builtin_amdgcn_logf(ltot);
    if (gi != 0) {
        bf16* OD = X.OD + (size_t)(gi - 1) * M * 256; float* LS = X.LSE + (size_t)(gi - 1) * M * 4;
        if (hi == 0) { wsf[r32] = inv; LS[R * 4 + s] = lse; }
        asm volatile("s_waitcnt lgkmcnt(0)" ::: "memory");
#pragma unroll
        for (int r = 0; r < 16; ++r) { const int q = crow(r, hi); const float fr = wsf[q]; const size_t Rq = (size_t)b * SEQ + ((size_t)(Nw + q) << lg) + res;
            bf16* op = OD + Rq * 256 + s * 64 + (lane & 31);
            op[0] = (bf16)f2bf(o[0][r] * fr); op[32] = (bf16)f2bf(o[1][r] * fr); }
        asm volatile("s_waitcnt lgkmcnt(0)" ::: "memory");
    } else {
        const float l4 = X.LSE[R * 4 + s], l16 = X.LSE[(size_t)M * 4 + R * 4 + s];
        const float mx = fmaxf(lse, fmaxf(l4, l16));
        const float w1 = __builtin_amdgcn_exp2f(lse - mx), w4 = __builtin_amdgcn_exp2f(l4 - mx), w16 = __builtin_amdgcn_exp2f(l16 - mx), iw = 1.0f / (w1 + w4 + w16);
        if (hi == 0) { wsf[r32] = w1 * iw * inv; wsf[32 + r32] = w4 * iw; wsf[64 + r32] = w16 * iw; }
        asm volatile("s_waitcnt lgkmcnt(0)" ::: "memory");
#pragma unroll
        for (int r = 0; r < 16; ++r) { const int q = crow(r, hi); const float a1 = wsf[q], a4 = wsf[32 + q], a16 = wsf[64 + q]; const size_t Rq = (size_t)b * SEQ + Nw + q;
            const bf16* p4 = X.OD + Rq * 256 + s * 64 + (lane & 31); const bf16* p16 = p4 + (size_t)M * 256;
            bf16* op = X.YD + Rq * 256 + s * 64 + (lane & 31);
            const float v0 = o[0][r] * a1 + __uint_as_float((unsigned)p4[0] << 16) * a4 + __uint_as_float((unsigned)p16[0] << 16) * a16;
            const float v1 = o[1][r] * a1 + __uint_as_float((unsigned)p4[32] << 16) * a4 + __uint_as_float((unsigned)p16[32] << 16) * a16;
            op[0] = (bf16)f2bf(v0); op[32] = (bf16)f2bf(v1); }
        asm volatile("s_waitcnt lgkmcnt(0)" ::: "memory");
    }
}

__device__ __forceinline__ void cmp_unit(Frame& F, const Mix& X, int cu) {
    using namespace att;
    const int tid = fresh_tid(), lane = tid & 63, wave = __builtin_amdgcn_readfirstlane(tid >> 6), r32 = lane & 31, hi = lane >> 5;
    const int ts = cu >> 6, rb = cu & 63, plane = rb >> 4, i0 = (rb & 15) * 32;
    const bf16* src = X.PL + (size_t)ts * PLSZ + (size_t)plane * SEQ * 64;
    const bf16* W1 = ts ? X.WC1V : X.WC1K; const bf16* W2 = ts ? X.WC2V : X.WC2K; const float* cb = X.CB + ts * 256;
    bf16* dst = (ts ? X.VCMP : X.KCMP) + (size_t)plane * 512 * 64;
    LAS unsigned char* aimg = F.lds;
    LAS unsigned char* hid = F.lds + 69632;
    __syncthreads();
    for (int chn = tid; chn < 528 * 8; chn += NWAVES * 64) { const int tau = chn >> 3, c8 = chn & 7; int tk = 16 * i0 + tau; tk = tk > SEQ - 1 ? SEQ - 1 : tk;
        *(LAS v4u*)(aimg + tau * 128 + 16 * (tau >> 4) + c8 * 16) = *(const GAS v4u*)(src + (size_t)tk * 64 + c8 * 8); }
    __syncthreads();
    f32x16 acc = f32x16{};
    const LAS unsigned char* ap = aimg + r32 * 2064 + 16 * hi;
    const bf16* bp = W1 + ((size_t)wave * 128 * 64 + lane) * 8;
#pragma unroll 16
    for (int ks = 0; ks < 128; ++ks) {
        const int l = ks >> 2;
        const bf16x8 a = *(const LAS bf16x8*)(ap + 128 * l + 16 * (l >> 4) + 32 * (ks & 3));
        const bf16x8 bb = ldq(bp + (size_t)ks * 512);
        acc = __builtin_amdgcn_mfma_f32_32x32x16_bf16(a, bb, acc, 0, 0, 0);
    }
    { const int col = 32 * wave + r32; const float bias = cb[col];
#pragma unroll
      for (int r = 0; r < 16; ++r) { const float v = acc[r] + bias; const float hv = v * __builtin_amdgcn_rcpf(1.0f + __builtin_amdgcn_exp2f(-LOG2E * v));
          *(LAS unsigned short*)(hid + crow(r, hi) * 528 + col * 2) = (unsigned short)f2bf(hv); } }
    __syncthreads();
    if (wave < 2) {
        const int nt = wave;
        f32x16 o2 = f32x16{};
        const LAS unsigned char* hp = hid + r32 * 528 + 16 * hi; const bf16* b2 = W2 + (size_t)(32 * nt + r32) * 256 + 8 * hi;
#pragma unroll
        for (int k0 = 0; k0 < 256; k0 += 16) { const bf16x8 a = *(const LAS bf16x8*)(hp + k0 * 2); const bf16x8 bb = ldq(b2 + k0); o2 = __builtin_amdgcn_mfma_f32_32x32x16_bf16(a, bb, o2, 0, 0, 0); }
#pragma unroll
        for (int r = 0; r < 16; ++r) { const int i = i0 + crow(r, hi); dst[(size_t)i * 64 + 32 * nt + r32] = (bf16)f2bf(o2[r]); }
    }
}

#ifndef MK_N_LAUNCHES
#define MK_N_LAUNCHES 1
#endif
constexpr int N_PHASES = 13;
constexpr int N_LAUNCHES = MK_N_LAUNCHES;
struct Args { const float* in[22]; float* out; unsigned char* ws; int ph_lo, ph_hi, li, pad; };
__global__ void __launch_bounds__(NWAVES * 64, 2) mk_fwd(Args args) {
    extern __shared__ __attribute__((aligned(16))) unsigned char lds[];
    Frame F;
    F.lds = (LAS unsigned char*)lds;
    F.MISC = (volatile LAS unsigned*)(F.lds + MISC_OFF);
    F.G = gridDim.x; { const int bx = blockIdx.x; F.vcu = (F.G % 8 == 0) ? (bx % 8) * (F.G / 8) + bx / 8 : bx; }
    unsigned char* ws = args.ws;
    F.ctl = (gu32*)(ws + WS_CTL);
    In in;
    in.x = args.in[0]; in.f1_pre = args.in[1]; in.f1_wgu = args.in[2]; in.f1_wd = args.in[3]; in.f1_post = args.in[4]; in.mix_pre = args.in[5]; in.w_in = args.in[6];
    in.cpos_k = args.in[7]; in.cw1_k = args.in[8]; in.cw2_k = args.in[9]; in.cpos_v = args.in[10]; in.cw1_v = args.in[11]; in.cw2_v = args.in[12];
    in.w_bn = args.in[13]; in.w_bd = args.in[14]; in.w_out = args.in[15]; in.mix_post = args.in[16]; in.f2_pre = args.in[17]; in.f2_wgu = args.in[18]; in.f2_wd = args.in[19]; in.f2_post = args.in[20]; in.rel_bias = args.in[21];
    float* out = args.out;
    for (int u = threadIdx.x; u < (LDS_BYTES - LDSCTL_OFF) / 4; u += NWAVES * 64) ((LAS unsigned*)(F.lds + LDSCTL_OFF))[u] = 0u;
    __syncthreads();
    const bool use_bar = (args.ph_hi - args.ph_lo) > 1;
    XcdBarrier bar; bar.bar = (unsigned*)(F.ctl + CW_BAR) + args.li * XCD_BAR_WORDS; bar.x = 0; bar.st = nullptr;
    if (use_bar) bar = xcd_barrier_post((unsigned*)(F.ctl + CW_BAR) + args.li * XCD_BAR_WORDS, F.MISC + 8);
    const int lo = args.ph_lo, hi = args.ph_hi;
#define IN(k) (lo <= (k) && (k) < hi)
#define SEAM(k) do { if (IN(k) && IN((k) + 1)) xcd_barrier(bar); } while (0)
    bf16* XN = (bf16*)(ws + WS_XN); bf16* H = (bf16*)(ws + WS_H); bf16* Y = (bf16*)(ws + WS_Y); bf16* Y2P = (bf16*)(ws + WS_Y2P); bf16* MG = (bf16*)(ws + WS_MG);
    Mix X; X.QN = (bf16*)(ws + WS_QN); X.YN = (bf16*)(ws + WS_YN); X.SCR = (bf16*)(ws + WS_Y); F.nrep = args.pad; X.PL = (bf16*)(ws + WS_PL); X.QD = (bf16*)(ws + WS_QD); X.KD = (bf16*)(ws + WS_KD); X.VD = (bf16*)(ws + WS_VD); X.YD = (bf16*)(ws + WS_YD); X.OD = (bf16*)(ws + WS_OD); X.LSE = (float*)(ws + WS_LSE);
    X.KCMP = (bf16*)(ws + WS_KCMP); X.VCMP = (bf16*)(ws + WS_VCMP); X.GN = (const float*)(ws + WS_GN); X.LUTN = (const float*)(ws + WS_LUTN); X.LUTD = (const float*)(ws + WS_LUTD); X.CB = (const float*)(ws + WS_CB);
    X.WC1K = (const bf16*)(ws + WS_WC1K); X.WC1V = (const bf16*)(ws + WS_WC1V); X.WC2K = (const bf16*)(ws + WS_WC2K); X.WC2V = (const bf16*)(ws + WS_WC2V);
    bf16* GA = (bf16*)(ws + WS_GA); bf16* GB = (bf16*)(ws + WS_GB);

    if (IN(0)) { p0_prologue(F, in, ws); }
    SEAM(0);
    if (IN(1)) { pg8::Gemm g{XN, (const bf16*)(ws + WS_WGU1), M, 2 * FF, D}; pg8::StaticOrder S; S.init(M, 2 * FF, F.G, (int)blockIdx.x);
        pg8::EpiSwiGLU E{H, FF}; pg8::gemm_phase<pg8::EpiSwiGLU, pg8::StaticOrder, true, true>(F.lds + RING_OFF, g, S, E); }
    SEAM(1);
    if (IN(2)) { pg8::Gemm g{H, (const bf16*)(ws + WS_WD1), M, D, FF}; pg8::StaticOrder S; S.init(M, D, F.G, (int)blockIdx.x);
        pg8::EpiBf16 E{Y, D}; pg8::gemm_phase<pg8::EpiBf16, pg8::StaticOrder, true, true>(F.lds + RING_OFF, g, S, E); }
    SEAM(2);
    if (IN(3)) { row_pass<false, true>(F, Y, in.x, out, 0.5f, in.f1_post, in.mix_pre, XN); }
    SEAM(3);
    if (IN(4)) { pg8::Gemm g{XN, (const bf16*)(ws + WS_WIN), M, NPROJ, D}; pg8::StaticOrder S; S.init(M, NPROJ, F.G, (int)blockIdx.x);
        pg8::EpiProj E{X.QN, X.PL, X.QD, X.KD, X.VD, GA, GB, (float*)(ws + WS_GN), QSCALE};
        pg8::gemm_phase<pg8::EpiProj, pg8::StaticOrder, true, true>(F.lds + RING_OFF, g, S, E); }
    SEAM(4);
    if (IN(5)) { int buf = 0;
        for (int cu = F.vcu; cu < 128; cu += F.G) cmp_unit(F, X, cu);
#pragma unroll 1
        for (int w = F.vcu; w < 512; w += F.G) { const int gi = 2 - (w >> 8), du = w & 255; dil_unit(F, X, gi, du >> 7, (du >> 5) & 3, du & 31, buf); }
        __syncthreads(); }
    SEAM(5);
    if (IN(6)) { int buf = 0;
        for (int p = F.vcu; p < 256; p += F.G) { const int b = p >> 7, g = (p >> 6) & 1, cc = p & 63;
#pragma unroll 1
            for (int k = 0; k < 2; ++k) nsa_unit(F, X, b, g, k ? cc : 127 - cc, buf, k == 0); }
#pragma unroll 1
        for (int du = F.vcu; du < 256; du += F.G) dil_unit(F, X, 0, du >> 7, (du >> 5) & 3, du & 31, buf);
        __syncthreads(); }
    SEAM(6);
    if (IN(7)) {
        { pg8::Gemm g{X.YN, (const bf16*)(ws + WS_WBN), M, D, 512}; pg8::StaticOrder S; S.init(M, D, F.G, (int)blockIdx.x);
          pg8::EpiBranchA E{GA, Y2P}; pg8::gemm_phase<pg8::EpiBranchA, pg8::StaticOrder, true, true>(F.lds + RING_OFF, g, S, E); }
        { pg8::Gemm g{X.YD, (const bf16*)(ws + WS_WBD), M, D, 256}; pg8::StaticOrder S; S.init(M, D, F.G, (int)blockIdx.x);
          pg8::EpiBranchB E{GB, Y2P, MG}; pg8::gemm_phase<pg8::EpiBranchB, pg8::StaticOrder, true, true>(F.lds + RING_OFF, g, S, E); }
    }
    SEAM(7);
    if (IN(8)) { pg8::Gemm g{MG, (const bf16*)(ws + WS_WOUT), M, D, D}; pg8::StaticOrder S; S.init(M, D, F.G, (int)blockIdx.x);
        pg8::EpiBf16 E{Y, D}; pg8::gemm_phase<pg8::EpiBf16, pg8::StaticOrder, true, true>(F.lds + RING_OFF, g, S, E); }
    SEAM(8);
    if (IN(9)) { row_pass<true, true>(F, Y, out, ws + WS_X2, 1.0f, in.mix_post, in.f2_pre, XN); }
    SEAM(9);
    if (IN(10)) { pg8::Gemm g{XN, (const bf16*)(ws + WS_WGU2), M, 2 * FF, D}; pg8::StaticOrder S; S.init(M, 2 * FF, F.G, (int)blockIdx.x);
        pg8::EpiSwiGLU E{H, FF}; pg8::gemm_phase<pg8::EpiSwiGLU, pg8::StaticOrder, true, true>(F.lds + RING_OFF, g, S, E); }
    SEAM(10);
    if (IN(11)) { pg8::Gemm g{H, (const bf16*)(ws + WS_WD2), M, D, FF}; pg8::StaticOrder S; S.init(M, D, F.G, (int)blockIdx.x);
        pg8::EpiBf16 E{Y, D}; pg8::gemm_phase<pg8::EpiBf16, pg8::StaticOrder, true, true>(F.lds + RING_OFF, g, S, E); }
    SEAM(11);
    if (IN(12)) { row_pass<true, false>(F, Y, ws + WS_X2, out, 0.5f, in.f2_post, nullptr, nullptr); }
#undef IN
#undef SEAM
}

extern "C" void kernel_launch(void* const* d_in, const int* in_sizes, int n_in, void* d_out, int out_size, void* d_ws, size_t ws_size, hipStream_t stream) {
    static int grid = 0;
    if (grid == 0) {
        if (n_in != 22 || in_sizes[0] != M * D || out_size != M * D || ws_size < WS_END) { fprintf(stderr, "kernel_launch: unexpected shapes (n_in %d, in0 %d, out %d, ws %zu); nothing launched\n", n_in, n_in > 0 ? in_sizes[0] : -1, out_size, ws_size); grid = -1; return; }
        int dev = 0, cus = 0, per_cu = 0;
        if (hipGetDevice(&dev) != hipSuccess || hipDeviceGetAttribute(&cus, hipDeviceAttributeMultiprocessorCount, dev) != hipSuccess) { grid = -1; return; }
        if (hipFuncSetAttribute((const void*)mk_fwd, hipFuncAttributeMaxDynamicSharedMemorySize, LDS_BYTES) != hipSuccess) { fprintf(stderr, "kernel_launch: hipFuncSetAttribute failed\n"); grid = -1; return; }
        if (hipOccupancyMaxActiveBlocksPerMultiprocessor(&per_cu, (const void*)mk_fwd, NWAVES * 64, LDS_BYTES) != hipSuccess || per_cu < 1)
            fprintf(stderr, "kernel_launch: note: occupancy query reports %d workgroups per CU\n", per_cu);
        (void)hipGetLastError();
        grid = cus;
    }
    if (grid < 0) return;
    if (hipMemsetAsync((char*)d_ws + WS_CTL, 0, CTL_ZERO_BYTES, stream) != hipSuccess) return;
    Args a{};
    for (int i = 0; i < 22; ++i) a.in[i] = (const float*)d_in[i];
    a.out = (float*)d_out; a.ws = (unsigned char*)d_ws; a.pad = 2;
#ifdef PROBE_RANGES
    { static const int rg[][2] = PROBE_RANGES;
      for (int li = 0; li < (int)(sizeof(rg) / sizeof(rg[0])); ++li) { a.ph_lo = rg[li][0]; a.ph_hi = rg[li][1]; a.li = li; hipLaunchKernelGGL(mk_fwd, dim3(grid), dim3(NWAVES * 64), LDS_BYTES, stream, a); } }
#else
    if (N_LAUNCHES == 1) { a.ph_lo = 0; a.ph_hi = N_PHASES; a.li = 0; hipLaunchKernelGGL(mk_fwd, dim3(grid), dim3(NWAVES * 64), LDS_BYTES, stream, a); }
    else { for (int li = 0; li < N_PHASES; ++li) { a.ph_lo = li; a.ph_hi = li + 1; a.li = 0; hipLaunchKernelGGL(mk_fwd, dim3(grid), dim3(NWAVES * 64), LDS_BYTES, stream, a); } }
#endif
}
```
